# Optimizing an MI355X kernel written in HIP

```python
import jax, jax.numpy as jnp
from jax import lax
import numpy as np

D_MODEL = 2048
BATCH = 8
SEQ = 4096
DEPTH = 4

HG_WIDTH = D_MODEL // 4
MLA_WIDTH = D_MODEL // 2
RW_WIDTH = D_MODEL // 4
MIX_WIDTH = HG_WIDTH + MLA_WIDTH + RW_WIDTH

HG_HEAD_DIM = 128
HG_HEADS = HG_WIDTH // HG_HEAD_DIM
HG_CHUNK = 64

MLA_NOPE = 128
MLA_ROPE = 64
MLA_V = 128
MLA_HEADS = MLA_WIDTH // MLA_V
MLA_Q_RANK = 512
MLA_KV_RANK = 256
MLA_QK_DIM = MLA_NOPE + MLA_ROPE
ROPE_THETA = 10000.0
Q_BLOCK = 128
MASK_VALUE = -1e30

RW_HEAD = 64
RW_HEADS = RW_WIDTH // RW_HEAD
RW_W_RANK = 64
RW_A_RANK = 64
RW_V_RANK = 32
RW_G_RANK = 128
RW_GN_EPS = 64e-5
RW_SIZES = (RW_WIDTH, RW_WIDTH, RW_WIDTH, RW_W_RANK, RW_A_RANK, RW_G_RANK)
RW_IN = sum(RW_SIZES)

IN_SIZES = (HG_WIDTH, HG_WIDTH, HG_WIDTH, HG_WIDTH, MLA_Q_RANK, MLA_KV_RANK, MLA_ROPE, RW_IN)
IN_WIDTH = sum(IN_SIZES)

D_FF = ((8 * D_MODEL + 3 * 256 - 1) // (3 * 256)) * 256
RMS_EPS = 1e-6

kernel_name = "hymba_style_hgrn2_mla_rwkv7_hybrid"


def split_cols(t, sizes):
    out, start = [], 0
    for s in sizes:
        out.append(t[..., start:start + s])
        start += s
    return out


def rms_norm(x, gain):
    xf = x.astype(jnp.float32)
    y = xf * lax.rsqrt(jnp.mean(xf * xf, axis=-1, keepdims=True) + RMS_EPS)
    return (y * gain.astype(jnp.float32)).astype(x.dtype)


def rope_tables(positions):
    half = MLA_ROPE // 2
    inv_freq = ROPE_THETA ** (-jnp.arange(half, dtype=jnp.float32) / half)
    ang = positions.astype(jnp.float32)[..., None] * inv_freq
    return jnp.cos(ang), jnp.sin(ang)


def apply_rope(x, cos, sin):
    x1, x2 = jnp.split(x.astype(jnp.float32), 2, axis=-1)
    return jnp.concatenate([x1 * cos - x2 * sin, x2 * cos + x1 * sin], axis=-1).astype(x.dtype)


def hgrn2_chunkwise(q, log_f, k, v):
    B, S, H, DK = q.shape
    DV = v.shape[-1]
    nc = S // HG_CHUNK
    to_chunks = lambda t: t.reshape(B, nc, HG_CHUNK, H, t.shape[-1]).transpose(1, 0, 3, 2, 4)
    causal = jnp.tril(jnp.ones((HG_CHUNK, HG_CHUNK), dtype=bool))[:, :, None]

    def step(state, inp):
        q_c, lf_c, k_c, v_c = inp
        b = jnp.cumsum(lf_c, axis=2)
        o_inter = jnp.einsum('bhtk,bhkv->bhtv', q_c * jnp.exp(b), state)
        diff = b[:, :, :, None, :] - b[:, :, None, :, :]
        decay = jnp.where(causal, jnp.exp(jnp.where(causal, diff, 0.0)), 0.0)
        scores = jnp.einsum('bhtk,bhsk,bhtsk->bhts', q_c, k_c, decay)
        o = o_inter + jnp.einsum('bhts,bhsv->bhtv', scores, v_c)
        b_last = b[:, :, -1:, :]
        state = state * jnp.exp(b_last[:, :, 0, :, None]) + jnp.einsum(
            'bhsk,bhsv->bhkv', k_c * jnp.exp(b_last - b), v_c)
        return state, o

    s0 = jnp.zeros((B, H, DK, DV), jnp.float32)
    _, o = lax.scan(step, s0, (to_chunks(q), to_chunks(log_f), to_chunks(k), to_chunks(v)))
    return o.transpose(1, 0, 3, 2, 4).reshape(B, S, H, DV)


def hgrn2_mixer(q_raw, f_raw, i_raw, g_raw, lower_bound, out_gain):
    B, S, _ = q_raw.shape
    shp = (B, S, HG_HEADS, HG_HEAD_DIM)
    q = jax.nn.silu(q_raw.astype(jnp.float32)).reshape(shp)
    z = f_raw.astype(jnp.float32).reshape(shp)
    lb = lower_bound.astype(jnp.float32).reshape(HG_HEADS, HG_HEAD_DIM)
    log_f = jnp.log(lb + (1.0 - lb) * jax.nn.sigmoid(z))
    k = (1.0 - lb) * jax.nn.sigmoid(-z)
    v = i_raw.astype(jnp.float32).reshape(shp)
    o = hgrn2_chunkwise(q, log_f, k, v)
    o = rms_norm(o, out_gain) * jax.nn.silu(g_raw.astype(jnp.float32)).reshape(shp)
    return o.reshape(B, S, HG_WIDTH).astype(q_raw.dtype)


def causal_block_attention(q_nope, q_rope, k_nope, k_rope, v):
    B, S, H, _ = q_nope.shape
    nb = S // Q_BLOCK
    blocks = lambda t: jnp.moveaxis(t.reshape(B, nb, Q_BLOCK, *t.shape[2:]), 1, 0)
    k_idx = jnp.arange(S)
    scale = MLA_QK_DIM ** -0.5

    def one_block(args):
        qn, qr, blk = args
        s = (jnp.einsum('bqhd,bkhd->bhqk', qn, k_nope)
             + jnp.einsum('bqhd,bkd->bhqk', qr, k_rope))
        q_idx = blk * Q_BLOCK + jnp.arange(Q_BLOCK)
        s = jnp.where(k_idx[None, :] <= q_idx[:, None], s.astype(jnp.float32) * scale, MASK_VALUE)
        p = jax.nn.softmax(s, axis=-1)
        return jnp.einsum('bhqk,bkhd->bqhd', p.astype(v.dtype), v)

    out = lax.map(one_block, (blocks(q_nope), blocks(q_rope), jnp.arange(nb)))
    return jnp.moveaxis(out, 0, 1).reshape(B, S, H * v.shape[-1])


def mla_mixer(q_a, kv_a, k_rope_raw, cos, sin, q_a_gain, w_qb, kv_a_gain, w_kvb, q_gain, k_gain):
    B, S, _ = q_a.shape
    q = (rms_norm(q_a, q_a_gain) @ w_qb).reshape(B, S, MLA_HEADS, MLA_QK_DIM)
    kv = (rms_norm(kv_a, kv_a_gain) @ w_kvb).reshape(B, S, MLA_HEADS, MLA_NOPE + MLA_V)
    q_nope, q_rope = q[..., :MLA_NOPE], q[..., MLA_NOPE:]
    k_nope, v = kv[..., :MLA_NOPE], kv[..., MLA_NOPE:]
    q_nope = rms_norm(q_nope, q_gain[:MLA_NOPE])
    q_rope = rms_norm(q_rope, q_gain[MLA_NOPE:])
    k_nope = rms_norm(k_nope, k_gain[:MLA_NOPE])
    k_rope = rms_norm(k_rope_raw, k_gain[MLA_NOPE:])
    q_rope = apply_rope(q_rope, cos[:, :, None, :], sin[:, :, None, :])
    k_rope = apply_rope(k_rope, cos, sin)
    o = causal_block_attention(q_nope, q_rope, k_nope, k_rope, v)
    return o.astype(q_a.dtype)


def rwkv7_mixer(proj, mu, w0, w2, a0, a2, g2, k_k, k_a, r_k, ln_w, ln_b, v_first, v_res):
    B, S, _ = proj.shape
    p = proj.astype(jnp.float32)
    prev = jnp.pad(p, ((0, 0), (1, 0), (0, 0)))[:, :S]
    p = p + (prev - p) * mu
    r, k, v, wd, ad, gd = split_cols(p, RW_SIZES)
    w_log = -jax.nn.softplus(-(w0 + jnp.tanh(wd) @ w2)) - 0.5
    a = jax.nn.sigmoid(a0 + ad @ a2)
    g = jax.nn.sigmoid(gd) @ g2
    if v_res is None:
        v_first = v
    else:
        v0, v1, v2 = v_res
        v = v + (v_first - v) * jax.nn.sigmoid(v0 + (v @ v1) @ v2)
    heads = lambda t: t.reshape(B, S, RW_HEADS, RW_HEAD)
    kk = heads(k * k_k)
    kk = kk / jnp.maximum(jnp.sqrt(jnp.sum(kk * kk, axis=-1, keepdims=True)), 1e-12)
    k = heads(k * (1.0 + (a - 1.0) * k_a))
    r, v, a = heads(r), heads(v), heads(a)
    decay = jnp.exp(-jnp.exp(heads(w_log)))
    time_major = lambda t: jnp.moveaxis(t, 1, 0)

    def step(state, inp):
        r_t, w_t, k_t, v_t, kk_t, a_t = inp
        sa = jnp.einsum('bhvk,bhk->bhv', state, -kk_t)
        state = (state * w_t[:, :, None, :]
                 + sa[..., :, None] * (kk_t * a_t)[..., None, :]
                 + v_t[..., :, None] * k_t[..., None, :])
        return state, jnp.einsum('bhvk,bhk->bhv', state, r_t)

    s0 = jnp.zeros((B, RW_HEADS, RW_HEAD, RW_HEAD), jnp.float32)
    _, y = lax.scan(step, s0, (time_major(r), time_major(decay), time_major(k),
                               time_major(v), time_major(kk), time_major(a)))
    y = jnp.moveaxis(y, 0, 1)
    mean = jnp.mean(y, axis=-1, keepdims=True)
    var = jnp.mean(jnp.square(y - mean), axis=-1, keepdims=True)
    y = ((y - mean) * lax.rsqrt(var + RW_GN_EPS)).reshape(B, S, RW_WIDTH) * ln_w + ln_b
    bonus = (jnp.sum(r * k * r_k, axis=-1, keepdims=True) * v).reshape(B, S, RW_WIDTH)
    out = (y + bonus) * g
    return out.astype(proj.dtype), v_first


def setup_inputs(seed: int = 0) -> dict:
    key = jax.random.key(seed)
    ks = iter(jax.random.split(key, 40))
    nrm = lambda shape, scale: jax.random.normal(next(ks), shape, jnp.float32) * scale
    gain = lambda shape: 1.0 + nrm(shape, 0.02)
    L = DEPTH
    return {
        "x": nrm((BATCH, SEQ, D_MODEL), 1.0),
        "positions": jnp.arange(SEQ, dtype=jnp.int32)[None, :]
                     + jax.random.randint(next(ks), (BATCH, 1), 0, 64, dtype=jnp.int32),
        "attn_norm": gain((L, D_MODEL)),
        "w_in": nrm((L, D_MODEL, IN_WIDTH), D_MODEL ** -0.5),
        "hg_lower_bounds": nrm((L, HG_WIDTH), 0.1),
        "hg_out_norm": gain((L, HG_HEAD_DIM)),
        "mla_q_a_norm": gain((L, MLA_Q_RANK)),
        "mla_w_qb": nrm((L, MLA_Q_RANK, MLA_HEADS * MLA_QK_DIM), MLA_Q_RANK ** -0.5),
        "mla_kv_a_norm": gain((L, MLA_KV_RANK)),
        "mla_w_kvb": nrm((L, MLA_KV_RANK, MLA_HEADS * (MLA_NOPE + MLA_V)), MLA_KV_RANK ** -0.5),
        "mla_q_norm": gain((L, MLA_QK_DIM)),
        "mla_k_norm": gain((L, MLA_QK_DIM)),
        "rw_mu": jax.random.uniform(next(ks), (L, RW_IN), jnp.float32),
        "rw_w0": jax.random.uniform(next(ks), (L, RW_WIDTH), jnp.float32, -5.0, 1.0),
        "rw_w2": nrm((L, RW_W_RANK, RW_WIDTH), RW_W_RANK ** -0.5),
        "rw_a0": nrm((L, RW_WIDTH), 0.1),
        "rw_a2": nrm((L, RW_A_RANK, RW_WIDTH), RW_A_RANK ** -0.5),
        "rw_g2": nrm((L, RW_G_RANK, RW_WIDTH), RW_G_RANK ** -0.5),
        "rw_v0": nrm((L - 1, RW_WIDTH), 0.1),
        "rw_v1": nrm((L - 1, RW_WIDTH, RW_V_RANK), RW_WIDTH ** -0.5),
        "rw_v2": nrm((L - 1, RW_V_RANK, RW_WIDTH), RW_V_RANK ** -0.5),
        "rw_k_k": 0.85 + nrm((L, RW_WIDTH), 0.02),
        "rw_k_a": gain((L, RW_WIDTH)),
        "rw_r_k": nrm((L, RW_HEADS, RW_HEAD), 0.1),
        "rw_ln_w": gain((L, RW_WIDTH)),
        "rw_ln_b": nrm((L, RW_WIDTH), 0.02),
        "w_o": nrm((L, MIX_WIDTH, D_MODEL), MIX_WIDTH ** -0.5),
        "ffn_norm": gain((L, D_MODEL)),
        "w_gate_up": nrm((L, D_MODEL, 2 * D_FF), D_MODEL ** -0.5),
        "w_down": nrm((L, D_FF, D_MODEL), D_FF ** -0.5),
    }


def reference(x, positions, attn_norm, w_in, hg_lower_bounds, hg_out_norm,
              mla_q_a_norm, mla_w_qb, mla_kv_a_norm, mla_w_kvb, mla_q_norm, mla_k_norm,
              rw_mu, rw_w0, rw_w2, rw_a0, rw_a2, rw_g2, rw_v0, rw_v1, rw_v2,
              rw_k_k, rw_k_a, rw_r_k, rw_ln_w, rw_ln_b,
              w_o, ffn_norm, w_gate_up, w_down):
    lb_sm = jax.nn.softmax(hg_lower_bounds.astype(jnp.float32), axis=0)
    lower_bounds = jnp.cumsum(lb_sm, axis=0) - lb_sm[0]
    cos, sin = rope_tables(positions)
    v_first = None
    for l in range(DEPTH):
        h = rms_norm(x, attn_norm[l])
        p = h @ w_in[l]
        hq, hf, hi, hg, mq, mkv, mkr, rw = split_cols(p, IN_SIZES)
        o_hg = hgrn2_mixer(hq, hf, hi, hg, lower_bounds[l], hg_out_norm[l])
        o_mla = mla_mixer(mq, mkv, mkr, cos, sin, mla_q_a_norm[l], mla_w_qb[l],
                          mla_kv_a_norm[l], mla_w_kvb[l], mla_q_norm[l], mla_k_norm[l])
        v_res = None if l == 0 else (rw_v0[l - 1], rw_v1[l - 1], rw_v2[l - 1])
        o_rw, v_first = rwkv7_mixer(rw, rw_mu[l], rw_w0[l], rw_w2[l], rw_a0[l], rw_a2[l], rw_g2[l],
                                    rw_k_k[l], rw_k_a[l], rw_r_k[l], rw_ln_w[l], rw_ln_b[l],
                                    v_first, v_res)
        mixed = jnp.concatenate([o_hg, o_mla, o_rw], axis=-1)
        x = x + (mixed @ w_o[l]).astype(x.dtype)
        h = rms_norm(x, ffn_norm[l])
        gate, up = jnp.split(h @ w_gate_up[l], 2, axis=-1)
        x = x + ((jax.nn.silu(gate) * up) @ w_down[l]).astype(x.dtype)
    return x
```

```cpp
#include <hip/hip_runtime.h>
#include <hip/hip_bf16.h>
#include <hip/hip_cooperative_groups.h>
#include <cstdio>
#include <cstdint>
namespace cg = cooperative_groups;

constexpr int BATCH = 8, SEQ = 4096, DM = 2048, DEPTH = 4;
constexpr int T = BATCH * SEQ;
constexpr int NP = 4864;
constexpr int INW = 4672;
constexpr int FF = 5632;
constexpr int C_HQ = 0, C_HF = 512, C_HI = 1024, C_HG = 1536, C_MQ = 2048, C_MKV = 2560, C_MKR = 2816, C_RW = 2880;
constexpr int C_RR = C_RW, C_RK = C_RW + 512, C_RV = C_RW + 1024, C_RWD = C_RW + 1536, C_RAD = C_RW + 1600, C_RGD = C_RW + 1664;
constexpr int QW = 1536, KVW = 2048;
constexpr float RMS_EPS = 1e-6f;

typedef unsigned short bf16_t;
typedef short bf16x8 __attribute__((ext_vector_type(8)));
typedef short s16x4 __attribute__((ext_vector_type(4)));
typedef float f32x2 __attribute__((ext_vector_type(2)));
typedef float f32x4 __attribute__((ext_vector_type(4)));
typedef float f32x16 __attribute__((ext_vector_type(16)));
typedef unsigned u32x2 __attribute__((ext_vector_type(2)));
typedef unsigned u32x4 __attribute__((ext_vector_type(4)));
#define LAS __attribute__((address_space(3)))

constexpr size_t MiB = 1u << 20;
constexpr size_t WS_CTL = 0;
constexpr size_t CTL_BYTES = 65536;
constexpr size_t WS_RS = 1 * MiB;
constexpr size_t WS_SSB = WS_RS + 128 * 1024;
constexpr size_t WS_RSQ = WS_SSB;
constexpr size_t WS_RSKV = WS_RSQ + 128 * 1024;
constexpr size_t WS_LB = WS_RSKV + 128 * 1024;
constexpr size_t WS_RIN = 2 * MiB;
constexpr size_t WS_BS = 3 * MiB;
constexpr size_t WS_W = 4 * MiB;
constexpr size_t W_LAYER = 96 * MiB;
constexpr size_t WO_IN = 0;
constexpr size_t WO_QB = WO_IN + (size_t)NP * DM * 2;
constexpr size_t WO_KVB = WO_QB + (size_t)QW * 512 * 2;
constexpr size_t WO_O = WO_KVB + (size_t)KVW * 256 * 2;
constexpr size_t WO_GU = WO_O + (size_t)DM * DM * 2;
constexpr size_t WO_DN = WO_GU + (size_t)2 * FF * DM * 2;
constexpr size_t WO_LORA = WO_DN + (size_t)DM * FF * 2;
static_assert(WO_LORA + 163840 * 2 <= W_LAYER, "weight layer stride");
constexpr size_t WS_XB = WS_W + DEPTH * W_LAYER;
constexpr size_t WS_P = WS_XB + 128 * MiB;
constexpr size_t WS_MIX = WS_P + 304 * MiB;
constexpr size_t WS_D = WS_MIX + 128 * MiB;
constexpr size_t WS_Q = WS_D;
constexpr size_t WS_KV = WS_Q + 96 * MiB;
constexpr size_t WS_KR = WS_KV + 128 * MiB;
constexpr size_t WS_RWR = WS_KR + 4 * MiB;
constexpr size_t WS_RWK = WS_RWR + 32 * MiB;
constexpr size_t WS_RWV = WS_RWK + 32 * MiB;
constexpr size_t WS_RWKK = WS_RWV + 32 * MiB;
constexpr size_t WS_RWB = WS_RWKK + 32 * MiB;
constexpr size_t WS_VFIRST = WS_RWB + 32 * MiB;
constexpr size_t WS_SSA = WS_VFIRST + 32 * MiB;
constexpr size_t WS_SSBP = WS_SSA + 4 * MiB;
constexpr size_t WS_END = WS_SSBP + 4 * MiB;
constexpr size_t WS_ACT = WS_D;
static_assert(WS_ACT + (size_t)T * FF * 2 <= WS_VFIRST, "act overlay must not reach v_first");
constexpr size_t WS_RWW = WS_XB;
constexpr size_t WS_RWG = WS_XB + 64 * MiB;
constexpr size_t WS_RWBON = WS_XB + 96 * MiB;

__device__ __forceinline__ int tid_from(int wv) { unsigned z = 0u; asm volatile("" : "+v"(z)); return (wv << 6) | (int)__builtin_amdgcn_mbcnt_hi(~0u, __builtin_amdgcn_mbcnt_lo(~0u, z)); }
#define TID() tid_from(wv__)
__device__ __forceinline__ float bf2f(bf16_t v) { return __uint_as_float(((unsigned)v) << 16); }
typedef __bf16 bf16x2_t __attribute__((ext_vector_type(2)));
__device__ __forceinline__ unsigned cvt_pk_bf16(float lo, float hi) { f32x2 v = {lo, hi}; bf16x2_t b = __builtin_convertvector(v, bf16x2_t); return __builtin_bit_cast(unsigned, b); }
__device__ __forceinline__ bf16_t f2bf(float f) { return (bf16_t)(cvt_pk_bf16(f, 0.f) & 0xffffu); }
__device__ __forceinline__ float lo_bf(unsigned w) { return __uint_as_float(w << 16); }
__device__ __forceinline__ float hi_bf(unsigned w) { return __uint_as_float(w & 0xffff0000u); }
__device__ __forceinline__ float fast_exp(float x) { return __builtin_amdgcn_exp2f(x * 1.4426950408889634f); }
__device__ __forceinline__ float fast_rcp(float x) { return __builtin_amdgcn_rcpf(x); }
__device__ __forceinline__ float sigmoidf_(float x) { return fast_rcp(1.f + fast_exp(-x)); }
__device__ __forceinline__ float siluf_(float x) { return x * sigmoidf_(x); }
#define DPPF(x, CTRL) __int_as_float(__builtin_amdgcn_update_dpp(0, __float_as_int(x), CTRL, 0xf, 0xf, true))
__device__ __forceinline__ float wave_sum(float v) {
    v += DPPF(v, 0xB1);
    v += DPPF(v, 0x4E);
    v += DPPF(v, 0x141);
    v += DPPF(v, 0x140);
    const float r0 = __int_as_float(__builtin_amdgcn_readlane(__float_as_int(v), 0)), r1 = __int_as_float(__builtin_amdgcn_readlane(__float_as_int(v), 16));
    const float r2 = __int_as_float(__builtin_amdgcn_readlane(__float_as_int(v), 32)), r3 = __int_as_float(__builtin_amdgcn_readlane(__float_as_int(v), 48));
    return (r0 + r1) + (r2 + r3);
}
__device__ __forceinline__ float xor32f(float x, int lane) { auto rr = __builtin_amdgcn_permlane32_swap(__float_as_uint(x), __float_as_uint(x), false, false); return __uint_as_float(lane < 32 ? rr[1] : rr[0]); }
__device__ __forceinline__ float sum8f(float x) { x += DPPF(x, 0xB1); x += DPPF(x, 0x4E); x += DPPF(x, 0x141); return x; }
#define MK_COOP 1
#define CONV_IN_MIXERS 1
#define CONV_EVERY 5
namespace pg8 {
#define PG8_LAS __attribute__((address_space(3)))
typedef unsigned short bf16_t;
typedef short bf16x8 __attribute__((ext_vector_type(8)));
typedef float f32x4 __attribute__((ext_vector_type(4)));
typedef unsigned u32x4 __attribute__((ext_vector_type(4)));
constexpr int BM = 256, BK = 64, HALF = 128, HTB = HALF * BK * 2  , STAGE_BYTES = 8 * HTB, NXCD = 8, WGM = 8;

__host__ __device__ __forceinline__ int lds_byte(int r, int c) { const int st = (r >> 4) * 2 + (c >> 5), rr = r & 15, cc = c & 31, ob = rr * 64 + cc * 2; return st * 1024 + (ob ^ (((ob >> 9) & 1) << 5)); }
__host__ __device__ __forceinline__ void stage_rc(int b, int& R, int& C) { const int st = b / 1024, sb = b % 1024, swz = sb ^ (((sb >> 9) & 1) << 5); R = (st >> 1) * 16 + swz / 64; C = (st & 1) * 32 + (swz % 64) / 2; }
__host__ __device__ __forceinline__ int perm32(int rho) { const int n = rho >> 4, i = rho & 15; return 8 * (i >> 2) + 4 * n + (i & 3); }

struct Unit { int pm, pn; };
struct Gemm { const bf16_t* A; const bf16_t* Bt; int M, N, K, lda; };

struct StaticOrder {
    int nM, nN, nwg, G, c;
    __host__ __device__ void init(int M, int N, int G_, int c_) { nM = M / BM; nN = N / BM; nwg = nM * nN; G = G_; c = c_; }
    __host__ __device__ bool next(int i, Unit& u) const {
        const long L = (long)i * G + c; if (L >= nwg) return false;
        int wgid = (int)L; { const int q = nwg / NXCD, r = nwg % NXCD, xcd = wgid % NXCD, off = wgid / NXCD; wgid = (xcd < r ? xcd * (q + 1) : r * (q + 1) + (xcd - r) * q) + off; }
        const int nig = WGM * nN, gid = wgid / nig, fm = gid * WGM, gsz = (nM - fm) < WGM ? (nM - fm) : WGM;
        u.pm = fm + ((wgid % nig) % gsz); u.pn = (wgid % nig) / gsz; return true;
    }
    __device__ __forceinline__ void a_ready(const Unit&) const {}
    __device__ __forceinline__ void done(const Unit&) const {}
};

using ::cvt_pk_bf16;
typedef float f32x2 __attribute__((ext_vector_type(2)));

__device__ __forceinline__ float row_scale32(const float* part, int row) {
    const f32x4* p = (const f32x4*)(part + (size_t)row * 32);
    f32x4 a = p[0] + p[1], b = p[2] + p[3], c = p[4] + p[5], d = p[6] + p[7];
    a = (a + b) + (c + d);
    return 1.f / sqrtf(((a[0] + a[1]) + (a[2] + a[3])) * (1.f / 2048.f) + 1e-6f);
}
struct EpiScaleBf16 {
    static constexpr bool PERM = true, AFTER_DRAIN = false;
    bf16_t* O; const float* rs; int ldc; int ssq;
    __device__ __forceinline__ void operator()(const f32x4 (&acc)[2][2][4][2], const Unit& u, int wr, int wc, int fr_, int fq_) const {
        unsigned z_ = 0u; asm volatile("" : "+v"(z_)); const int ln_ = (int)__builtin_amdgcn_mbcnt_hi(~0u, __builtin_amdgcn_mbcnt_lo(~0u, z_)); const int fr = ln_ & 15, fq = ln_ >> 4; (void)fr_; (void)fq_;
        const int row0 = u.pm * BM + wr * 64 + fr, col0 = u.pn * BM + wc * 32 + 8 * fq;
        float scv[2][4];
#pragma unroll
        for (int ai = 0; ai < 2; ++ai)
#pragma unroll
            for (int m = 0; m < 4; ++m) scv[ai][m] = rs ? rs[row0 + ai * HALF + m * 16] : 1.f;
#pragma unroll
        for (int ai = 0; ai < 2; ++ai)
#pragma unroll
            for (int m = 0; m < 4; ++m) { const int row = row0 + ai * HALF + m * 16; const float sc = scv[ai][m]; bf16_t* rowp = O + (size_t)row * ldc + col0;
#pragma unroll
                for (int bj = 0; bj < 2; ++bj) { const f32x4 v0 = acc[ai][bj][m][0] * sc, v1 = acc[ai][bj][m][1] * sc;
                    u32x4 w; w.x = cvt_pk_bf16(v0[0], v0[1]); w.y = cvt_pk_bf16(v0[2], v0[3]); w.z = cvt_pk_bf16(v1[0], v1[1]); w.w = cvt_pk_bf16(v1[2], v1[3]);
                    *(u32x4*)(rowp + bj * HALF) = w; } }
    }
};
struct EpiPlainBf16 {
    static constexpr bool PERM = true, AFTER_DRAIN = false;
    bf16_t* O; int ldc; int pad_;
    __device__ __forceinline__ void operator()(const f32x4 (&acc)[2][2][4][2], const Unit& u, int wr, int wc, int fr, int fq) const {
        const int row0 = u.pm * BM + wr * 64 + fr, col0 = u.pn * BM + wc * 32 + 8 * fq;
#pragma unroll
        for (int ai = 0; ai < 2; ++ai)
#pragma unroll
            for (int m = 0; m < 4; ++m) { bf16_t* rowp = O + (size_t)(row0 + ai * HALF + m * 16) * ldc + col0;
#pragma unroll
                for (int bj = 0; bj < 2; ++bj) { const f32x4 v0 = acc[ai][bj][m][0], v1 = acc[ai][bj][m][1];
                    u32x4 w; w.x = cvt_pk_bf16(v0[0], v0[1]); w.y = cvt_pk_bf16(v0[2], v0[3]); w.z = cvt_pk_bf16(v1[0], v1[1]); w.w = cvt_pk_bf16(v1[2], v1[3]);
                    *(u32x4*)(rowp + bj * HALF) = w; } }
    }
};
struct EpiResid {
    static constexpr bool PERM = false, AFTER_DRAIN = false;
    float* X; int ldc; int pad_;
    __device__ __forceinline__ void operator()(const f32x4 (&acc)[2][2][4][2], const Unit& u, int wr, int wc, int fr_, int fq_) const {
        unsigned z_ = 0u; asm volatile("" : "+v"(z_)); const int ln_ = (int)__builtin_amdgcn_mbcnt_hi(~0u, __builtin_amdgcn_mbcnt_lo(~0u, z_)); const int fr = ln_ & 15, fq = ln_ >> 4; (void)fr_; (void)fq_;
        const int row0 = u.pm * BM + wr * 64 + fr, col0 = u.pn * BM + wc * 32 + 4 * fq;
#pragma unroll
        for (int ai = 0; ai < 2; ++ai)
#pragma unroll
            for (int m = 0; m < 4; ++m) { float* rowp = X + (size_t)(row0 + ai * HALF + m * 16) * ldc + col0;
                f32x4 xv[2][2];
#pragma unroll
                for (int bj = 0; bj < 2; ++bj)
#pragma unroll
                    for (int n = 0; n < 2; ++n) xv[bj][n] = *(const f32x4*)(rowp + bj * HALF + n * 16);
#pragma unroll
                for (int bj = 0; bj < 2; ++bj)
#pragma unroll
                    for (int n = 0; n < 2; ++n) *(f32x4*)(rowp + bj * HALF + n * 16) = xv[bj][n] + acc[ai][bj][m][n]; }
    }
};
struct EpiKV {
    static constexpr bool PERM = true, AFTER_DRAIN = false;
    bf16_t* O; const float* rs; const float* kg; PG8_LAS float* red; int ldc; int pad_;
    __device__ __forceinline__ void operator()(const f32x4 (&acc)[2][2][4][2], const Unit& u, int wr, int wc, int fr_, int fq_) const {
        unsigned z_ = 0u; asm volatile("" : "+v"(z_)); const int ln_ = (int)__builtin_amdgcn_mbcnt_hi(~0u, __builtin_amdgcn_mbcnt_lo(~0u, z_)); const int fr = ln_ & 15, fq = ln_ >> 4; (void)fr_; (void)fq_;
        const int rl0 = wr * 64 + fr;
        const int col0 = u.pn * BM + wc * 32 + 8 * fq;
#pragma unroll
        for (int ai = 0; ai < 2; ++ai)
#pragma unroll
            for (int m = 0; m < 4; ++m) { const f32x4 a = acc[ai][0][m][0], b = acc[ai][0][m][1];
                float s = ((a[0] * a[0] + a[1] * a[1]) + (a[2] * a[2] + a[3] * a[3])) + ((b[0] * b[0] + b[1] * b[1]) + (b[2] * b[2] + b[3] * b[3]));
                { auto r16 = __builtin_amdgcn_permlane16_swap(__float_as_uint(s), __float_as_uint(s), false, false); s = __uint_as_float(r16[0]) + __uint_as_float(r16[1]);
                  auto r32 = __builtin_amdgcn_permlane32_swap(__float_as_uint(s), __float_as_uint(s), false, false); s = __uint_as_float(r32[0]) + __uint_as_float(r32[1]); }
                if (fq == 0) red[(rl0 + ai * HALF + m * 16) * 4 + wc] = s;
                asm volatile("" ::: "memory"); }
        asm volatile("s_waitcnt lgkmcnt(0)" ::: "memory"); __builtin_amdgcn_s_barrier(); asm volatile("" ::: "memory");
        const unsigned go = (unsigned)(wc * 32 + 8 * fq) * 4u;
        const f32x4 g0 = *(const f32x4*)((const char*)kg + go), g1 = *(const f32x4*)((const char*)kg + go + 16);
#pragma unroll
        for (int ai = 0; ai < 2; ++ai) {
            float scv[4];
#pragma unroll
            for (int m = 0; m < 4; ++m) scv[m] = rs[u.pm * BM + rl0 + ai * HALF + m * 16];
#pragma unroll
            for (int m = 0; m < 4; ++m) { const int rl = rl0 + ai * HALF + m * 16, row = u.pm * BM + rl;
                const f32x4 r4 = *(const PG8_LAS f32x4*)(red + rl * 4);
                const float rk = 1.f / sqrtf(((r4[0] + r4[1]) + (r4[2] + r4[3])) * (1.f / 128.f) + 1e-6f), sc = scv[m];
                bf16_t* rowp = O + (size_t)row * ldc + col0;
                { const f32x4 v0 = acc[ai][0][m][0] * rk * g0, v1 = acc[ai][0][m][1] * rk * g1;
                  u32x4 w; w.x = cvt_pk_bf16(v0[0], v0[1]); w.y = cvt_pk_bf16(v0[2], v0[3]); w.z = cvt_pk_bf16(v1[0], v1[1]); w.w = cvt_pk_bf16(v1[2], v1[3]);
                  *(u32x4*)rowp = w; }
                { const f32x4 v0 = acc[ai][1][m][0] * sc, v1 = acc[ai][1][m][1] * sc;
                  u32x4 w; w.x = cvt_pk_bf16(v0[0], v0[1]); w.y = cvt_pk_bf16(v0[2], v0[3]); w.z = cvt_pk_bf16(v1[0], v1[1]); w.w = cvt_pk_bf16(v1[2], v1[3]);
                  *(u32x4*)(rowp + HALF) = w; }
                asm volatile("" ::: "memory"); } }
        asm volatile("s_waitcnt lgkmcnt(0)" ::: "memory"); __builtin_amdgcn_s_barrier(); asm volatile("" ::: "memory");
    }
};
struct EpiResidN {
    static constexpr bool PERM = false, AFTER_DRAIN = false;
    const float* Xin; float* Xout; bf16_t* xb; float* ssq; int ldc; int pad_;
    __device__ __forceinline__ void operator()(const f32x4 (&acc)[2][2][4][2], const Unit& u, int wr, int wc, int fr_, int fq_) const {
        unsigned z_ = 0u; asm volatile("" : "+v"(z_)); const int ln_ = (int)__builtin_amdgcn_mbcnt_hi(~0u, __builtin_amdgcn_mbcnt_lo(~0u, z_)); const int fr = ln_ & 15, fq = ln_ >> 4; (void)fr_; (void)fq_;
        const int row0 = u.pm * BM + wr * 64 + fr, col0 = u.pn * BM + wc * 32 + 4 * fq;
#pragma unroll
        for (int ai = 0; ai < 2; ++ai)
        {   f32x4 xv[4][2][2];
#pragma unroll
            for (int m = 0; m < 4; ++m)
#pragma unroll
                for (int bj = 0; bj < 2; ++bj)
#pragma unroll
                    for (int n = 0; n < 2; ++n) xv[m][bj][n] = *(const f32x4*)(Xin + (size_t)(row0 + ai * HALF + m * 16) * ldc + col0 + bj * HALF + n * 16);
#pragma unroll
            for (int m = 0; m < 4; ++m) { const int row = row0 + ai * HALF + m * 16; const size_t off = (size_t)row * ldc + col0;
                float s = 0.f;
#pragma unroll
                for (int bj = 0; bj < 2; ++bj)
#pragma unroll
                    for (int n = 0; n < 2; ++n) { const f32x4 v = xv[m][bj][n] + acc[ai][bj][m][n]; *(f32x4*)(Xout + off + bj * HALF + n * 16) = v;
                        u32x2 w; w.x = cvt_pk_bf16(v[0], v[1]); w.y = cvt_pk_bf16(v[2], v[3]); *(u32x2*)(xb + off + bj * HALF + n * 16) = w;
                        s += (v[0] * v[0] + v[1] * v[1]) + (v[2] * v[2] + v[3] * v[3]); }
                { auto r16 = __builtin_amdgcn_permlane16_swap(__float_as_uint(s), __float_as_uint(s), false, false); s = __uint_as_float(r16[0]) + __uint_as_float(r16[1]);
                  auto r32 = __builtin_amdgcn_permlane32_swap(__float_as_uint(s), __float_as_uint(s), false, false); s = __uint_as_float(r32[0]) + __uint_as_float(r32[1]); }
                if (fq == 0) ssq[(size_t)row * 32 + u.pn * 4 + wc] = s; }
        }
    }
};
struct EpiResidB {
    static constexpr bool PERM = true, AFTER_DRAIN = false;
    const float* XinF; float* OutF; bf16_t* xb; float* ssq; int ldc; int pad_;
    __device__ __forceinline__ void operator()(const f32x4 (&acc)[2][2][4][2], const Unit& u, int wr, int wc, int fr_, int fq_) const {
        unsigned z_ = 0u; asm volatile("" : "+v"(z_)); const int ln_ = (int)__builtin_amdgcn_mbcnt_hi(~0u, __builtin_amdgcn_mbcnt_lo(~0u, z_)); const int fr = ln_ & 15, fq = ln_ >> 4; (void)fr_; (void)fq_;
        const int row0 = u.pm * BM + wr * 64 + fr, col0 = u.pn * BM + wc * 32 + 8 * fq;
#pragma unroll
        for (int ai = 0; ai < 2; ++ai) {
            f32x4 r0[4][2], r1[4][2];
#pragma unroll
            for (int m = 0; m < 4; ++m)
#pragma unroll
                for (int bj = 0; bj < 2; ++bj) { const size_t off = (size_t)(row0 + ai * HALF + m * 16) * ldc + col0 + bj * HALF;
                    if (XinF) { r0[m][bj] = *(const f32x4*)(XinF + off); r1[m][bj] = *(const f32x4*)(XinF + off + 4); }
                    else { const u32x4 w = *(const u32x4*)(xb + off); r0[m][bj] = (f32x4){lo_bf(w.x), hi_bf(w.x), lo_bf(w.y), hi_bf(w.y)}; r1[m][bj] = (f32x4){lo_bf(w.z), hi_bf(w.z), lo_bf(w.w), hi_bf(w.w)}; } }
#pragma unroll
            for (int m = 0; m < 4; ++m) { const int row = row0 + ai * HALF + m * 16; float s = 0.f;
#pragma unroll
                for (int bj = 0; bj < 2; ++bj) { const size_t off = (size_t)row * ldc + col0 + bj * HALF;
                    const f32x4 v0 = r0[m][bj] + acc[ai][bj][m][0], v1 = r1[m][bj] + acc[ai][bj][m][1];
                    u32x4 w; w.x = cvt_pk_bf16(v0[0], v0[1]); w.y = cvt_pk_bf16(v0[2], v0[3]); w.z = cvt_pk_bf16(v1[0], v1[1]); w.w = cvt_pk_bf16(v1[2], v1[3]);
                    *(u32x4*)(xb + off) = w;
                    if (OutF) { *(f32x4*)(OutF + off) = v0; *(f32x4*)(OutF + off + 4) = v1; }
                    s += ((v0[0] * v0[0] + v0[1] * v0[1]) + (v0[2] * v0[2] + v0[3] * v0[3])) + ((v1[0] * v1[0] + v1[1] * v1[1]) + (v1[2] * v1[2] + v1[3] * v1[3])); }
                { auto r16 = __builtin_amdgcn_permlane16_swap(__float_as_uint(s), __float_as_uint(s), false, false); s = __uint_as_float(r16[0]) + __uint_as_float(r16[1]);
                  auto r32 = __builtin_amdgcn_permlane32_swap(__float_as_uint(s), __float_as_uint(s), false, false); s = __uint_as_float(r32[0]) + __uint_as_float(r32[1]); }
                if (fq == 0) ssq[(size_t)row * 32 + u.pn * 4 + wc] = s; }
        }
    }
};
struct EpiSwiGLU {
    static constexpr bool PERM = true, AFTER_DRAIN = false;
    bf16_t* O; const float* rs; int ldc; int pad_;
    __device__ __forceinline__ void operator()(const f32x4 (&acc)[2][2][4][2], const Unit& u, int wr, int wc, int fr_, int fq_) const {
        unsigned z_ = 0u; asm volatile("" : "+v"(z_)); const int ln_ = (int)__builtin_amdgcn_mbcnt_hi(~0u, __builtin_amdgcn_mbcnt_lo(~0u, z_)); const int fr = ln_ & 15, fq = ln_ >> 4; (void)fr_; (void)fq_;
        const int row0 = u.pm * BM + wr * 64 + fr, col0 = u.pn * HALF + wc * 32 + 8 * fq;
        float scv[2][4];
#pragma unroll
        for (int ai = 0; ai < 2; ++ai)
#pragma unroll
            for (int m = 0; m < 4; ++m) scv[ai][m] = rs[row0 + ai * HALF + m * 16];
#pragma unroll
        for (int ai = 0; ai < 2; ++ai)
#pragma unroll
            for (int m = 0; m < 4; ++m) { const int row = row0 + ai * HALF + m * 16; const float sc = scv[ai][m]; bf16_t* rowp = O + (size_t)row * ldc + col0;
                float o[8];
#pragma unroll
                for (int n = 0; n < 2; ++n)
#pragma unroll
                    for (int i = 0; i < 4; ++i) { const float g = acc[ai][0][m][n][i] * sc, up = acc[ai][1][m][n][i] * sc;
                        o[n * 4 + i] = g * __builtin_amdgcn_rcpf(1.f + __builtin_amdgcn_exp2f(g * -1.4426950408889634f)) * up; }
                u32x4 w; w.x = cvt_pk_bf16(o[0], o[1]); w.y = cvt_pk_bf16(o[2], o[3]); w.z = cvt_pk_bf16(o[4], o[5]); w.w = cvt_pk_bf16(o[6], o[7]);
                *(u32x4*)rowp = w; }
    }
};

template <class Sched>
__device__ __forceinline__ void prep_row_scales(const float* part, float* rs, const Sched& S, int tid) {
    Unit u; int last = -1;
    for (int i = 0; S.next(i, u); ++i) {
        if (u.pm == last) continue;
        last = u.pm;
        const int row = u.pm * BM + (tid >> 1);
        const f32x4* p = (const f32x4*)(part + (size_t)row * 32 + (tid & 1) * 16);
        f32x4 a = (p[0] + p[1]) + (p[2] + p[3]);
        float s = (a[0] + a[1]) + (a[2] + a[3]);
        s += DPPF(s, 0xB1);
        if ((tid & 1) == 0) rs[row] = 1.f / sqrtf(s * (1.f / 2048.f) + 1e-6f);
    }
    asm volatile("s_waitcnt vmcnt(0)" ::: "memory");
    __syncthreads();
}
template <class Epi, class Sched, bool ALIGN_EPI = false, bool SP2 = false>
__device__ __forceinline__ void gemm_phase(PG8_LAS unsigned char* lds, const Gemm g, const Sched& S, const Epi& E, const int wv__) {
    const int tid = TID(), wid = __builtin_amdgcn_readfirstlane(tid >> 6), lane = tid & 63, wr = wid >> 2, wc = wid & 3, fr = lane & 15, fq = lane >> 4;
    const int K = g.K, nt = K / BK;
    unsigned voffA[2], voffB[2];
#pragma unroll
    for (int i = 0; i < 2; ++i) { int R, C; stage_rc(tid * 16 + i * 8192, R, C); const int Rb = Epi::PERM ? ((R & ~31) + perm32(R & 31)) : R;
        voffA[i] = (unsigned)(R * g.lda + C) * 2u; voffB[i] = (unsigned)(Rb * K + C) * 2u; }
    const size_t kstep = (size_t)(BK * 2);
    const size_t hstepA = (size_t)HALF * g.lda * 2, hstepB = (size_t)HALF * K * 2;
    const size_t tstepA = 2 * hstepA, tstepB = 2 * hstepB;
    const unsigned ldsw = (unsigned)wid * 1024u;
    const int aoff = lds_byte(wr * 64 + fr, fq * 8), boff = lds_byte(wc * 32 + fr, fq * 8);
#define PG8_SA(b, h) (((b) * 2 + (h)) * HTB)
#define PG8_SB(b, h) ((4 + (b) * 2 + (h)) * HTB)
#define PG8_STAGE(bufoff, gbase, voff) do { _Pragma("unroll") for (int _i = 0; _i < 2; ++_i) \
        __builtin_amdgcn_global_load_lds((const unsigned*)((const char*)(gbase) + (voff)[_i]), (PG8_LAS unsigned*)(lds + (bufoff) + ldsw + _i * 8192), 16, 0, 0); } while (0)
#define PG8_LDA(dst, b, h) do { _Pragma("unroll") for (int m = 0; m < 4; ++m) _Pragma("unroll") for (int k = 0; k < 2; ++k) dst[m][k] = *(const PG8_LAS bf16x8*)(lds + PG8_SA(b, h) + aoff + m * 2048 + k * 1024); } while (0)
#define PG8_LDB(dst, b, h) do { _Pragma("unroll") for (int n = 0; n < 2; ++n) _Pragma("unroll") for (int k = 0; k < 2; ++k) dst[n][k] = *(const PG8_LAS bf16x8*)(lds + PG8_SB(b, h) + boff + n * 2048 + k * 1024); } while (0)
#define PG8_MMA(ai, bj, At, Bt) do { __builtin_amdgcn_s_setprio(1); _Pragma("unroll") for (int m = 0; m < 4; ++m) _Pragma("unroll") for (int n = 0; n < 2; ++n) _Pragma("unroll") for (int k = 0; k < 2; ++k) \
        acc[ai][bj][m][n] = __builtin_amdgcn_mfma_f32_16x16x32_bf16(Bt[n][k], At[m][k], acc[ai][bj][m][n], 0, 0, 0); __builtin_amdgcn_s_setprio(0); } while (0)
#define PG8_WAIT_V(n) asm volatile("s_waitcnt vmcnt(" #n ")" ::: "memory")
#define PG8_WAIT_L(n) asm volatile("s_waitcnt lgkmcnt(" #n ")" ::: "memory")
#define PG8_BAR __builtin_amdgcn_s_barrier()
#define PG8_SCHED __builtin_amdgcn_sched_barrier(0)
    Unit cur, nxt; int ui = 0;
    if (!S.next(0, cur)) return;
    f32x4 acc[2][2][4][2];
#pragma unroll
    for (int a = 0; a < 2; ++a)
#pragma unroll
        for (int b = 0; b < 2; ++b)
#pragma unroll
            for (int m = 0; m < 4; ++m)
#pragma unroll
                for (int n = 0; n < 2; ++n) acc[a][b][m][n] = (f32x4){0.f, 0.f, 0.f, 0.f};
    bf16x8 At[4][2], B0[2][2], B1[2][2];
    const char* cA = (const char*)g.A + (size_t)cur.pm * tstepA; const char* cB = (const char*)g.Bt + (size_t)cur.pn * tstepB;
    S.a_ready(cur);
    if constexpr (SP2) {
        PG8_STAGE(PG8_SB(0, 0), cB, voffB); PG8_STAGE(PG8_SB(0, 1), cB + hstepB, voffB); PG8_STAGE(PG8_SA(0, 0), cA, voffA); PG8_STAGE(PG8_SA(0, 1), cA + hstepA, voffA);
        if (wr == 1) PG8_BAR;
        PG8_WAIT_V(2); PG8_BAR;
        PG8_STAGE(PG8_SB(1, 0), cB + kstep, voffB); PG8_STAGE(PG8_SA(1, 0), cA + kstep, voffA); PG8_STAGE(PG8_SB(1, 1), cB + hstepB + kstep, voffB);
        PG8_WAIT_V(6); PG8_BAR;
    } else {
        PG8_STAGE(PG8_SB(0, 0), cB, voffB); PG8_STAGE(PG8_SA(0, 0), cA, voffA); PG8_STAGE(PG8_SB(0, 1), cB + hstepB, voffB); PG8_STAGE(PG8_SA(0, 1), cA + hstepA, voffA);
        if (wr == 1) PG8_BAR;
        PG8_WAIT_V(4); PG8_BAR;
        PG8_STAGE(PG8_SB(1, 0), cB + kstep, voffB); PG8_STAGE(PG8_SA(1, 0), cA + kstep, voffA); PG8_STAGE(PG8_SB(1, 1), cB + hstepB + kstep, voffB);
        PG8_WAIT_V(6); PG8_BAR;
    }
    for (;;) {
        const bool has_next = S.next(ui + 1, nxt);
        const char* nA = has_next ? (const char*)g.A + (size_t)nxt.pm * tstepA : cA; const char* nB = has_next ? (const char*)g.Bt + (size_t)nxt.pn * tstepB : cB;
        for (int t = 0; t < nt; t += 2) {
            const bool last = (t == nt - 2);
            const char* a1 = cA + (size_t)(t + 1) * kstep;
            const char* a2 = last ? nA : cA + (size_t)(t + 2) * kstep; const char* b2 = last ? nB : cB + (size_t)(t + 2) * kstep;
            const char* a3 = a2 + kstep; const char* b3 = b2 + kstep;
            if (last && has_next) S.a_ready(nxt);
            if constexpr (SP2) {
            PG8_LDB(B0, 0, 0); PG8_LDB(B1, 0, 1); PG8_SCHED; PG8_LDA(At, 0, 0); PG8_STAGE(PG8_SA(1, 1), a1 + hstepA, voffA);
            PG8_WAIT_V(8); PG8_WAIT_L(0); PG8_BAR; PG8_MMA(0, 0, At, B0); PG8_MMA(0, 1, At, B1); PG8_BAR; PG8_SCHED;
            PG8_LDA(At, 0, 1); PG8_STAGE(PG8_SB(0, 0), b2, voffB); PG8_STAGE(PG8_SB(0, 1), b2 + hstepB, voffB); PG8_STAGE(PG8_SA(0, 0), a2, voffA);
            PG8_WAIT_V(8); PG8_WAIT_L(0); PG8_BAR; PG8_MMA(1, 0, At, B0); PG8_MMA(1, 1, At, B1); PG8_BAR; PG8_SCHED;
            PG8_LDB(B0, 1, 0); PG8_LDB(B1, 1, 1); PG8_SCHED; PG8_LDA(At, 1, 0); PG8_STAGE(PG8_SA(0, 1), a2 + hstepA, voffA);
            PG8_WAIT_V(8); PG8_WAIT_L(0); PG8_BAR; PG8_MMA(0, 0, At, B0); PG8_MMA(0, 1, At, B1); PG8_BAR; PG8_SCHED;
            PG8_LDA(At, 1, 1); PG8_STAGE(PG8_SB(1, 0), b3, voffB); PG8_STAGE(PG8_SB(1, 1), b3 + hstepB, voffB); PG8_STAGE(PG8_SA(1, 0), a3, voffA);
            PG8_WAIT_V(8); PG8_WAIT_L(0); PG8_BAR; PG8_MMA(1, 0, At, B0); PG8_MMA(1, 1, At, B1); PG8_BAR; PG8_SCHED;
            } else {
            PG8_LDB(B0, 0, 0); PG8_SCHED; PG8_LDA(At, 0, 0); PG8_STAGE(PG8_SA(1, 1), a1 + hstepA, voffA);
            PG8_WAIT_L(8); PG8_BAR; PG8_WAIT_L(0); PG8_MMA(0, 0, At, B0); PG8_BAR; PG8_SCHED;
            PG8_LDB(B1, 0, 1); PG8_STAGE(PG8_SB(0, 0), b2, voffB);
            PG8_BAR; PG8_WAIT_L(0); PG8_MMA(0, 1, At, B1); PG8_BAR;
            PG8_LDA(At, 0, 1); PG8_STAGE(PG8_SA(0, 0), a2, voffA);
            PG8_BAR; PG8_WAIT_L(0); PG8_MMA(1, 0, At, B0); PG8_BAR; PG8_SCHED;
            PG8_STAGE(PG8_SB(0, 1), b2 + hstepB, voffB);
            PG8_WAIT_V(6); PG8_BAR; PG8_MMA(1, 1, At, B1); PG8_BAR;
            PG8_LDB(B0, 1, 0); PG8_SCHED; PG8_LDA(At, 1, 0); PG8_STAGE(PG8_SA(0, 1), a2 + hstepA, voffA);
            PG8_WAIT_L(8); PG8_BAR; PG8_WAIT_L(0); PG8_MMA(0, 0, At, B0); PG8_BAR; PG8_SCHED;
            PG8_LDB(B1, 1, 1); PG8_STAGE(PG8_SB(1, 0), b3, voffB);
            PG8_BAR; PG8_WAIT_L(0); PG8_MMA(0, 1, At, B1); PG8_BAR;
            PG8_LDA(At, 1, 1); PG8_STAGE(PG8_SA(1, 0), a3, voffA);
            PG8_BAR; PG8_WAIT_L(0); PG8_MMA(1, 0, At, B0); PG8_BAR; PG8_SCHED;
            PG8_STAGE(PG8_SB(1, 1), b3 + hstepB, voffB);
            PG8_WAIT_V(6); PG8_BAR; PG8_MMA(1, 1, At, B1); PG8_BAR;
            }
        }
        if constexpr (ALIGN_EPI) { if (wr == 0) PG8_BAR; }
        if constexpr (!Epi::AFTER_DRAIN) { E(acc, cur, wr, wc, fr, fq); S.done(cur); }
        if (!has_next) break;
#pragma unroll
        for (int a = 0; a < 2; ++a)
#pragma unroll
            for (int b = 0; b < 2; ++b)
#pragma unroll
                for (int m = 0; m < 4; ++m)
#pragma unroll
                    for (int n = 0; n < 2; ++n) acc[a][b][m][n] = (f32x4){0.f, 0.f, 0.f, 0.f};
        cur = nxt; cA = nA; cB = nB; ++ui;
        if constexpr (ALIGN_EPI) { if (wr == 1) PG8_BAR; }
    }
    PG8_WAIT_V(0);
    if constexpr (!ALIGN_EPI) { if (wr == 0) PG8_BAR; }
    PG8_BAR;
    if constexpr (Epi::AFTER_DRAIN) { E.fused(acc, cur, wr, wc, fr, fq, lds, wid, lane); S.done(cur); }
#undef PG8_SA
#undef PG8_SB
#undef PG8_STAGE
#undef PG8_LDA
#undef PG8_LDB
#undef PG8_MMA
#undef PG8_WAIT_V
#undef PG8_WAIT_L
#undef PG8_BAR
#undef PG8_SCHED
}
}
__device__ __forceinline__ void rope_cs(int pos, int j, float& c, float& s) {
    const float inv_freq = exp2f(-(float)j * (13.287712379549449f / 32.f));
    const float ang = (float)pos * inv_freq;
    float rev = ang * 0.15915494309189535f; rev = rev - floorf(rev);
    c = __builtin_amdgcn_cosf(rev); s = __builtin_amdgcn_sinf(rev);
}
namespace att {
constexpr int NW = 8, QBLK = 32, KVBLK = 64, QB = NW * QBLK;
constexpr int QS = QW, KS = KVW, KRS = 64, OS = DM;
constexpr int SHM_V = KVBLK * 128 * 2, SHM_K = KVBLK * 128 * 2, SHM_KR = KVBLK * 64 * 2;
constexpr int OFF_V = 0, OFF_K = 2 * SHM_V, OFF_KR = OFF_K + 2 * SHM_K, OFF_WS = OFF_KR + 2 * SHM_KR, OFF_QR = OFF_WS + NW * 64 * 4;
constexpr int LDS_BYTES = OFF_QR + NW * 8 * 64 * 16;
constexpr float SCALE = 0.07216878364870322f;
constexpr float THR = 8.f;
constexpr int NQB = SEQ / QB;

#define KSWZ(row, colB) ((row) * 256 + ((colB) ^ (((row) & 7) << 4)))
#define KRSWZ(row, colB) ((row) * 128 + ((colB) ^ ((((row) >> 1) & 7) << 4)))
#define SBAR() __builtin_amdgcn_sched_barrier(0)
__device__ __forceinline__ int v_st(int k, int c) { const int kk = (k & ~0xC) | ((k & 4) << 1) | ((k & 8) >> 1); return ((kk >> 3) * 4 + (c >> 5)) * 512 + ((kk & 7) * 32 + (c & 31)) * 2; }
__device__ __forceinline__ int v_rd_base(int lane) { return ((lane & 3) << 3) | (((lane >> 2) & 3) << 6) | (((lane >> 4) & 1) << 5) | (((lane >> 5) & 1) << 8); }
constexpr int v_rd_off(int d0, int ks, int half) { return d0 * 512 + ks * 4096 + half * 2048; }
__device__ __forceinline__ int crow(int r, int hi) { return (r & 3) + 8 * (r >> 2) + 4 * hi; }
__device__ __forceinline__ unsigned cvtpk(float lo, float hi) { return cvt_pk_bf16(lo, hi); }
__device__ __forceinline__ bf16x8 load8(const bf16_t* p) { return *reinterpret_cast<const bf16x8*>(p); }

__device__ __forceinline__ void mask_tile(f32x16& p0, f32x16& p1, int dq) {
    const float NEG = -__builtin_inff();
#pragma unroll
    for (int r = 0; r < 16; ++r) {
        const int c = (r & 3) + 8 * (r >> 2);
        if (dq - c < 0) p0[r] = NEG;
        if (dq - c - 32 < 0) p1[r] = NEG;
    }
}
__device__ __forceinline__ void partialSM(f32x16& p0, f32x16& p1, float& m_reg, float& mn, float& alpha) {
    float pmax = p0[0];
#pragma unroll
    for (int r = 1; r < 16; ++r) pmax = fmaxf(pmax, p0[r]);
#pragma unroll
    for (int r = 0; r < 16; ++r) pmax = fmaxf(pmax, p1[r]);
    { auto rr = __builtin_amdgcn_permlane32_swap(__float_as_uint(pmax), __float_as_uint(pmax), false, false);
      pmax = fmaxf(__uint_as_float(rr[0]), __uint_as_float(rr[1])); }
    constexpr float C2 = 1.4426950408889634f * SCALE;
    if (__builtin_expect(__all((pmax - m_reg) * SCALE <= THR), 1)) { mn = m_reg; alpha = 1.f; }
    else { mn = fmaxf(m_reg, pmax); alpha = __builtin_amdgcn_exp2f((m_reg - mn) * C2); m_reg = mn; }
    const float mnL = -mn * C2;
#pragma unroll
    for (int r = 0; r < 16; ++r) p0[r] = fmaf(p0[r], C2, mnL);
#pragma unroll
    for (int r = 0; r < 16; ++r) p1[r] = fmaf(p1[r], C2, mnL);
#pragma unroll
    for (int r = 0; r < 16; ++r) p0[r] = __builtin_amdgcn_exp2f(p0[r]);
}
__device__ __forceinline__ void finishSM(f32x16& p0, f32x16& p1, float alpha, float& l_reg, bf16x8& pa0, bf16x8& pa1, bf16x8& pa2, bf16x8& pa3) {
#pragma unroll
    for (int r = 0; r < 16; ++r) p1[r] = __builtin_amdgcn_exp2f(p1[r]);
    float ps = 0;
#pragma unroll
    for (int r = 0; r < 16; ++r) ps += p0[r];
#pragma unroll
    for (int r = 0; r < 16; ++r) ps += p1[r];
    { auto rr = __builtin_amdgcn_permlane32_swap(__float_as_uint(ps), __float_as_uint(ps), false, false);
      ps = __uint_as_float(rr[0]) + __uint_as_float(rr[1]); }
    l_reg = l_reg * alpha + ps;
#define PK4(P, B_, OUT) do { unsigned a0 = cvtpk(P[B_+0], P[B_+1]), a1 = cvtpk(P[B_+2], P[B_+3]);                          \
        unsigned b0 = cvtpk(P[B_+4], P[B_+5]), b1 = cvtpk(P[B_+6], P[B_+7]);                                             \
        auto r0 = __builtin_amdgcn_permlane32_swap(a0, b0, false, false); auto r1 = __builtin_amdgcn_permlane32_swap(a1, b1, false, false); \
        u32x4 w = {r0[0], r1[0], r0[1], r1[1]}; OUT = *reinterpret_cast<bf16x8*>(&w); } while (0)
    PK4(p0, 0, pa0); PK4(p0, 8, pa1); PK4(p1, 0, pa2); PK4(p1, 8, pa3);
#undef PK4
}
template <int KB>
__device__ __forceinline__ void qkt(f32x16& p0, f32x16& p1, const char* lds, int r32, int hi, const bf16x8* qr, int qro) {
    p0 = f32x16{}; p1 = f32x16{};
    const char* kb[4];
#pragma unroll
    for (int dd = 0; dd < 4; ++dd) kb[dd] = lds + OFF_K + KB * SHM_K + KSWZ(r32, (dd * 16 + hi * 8) * 2);
#pragma unroll
    for (int d0 = 0; d0 < 8; ++d0) { const char* a = kb[d0 & 3] + (d0 >> 2) * 128;
        bf16x8 b0 = *reinterpret_cast<const bf16x8*>(a);
        bf16x8 b1 = *reinterpret_cast<const bf16x8*>(a + 32 * 256);
        const bf16x8 qq = qr[d0];
        p0 = __builtin_amdgcn_mfma_f32_32x32x16_bf16(b0, qq, p0, 0, 0, 0);
        p1 = __builtin_amdgcn_mfma_f32_32x32x16_bf16(b1, qq, p1, 0, 0, 0); }
#pragma unroll
    for (int dd = 0; dd < 4; ++dd) { const char* a = lds + OFF_KR + KB * SHM_KR + KRSWZ(r32, (dd * 16 + hi * 8) * 2);
        bf16x8 b0 = *reinterpret_cast<const bf16x8*>(a);
        bf16x8 b1 = *reinterpret_cast<const bf16x8*>(a + 32 * 128);
        const bf16x8 qq = *reinterpret_cast<const bf16x8*>(lds + qro + dd * 1024);
        p0 = __builtin_amdgcn_mfma_f32_32x32x16_bf16(b0, qq, p0, 0, 0, 0);
        p1 = __builtin_amdgcn_mfma_f32_32x32x16_bf16(b1, qq, p1, 0, 0, 0); }
}
template <int VB>
__device__ __forceinline__ void pv_tile(f32x16* o, int vb0, bf16x8 pa0, bf16x8 pa1, bf16x8 pa2, bf16x8 pa3) {
#define TRRD(dst, off) asm volatile("ds_read_b64_tr_b16 %0, %1 offset:%2" : "=&v"(dst) : "v"(vb0), "i"(off) : "memory")
#define PV_D0(d0) do { s16x4 l0, l1, l2, l3, h0, h1, h2, h3; constexpr int b_ = OFF_V + VB * SHM_V + v_rd_off(d0, 0, 0);   \
        TRRD(l0, b_); TRRD(h0, b_ + 2048); TRRD(l1, b_ + 4096); TRRD(h1, b_ + 6144); TRRD(l2, b_ + 8192); TRRD(h2, b_ + 10240); TRRD(l3, b_ + 12288); TRRD(h3, b_ + 14336); \
        asm volatile("s_waitcnt lgkmcnt(0)" ::: "memory"); SBAR();   \
        o[d0] = __builtin_amdgcn_mfma_f32_32x32x16_bf16(pa0, (bf16x8){l0[0], l0[1], l0[2], l0[3], h0[0], h0[1], h0[2], h0[3]}, o[d0], 0, 0, 0);   \
        o[d0] = __builtin_amdgcn_mfma_f32_32x32x16_bf16(pa1, (bf16x8){l1[0], l1[1], l1[2], l1[3], h1[0], h1[1], h1[2], h1[3]}, o[d0], 0, 0, 0);   \
        o[d0] = __builtin_amdgcn_mfma_f32_32x32x16_bf16(pa2, (bf16x8){l2[0], l2[1], l2[2], l2[3], h2[0], h2[1], h2[2], h2[3]}, o[d0], 0, 0, 0);   \
        o[d0] = __builtin_amdgcn_mfma_f32_32x32x16_bf16(pa3, (bf16x8){l3[0], l3[1], l3[2], l3[3], h3[0], h3[1], h3[2], h3[3]}, o[d0], 0, 0, 0); } while (0)
    PV_D0(0); PV_D0(1); PV_D0(2); PV_D0(3);
#undef PV_D0
#undef TRRD
}

struct BlockRef { const bf16_t* Q; const bf16_t* K; const bf16_t* V; const bf16_t* KR; bf16_t* O; const int* POS; const float* QG; int P0; };
struct Seam { bf16x8 qr[8]; bf16x8 st_v0, st_v1, st_k0, st_k1, st_kr; };
#define VMW() asm volatile("s_waitcnt vmcnt(0)" ::: "memory")
#define VMWN(n) asm volatile("s_waitcnt vmcnt(%0)" :: "i"(n) : "memory")
#define LDG8(base, off) (*reinterpret_cast<const bf16x8*>((const char*)(base) + (off)))
#define SLOAD_H(R_, k0) do { const char* kb_ = (const char*)((R_).K + (size_t)(k0) * KS); const char* rb_ = (const char*)((R_).KR + (size_t)(k0) * KRS);  \
                             S.st_v0 = LDG8(kb_ + 256, offA); S.st_v1 = LDG8(kb_ + 32 * KS * 2 + 256, offA);              \
                             S.st_k0 = LDG8(kb_, offA); S.st_k1 = LDG8(kb_ + 32 * KS * 2, offA);              \
                             S.st_kr = LDG8(rb_, offR); } while (0)
#define SWRITE_HK(bf) do { *(bf16x8*)(lds + OFF_K + (bf) * SHM_K + kws) = S.st_k0; *(bf16x8*)(lds + OFF_K + (bf) * SHM_K + kws + 32 * 256) = S.st_k1; \
                           *(bf16x8*)(lds + OFF_KR + (bf) * SHM_KR + krws) = S.st_kr; } while (0)
#define SWRITE_HV(bf) do { *(bf16x8*)(lds + OFF_V + (bf) * SHM_V + vst0) = S.st_v0; *(bf16x8*)(lds + OFF_V + (bf) * SHM_V + vst1) = S.st_v1; } while (0)
#define SWRITE_H(bf) do { SWRITE_HV(bf); SWRITE_HK(bf); } while (0)
#define QLOAD(R_) do { _Pragma("unroll") for (int d0 = 0; d0 < 8; ++d0) S.qr[d0] = LDG8((const char*)(R_).Q + d0 * 32, offQ); } while (0)

__device__ __forceinline__ void attn_prime(const BlockRef& cur, char* lds, Seam& S, const int wv__) {
    const int tid = TID(), wid = __builtin_amdgcn_readfirstlane(tid >> 6), lane = tid & 63, r32 = lane & 31, hi = lane >> 5;
    const int sr = tid >> 4, sc = (tid & 15) * 8, kws = KSWZ(sr, sc * 2), krr = tid >> 3, krc = (tid & 7) * 8, krws = KRSWZ(krr, krc * 2);
    unsigned offA = (unsigned)(sr * KS + sc) * 2u, offR = (unsigned)(krr * KRS + krc) * 2u, offQ = (unsigned)((wid * QBLK + r32) * QS + hi * 8) * 2u;
    asm volatile("" : "+v"(offA), "+v"(offR), "+v"(offQ));
    QLOAD(cur);
    SLOAD_H(cur, 0); VMW(); SWRITE_HK(0);
    __syncthreads();
}
__device__ __forceinline__ void attn_block(const BlockRef& cur, char* lds, Seam& S, const int wv__) {
    const int tid = TID(), wid = __builtin_amdgcn_readfirstlane(tid >> 6), lane = tid & 63, r32 = lane & 31, hi = lane >> 5;
    const int NT = (cur.P0 + QB) / KVBLK;
    const int qlo = cur.P0 + wid * QBLK, qm = qlo + r32 - 4 * hi;
    float* ws = (float*)(lds + OFF_WS) + wid * 64; float* li_l = ws, * al_l = ws + 32;
    float m_reg = -1e30f, l_reg = 0; f32x16 o[4] = {};
    const int sr = tid >> 4, sc = (tid & 15) * 8, vst0 = v_st(sr, sc), vst1 = v_st(32 + sr, sc), kws = KSWZ(sr, sc * 2);
    const int krr = tid >> 3, krc = (tid & 7) * 8, krws = KRSWZ(krr, krc * 2);
    unsigned offA = (unsigned)(sr * KS + sc) * 2u, offR = (unsigned)(krr * KRS + krc) * 2u, offQ = (unsigned)((wid * QBLK + r32) * QS + hi * 8) * 2u;
    asm volatile("" : "+v"(offA), "+v"(offR), "+v"(offQ));
    const int vb0 = (int)(uintptr_t)lds + v_rd_base(lane);
#define RESC(a) do { if (__any((a) < 1.f)) { if (hi == 0) al_l[r32] = (a); asm volatile("s_waitcnt lgkmcnt(0)" ::: "memory");              \
                     for (int d_ = 0; d_ < 4; ++d_) for (int r = 0; r < 16; ++r) o[d_][r] *= al_l[crow(r, hi)]; } } while (0)
#define KBASE(t) ((t) * KVBLK)
#define MASKT(P0_, P1_, t) do { const int kb_ = KBASE(t); if (kb_ + KVBLK - 1 > qlo) mask_tile(P0_, P1_, qm - kb_); } while (0)
    f32x16 pA0, pA1, pB0, pB1; float mnA, mnB, alA, alB; bf16x8 pa0, pa1, pa2, pa3;
    const int qro = OFF_QR + (wid * 8 * 64 + lane) * 16;
    { bf16x8 tq[8];
#pragma unroll
      for (int dd = 4; dd < 8; ++dd) tq[dd] = LDG8((const char*)cur.Q + 128 + dd * 32, offQ);
      const int pos = cur.POS[wid * QBLK + r32];
      float sn = 0.f, sr = 0.f;
#define UNP(F, x) const u32x4 w_ = __builtin_bit_cast(u32x4, F); float x[8] = {lo_bf(w_.x), hi_bf(w_.x), lo_bf(w_.y), hi_bf(w_.y), lo_bf(w_.z), hi_bf(w_.z), lo_bf(w_.w), hi_bf(w_.w)};
#pragma unroll
      for (int f = 0; f < 8; ++f) { UNP(S.qr[f], x)
#pragma unroll
          for (int e = 0; e < 8; ++e) sn += x[e] * x[e]; }
#pragma unroll
      for (int f = 4; f < 8; ++f) { UNP(tq[f], x)
#pragma unroll
          for (int e = 0; e < 8; ++e) sr += x[e] * x[e]; }
      { auto r0 = __builtin_amdgcn_permlane32_swap(__float_as_uint(sn), __float_as_uint(sn), false, false); sn = __uint_as_float(r0[0]) + __uint_as_float(r0[1]);
        auto r1 = __builtin_amdgcn_permlane32_swap(__float_as_uint(sr), __float_as_uint(sr), false, false); sr = __uint_as_float(r1[0]) + __uint_as_float(r1[1]); }
      const float rn = 1.f / sqrtf(sn * (1.f / 128.f) + RMS_EPS), rr = 1.f / sqrtf(sr * (1.f / 64.f) + RMS_EPS);
#pragma unroll
      for (int f = 0; f < 8; ++f) { UNP(S.qr[f], x)
          const f32x4 g0 = *(const f32x4*)(cur.QG + f * 16 + hi * 8), g1 = *(const f32x4*)(cur.QG + f * 16 + hi * 8 + 4);
          const float g[8] = {g0.x, g0.y, g0.z, g0.w, g1.x, g1.y, g1.z, g1.w};
          u32x4 o; o.x = cvt_pk_bf16(x[0] * rn * g[0], x[1] * rn * g[1]); o.y = cvt_pk_bf16(x[2] * rn * g[2], x[3] * rn * g[3]);
          o.z = cvt_pk_bf16(x[4] * rn * g[4], x[5] * rn * g[5]); o.w = cvt_pk_bf16(x[6] * rn * g[6], x[7] * rn * g[7]);
          S.qr[f] = __builtin_bit_cast(bf16x8, o); }
#pragma unroll
      for (int dd = 0; dd < 2; ++dd) {
          float x1[8], x2[8];
          { UNP(tq[4 + dd], x) for (int e = 0; e < 8; ++e) x1[e] = x[e]; }
          { UNP(tq[6 + dd], x) for (int e = 0; e < 8; ++e) x2[e] = x[e]; }
          const f32x4 ga0 = *(const f32x4*)(cur.QG + 128 + dd * 16 + hi * 8), ga1 = *(const f32x4*)(cur.QG + 128 + dd * 16 + hi * 8 + 4);
          const f32x4 gb0 = *(const f32x4*)(cur.QG + 160 + dd * 16 + hi * 8), gb1 = *(const f32x4*)(cur.QG + 160 + dd * 16 + hi * 8 + 4);
          const float ga[8] = {ga0.x, ga0.y, ga0.z, ga0.w, ga1.x, ga1.y, ga1.z, ga1.w}, gb[8] = {gb0.x, gb0.y, gb0.z, gb0.w, gb1.x, gb1.y, gb1.z, gb1.w};
          float o1[8], o2[8];
#pragma unroll
          for (int e = 0; e < 8; ++e) { float c, s; rope_cs(pos, dd * 16 + hi * 8 + e, c, s);
              const float a = x1[e] * rr * ga[e], b = x2[e] * rr * gb[e]; o1[e] = a * c - b * s; o2[e] = b * c + a * s; }
          u32x4 w1, w2; w1.x = cvt_pk_bf16(o1[0], o1[1]); w1.y = cvt_pk_bf16(o1[2], o1[3]); w1.z = cvt_pk_bf16(o1[4], o1[5]); w1.w = cvt_pk_bf16(o1[6], o1[7]);
          w2.x = cvt_pk_bf16(o2[0], o2[1]); w2.y = cvt_pk_bf16(o2[2], o2[3]); w2.z = cvt_pk_bf16(o2[4], o2[5]); w2.w = cvt_pk_bf16(o2[6], o2[7]);
          tq[4 + dd] = __builtin_bit_cast(bf16x8, w1); tq[6 + dd] = __builtin_bit_cast(bf16x8, w2);
      }
#undef UNP
#pragma unroll
      for (int dd = 0; dd < 4; ++dd) *(bf16x8*)(lds + qro + dd * 1024) = tq[4 + dd]; }
    SWRITE_HV(0); SBAR();
    if (NT > 1) SLOAD_H(cur, KBASE(1));
    SBAR(); qkt<0>(pA0, pA1, lds, r32, hi, S.qr, qro);
    MASKT(pA0, pA1, 0); partialSM(pA0, pA1, m_reg, mnA, alA);
    if (NT > 1) { VMW(); SWRITE_H(1); }
    __syncthreads();
#define HALF_STEP(PX0, PX1, mnX, alX, PY0, PY1, alY, t, KB, VB, SB) do {                                                      \
        SBAR(); qkt<KB>(PX0, PX1, lds, r32, hi, S.qr, qro);                                             \
        finishSM(PY0, PY1, alY, l_reg, pa0, pa1, pa2, pa3); SBAR();                                                           \
        if ((t) + 1 < NT) { SLOAD_H(cur, KBASE((t) + 1)); SBAR(); }                                               \
        pv_tile<VB>(o, vb0, pa0, pa1, pa2, pa3); MASKT(PX0, PX1, (t)); partialSM(PX0, PX1, m_reg, mnX, alX);                                        \
        __syncthreads();                                                                                                      \
        if ((t) + 1 < NT) { VMW(); SWRITE_H(SB); }                                                                          \
        RESC(alX); __syncthreads(); } while (0)
    for (int t = 1; t + 1 < NT; t += 2) {
        HALF_STEP(pB0, pB1, mnB, alB, pA0, pA1, alA, t, 1, 0, 0);
        HALF_STEP(pA0, pA1, mnA, alA, pB0, pB1, alB, t + 1, 0, 1, 1);
    }
    SBAR(); qkt<1>(pB0, pB1, lds, r32, hi, S.qr, qro); SBAR();
    finishSM(pA0, pA1, alA, l_reg, pa0, pa1, pa2, pa3); SBAR();
    pv_tile<0>(o, vb0, pa0, pa1, pa2, pa3);
    MASKT(pB0, pB1, NT - 1); partialSM(pB0, pB1, m_reg, mnB, alB); __syncthreads(); RESC(alB);
    finishSM(pB0, pB1, alB, l_reg, pa0, pa1, pa2, pa3); SBAR(); pv_tile<1>(o, vb0, pa0, pa1, pa2, pa3);
    if (hi == 0) li_l[r32] = l_reg; asm volatile("s_waitcnt lgkmcnt(0)" ::: "memory");
    float rli[16];
#pragma unroll
    for (int r = 0; r < 16; ++r) rli[r] = __builtin_amdgcn_rcpf(li_l[crow(r, hi)]);
    unsigned obase = (unsigned)((wid * QBLK + 4 * hi) * OS + r32) * 2u; asm volatile("" : "+v"(obase));
#pragma unroll
    for (int r = 0; r < 16; ++r) { const unsigned orow_off = (unsigned)(((r & 3) + 8 * (r >> 2)) * OS) * 2u;
#pragma unroll
        for (int d0 = 0; d0 < 4; ++d0) { const float v = o[d0][r] * rli[r];
            const float vn = DPPF(v, 0xB1);
            if ((r32 & 1) == 0) *(unsigned*)((char*)cur.O + (obase + orow_off + (unsigned)(d0 * 64))) = cvtpk(v, vn); } }
    __syncthreads();
#undef RESC
#undef KBASE
#undef MASKT
#undef HALF_STEP
}
#undef VMW
#undef VMWN
#undef SLOAD_H
#undef SWRITE_HK
#undef SWRITE_HV
#undef SWRITE_H
#undef QLOAD
#undef LDG8

__device__ __forceinline__ BlockRef make_ref(int bh, int qb, const bf16_t* q, const bf16_t* kv, const bf16_t* kr, bf16_t* mixed, const int* pos, const float* qg) {
    const int b = bh >> 3, h = bh & 7; BlockRef r;
    r.Q = q + ((size_t)b * SEQ + (size_t)qb * QB) * QS + h * 192;
    r.K = kv + (size_t)b * SEQ * KS + h * 256; r.V = r.K + 128;
    r.KR = kr + (size_t)b * SEQ * KRS;
    r.O = mixed + ((size_t)b * SEQ + (size_t)qb * QB) * OS + 512 + h * 128; r.P0 = qb * QB;
    r.POS = pos + (size_t)b * SEQ + (size_t)qb * QB; r.QG = qg;
    return r;
}
constexpr int N_BLOCKS = BATCH * 8 * NQB;
__device__ __forceinline__ void attn_one(char* lds, const bf16_t* q, const bf16_t* kv, const bf16_t* kr, bf16_t* mixed, int i, const int* pos, const float* qg, const int wv__) {
    Seam S;
    const BlockRef cur = make_ref(i & 63, NQB - 1 - (i >> 6), q, kv, kr, mixed, pos, qg);
    attn_prime(cur, lds, S, wv__);
    attn_block(cur, lds, S, wv__);
}
#undef KSWZ
#undef KRSWZ
#undef SBAR
}
namespace tok {
constexpr int PT = 32;
constexpr int NTILES = T / PT;
constexpr int S_VM = 1040, S_XW = 144, S_XG = 272;
constexpr int O_VM = 0, O_XR = O_VM + PT * S_VM, O_XK = O_XR + PT * S_VM, O_XW = O_XK + PT * S_VM, O_XA = O_XW + PT * S_XW, O_XG = O_XA + PT * S_XW, O_PAR = O_XG + PT * S_XG, O_WB = O_PAR + 6 * 2048, O_END = O_WB + 8 * 2560;
constexpr int LDS_BYTES = O_END;
constexpr size_t WL_W2 = 0, WL_A2 = WL_W2 + 512 * 64, WL_G2 = WL_A2 + 512 * 64, WL_V1 = WL_G2 + 512 * 128, WL_V2 = WL_V1 + 32 * 512, WL_END = WL_V2 + 512 * 32;

struct Args {
    const bf16_t* p; const int* pos;
    const float *k_gain;
    const float *mu, *w0, *a0, *v0, *k_k, *k_a, *r_k;
    const bf16_t* wl;
    float *rs_q, *rs_kv; bf16_t* kr;
    bf16_t *R, *K, *V, *KK, *B, *G, *BON, *VFIRST; float* W; float *RIN, *BS;
};
__device__ __forceinline__ float4 ld4f(const float* p) { return *(const float4*)p; }
__device__ __forceinline__ void bf4(u32x2 w, float* o) { o[0] = lo_bf(w.x); o[1] = hi_bf(w.x); o[2] = lo_bf(w.y); o[3] = hi_bf(w.y); }
__device__ __forceinline__ u32x2 pk4(const float* v) { u32x2 w; w.x = cvt_pk_bf16(v[0], v[1]); w.y = cvt_pk_bf16(v[2], v[3]); return w; }

__device__ __forceinline__ void wave_store_bf16(LAS unsigned char* wb, const u32x2 (&v)[4], bf16_t* gbase, int r32, int hi, int lane) {
#pragma unroll
    for (int g = 0; g < 4; ++g) *(LAS u32x2*)(wb + r32 * 80 + 16 * g + 8 * hi) = v[g];
    asm volatile("" ::: "memory");
#pragma unroll
    for (int i = 0; i < 2; ++i) { const int tk_ = i * 16 + (lane >> 2); const u32x4 x = *(const LAS u32x4*)(wb + tk_ * 80 + (lane & 3) * 16);
        *(u32x4*)((char*)gbase + (size_t)tk_ * 1024 + (lane & 3) * 16) = x; }
    asm volatile("" ::: "memory");
}
__device__ __forceinline__ void wave_store_f32h(LAS unsigned char* wb, const f32x4 (&v)[2], float* gbase, int r32, int hi, int lane) {
#pragma unroll
    for (int j = 0; j < 2; ++j) *(LAS f32x4*)(wb + r32 * 80 + (8 * j + 4 * hi) * 4) = v[j];
    asm volatile("" ::: "memory");
#pragma unroll
    for (int i = 0; i < 2; ++i) { const int tk_ = i * 16 + (lane >> 2); const f32x4 x = *(const LAS f32x4*)(wb + tk_ * 80 + (lane & 3) * 16);
        *(f32x4*)((char*)gbase + (size_t)tk_ * 2048 + (lane & 3) * 16) = x; }
    asm volatile("" ::: "memory");
}
__device__ __forceinline__ void stage_params(const Args& A, LAS unsigned char* lds, int tid) {
    LAS float* P = (LAS float*)(lds + O_PAR);
    P[tid] = A.w0[tid]; P[512 + tid] = A.a0[tid]; P[1024 + tid] = A.v0[tid]; P[1536 + tid] = A.k_k[tid]; P[2048 + tid] = A.k_a[tid]; P[2560 + tid] = A.r_k[tid];
}
template <int LAYER>
__device__ __forceinline__ void tile(const Args& A, LAS unsigned char* lds, int tl, const int wv__, const int mode = 7) {
    const int tid = TID(), lane = tid & 63, wid = __builtin_amdgcn_readfirstlane(tid >> 6), r32 = lane & 31, hi = lane >> 5;
    const int tok0 = tl * PT;
    const bf16_t* p = A.p;
    if (mode & 1) {
        u32x2 k4v[4]; bf16_t krv[4]; int posv[4];
#pragma unroll
        for (int i = 0; i < 4; ++i) {
            const int tk = tok0 + wid + 8 * i; const bf16_t* pr = p + (size_t)tk * NP;
            k4v[i] = *(const u32x2*)(pr + C_MKV + lane * 4); krv[i] = pr[C_MKR + lane]; posv[i] = A.pos[tk];
        }
        const float kg = A.k_gain[128 + lane];
#pragma unroll
        for (int i = 0; i < 4; ++i) {
            const int tk = tok0 + wid + 8 * i;
            const u32x2 k4 = k4v[i];
            float sk = 0.f;
            { float a; a = lo_bf(k4.x); sk += a * a; a = hi_bf(k4.x); sk += a * a; a = lo_bf(k4.y); sk += a * a; a = hi_bf(k4.y); sk += a * a; }
            const float kr = bf2f(krv[i]);
            float skr = kr * kr;
            sk = wave_sum(sk); skr = wave_sum(skr);
            if (lane == 0) A.rs_kv[tk] = 1.f / sqrtf(sk * (1.f / 256.f) + RMS_EPS);
            const float krn = kr * (1.f / sqrtf(skr * (1.f / 64.f) + RMS_EPS)) * kg;
            const float other = xor32f(krn, lane);
            float c, s; rope_cs(posv[i], lane & 31, c, s);
            const float o = (lane < 32) ? (krn * c - other * s) : (krn * c + other * s);
            A.kr[(size_t)tk * 64 + lane] = f2bf(o);
        }
    }
    if (mode & 2) {
#pragma unroll 1
    for (int it = 0; it < 7; ++it) {
        u32x4 cu[2], pv[2]; f32x4 m0[2], m1[2]; int tt[2], jj[2];
#pragma unroll
        for (int u = 0; u < 2; ++u) {
            const int task = tid + (2 * it + u) * 512;
            const int t = task / 224, j = task - t * 224; tt[u] = t; jj[u] = j;
            const int tk = tok0 + t; const bool first = (tk & (SEQ - 1)) == 0;
            const bf16_t* pr = p + (size_t)tk * NP + C_RR + 8 * j;
            cu[u] = *(const u32x4*)pr;
            pv[u] = (u32x4){0u, 0u, 0u, 0u};
            if (!first) pv[u] = *(const u32x4*)(pr - NP);
            m0[u] = *(const f32x4*)(A.mu + 8 * j); m1[u] = *(const f32x4*)(A.mu + 8 * j + 4);
        }
#pragma unroll
        for (int u = 0; u < 2; ++u) {
            const int t = tt[u], j = jj[u];
            const float mu[8] = {m0[u].x, m0[u].y, m0[u].z, m0[u].w, m1[u].x, m1[u].y, m1[u].z, m1[u].w};
            const float c8[8] = {lo_bf(cu[u].x), hi_bf(cu[u].x), lo_bf(cu[u].y), hi_bf(cu[u].y), lo_bf(cu[u].z), hi_bf(cu[u].z), lo_bf(cu[u].w), hi_bf(cu[u].w)};
            const float p8[8] = {lo_bf(pv[u].x), hi_bf(pv[u].x), lo_bf(pv[u].y), hi_bf(pv[u].y), lo_bf(pv[u].z), hi_bf(pv[u].z), lo_bf(pv[u].w), hi_bf(pv[u].w)};
            float o[8];
#pragma unroll
            for (int i = 0; i < 8; ++i) o[i] = c8[i] + (p8[i] - c8[i]) * mu[i];
            if (j >= 192) {
#pragma unroll
                for (int i = 0; i < 8; ++i) { const float m = o[i]; const float e = fast_exp(j < 200 ? 2.f * m : -m); const float r = fast_rcp(e + 1.f);
                    o[i] = j < 200 ? 1.f - 2.f * r : (j < 208 ? m : r); }
            }
            u32x4 w; w.x = cvt_pk_bf16(o[0], o[1]); w.y = cvt_pk_bf16(o[2], o[3]); w.z = cvt_pk_bf16(o[4], o[5]); w.w = cvt_pk_bf16(o[6], o[7]);
            int off;
            if (j < 64) off = O_XR + t * S_VM + j * 16; else if (j < 128) off = O_XK + t * S_VM + (j - 64) * 16; else if (j < 192) off = O_VM + t * S_VM + (j - 128) * 16;
            else if (j < 200) off = O_XW + t * S_XW + (j - 192) * 16; else if (j < 208) off = O_XA + t * S_XW + (j - 200) * 16; else off = O_XG + t * S_XG + (j - 208) * 16;
            *(LAS u32x4*)(lds + off) = w;
        }
    }
    }
    __syncthreads();
    const int h = wid;
    unsigned wo64 = (unsigned)(r32 * 64 + hi * 8) * 2u, wo128 = (unsigned)(r32 * 128 + hi * 8) * 2u, wo32 = (unsigned)(r32 * 32 + hi * 8) * 2u, wo512 = (unsigned)(r32 * 512 + hi * 8) * 2u;
#define GLD8(base, off) (*(const bf16x8*)((const char*)(base) + (off)))
    const bf16_t* w2t = A.wl + WL_W2 + (size_t)(h * 64) * 64; const bf16_t* a2t = A.wl + WL_A2 + (size_t)(h * 64) * 64;
    const bf16_t* g2t = A.wl + WL_G2 + (size_t)(h * 64) * 128; const bf16_t* v2p = A.wl + WL_V2 + (size_t)(h * 64) * 32; const bf16_t* v1t = A.wl + WL_V1;
    if (mode & 4) {
        constexpr int nb = 0;
        asm volatile("" : "+v"(wo64), "+v"(wo128), "+v"(wo32), "+v"(wo512));
        const int trow = nb * 32 + r32;
        const int tk = tok0 + trow; const bool first = (tk & (SEQ - 1)) == 0;
        unsigned e512 = (unsigned)(trow * 512 + 4 * hi);
        asm volatile("" : "+v"(e512));
        const size_t t512 = (size_t)tok0 * 512;
#define CB (h * 64 + mb * 32 + 8 * g)
#define PL4(idx) (*(const LAS f32x4*)(lds + O_PAR + (idx) * 2048 + (CB + 4 * hi) * 4))
#define A2(ptr) ((char*)((ptr) + t512 + CB) + e512 * 2u)
#define A4(ptr) ((char*)((ptr) + t512 + CB) + e512 * 4u)
        bf16x8 vvf[2];
        if (LAYER > 0) {
            f32x16 vv = f32x16{};
#pragma unroll 4
            for (int ks = 0; ks < 32; ++ks) {
                const bf16x8 bv = *(const LAS bf16x8*)(lds + O_VM + trow * S_VM + (ks * 16 + hi * 8) * 2);
                const bf16x8 av = GLD8(v1t + ks * 16, wo512);
                vv = __builtin_amdgcn_mfma_f32_32x32x16_bf16(av, bv, vv, 0, 0, 0);
            }
#pragma unroll
            for (int s = 0; s < 2; ++s) {
                u32x4 bw; bw.x = cvt_pk_bf16(vv[8 * s + 0], vv[8 * s + 1]); bw.y = cvt_pk_bf16(vv[8 * s + 2], vv[8 * s + 3]); bw.z = cvt_pk_bf16(vv[8 * s + 4], vv[8 * s + 5]); bw.w = cvt_pk_bf16(vv[8 * s + 6], vv[8 * s + 7]);
                vvf[s] = __builtin_bit_cast(bf16x8, bw);
            }
        }
        float ss = 0.f, bs = 0.f;
#pragma unroll
        for (int mb = 0; mb < 2; ++mb) {
            f32x16 accW = f32x16{}, accA = f32x16{}, accG = f32x16{}, accV = f32x16{};
            u32x2 vfraw[4];
            if (LAYER > 0) {
#pragma unroll
                for (int g = 0; g < 4; ++g) vfraw[g] = *(const u32x2*)A2(A.VFIRST);
            }
#pragma unroll
            for (int ks = 0; ks < 4; ++ks) {
                const bf16x8 bw = *(const LAS bf16x8*)(lds + O_XW + trow * S_XW + (ks * 16 + hi * 8) * 2);
                const bf16x8 ba = *(const LAS bf16x8*)(lds + O_XA + trow * S_XW + (ks * 16 + hi * 8) * 2);
                const bf16x8 aw = GLD8(w2t + mb * 32 * 64 + ks * 16, wo64);
                const bf16x8 aa = GLD8(a2t + mb * 32 * 64 + ks * 16, wo64);
                accW = __builtin_amdgcn_mfma_f32_32x32x16_bf16(aw, bw, accW, 0, 0, 0);
                accA = __builtin_amdgcn_mfma_f32_32x32x16_bf16(aa, ba, accA, 0, 0, 0);
            }
#pragma unroll
            for (int ks = 0; ks < 8; ++ks) {
                const bf16x8 bg = *(const LAS bf16x8*)(lds + O_XG + trow * S_XG + (ks * 16 + hi * 8) * 2);
                const bf16x8 ag = GLD8(g2t + mb * 32 * 128 + ks * 16, wo128);
                accG = __builtin_amdgcn_mfma_f32_32x32x16_bf16(ag, bg, accG, 0, 0, 0);
            }
            if (LAYER > 0) {
#pragma unroll
                for (int s = 0; s < 2; ++s) {
                    const bf16x8 a2 = GLD8(v2p + mb * 32 * 32 + s * 16, wo32);
                    accV = __builtin_amdgcn_mfma_f32_32x32x16_bf16(a2, vvf[s], accV, 0, 0, 0);
                }
            }
            asm volatile("" ::: "memory");
            f32x4 oW[4]; u32x2 oG[4], oV[4], oR[4], oK[4], oKK[4], oB[4];
#pragma unroll
            for (int g = 0; g < 4; ++g) {
                const f32x4 w0 = PL4(0), a0 = PL4(1);
                const float w0a[4] = {w0.x, w0.y, w0.z, w0.w}, a0a[4] = {a0.x, a0.y, a0.z, a0.w};
                float dec[4], gt[4], av[4];
#pragma unroll
                for (int i = 0; i < 4; ++i) {
                    dec[i] = fast_exp(-0.6065306597126334f * sigmoidf_(accW[4 * g + i] + w0a[i]));
                    gt[i] = accG[4 * g + i];
                    av[i] = sigmoidf_(accA[4 * g + i] + a0a[i]);
                }
                oW[g] = (f32x4){dec[0], dec[1], dec[2], dec[3]};
                oG[g] = pk4(gt);
                float vm[4]; bf4(*(const LAS u32x2*)(lds + O_VM + trow * S_VM + (CB + 4 * hi) * 2), vm);
                float vf[4];
                if (LAYER > 0) {
                    const f32x4 v0 = PL4(2); const float v0a[4] = {v0.x, v0.y, v0.z, v0.w};
                    float vfi[4]; bf4(vfraw[g], vfi);
#pragma unroll
                    for (int i = 0; i < 4; ++i) vf[i] = vm[i] + (vfi[i] - vm[i]) * sigmoidf_(accV[4 * g + i] + v0a[i]);
                } else {
#pragma unroll
                    for (int i = 0; i < 4; ++i) vf[i] = vm[i];
                }
                oV[g] = pk4(vf);
                float xr[4], xk4[4];
                const u32x2 xrraw = *(const LAS u32x2*)(lds + O_XR + trow * S_VM + (CB + 4 * hi) * 2);
                bf4(xrraw, xr); bf4(*(const LAS u32x2*)(lds + O_XK + trow * S_VM + (CB + 4 * hi) * 2), xk4);
                const f32x4 kk4 = PL4(3), ka4 = PL4(4), rk4 = PL4(5);
                const float kka[4] = {kk4.x, kk4.y, kk4.z, kk4.w}, kaa[4] = {ka4.x, ka4.y, ka4.z, ka4.w}, rka[4] = {rk4.x, rk4.y, rk4.z, rk4.w};
                float k2[4], kkv[4], bn[4];
#pragma unroll
                for (int i = 0; i < 4; ++i) {
                    const float xk = xk4[i];
                    kkv[i] = xk * kka[i];
                    ss += kkv[i] * kkv[i];
                    k2[i] = xk * (1.f + (av[i] - 1.f) * kaa[i]);
                    bs += xr[i] * k2[i] * rka[i];
                    bn[i] = -kkv[i] * av[i];
                }
                oR[g] = xrraw; oK[g] = pk4(k2); oKK[g] = pk4(kkv); oB[g] = pk4(bn);
            }
#ifdef TOKPROBE
            if (mode & 8) { unsigned cs = 0u;
#pragma unroll
              for (int g = 0; g < 4; ++g) cs ^= oG[g].x ^ oG[g].y ^ oV[g].x ^ oV[g].y ^ oR[g].x ^ oR[g].y ^ oK[g].x ^ oK[g].y ^ oKK[g].x ^ oKK[g].y ^ oB[g].x ^ oB[g].y ^ __float_as_uint(oW[g].x) ^ __float_as_uint(oW[g].y) ^ __float_as_uint(oW[g].z) ^ __float_as_uint(oW[g].w);
              if (cs == 0x12345679u) A.G[(size_t)tok0 * 512 + lane] = 1; } else
#endif
            { LAS unsigned char* wb = lds + O_WB + wid * 2560;
              const size_t eb = (size_t)tok0 * 512 + h * 64 + mb * 32;
              wave_store_bf16(wb, oG, A.G + eb, r32, hi, lane);
              wave_store_bf16(wb, oV, A.V + eb, r32, hi, lane);
              if (LAYER == 0) wave_store_bf16(wb, oV, A.VFIRST + eb, r32, hi, lane);
              wave_store_bf16(wb, oR, A.R + eb, r32, hi, lane);
              wave_store_bf16(wb, oK, A.K + eb, r32, hi, lane);
              wave_store_bf16(wb, oKK, A.KK + eb, r32, hi, lane);
              wave_store_bf16(wb, oB, A.B + eb, r32, hi, lane);
              { const f32x4 w01[2] = {oW[0], oW[1]}, w23[2] = {oW[2], oW[3]};
                wave_store_f32h(wb, w01, A.W + eb, r32, hi, lane); wave_store_f32h(wb, w23, A.W + eb + 16, r32, hi, lane); } }
        }
        { auto r0 = __builtin_amdgcn_permlane32_swap(__float_as_uint(ss), __float_as_uint(ss), false, false); ss = __uint_as_float(r0[0]) + __uint_as_float(r0[1]);
          auto r1 = __builtin_amdgcn_permlane32_swap(__float_as_uint(bs), __float_as_uint(bs), false, false); bs = __uint_as_float(r1[0]) + __uint_as_float(r1[1]); }
        if (hi == 0) { A.RIN[(size_t)tk * 8 + h] = 1.f / fmaxf(sqrtf(ss), 1e-12f); A.BS[(size_t)tk * 8 + h] = bs; }
    }
#undef CB
#undef PL4
#undef A2
#undef A4
#undef GLD8
    __syncthreads();
}
__device__ __forceinline__ void lora_prep(const float* w2, const float* a2, const float* g2, const float* v1, const float* v2, bf16_t* wl, int gtid, int nthr) {
    for (int i = gtid; i < 512 * 64; i += nthr) { const int n = i >> 6, k = i & 63; wl[WL_W2 + i] = f2bf(w2[k * 512 + n]); wl[WL_A2 + i] = f2bf(a2[k * 512 + n]); }
    for (int i = gtid; i < 512 * 128; i += nthr) { const int n = i >> 7, k = i & 127; wl[WL_G2 + i] = f2bf(g2[k * 512 + n]); }
    if (v1) {
        for (int i = gtid; i < 32 * 512; i += nthr) { const int j = i >> 9, k = i & 511; wl[WL_V1 + i] = f2bf(v1[k * 32 + j]); }
        for (int i = gtid; i < 512 * 32; i += nthr) { const int n = i >> 5, q = i & 31, s = q >> 4, hh = (q >> 3) & 1, jj = q & 7;
            const int kidx = 16 * s + 8 * (jj >> 2) + 4 * hh + (jj & 3); wl[WL_V2 + i] = f2bf(v2[kidx * 512 + n]); }
    }
}
}
struct Ptrs {
    const float* in[30]; float* out; unsigned char* ws;
};
__device__ __forceinline__ void transpose_item(const float* W, int K, int N, bf16_t* WT, const float* gain, int mode, LAS float* scr, int item, int lane) {
    const int nblk = N / 64, kb = item / nblk, nb = item % nblk, k0 = 64 * kb, n0 = 64 * nb;
#pragma unroll 64
    for (int kk = 0; kk < 64; ++kk) { const float g = gain ? gain[k0 + kk] : 1.f; scr[kk * 65 + lane] = W[(size_t)(k0 + kk) * N + n0 + lane] * g; }
    asm volatile("s_waitcnt lgkmcnt(0)" ::: "memory");
    const int c = lane & 7;
#pragma unroll
    for (int j = 0; j < 8; ++j) { const int n = (lane >> 3) + 8 * j; const LAS float* s = scr + (8 * c) * 65 + n;
        u32x4 o; o.x = cvt_pk_bf16(s[0 * 65], s[1 * 65]); o.y = cvt_pk_bf16(s[2 * 65], s[3 * 65]); o.z = cvt_pk_bf16(s[4 * 65], s[5 * 65]); o.w = cvt_pk_bf16(s[6 * 65], s[7 * 65]);
        const int ng = n0 + n; int drow = ng;
        if (mode == 1) { if (ng < FF) drow = 256 * (ng >> 7) + (ng & 127); else { const int f = ng - FF; drow = 256 * (f >> 7) + 128 + (f & 127); } }
        *(u32x4*)(WT + (size_t)drow * K + k0 + 8 * c) = o; }
    asm volatile("s_waitcnt lgkmcnt(0)" ::: "memory");
}
typedef const Ptrs __attribute__((address_space(4)))* PtrTab;
constexpr int CV_IN = (DM / 64) * (INW / 64), CV_QB = (512 / 64) * (QW / 64), CV_KVB = (256 / 64) * (KVW / 64), CV_O = (DM / 64) * (DM / 64),
              CV_GU = (DM / 64) * (2 * FF / 64), CV_DN = (FF / 64) * (DM / 64);
constexpr int CV_NI = CV_IN + CV_QB + CV_KVB + CV_O + CV_GU + CV_DN;
__device__ __forceinline__ void convert_wave_item(PtrTab pt, int l, int it, LAS float* scr, int lane) {
    unsigned char* wl = pt->ws + WS_W + (size_t)l * W_LAYER;
    int r = it;
    if (r < CV_IN) { transpose_item(pt->in[3] + (size_t)l * DM * INW, DM, INW, (bf16_t*)(wl + WO_IN), pt->in[2] + l * DM, 0, scr, r, lane); return; } r -= CV_IN;
    if (r < CV_QB) { transpose_item(pt->in[7] + (size_t)l * 512 * QW, 512, QW, (bf16_t*)(wl + WO_QB), pt->in[6] + l * 512, 0, scr, r, lane); return; } r -= CV_QB;
    if (r < CV_KVB) { transpose_item(pt->in[9] + (size_t)l * 256 * KVW, 256, KVW, (bf16_t*)(wl + WO_KVB), pt->in[8] + l * 256, 0, scr, r, lane); return; } r -= CV_KVB;
    if (r < CV_O) { transpose_item(pt->in[26] + (size_t)l * DM * DM, DM, DM, (bf16_t*)(wl + WO_O), nullptr, 0, scr, r, lane); return; } r -= CV_O;
    if (r < CV_GU) { transpose_item(pt->in[28] + (size_t)l * DM * 2 * FF, DM, 2 * FF, (bf16_t*)(wl + WO_GU), pt->in[27] + l * DM, 1, scr, r, lane); return; } r -= CV_GU;
    transpose_item(pt->in[29] + (size_t)l * FF * DM, FF, DM, (bf16_t*)(wl + WO_DN), nullptr, 0, scr, r, lane);
}
__device__ __forceinline__ void convert_misc(PtrTab pt, int l, int gtid, int nthr) {
    unsigned char* wl = pt->ws + WS_W + (size_t)l * W_LAYER;
    { u32x4* z = (u32x4*)(wl + WO_IN + (size_t)INW * DM * 2); const int n16 = (NP - INW) * DM * 2 / 16;
      for (int i = gtid; i < n16; i += nthr) z[i] = (u32x4){0u, 0u, 0u, 0u}; }
    tok::lora_prep(pt->in[14] + (size_t)l * 64 * 512, pt->in[16] + (size_t)l * 64 * 512, pt->in[17] + (size_t)l * 128 * 512,
                   l > 0 ? pt->in[19] + (size_t)(l - 1) * 512 * 32 : nullptr, l > 0 ? pt->in[20] + (size_t)(l - 1) * 32 * 512 : nullptr,
                   (bf16_t*)(wl + WO_LORA), gtid, nthr);
}
constexpr int CV_TI = (CV_NI + 63) / 64, CV_MISC = 8, CV_ITEMS = CV_TI + CV_MISC;
constexpr int CV_EARLY = CV_IN + CV_QB + CV_KVB;
constexpr int CV_LATE0 = (CV_NI - CV_EARLY + 63) / 64;
__device__ __forceinline__ void convert_queue_item(PtrTab pt, int l, int ci, LAS float* scr, int wid, int lane) {
    asm volatile("" : "+s"(pt));
    if (ci < CV_TI) {
        for (int k = 0; k < 8; ++k) { const int it = ci * 64 + k * 8 + wid; if (it < CV_NI) convert_wave_item(pt, l, it, scr, lane); }
    } else if (ci < CV_ITEMS) convert_misc(pt, l, (ci - CV_TI) * 512 + wid * 64 + lane, CV_MISC * 512);
    else { for (int k = 0; k < 8; ++k) { const int it = CV_EARLY + (ci - CV_ITEMS) * 64 + k * 8 + wid; if (it < CV_NI) convert_wave_item(pt, 0, it, scr, lane); } }
}
__device__ __forceinline__ void prologue_phase(PtrTab pt, LAS float* scr, int gw, int ngw, int lane) {
#ifdef CONV_IN_MIXERS
    for (int it = gw; it < CV_NI; it += ngw) convert_wave_item(pt, 0, it, scr, lane);
    convert_misc(pt, 0, gw * 64 + lane, ngw * 64);
#else
    for (int l = 0; l < DEPTH; ++l) {
        for (int it = gw; it < CV_NI; it += ngw) convert_wave_item(pt, l, it, scr, lane);
        convert_misc(pt, l, gw * 64 + lane, ngw * 64);
    }
#endif
    const float* x_in = pt->in[0]; const float* hb_in = pt->in[4]; unsigned char* ws_ = pt->ws;
    { bf16_t* xb = (bf16_t*)(ws_ + WS_XB); float* ssa = (float*)(ws_ + WS_SSA);
      for (int m0 = gw; m0 < T; m0 += 2 * ngw) {
        f32x4 v[2][8];
#pragma unroll
        for (int u = 0; u < 2; ++u) { const f32x4* xr = (const f32x4*)(x_in + (size_t)(m0 + u * ngw) * DM) + lane;
#pragma unroll
          for (int j = 0; j < 8; ++j) v[u][j] = xr[64 * j]; }
#pragma unroll
        for (int u = 0; u < 2; ++u) {
          const int m = m0 + u * ngw; float s = 0.f;
#pragma unroll
          for (int j = 0; j < 8; ++j) s += (v[u][j].x * v[u][j].x + v[u][j].y * v[u][j].y) + (v[u][j].z * v[u][j].z + v[u][j].w * v[u][j].w);
          s = wave_sum(s);
          if (lane < 32) ssa[(size_t)m * 32 + lane] = lane == 0 ? s : 0.f;
          u32x2* o = (u32x2*)(xb + (size_t)m * DM) + lane;
#pragma unroll
          for (int j = 0; j < 8; ++j) { u32x2 w; w.x = cvt_pk_bf16(v[u][j].x, v[u][j].y); w.y = cvt_pk_bf16(v[u][j].z, v[u][j].w); o[64 * j] = w; }
        }
      } }
    { float* lb = (float*)(ws_ + WS_LB); const float* hb = hb_in;
      for (int c = gw * 64 + lane; c < 512; c += ngw * 64) {
          float v[DEPTH], mx = -1e30f, s = 0.f;
          for (int l = 0; l < DEPTH; ++l) { v[l] = hb[l * 512 + c]; mx = fmaxf(mx, v[l]); }
          for (int l = 0; l < DEPTH; ++l) { v[l] = expf(v[l] - mx); s += v[l]; }
          float cum = 0.f; const float inv = 1.f / s;
          for (int l = 0; l < DEPTH; ++l) { cum += v[l] * inv; lb[l * 512 + c] = cum - v[0] * inv; }
      } }
}

__device__ __forceinline__ void rownorm_phase(const float* x, bf16_t* xb, float* rs, int gw, int ngw, int lane) {
    for (int m = gw; m < T; m += ngw) {
        const f32x4* xr = (const f32x4*)(x + (size_t)m * DM) + lane;
        f32x4 v[8]; float s = 0.f;
#pragma unroll
        for (int j = 0; j < 8; ++j) { v[j] = xr[64 * j]; s += (v[j].x * v[j].x + v[j].y * v[j].y) + (v[j].z * v[j].z + v[j].w * v[j].w); }
        s = wave_sum(s);
        if (lane == 0) rs[m] = 1.f / sqrtf(s * (1.f / DM) + RMS_EPS);
        u32x2* o = (u32x2*)(xb + (size_t)m * DM) + lane;
#pragma unroll
        for (int j = 0; j < 8; ++j) { u32x2 w; w.x = cvt_pk_bf16(v[j].x, v[j].y); w.y = cvt_pk_bf16(v[j].z, v[j].w); o[64 * j] = w; }
    }
}

__device__ __forceinline__ void qknorm_phase(bf16_t* q, bf16_t* kv, const int* pos, const float* q_gain, const float* k_gain, int gw, int ngw, int lane, bf16_t* qo = nullptr, bf16_t* kvo = nullptr) {
    if (!qo) { qo = q; kvo = kv; }
    const float gk0 = k_gain[2 * lane], gk1 = k_gain[2 * lane + 1];
#pragma unroll 2
    for (int tk = gw; tk < T; tk += ngw) {
        bf16_t* qrow = q + (size_t)tk * QW; bf16_t* krow = kv + (size_t)tk * KVW; bf16_t* qorow = qo + (size_t)tk * QW; bf16_t* korow = kvo + (size_t)tk * KVW;
#pragma unroll
        for (int h = 0; h < 8; ++h) {
            const unsigned kn = *(const unsigned*)(krow + h * 256 + 2 * lane);
            const float b0 = lo_bf(kn), b1 = hi_bf(kn);
            const float sk = wave_sum(b0 * b0 + b1 * b1);
            const float rk = 1.f / sqrtf(sk * (1.f / 128.f) + RMS_EPS);
            *(unsigned*)(korow + h * 256 + 2 * lane) = cvt_pk_bf16(b0 * rk * gk0, b1 * rk * gk1);
        }
    }
}
namespace rwk {
constexpr int TC = 64;
constexpr int NCH = SEQ / TC;
constexpr int N_ITEMS = BATCH * 8 * 2;
constexpr int OPS = 320;
constexpr int VS = TC + 4;
constexpr int L_KK = 0, L_W = 64, L_BN = 128, L_KP = 192, L_R = 256, L_V = TC * OPS, L_Y = L_V + 32 * VS, L_DUM = L_Y + 32 * VS, L_END = L_DUM + 512 * 4;
constexpr int LDS_BYTES = L_END * 4;
struct Args { const bf16_t *R, *K, *KK, *B; bf16_t* V; const float* W; const float* RIN; bf16_t* Yout; };

__device__ __forceinline__ float dpp_xor1(float x) { return __int_as_float(__builtin_amdgcn_update_dpp(0, __float_as_int(x), 0xB1, 0xf, 0xf, true)); }
__device__ __forceinline__ float dpp_xor2(float x) { return __int_as_float(__builtin_amdgcn_update_dpp(0, __float_as_int(x), 0x4E, 0xf, 0xf, true)); }
__device__ __forceinline__ float dpp_hmir(float x) { return __int_as_float(__builtin_amdgcn_update_dpp(0, __float_as_int(x), 0x141, 0xf, 0xf, true)); }
__device__ __forceinline__ float red8(float x) { x += dpp_xor1(x); x += dpp_xor2(x); x += dpp_hmir(x); return x; }

struct Pre { u32x4 r, k, v, kk, b; f32x4 w0, w1; float rin; };
__device__ __forceinline__ void pre_load(Pre& q, const Args& A, size_t off, bool hasv) {
    q.r = *(const u32x4*)(A.R + off); q.k = *(const u32x4*)(A.K + off); q.kk = *(const u32x4*)(A.KK + off); q.b = *(const u32x4*)(A.B + off);
    if (hasv) q.v = *(const u32x4*)(A.V + off);
    q.w0 = *(const f32x4*)(A.W + off); q.w1 = *(const f32x4*)(A.W + off + 4);
    q.rin = A.RIN[(off >> 9) * 8 + ((off >> 6) & 7)];
}
__device__ __forceinline__ void st8(LAS float* d, u32x4 w, float sc = 1.f) {
    *(LAS f32x4*)d = (f32x4){lo_bf(w.x) * sc, hi_bf(w.x) * sc, lo_bf(w.y) * sc, hi_bf(w.y) * sc}; *(LAS f32x4*)(d + 4) = (f32x4){lo_bf(w.z) * sc, hi_bf(w.z) * sc, lo_bf(w.w) * sc, hi_bf(w.w) * sc};
}

template <int VAR = 0>
__device__ __forceinline__ void item(const Args& A, LAS float* lds, int it, const int wv__) {
    const int tid = TID(), bh = it >> 1, half = it & 1, b = bh >> 3, h = bh & 7;
    const int st = tid >> 3, sc8 = (tid & 7) * 8;
    const bool hasv = ((tid & 7) >> 2) == half;
    const int vc8 = sc8 - half * 32;
    const size_t base = (size_t)b * SEQ * 512 + h * 64;
    const int row = tid >> 3, kp = tid & 7;
    f32x2 s0[4];
#pragma unroll
    for (int i = 0; i < 4; ++i) s0[i] = (f32x2){0.f, 0.f};
    Pre pre; pre_load(pre, A, base + (size_t)st * 512 + sc8, hasv);
    for (int ck = 0; ck < NCH; ++ck) {
        { const int o = st * OPS + sc8;
          st8(lds + L_R + o, pre.r); st8(lds + L_KP + o, pre.k); st8(lds + L_KK + o, pre.kk, pre.rin); st8(lds + L_BN + o, pre.b, pre.rin);
          *(LAS f32x4*)(lds + L_W + o) = pre.w0; *(LAS f32x4*)(lds + L_W + o + 4) = pre.w1;
          if (hasv) { LAS float* vd = lds + L_V + vc8 * VS + st;
            vd[0 * VS] = lo_bf(pre.v.x); vd[1 * VS] = hi_bf(pre.v.x); vd[2 * VS] = lo_bf(pre.v.y); vd[3 * VS] = hi_bf(pre.v.y);
            vd[4 * VS] = lo_bf(pre.v.z); vd[5 * VS] = hi_bf(pre.v.z); vd[6 * VS] = lo_bf(pre.v.w); vd[7 * VS] = hi_bf(pre.v.w); } }
        __syncthreads();
        if (ck + 1 < NCH) pre_load(pre, A, base + (size_t)((ck + 1) * TC + st) * 512 + sc8, hasv);
        if (tid < 256) {
            const LAS float* pk = lds + 8 * kp;
            const LAS float* pv = lds + L_V + row * VS;
            LAS float* pyw = kp == 0 ? lds + L_Y + row * VS : lds + L_DUM + tid * 4;
            const int pyinc = kp == 0 ? 4 : 0;
#define RW_LOAD(P, t_) do { const LAS float* q_ = pk + (t_) * OPS; \
                P##kk0 = *(const LAS f32x4*)(q_ + L_KK); P##kk1 = *(const LAS f32x4*)(q_ + L_KK + 4); \
                P##w0 = *(const LAS f32x4*)(q_ + L_W); P##w1 = *(const LAS f32x4*)(q_ + L_W + 4); \
                P##b0 = *(const LAS f32x4*)(q_ + L_BN); P##b1 = *(const LAS f32x4*)(q_ + L_BN + 4); \
                P##k0 = *(const LAS f32x4*)(q_ + L_KP); P##k1 = *(const LAS f32x4*)(q_ + L_KP + 4); \
                P##r0 = *(const LAS f32x4*)(q_ + L_R); P##r1 = *(const LAS f32x4*)(q_ + L_R + 4); } while (0)
#define F2(v4, i) ((f32x2){(v4)[2 * (i)], (v4)[2 * (i) + 1]})
#define RW_DOT(S, A0, A1) ({ f32x2 p_ = S[0] * F2(A0, 0); p_ = __builtin_elementwise_fma(S[1], F2(A0, 1), p_); p_ = __builtin_elementwise_fma(S[2], F2(A1, 0), p_); p_ = __builtin_elementwise_fma(S[3], F2(A1, 1), p_); p_.x + p_.y; })
#define RW_STEP(P, v_, yo_) do { \
                float sa0 = RW_DOT(s0, P##kk0, P##kk1); \
                const f32x2 va = (f32x2){v_, v_}; \
                f32x2 ta[4]; \
                ta[0] = va * F2(P##k0, 0); ta[1] = va * F2(P##k0, 1); ta[2] = va * F2(P##k1, 0); ta[3] = va * F2(P##k1, 1); \
                sa0 = red8(sa0); \
                const f32x2 sA = (f32x2){sa0, sa0}; \
                ta[0] = __builtin_elementwise_fma(sA, F2(P##b0, 0), ta[0]); ta[1] = __builtin_elementwise_fma(sA, F2(P##b0, 1), ta[1]); \
                ta[2] = __builtin_elementwise_fma(sA, F2(P##b1, 0), ta[2]); ta[3] = __builtin_elementwise_fma(sA, F2(P##b1, 1), ta[3]); \
                s0[0] = __builtin_elementwise_fma(s0[0], F2(P##w0, 0), ta[0]); s0[1] = __builtin_elementwise_fma(s0[1], F2(P##w0, 1), ta[1]); \
                s0[2] = __builtin_elementwise_fma(s0[2], F2(P##w1, 0), ta[2]); s0[3] = __builtin_elementwise_fma(s0[3], F2(P##w1, 1), ta[3]); \
                float y0 = RW_DOT(s0, P##r0, P##r1); \
                yo_ = red8(y0); } while (0)
            f32x4 Akk0, Akk1, Aw0, Aw1, Ab0, Ab1, Ak0, Ak1, Ar0, Ar1;
            f32x4 Bkk0, Bkk1, Bw0, Bw1, Bb0, Bb1, Bk0, Bk1, Br0, Br1;
            RW_LOAD(A, 0);
            f32x4 v4 = *(const LAS f32x4*)pv;
#pragma unroll 1
            for (int t = 0; t < TC; t += 4) {
                const f32x4 vn = *(const LAS f32x4*)(pv + t + 4);
                f32x4 y4;
                RW_LOAD(B, t + 1); RW_STEP(A, v4.x, y4.x);
                RW_LOAD(A, t + 2); RW_STEP(B, v4.y, y4.y);
                RW_LOAD(B, t + 3); RW_STEP(A, v4.z, y4.z);
                RW_LOAD(A, t + 4); RW_STEP(B, v4.w, y4.w);
                *(LAS f32x4*)pyw = y4; pyw += pyinc;
                v4 = vn;
            }
#undef RW_LOAD
#undef RW_DOT
#undef RW_STEP
#undef F2
        }
        __syncthreads();
        if (tid >= 256) {
            const int t = (tid - 256) >> 2, c8 = (tid & 3) * 8;
            const LAS float* yr = lds + L_Y + c8 * VS + t;
            u32x4 w; w.x = cvt_pk_bf16(yr[0 * VS], yr[1 * VS]); w.y = cvt_pk_bf16(yr[2 * VS], yr[3 * VS]); w.z = cvt_pk_bf16(yr[4 * VS], yr[5 * VS]); w.w = cvt_pk_bf16(yr[6 * VS], yr[7 * VS]);
            *(u32x4*)(A.Yout + base + (size_t)(ck * TC + t) * 512 + half * 32 + c8) = w;
        }
    }
    __syncthreads();
}

struct PostArgs { const bf16_t *Y, *G, *BON; const float *ln_w, *ln_b, *BS; bf16_t* mixed; };
__device__ __forceinline__ void post_phase(const PostArgs& A, int gw, int ngw, int lane) {
    float lnw[8], lnb[8];
#pragma unroll
    for (int i = 0; i < 8; ++i) { lnw[i] = A.ln_w[lane * 8 + i]; lnb[i] = A.ln_b[lane * 8 + i]; }
    for (int tk = gw; tk < T; tk += ngw) {
        const size_t o = (size_t)tk * 512 + lane * 8;
        const u32x4 y4 = *(const u32x4*)(A.Y + o), g4 = *(const u32x4*)(A.G + o), b4 = *(const u32x4*)(A.BON + o);
        float y[8] = {lo_bf(y4.x), hi_bf(y4.x), lo_bf(y4.y), hi_bf(y4.y), lo_bf(y4.z), hi_bf(y4.z), lo_bf(y4.w), hi_bf(y4.w)};
        const float g[8] = {lo_bf(g4.x), hi_bf(g4.x), lo_bf(g4.y), hi_bf(g4.y), lo_bf(g4.z), hi_bf(g4.z), lo_bf(g4.w), hi_bf(g4.w)};
        const float bo[8] = {lo_bf(b4.x), hi_bf(b4.x), lo_bf(b4.y), hi_bf(b4.y), lo_bf(b4.z), hi_bf(b4.z), lo_bf(b4.w), hi_bf(b4.w)};
        const float bsc = A.BS[(size_t)tk * 8 + (lane >> 3)];
        float sm = 0.f;
#pragma unroll
        for (int i = 0; i < 8; ++i) sm += y[i];
        sm = red8(sm); const float mean = sm * (1.f / 64.f);
        float sv = 0.f;
#pragma unroll
        for (int i = 0; i < 8; ++i) { y[i] -= mean; sv += y[i] * y[i]; }
        sv = red8(sv); const float rstd = 1.f / sqrtf(sv * (1.f / 64.f) + 64e-5f);
        float ov[8];
#pragma unroll
        for (int i = 0; i < 8; ++i) ov[i] = (y[i] * rstd * lnw[i] + lnb[i] + bsc * bo[i]) * g[i];
        u32x4 w; w.x = cvt_pk_bf16(ov[0], ov[1]); w.y = cvt_pk_bf16(ov[2], ov[3]); w.z = cvt_pk_bf16(ov[4], ov[5]); w.w = cvt_pk_bf16(ov[6], ov[7]);
        *(u32x4*)(A.mixed + (size_t)tk * DM + 1536 + lane * 8) = w;
    }
}
}
namespace rwc {
constexpr int TB = 32;
constexpr int NB = SEQ / TB;
constexpr int OPS = 320;
constexpr int L_KK = 0, L_W = 64, L_BN = 128, L_KP = 192, L_R = 256;
constexpr int O_RAW = 0;
constexpr int O_VT = O_RAW + TB * OPS * 4;
constexpr int VT_ROW = 40, VT_BUF = 2 * 64 * VT_ROW;
constexpr int O_IMG = O_VT + 2 * VT_BUF;
constexpr int RS = 144;
constexpr int I_A = 0, I_R = I_A + 16 * RS, I_B = I_R + 16 * RS, I_K = I_B + 16 * RS, I_BKT = I_K + 16 * RS;
constexpr int SR = 80;
constexpr int I_LAK = I_BKT + 64 * SR, I_TP = I_LAK + 16 * SR, I_MM = I_TP + 16 * SR, I_GC = I_MM + 16 * SR, I_LAB = I_GC + 256, IMG_BYTES = I_LAB + 16 * SR;
constexpr int O_YB = O_IMG + 2 * IMG_BYTES;
constexpr int LDS_BYTES = O_YB + TB * 64 * 4;
struct Args { const bf16_t *R, *K, *KK, *B, *V; const float* W; const float* RIN; const bf16_t* G; const float *BS, *ln_w, *ln_b; bf16_t* mixed; };
typedef unsigned short u16;

struct Pre { u32x2 r, k, kk, b, v; f32x4 w; float rin; };
__device__ __forceinline__ void pre_load(Pre& q, const Args& A, size_t off) {
    q.r = *(const u32x2*)(A.R + off); q.k = *(const u32x2*)(A.K + off); q.kk = *(const u32x2*)(A.KK + off); q.b = *(const u32x2*)(A.B + off); q.v = *(const u32x2*)(A.V + off);
    q.w = *(const f32x4*)(A.W + off);
    q.rin = A.RIN[(off >> 9) * 8 + ((off >> 6) & 7)];
}
__device__ __forceinline__ float red16(float x) { x += DPPF(x, 0xB1); x += DPPF(x, 0x4E); x += DPPF(x, 0x141); x += DPPF(x, 0x140); return x; }
__device__ __forceinline__ void st4(LAS float* d, u32x2 w, float sc = 1.f) { *(LAS f32x4*)d = (f32x4){lo_bf(w.x) * sc, hi_bf(w.x) * sc, lo_bf(w.y) * sc, hi_bf(w.y) * sc}; }
__device__ __forceinline__ f32x4 mfma16(u32x4 a, u32x4 b, f32x4 c) { return __builtin_amdgcn_mfma_f32_16x16x32_bf16(__builtin_bit_cast(bf16x8, a), __builtin_bit_cast(bf16x8, b), c, 0, 0, 0); }

__device__ __forceinline__ void item(const Args& A, LAS unsigned char* lds, int bh, const int wv__) {
    const int tid = TID(), lane = tid & 63, wid = __builtin_amdgcn_readfirstlane(tid >> 6);
    const int b = bh >> 3, h = bh & 7;
    const size_t base = (size_t)b * SEQ * 512 + h * 64;
    const int st = tid >> 4, c4 = (tid & 15) * 4;
    const int n16 = lane & 15, g = lane >> 4;
    f32x4 Z[4];
#pragma unroll
    for (int i = 0; i < 4; ++i) Z[i] = (f32x4){0.f, 0.f, 0.f, 0.f};
    u32x4 Zq[2] = {(u32x4){0u, 0u, 0u, 0u}, (u32x4){0u, 0u, 0u, 0u}};
    Pre pre; pre_load(pre, A, base + (size_t)st * 512 + c4);
    LAS float* raw = (LAS float*)(lds + O_RAW);
    LAS float* yb = (LAS float*)(lds + O_YB);
    const f32x4 lnw = *(const f32x4*)(A.ln_w + h * 64 + c4), lnb = *(const f32x4*)(A.ln_b + h * 64 + c4);
    u32x2 vprev = (u32x2){0u, 0u}, gq = (u32x2){0u, 0u}; float bsq = 0.f;
#define RWC_POST(bprev) do { \
        const f32x4 y4 = *(const LAS f32x4*)(yb + st * 64 + c4); \
        float sm = (y4.x + y4.y) + (y4.z + y4.w); sm = red16(sm); const float mean = sm * (1.f / 64.f); \
        const float d0 = y4.x - mean, d1 = y4.y - mean, d2 = y4.z - mean, d3 = y4.w - mean; \
        float sv = (d0 * d0 + d1 * d1) + (d2 * d2 + d3 * d3); sv = red16(sv); const float rstd = 1.f / sqrtf(sv * (1.f / 64.f) + 64e-5f); \
        const float o0 = (d0 * rstd * lnw.x + lnb.x + bsq * lo_bf(vprev.x)) * lo_bf(gq.x), o1 = (d1 * rstd * lnw.y + lnb.y + bsq * hi_bf(vprev.x)) * hi_bf(gq.x); \
        const float o2 = (d2 * rstd * lnw.z + lnb.z + bsq * lo_bf(vprev.y)) * lo_bf(gq.y), o3 = (d3 * rstd * lnw.w + lnb.w + bsq * hi_bf(vprev.y)) * hi_bf(gq.y); \
        *(u32x2*)(A.mixed + ((size_t)b * SEQ + (bprev) * TB + st) * DM + 1536 + h * 64 + c4) = (u32x2){cvt_pk_bf16(o0, o1), cvt_pk_bf16(o2, o3)}; } while (0)
    for (int bt = 0; bt < NB; ++bt) {
        LAS unsigned char* vt = lds + O_VT + (bt & 1) * VT_BUF;
        { LAS float* d = raw + st * OPS + c4;
          st4(d + L_R, pre.r); st4(d + L_KP, pre.k); st4(d + L_KK, pre.kk, pre.rin); st4(d + L_BN, pre.b, pre.rin); *(LAS f32x4*)(d + L_W) = pre.w;
          LAS unsigned char* vd = vt + ((st >> 4) * 64 + c4) * VT_ROW + (st & 15) * 2;
          *(LAS u16*)(vd) = (u16)(pre.v.x & 0xffffu); *(LAS u16*)(vd + VT_ROW) = (u16)(pre.v.x >> 16); *(LAS u16*)(vd + 2 * VT_ROW) = (u16)(pre.v.y & 0xffffu); *(LAS u16*)(vd + 3 * VT_ROW) = (u16)(pre.v.y >> 16); }
        __syncthreads();
        if (bt > 0) RWC_POST(bt - 1);
        vprev = pre.v;
        { const size_t tk = (size_t)b * SEQ + bt * TB + st; gq = *(const u32x2*)(A.G + tk * 512 + h * 64 + c4); bsq = A.BS[tk * 8 + h]; }
        if (bt + 1 < NB) pre_load(pre, A, base + (size_t)((bt + 1) * TB + st) * 512 + c4);
        { const int c = wid >> 2, gg = wid & 3, j = lane;
          LAS unsigned char* img = lds + O_IMG + c * IMG_BYTES;
          const LAS float* rw = raw + (16 * c) * OPS + j;
          float G = 1.f;
          for (int tp = 0; tp < 4 * gg; ++tp) G *= rw[tp * OPS + L_W];
          float bq[4], kq[4];
#pragma unroll
          for (int e = 0; e < 4; ++e) {
              const int t = 4 * gg + e; const LAS float* q = rw + t * OPS;
              const float Gm1 = G; G *= q[L_W]; const float inv = 1.f / G;
              const float at = q[L_KK] * Gm1, rt = q[L_R] * G; bq[e] = q[L_BN] * inv; kq[e] = q[L_KP] * inv;
              LAS unsigned char* o = img + t * RS + j * 2;
              *(LAS u16*)(o + I_A) = f2bf(at); *(LAS u16*)(o + I_R) = f2bf(rt); *(LAS u16*)(o + I_B) = f2bf(bq[e]); *(LAS u16*)(o + I_K) = f2bf(kq[e]);
          }
          *(LAS u32x4*)(img + I_BKT + j * SR + gg * 16) = (u32x4){cvt_pk_bf16(bq[0], bq[1]), cvt_pk_bf16(bq[2], bq[3]), cvt_pk_bf16(kq[0], kq[1]), cvt_pk_bf16(kq[2], kq[3])};
          if (gg == 3) *(LAS float*)(img + I_GC + j * 4) = G;
        }
        __syncthreads();
        { const int c = wid >> 2, tt = wid & 3;
          LAS unsigned char* img = lds + O_IMG + c * IMG_BYTES;
          const LAS unsigned char* ia = img + (tt < 2 ? I_A : I_R) + n16 * RS + g * 16;
          const LAS unsigned char* ib = img + ((tt & 1) ? I_K : I_B) + n16 * RS + g * 16;
          f32x4 p = (f32x4){0.f, 0.f, 0.f, 0.f};
          p = mfma16(*(const LAS u32x4*)ia, *(const LAS u32x4*)ib, p);
          p = mfma16(*(const LAS u32x4*)(ia + 64), *(const LAS u32x4*)(ib + 64), p);
          const int s = n16;
          if (tt == 0) {
              LAS float* lab = (LAS float*)(img + I_LAB);
#pragma unroll
              for (int r = 0; r < 4; ++r) { const int t = 4 * g + r; lab[t * 20 + s] = t > s ? p[r] : 0.f; }
              asm volatile("s_waitcnt lgkmcnt(0)" ::: "memory");
              float T[16];
#pragma unroll
              for (int t = 0; t < 16; ++t) {
                  float acc = (s == t) ? 1.f : 0.f;
#pragma unroll
                  for (int q4 = 0; q4 * 4 < t; ++q4) {
                      const f32x4 l4 = *(const LAS f32x4*)(lab + t * 20 + 4 * q4);
#pragma unroll
                      for (int e = 0; e < 4; ++e) if (4 * q4 + e < t) acc += l4[e] * T[4 * q4 + e];
                  }
                  T[t] = acc;
              }
#pragma unroll
              for (int t = 0; t < 16; ++t) *(LAS u16*)(img + I_TP + t * SR + (s >> 2) * 16 + (s & 3) * 2) = f2bf(T[t] - ((s == t) ? 1.f : 0.f));
          } else {
              const int ofs = (tt == 1 ? I_LAK : I_MM) + (s >> 2) * 16 + (tt == 3 ? 8 : 0) + (s & 3) * 2;
#pragma unroll
              for (int r = 0; r < 4; ++r) { const int t = 4 * g + r; const bool keep = tt == 1 ? (t > s) : (t >= s); *(LAS u16*)(img + ofs + t * SR) = f2bf(keep ? p[r] : 0.f); }
          }
        }
        __syncthreads();
        if (wid < 4) {
            const int i = 16 * wid + n16;
#pragma unroll 1
            for (int c = 0; c < 2; ++c) {
                const LAS unsigned char* img = lds + O_IMG + c * IMG_BYTES;
                const LAS unsigned char* ra = img + n16 * RS + g * 8;
                f32x4 D1 = (f32x4){0.f, 0.f, 0.f, 0.f}, D2 = D1;
#pragma unroll
                for (int ks = 0; ks < 2; ++ks) {
                    const u32x2 a0 = *(const LAS u32x2*)(ra + I_A + ks * 64), a1 = *(const LAS u32x2*)(ra + I_A + ks * 64 + 32);
                    const u32x2 r0 = *(const LAS u32x2*)(ra + I_R + ks * 64), r1 = *(const LAS u32x2*)(ra + I_R + ks * 64 + 32);
                    D1 = mfma16((u32x4){a0.x, a0.y, a1.x, a1.y}, Zq[ks], D1);
                    D2 = mfma16((u32x4){r0.x, r0.y, r1.x, r1.y}, Zq[ks], D2);
                }
                const u32x2 vv = *(const LAS u32x2*)(vt + (c * 64 + i) * VT_ROW + g * 8);
                const u32x2 al = *(const LAS u32x2*)(img + I_LAK + n16 * SR + g * 16);
                D1 = mfma16((u32x4){al.x, al.y, 0u, 0u}, (u32x4){vv.x, vv.y, 0u, 0u}, D1);
                const u32x2 at = *(const LAS u32x2*)(img + I_TP + n16 * SR + g * 16);
                const f32x4 U = mfma16((u32x4){at.x, at.y, 0u, 0u}, (u32x4){cvt_pk_bf16(D1[0], D1[1]), cvt_pk_bf16(D1[2], D1[3]), 0u, 0u}, D1);
                const u32x4 buv = (u32x4){cvt_pk_bf16(U[0], U[1]), cvt_pk_bf16(U[2], U[3]), vv.x, vv.y};
                const f32x4 Y = mfma16(*(const LAS u32x4*)(img + I_MM + n16 * SR + g * 16), buv, D2);
#pragma unroll
                for (int jt = 0; jt < 4; ++jt) {
                    Z[jt] = mfma16(*(const LAS u32x4*)(img + I_BKT + (16 * jt + n16) * SR + g * 16), buv, Z[jt]);
                    const f32x4 gc = *(const LAS f32x4*)(img + I_GC + (16 * jt + 4 * g) * 4);
                    Z[jt] = Z[jt] * gc;
                }
                Zq[0] = (u32x4){cvt_pk_bf16(Z[0][0], Z[0][1]), cvt_pk_bf16(Z[0][2], Z[0][3]), cvt_pk_bf16(Z[1][0], Z[1][1]), cvt_pk_bf16(Z[1][2], Z[1][3])};
                Zq[1] = (u32x4){cvt_pk_bf16(Z[2][0], Z[2][1]), cvt_pk_bf16(Z[2][2], Z[2][3]), cvt_pk_bf16(Z[3][0], Z[3][1]), cvt_pk_bf16(Z[3][2], Z[3][3])};
                LAS float* yo = yb + (16 * c + 4 * g) * 64 + i;
#pragma unroll
                for (int r = 0; r < 4; ++r) yo[r * 64] = Y[r];
            }
        }
    }
    __syncthreads();
    RWC_POST(NB - 1);
    __syncthreads();
#undef RWC_POST
}
}
namespace hg {
constexpr int C = 64, NCH = SEQ / C, HD = 128;
constexpr int RS128 = 272, RS64 = 144;
constexpr int O_QM = 0, O_KM = O_QM + C * RS128, O_QE = O_KM + C * RS128, O_KET = O_QE + C * RS128, O_VT = O_KET + HD * RS64,
              O_STT = O_VT + HD * RS64, O_P = O_STT + HD * RS128, O_TOT = O_P + C * RS64, O_DEC = O_TOT + 4 * HD * 4, O_END = O_DEC + HD * 4;
constexpr int OB_STRIDE = 132;
static_assert(C * OB_STRIDE * 4 <= 2 * C * RS128, "OBUF alias");
constexpr int LDS_BYTES = O_END;
struct Args { const bf16_t* p; const float* lb; const float* out_gain; bf16_t* mixed; };

__device__ __forceinline__ bf16x8 lda8(const LAS unsigned char* base, int row, int rs, int colB) { return *(const LAS bf16x8*)(base + row * rs + colB); }

__device__ __forceinline__ void item(const Args& A, LAS unsigned char* lds, int bh, const int wv__) {
    const int tid = TID(), lane = tid & 63, wid = __builtin_amdgcn_readfirstlane(tid >> 6), r32 = lane & 31, hi = lane >> 5;
    const int b = bh >> 2, h = bh & 3;
    const int ch = tid & 127, part = tid >> 7;
    const float lbc = A.lb[h * HD + ch], omlb = 1.f - lbc;
    const bf16_t* pbase = A.p + (size_t)b * SEQ * NP + h * HD;
    f32x16 sacc[2]; sacc[0] = f32x16{}; sacc[1] = f32x16{};
    const int kb = wid >> 1, vb0 = 2 * (wid & 1);
    for (int i = tid; i < HD * RS128 / 16; i += 512) *(LAS u32x4*)(lds + O_STT + i * 16) = (u32x4){0u, 0u, 0u, 0u};
    LAS float* tot = (LAS float*)(lds + O_TOT);
    LAS float* dec = (LAS float*)(lds + O_DEC);
    LAS float* obuf = (LAS float*)(lds + O_QM);
    bf16_t rq[16], rf[16], ri[16];
    { const bf16_t* pc0 = pbase + (size_t)(part * 16) * NP + ch;
#pragma unroll
      for (int i = 0; i < 16; ++i) { rf[i] = pc0[(size_t)i * NP + C_HF]; rq[i] = pc0[(size_t)i * NP + C_HQ]; ri[i] = pc0[(size_t)i * NP + C_HI]; } }
    for (int ck = 0; ck < NCH; ++ck) {
        const size_t tk_e = (size_t)b * SEQ + ck * C + (tid >> 3);
        const bf16_t* gp_e = A.p + tk_e * NP + C_HG + h * HD + (tid & 7) * 16;
        const u32x4 g0 = *(const u32x4*)gp_e, g1 = *(const u32x4*)(gp_e + 8);
        float lf[16], qv[16], kv[16];
        float run = 0.f;
#pragma unroll
        for (int i = 0; i < 16; ++i) {
            const float z = bf2f(rf[i]);
            const float sg = sigmoidf_(z);
            const float f = lbc + omlb * sg;
            kv[i] = 1.f - f;
            run += __logf(f); lf[i] = run;
            qv[i] = siluf_(bf2f(rq[i]));
        }
        tot[part * HD + ch] = run;
        { unsigned w[8];
#pragma unroll
          for (int i = 0; i < 8; ++i) w[i] = (unsigned)ri[2 * i] | ((unsigned)ri[2 * i + 1] << 16);
          LAS u32x4* d = (LAS u32x4*)(lds + O_VT + ch * RS64 + part * 32);
          d[0] = (u32x4){w[0], w[1], w[2], w[3]}; d[1] = (u32x4){w[4], w[5], w[6], w[7]}; }
        __syncthreads();
        if (ck + 1 < NCH) { const bf16_t* pcn = pbase + (size_t)((ck + 1) * C + part * 16) * NP + ch;
#pragma unroll
            for (int i = 0; i < 16; ++i) { rf[i] = pcn[(size_t)i * NP + C_HF]; rq[i] = pcn[(size_t)i * NP + C_HQ]; ri[i] = pcn[(size_t)i * NP + C_HI]; } }
        float off = 0.f;
#pragma unroll
        for (int pp = 0; pp < 4; ++pp) off += (pp < part) ? tot[pp * HD + ch] : 0.f;
        const float bref = tot[ch] + tot[HD + ch];
        const float blast = bref + tot[2 * HD + ch] + tot[3 * HD + ch];
        const float c_blast = __expf(blast), c_bref = __expf(bref), c_nbref = fast_rcp(c_bref);
        if (part == 0) dec[ch] = c_blast;
        {
            unsigned wk[8];
#pragma unroll
            for (int i = 0; i < 16; ++i) {
                const float bt = off + lf[i];
                const int t = part * 16 + i;
                const float e1 = __expf(fmaxf(bt, -80.f)), e2 = fast_rcp(e1);
                const float qe = qv[i] * e1, qm = qe * c_nbref, km = kv[i] * e2 * c_bref, ke = kv[i] * e2 * c_blast;
                *(LAS bf16_t*)(lds + O_QM + t * RS128 + ch * 2) = f2bf(qm);
                *(LAS bf16_t*)(lds + O_KM + t * RS128 + ch * 2) = f2bf(km);
                *(LAS bf16_t*)(lds + O_QE + t * RS128 + ch * 2) = f2bf(qe);
                if (i & 1) wk[i >> 1] |= ((unsigned)f2bf(ke)) << 16; else wk[i >> 1] = (unsigned)f2bf(ke);
            }
            LAS u32x4* d = (LAS u32x4*)(lds + O_KET + ch * RS64 + part * 32);
            d[0] = (u32x4){wk[0], wk[1], wk[2], wk[3]}; d[1] = (u32x4){wk[4], wk[5], wk[6], wk[7]};
        }
        __syncthreads();
        if (wid < 3) {
            const int ti = wid == 0 ? 0 : 1, si = wid == 2 ? 1 : 0;
            f32x16 sc = f32x16{};
#pragma unroll
            for (int ks = 0; ks < 8; ++ks) {
                const bf16x8 a = lda8(lds + O_QM, ti * 32 + r32, RS128, (ks * 16 + hi * 8) * 2);
                const bf16x8 bb = lda8(lds + O_KM, si * 32 + r32, RS128, (ks * 16 + hi * 8) * 2);
                sc = __builtin_amdgcn_mfma_f32_32x32x16_bf16(a, bb, sc, 0, 0, 0);
            }
#pragma unroll
            for (int r = 0; r < 16; ++r) { const int tl = (r & 3) + 8 * (r >> 2) + 4 * hi; const int tg = ti * 32 + tl, sg = si * 32 + r32;
                const float v = (sg <= tg) ? sc[r] : 0.f;
                *(LAS bf16_t*)(lds + O_P + tg * RS64 + sg * 2) = f2bf(v); }
        } else if (wid == 3) {
#pragma unroll
            for (int r = 0; r < 16; ++r) { const int tl = (r & 3) + 8 * (r >> 2) + 4 * hi; *(LAS bf16_t*)(lds + O_P + tl * RS64 + (32 + r32) * 2) = (bf16_t)0; }
        }
        __syncthreads();
        {
            const int ti = wid >> 2, vj = wid & 3;
            f32x16 oc = f32x16{};
#pragma unroll
            for (int ks = 0; ks < 8; ++ks) {
                const bf16x8 a = lda8(lds + O_QE, ti * 32 + r32, RS128, (ks * 16 + hi * 8) * 2);
                const bf16x8 bb = lda8(lds + O_STT, vj * 32 + r32, RS128, (ks * 16 + hi * 8) * 2);
                oc = __builtin_amdgcn_mfma_f32_32x32x16_bf16(a, bb, oc, 0, 0, 0);
            }
#pragma unroll
            for (int ss = 0; ss < 4; ++ss) {
                const bf16x8 a = lda8(lds + O_P, ti * 32 + r32, RS64, (ss * 16 + hi * 8) * 2);
                const bf16x8 bb = lda8(lds + O_VT, vj * 32 + r32, RS64, (ss * 16 + hi * 8) * 2);
                oc = __builtin_amdgcn_mfma_f32_32x32x16_bf16(a, bb, oc, 0, 0, 0);
            }
#pragma unroll
            for (int r = 0; r < 16; ++r) { const int tl = (r & 3) + 8 * (r >> 2) + 4 * hi; obuf[(ti * 32 + tl) * OB_STRIDE + vj * 32 + r32] = oc[r]; }
        }
#pragma unroll
        for (int j = 0; j < 2; ++j) {
#pragma unroll
            for (int r = 0; r < 16; ++r) { const int kl = (r & 3) + 8 * (r >> 2) + 4 * hi; sacc[j][r] *= dec[kb * 32 + kl]; }
#pragma unroll
            for (int ss = 0; ss < 4; ++ss) {
                const bf16x8 a = lda8(lds + O_KET, kb * 32 + r32, RS64, (ss * 16 + hi * 8) * 2);
                const bf16x8 bb = lda8(lds + O_VT, (vb0 + j) * 32 + r32, RS64, (ss * 16 + hi * 8) * 2);
                sacc[j] = __builtin_amdgcn_mfma_f32_32x32x16_bf16(a, bb, sacc[j], 0, 0, 0);
            }
        }
        __syncthreads();
#pragma unroll
        for (int j = 0; j < 2; ++j)
#pragma unroll
            for (int g = 0; g < 4; ++g) {
                u32x2 w; w.x = cvt_pk_bf16(sacc[j][4 * g], sacc[j][4 * g + 1]); w.y = cvt_pk_bf16(sacc[j][4 * g + 2], sacc[j][4 * g + 3]);
                *(LAS u32x2*)(lds + O_STT + ((vb0 + j) * 32 + r32) * RS128 + (kb * 32 + 8 * g + 4 * hi) * 2) = w;
            }
        {
            const int t = tid >> 3, c0 = (tid & 7) * 16;
            const LAS float* orow = obuf + t * OB_STRIDE + c0;
            float o[16]; float ss = 0.f;
#pragma unroll
            for (int i = 0; i < 4; ++i) { const f32x4 x = *(const LAS f32x4*)(orow + 4 * i); o[4 * i] = x.x; o[4 * i + 1] = x.y; o[4 * i + 2] = x.z; o[4 * i + 3] = x.w; ss += x.x * x.x + x.y * x.y + x.z * x.z + x.w * x.w; }
            ss = sum8f(ss);
            const float rn = 1.f / sqrtf(ss * (1.f / 128.f) + RMS_EPS);
            const size_t tk = tk_e;
            const float gr[16] = {lo_bf(g0.x), hi_bf(g0.x), lo_bf(g0.y), hi_bf(g0.y), lo_bf(g0.z), hi_bf(g0.z), lo_bf(g0.w), hi_bf(g0.w),
                                  lo_bf(g1.x), hi_bf(g1.x), lo_bf(g1.y), hi_bf(g1.y), lo_bf(g1.z), hi_bf(g1.z), lo_bf(g1.w), hi_bf(g1.w)};
            float ov[16];
#pragma unroll
            for (int i = 0; i < 16; ++i) ov[i] = o[i] * rn * A.out_gain[c0 + i] * siluf_(gr[i]);
            u32x4 w0, w1;
            w0.x = cvt_pk_bf16(ov[0], ov[1]); w0.y = cvt_pk_bf16(ov[2], ov[3]); w0.z = cvt_pk_bf16(ov[4], ov[5]); w0.w = cvt_pk_bf16(ov[6], ov[7]);
            w1.x = cvt_pk_bf16(ov[8], ov[9]); w1.y = cvt_pk_bf16(ov[10], ov[11]); w1.z = cvt_pk_bf16(ov[12], ov[13]); w1.w = cvt_pk_bf16(ov[14], ov[15]);
            bf16_t* mp = A.mixed + tk * DM + h * HD + c0;
            *(u32x4*)mp = w0; *(u32x4*)(mp + 8) = w1;
        }
        __syncthreads();
    }
}
}
#define RLX_AGENT __ATOMIC_RELAXED, __HIP_MEMORY_SCOPE_AGENT
#define XB_TMO      128
#define XB_XCNT(j)  (256  + 64 * (j))
#define XB_XSUB(j)  (1280 + 64 * (j))
#define XB_XGEN(j)  (2304 + 64 * (j))
#define XB_TOP      3328
#define XB_TOPGEN   3392
#define XCD_BAR_WORDS 3456
#define XB_SPIN_CAP (1u << 18)

__device__ __forceinline__ unsigned xb_ld(unsigned* p)              { return __hip_atomic_load(p, __ATOMIC_RELAXED, __HIP_MEMORY_SCOPE_AGENT); }
__device__ __forceinline__ unsigned xb_add(unsigned* p, unsigned v) { return __hip_atomic_fetch_add(p, v, __ATOMIC_RELAXED, __HIP_MEMORY_SCOPE_AGENT); }
__device__ __forceinline__ unsigned xb_xcc_id() { return (unsigned)__builtin_amdgcn_s_getreg((3 << 11) | 20) & 0xFu; }
#define XB_SPIN(cond, bar) do { unsigned _sp = 0; while (cond) { __builtin_amdgcn_s_sleep(1); \
    if ((++_sp & 255u) == 0u) { if (xb_ld(&(bar)[XB_TMO])) break; if (_sp > XB_SPIN_CAP) { atomicAdd(&(bar)[XB_TMO], 1u); break; } } } } while (0)

struct XcdBarrier {
    unsigned* bar; unsigned x;
    volatile LAS unsigned* st;
};

__device__ __forceinline__ XcdBarrier xcd_barrier_post(unsigned* bar, volatile LAS unsigned* st, const int wv__) {
    XcdBarrier b; b.bar = bar; b.x = xb_xcc_id(); b.st = st;
    if (TID() == 0) (void)xb_add(&bar[XB_XCNT(b.x)], 1u);
    return b;
}
__device__ __forceinline__ void xcd_barrier_complete(unsigned* bar, unsigned x, unsigned& nloc, unsigned& nx) {
    const unsigned G = gridDim.x * gridDim.y * gridDim.z;
    unsigned sum, cnt, mine, sp = 0u;
    for (;;) {
        sum = 0u; cnt = 0u; mine = 0u;
#pragma unroll
        for (unsigned j = 0; j < 16; ++j) { const unsigned c = xb_ld(&bar[XB_XCNT(j)]); sum += c; cnt += (c > 0u) ? 1u : 0u; mine = (j == x) ? c : mine; }
        if (sum == G) break;
        __builtin_amdgcn_s_sleep(1);
        if ((++sp & 255u) == 0u) { if (xb_ld(&bar[XB_TMO])) break; if (sp > XB_SPIN_CAP) { atomicAdd(&bar[XB_TMO], 1u); break; } }
    }
    nloc = mine > 0u ? mine : 1u; nx = cnt > 0u ? cnt : 1u;
}

__device__ __forceinline__ void xcd_barrier(const XcdBarrier& b, const int wv__) {
    asm volatile("s_waitcnt vmcnt(0)" ::: "memory");
    __syncthreads();
    if (TID() == 0) {
        unsigned* bar = b.bar;
        __builtin_amdgcn_s_waitcnt(0);
        unsigned nloc = b.st[0], nx = b.st[1];
        if (nloc == 0u) { xcd_barrier_complete(bar, b.x, nloc, nx); b.st[0] = nloc; b.st[1] = nx; }
        const unsigned old = xb_add(&bar[XB_XSUB(b.x)], 1u);
        const unsigned gen = old / nloc;
        if (old + 1u == (gen + 1u) * nloc) {
            __builtin_amdgcn_fence(__ATOMIC_RELEASE, "agent");
            asm volatile("s_waitcnt vmcnt(0)" ::: "memory");
            const unsigned og = xb_add(&bar[XB_TOP], 1u);
            const unsigned tg = og / nx;
            if (og + 1u == (tg + 1u) * nx) xb_add(&bar[XB_TOPGEN], 1u);
            else XB_SPIN(xb_ld(&bar[XB_TOPGEN]) == tg, bar);
            __builtin_amdgcn_fence(__ATOMIC_ACQUIRE, "agent");
            xb_add(&bar[XB_XGEN(b.x)], 1u);
            asm volatile("s_waitcnt vmcnt(0)" ::: "memory");
        } else {
            XB_SPIN(xb_ld(&bar[XB_XGEN(b.x)]) == gen, bar);
            __builtin_amdgcn_fence(__ATOMIC_ACQUIRE, "agent");
            asm volatile("s_waitcnt vmcnt(0)" ::: "memory");
        }
    }
    __syncthreads();
}

constexpr int NTHREADS = 512, NWAVES = 8;
constexpr int LDS_ALL = 153600;
static_assert(LDS_ALL >= hg::LDS_BYTES && LDS_ALL >= tok::LDS_BYTES && LDS_ALL >= rwk::LDS_BYTES && LDS_ALL >= rwc::LDS_BYTES && LDS_ALL >= att::LDS_BYTES && LDS_ALL >= pg8::STAGE_BYTES, "LDS");
constexpr int CW_BAR = 4096;
constexpr int PH_PER_LAYER = 7, N_PHASES = 1 + DEPTH * PH_PER_LAYER;

struct KArgs { Ptrs P; int ph_lo, ph_hi, coop, pad; };

#ifdef DUP_TOKMODE
#define TOKMODE (rep ? DUP_TOKMODE : 7)
#else
#define TOKMODE 7
#endif
template <int ph>
__device__ __forceinline__ void run_phase(LAS unsigned char* lds, unsigned char* lds_raw, cg::grid_group& grid, const int G, const int bid, const int wv__) {
        const KArgs __attribute__((address_space(4)))* ka = (const KArgs __attribute__((address_space(4)))*)__builtin_amdgcn_kernarg_segment_ptr();
        asm volatile("" : "+s"(ka));
#define PIN(i) (ka->P.in[i])
        const int tid = TID(), lane = tid & 63, wid = __builtin_amdgcn_readfirstlane(tid >> 6);
        const int gw = bid * NWAVES + wid, ngw = G * NWAVES;
        unsigned char* ws = ka->P.ws;
        float* x = ka->P.out;
        bf16_t* xb = (bf16_t*)(ws + WS_XB); bf16_t* pbuf = (bf16_t*)(ws + WS_P); bf16_t* mixed = (bf16_t*)(ws + WS_MIX);
        bf16_t* qbuf = (bf16_t*)(ws + WS_Q); bf16_t* kvbuf = (bf16_t*)(ws + WS_KV); bf16_t* krbuf = (bf16_t*)(ws + WS_KR);
        bf16_t* act = (bf16_t*)(ws + WS_ACT);
        float* ssA = (float*)(ws + WS_SSA); float* ssB = (float*)(ws + WS_SSBP); float* rsb = (float*)(ws + WS_RS); float* rsq = (float*)(ws + WS_RSQ); float* rskv = (float*)(ws + WS_RSKV);
        const int* pos = (const int*)PIN(1);
        if constexpr (ph == 0) {
            prologue_phase(&ka->P, (LAS float*)lds + wid * (64 * 65), gw, ngw, lane);
#ifdef DUP_PRO
            __syncthreads(); prologue_phase(&ka->P, (LAS float*)lds + wid * (64 * 65), gw, ngw, lane);
#endif
        } else {
            constexpr int l = (ph - 1) / PH_PER_LAYER, sp = (ph - 1) % PH_PER_LAYER;
            unsigned char* wl = ws + WS_W + (size_t)l * W_LAYER;
#ifdef DUP_SP
            const int nrep = (sp == DUP_SP) ? 2 : 1;
#else
            const int nrep = 1;
#endif
            for (int rep = 0; rep < nrep; ++rep) {
            if (rep) { XcdBarrier xb; xb.bar = (unsigned*)(ws + WS_CTL) + CW_BAR; xb.x = xb_xcc_id(); xb.st = (volatile LAS unsigned*)(lds + LDS_ALL - 128); xcd_barrier(xb, wv__); }
            switch (sp) {
            case 0: {
                pg8::Gemm g{xb, (const bf16_t*)(wl + WO_IN), T, NP, DM, DM}; pg8::StaticOrder S; S.init(T, NP, G, bid);
                pg8::prep_row_scales(ssA, rsb, S, tid);
                pg8::EpiScaleBf16 E{pbuf, rsb, NP, 0};
                pg8::gemm_phase<pg8::EpiScaleBf16, pg8::StaticOrder, true, true>(lds, g, S, E, wv__);
            } break;
            case 1: {
                tok::Args A;
                A.p = pbuf; A.pos = pos; A.k_gain = PIN(11) + l * 192;
                A.mu = PIN(12) + l * 1792; A.w0 = PIN(13) + l * 512; A.a0 = PIN(15) + l * 512;
                constexpr int lm = l > 0 ? l - 1 : 0;
                A.v0 = PIN(18) + lm * 512;
                A.k_k = PIN(21) + l * 512; A.k_a = PIN(22) + l * 512; A.r_k = PIN(23) + l * 512;
                A.wl = (const bf16_t*)(wl + WO_LORA);
                A.rs_q = rsq; A.rs_kv = rskv; A.kr = krbuf;
                A.R = (bf16_t*)(ws + WS_RWR); A.K = (bf16_t*)(ws + WS_RWK); A.V = (bf16_t*)(ws + WS_RWV); A.KK = (bf16_t*)(ws + WS_RWKK); A.B = (bf16_t*)(ws + WS_RWB);
                A.G = (bf16_t*)((unsigned char*)x + 64 * MiB); A.BON = (bf16_t*)((unsigned char*)x + 96 * MiB); A.VFIRST = (bf16_t*)(ws + WS_VFIRST); A.W = (float*)((unsigned char*)x); A.RIN = (float*)(ws + WS_RIN); A.BS = (float*)(ws + WS_BS);
#ifdef TOKPROBE
                if (rep) { unsigned char* dq = ws + WS_Q; A.R = (bf16_t*)dq; A.K = (bf16_t*)(dq + 32 * MiB); A.V = (bf16_t*)(dq + 64 * MiB); A.KK = (bf16_t*)(dq + 96 * MiB); A.B = (bf16_t*)(dq + 128 * MiB);
                    A.G = (bf16_t*)(dq + 160 * MiB); A.VFIRST = l == 0 ? (bf16_t*)(dq + 192 * MiB) : A.VFIRST; A.W = (float*)(ws + WS_MIX); A.RIN = (float*)(ws + WS_MIX + 64 * MiB); A.BS = (float*)(ws + WS_MIX + 65 * MiB); }
#endif
                tok::stage_params(A, lds, tid);
                for (int tl = bid; tl < tok::NTILES; tl += G) tok::tile<l>(A, lds, tl, wv__, TOKMODE);
            } break;
            case 2: {
                { pg8::Gemm g{pbuf + C_MQ, (const bf16_t*)(wl + WO_QB), T, QW, 512, NP}; pg8::StaticOrder S; S.init(T, QW, G, bid);
                  pg8::EpiPlainBf16 E{qbuf, QW, 0};
                  pg8::gemm_phase<pg8::EpiPlainBf16, pg8::StaticOrder, true, true>(lds, g, S, E, wv__); }
                { pg8::Gemm g{pbuf + C_MKV, (const bf16_t*)(wl + WO_KVB), T, KVW, 256, NP}; pg8::StaticOrder S; S.init(T, KVW, G, bid);
                  pg8::EpiKV E{kvbuf, rskv, PIN(11) + l * 192, (LAS float*)(lds + pg8::STAGE_BYTES), KVW, 0};
                  pg8::gemm_phase<pg8::EpiKV, pg8::StaticOrder, true, true>(lds, g, S, E, wv__); }
            } break;
            case 3: {
                unsigned* ctr = (unsigned*)(ws + WS_CTL) + 64 * l + 16 * rep;
                LAS int* qslot = (LAS int*)(lds + LDS_ALL - 64);
                constexpr int NQ = 96 + att::N_BLOCKS;
#ifdef DUP_MIX
                const int qlo = rep ? (DUP_MIX == 1 ? 0 : DUP_MIX == 2 ? 64 : 96) : 0, qhi = rep ? (DUP_MIX == 1 ? 64 : DUP_MIX == 2 ? 96 : NQ) : NQ;
#else
                const int qlo = 0, qhi = NQ;
#endif
#ifdef CONV_IN_MIXERS
                if constexpr (l + 1 < DEPTH) {
                    if (!rep && bid % CONV_EVERY == 0) {
                        for (;;) {
                            __syncthreads();
                            if (tid == 0) *qslot = (int)__hip_atomic_fetch_add(ctr + 8, 1u, __ATOMIC_RELAXED, __HIP_MEMORY_SCOPE_AGENT);
                            __syncthreads();
                            const int ci = __builtin_amdgcn_readfirstlane(*qslot);
                            if (ci >= CV_ITEMS) break;
                            convert_queue_item(&ka->P, l + 1, ci, (LAS float*)lds + wid * (64 * 65), wid, lane);
                        }
                    }
                }
#endif
                for (;;) {
                    __syncthreads();
                    if (tid == 0) *qslot = (int)__hip_atomic_fetch_add(ctr, 1u, __ATOMIC_RELAXED, __HIP_MEMORY_SCOPE_AGENT);
                    __syncthreads();
                    const int it = qlo + __builtin_amdgcn_readfirstlane(*qslot);
                    if (it >= qhi) break;
                    if (it < 64) {
                        rwc::Args RA; RA.R = (const bf16_t*)(ws + WS_RWR); RA.K = (const bf16_t*)(ws + WS_RWK); RA.V = (const bf16_t*)(ws + WS_RWV); RA.KK = (const bf16_t*)(ws + WS_RWKK);
                        RA.B = (const bf16_t*)(ws + WS_RWB); RA.W = (const float*)((unsigned char*)x); RA.RIN = (const float*)(ws + WS_RIN);
                        RA.G = (const bf16_t*)((unsigned char*)x + 64 * MiB); RA.BS = (const float*)(ws + WS_BS); RA.ln_w = PIN(24) + l * 512; RA.ln_b = PIN(25) + l * 512;
                        RA.mixed = rep ? (bf16_t*)((unsigned char*)x + 128 * MiB) : mixed;
                        rwc::item(RA, lds, it, wv__);
                    } else if (it < 96) {
                        hg::Args HA; HA.p = pbuf; HA.lb = (const float*)(ws + WS_LB) + l * 512; HA.out_gain = PIN(5) + l * 128; HA.mixed = mixed;
                        hg::item(HA, lds, it - 64, wv__);
                    }
                    else att::attn_one((char*)lds_raw, qbuf, kvbuf, krbuf, mixed, it - 96, pos, PIN(10) + l * 192, wv__);
                }
            } break;
            case 4: {
                pg8::Gemm g{mixed, (const bf16_t*)(wl + WO_O), T, DM, DM, DM}; pg8::StaticOrder S; S.init(T, DM, G, bid);
                pg8::EpiResidB E{l == 0 ? PIN(0) : (const float*)nullptr, (float*)nullptr, xb, ssB, DM, 0};
                pg8::gemm_phase<pg8::EpiResidB, pg8::StaticOrder, true, true>(lds, g, S, E, wv__);
            } break;
            case 5: {
                pg8::Gemm g{xb, (const bf16_t*)(wl + WO_GU), T, 2 * FF, DM, DM}; pg8::StaticOrder S; S.init(T, 2 * FF, G, bid);
                pg8::prep_row_scales(ssB, rsb, S, tid);
                pg8::EpiSwiGLU E{act, rsb, FF, 0};
                pg8::gemm_phase<pg8::EpiSwiGLU, pg8::StaticOrder, true, true>(lds, g, S, E, wv__);
            } break;
            case 6: {
                pg8::Gemm g{act, (const bf16_t*)(wl + WO_DN), T, DM, FF, FF}; pg8::StaticOrder S; S.init(T, DM, G, bid);
                pg8::EpiResidB E{(const float*)nullptr, l == DEPTH - 1 ? x : (float*)nullptr, xb, ssA, DM, 0};
                pg8::gemm_phase<pg8::EpiResidB, pg8::StaticOrder, true, true>(lds, g, S, E, wv__);
            } break;
            }
            }
        }
}
template <int PH0, int PH1>
__device__ __forceinline__ void run_phases(LAS unsigned char* lds, unsigned char* lds_raw, cg::grid_group& grid, const int G, const int bid, const int wv__) {
    if constexpr (PH0 < PH1) {
        run_phase<PH0>(lds, lds_raw, grid, G, bid, wv__);
        if constexpr (PH0 + 1 < PH1) {
            const KArgs __attribute__((address_space(4)))* ka = (const KArgs __attribute__((address_space(4)))*)__builtin_amdgcn_kernarg_segment_ptr();
            XcdBarrier xb; xb.bar = (unsigned*)(ka->P.ws + WS_CTL) + CW_BAR; xb.x = xb_xcc_id(); xb.st = (volatile LAS unsigned*)(lds + LDS_ALL - 128);
            xcd_barrier(xb, wv__);
        }
        run_phases<PH0 + 1, PH1>(lds, lds_raw, grid, G, bid, wv__);
    }
}
__global__ void __launch_bounds__(NTHREADS, 2) mega(KArgs args) {
    extern __shared__ __attribute__((aligned(16))) unsigned char lds_raw[];
    LAS unsigned char* lds = (LAS unsigned char*)lds_raw;
    const int G = gridDim.x, bid = blockIdx.x;
    const int wv__ = __builtin_amdgcn_readfirstlane((int)threadIdx.x >> 6);
    cg::grid_group grid = cg::this_grid();
    {
        volatile LAS unsigned* st = (volatile LAS unsigned*)(lds + LDS_ALL - 128);
        if (threadIdx.x < 2) st[threadIdx.x] = 0u;
        __syncthreads();
        (void)xcd_barrier_post((unsigned*)(args.P.ws + WS_CTL) + CW_BAR, st, wv__);
        grid.sync();
    }
#ifdef DUP_SYNC
    for (int i = 0; i < DUP_SYNC; ++i) { XcdBarrier xb; xb.bar = (unsigned*)(args.P.ws + WS_CTL) + CW_BAR; xb.x = xb_xcc_id(); xb.st = (volatile LAS unsigned*)(lds + LDS_ALL - 128); xcd_barrier(xb, wv__); }
#endif
    run_phases<0, N_PHASES>(lds, lds_raw, grid, G, bid, wv__);
}

extern "C" void kernel_launch(void* const* d_in, const int* in_sizes, int n_in, void* d_out, int out_size, void* d_ws, size_t ws_size, hipStream_t stream) {
    static int grid = 0;
    if (grid == 0) {
        int dev = 0, cus = 0, per_cu = 0;
        hipGetDevice(&dev);
        hipDeviceGetAttribute(&cus, hipDeviceAttributeMultiprocessorCount, dev);
        hipFuncSetAttribute((const void*)mega, hipFuncAttributeMaxDynamicSharedMemorySize, LDS_ALL);
        hipOccupancyMaxActiveBlocksPerMultiprocessor(&per_cu, (const void*)mega, NTHREADS, LDS_ALL);
        if (per_cu < 1) { fprintf(stderr, "kernel_launch: occupancy query says %d blocks/CU\n", per_cu); per_cu = 1; }
        grid = cus * 1;
        if (ws_size < WS_END) fprintf(stderr, "kernel_launch: workspace too small: %zu < %zu\n", ws_size, (size_t)WS_END);
        (void)hipGetLastError();
    }
    hipMemsetAsync((char*)d_ws + WS_CTL, 0, CTL_BYTES, stream);
    KArgs a{};
    for (int i = 0; i < 30; ++i) a.P.in[i] = (const float*)d_in[i];
    a.P.out = (float*)d_out; a.P.ws = (unsigned char*)d_ws;
#if MK_COOP
    a.ph_lo = 0; a.ph_hi = N_PHASES; a.coop = 1;
    void* kargs[] = {&a};
    hipError_t e = hipLaunchCooperativeKernel((const void*)mega, dim3(grid), dim3(NTHREADS), kargs, LDS_ALL, stream);
    if (e != hipSuccess) fprintf(stderr, "cooperative launch failed: %s (grid %d)\n", hipGetErrorString(e), grid);
#else
    for (int ph = 0; ph < N_PHASES; ++ph) {
        a.ph_lo = ph; a.ph_hi = ph + 1; a.coop = 0;
        hipLaunchKernelGGL(mega, dim3(grid), dim3(NTHREADS), LDS_ALL, stream, a);
    }
#endif
}
```

```cpp
#include <hip/hip_runtime.h>
#include <hip/hip_bf16.h>
#include <hip/hip_cooperative_groups.h>
#include <cstdio>
#include <cstdint>
namespace cg = cooperative_groups;

constexpr int BATCH = 8, SEQ = 4096, DM = 2048, DEPTH = 4;
constexpr int T = BATCH * SEQ;
constexpr int NP = 4864;
constexpr int INW = 4672;
constexpr int FF = 5632;
constexpr int C_HQ = 0, C_HF = 512, C_HI = 1024, C_HG = 1536, C_MQ = 2048, C_MKV = 2560, C_MKR = 2816, C_RW = 2880;
constexpr int C_RR = C_RW, C_RK = C_RW + 512, C_RV = C_RW + 1024, C_RWD = C_RW + 1536, C_RAD = C_RW + 1600, C_RGD = C_RW + 1664;
constexpr int QW = 1536, KVW = 2048;
constexpr float RMS_EPS = 1e-6f;

typedef unsigned short bf16_t;
typedef short bf16x8 __attribute__((ext_vector_type(8)));
typedef short s16x4 __attribute__((ext_vector_type(4)));
typedef float f32x2 __attribute__((ext_vector_type(2)));
typedef float f32x4 __attribute__((ext_vector_type(4)));
typedef float f32x16 __attribute__((ext_vector_type(16)));
typedef unsigned u32x2 __attribute__((ext_vector_type(2)));
typedef unsigned u32x4 __attribute__((ext_vector_type(4)));
#define LAS __attribute__((address_space(3)))

constexpr size_t MiB = 1u << 20;
constexpr size_t WS_CTL = 0;
constexpr size_t CTL_BYTES = 65536;
constexpr size_t WS_RS = 1 * MiB;
constexpr size_t WS_SSB = WS_RS + 128 * 1024;
constexpr size_t WS_RSQ = WS_SSB;
constexpr size_t WS_RSKV = WS_RSQ + 128 * 1024;
constexpr size_t WS_LB = WS_RSKV + 128 * 1024;
constexpr size_t WS_RIN = 2 * MiB;
constexpr size_t WS_BS = 3 * MiB;
constexpr size_t WS_W = 4 * MiB;
constexpr size_t W_LAYER = 96 * MiB;
constexpr size_t WO_IN = 0;
constexpr size_t WO_QB = WO_IN + (size_t)NP * DM * 2;
constexpr size_t WO_KVB = WO_QB + (size_t)QW * 512 * 2;
constexpr size_t WO_O = WO_KVB + (size_t)KVW * 256 * 2;
constexpr size_t WO_GU = WO_O + (size_t)DM * DM * 2;
constexpr size_t WO_DN = WO_GU + (size_t)2 * FF * DM * 2;
constexpr size_t WO_LORA = WO_DN + (size_t)DM * FF * 2;
static_assert(WO_LORA + 163840 * 2 <= W_LAYER, "weight layer stride");
constexpr size_t WS_XB = WS_W + DEPTH * W_LAYER;
constexpr size_t WS_P = WS_XB + 128 * MiB;
constexpr size_t WS_MIX = WS_P + 304 * MiB;
constexpr size_t WS_D = WS_MIX + 128 * MiB;
constexpr size_t WS_Q = WS_D;
constexpr size_t WS_KV = WS_Q + 96 * MiB;
constexpr size_t WS_KR = WS_KV + 128 * MiB;
constexpr size_t WS_RWR = WS_KR + 4 * MiB;
constexpr size_t WS_RWK = WS_RWR + 32 * MiB;
constexpr size_t WS_RWV = WS_RWK + 32 * MiB;
constexpr size_t WS_RWKK = WS_RWV + 32 * MiB;
constexpr size_t WS_RWB = WS_RWKK + 32 * MiB;
constexpr size_t WS_VFIRST = WS_RWB + 32 * MiB;
constexpr size_t WS_SSA = WS_VFIRST + 32 * MiB;
constexpr size_t WS_SSBP = WS_SSA + 4 * MiB;
constexpr size_t WS_END = WS_SSBP + 4 * MiB;
constexpr size_t WS_ACT = WS_D;
static_assert(WS_ACT + (size_t)T * FF * 2 <= WS_VFIRST, "act overlay must not reach v_first");
constexpr size_t WS_RWW = WS_XB;
constexpr size_t WS_RWG = WS_XB + 64 * MiB;
constexpr size_t WS_RWBON = WS_XB + 96 * MiB;

__device__ __forceinline__ int tid_from(int wv) { unsigned z = 0u; asm volatile("" : "+v"(z)); return (wv << 6) | (int)__builtin_amdgcn_mbcnt_hi(~0u, __builtin_amdgcn_mbcnt_lo(~0u, z)); }
#define TID() tid_from(wv__)
__device__ __forceinline__ float bf2f(bf16_t v) { return __uint_as_float(((unsigned)v) << 16); }
typedef __bf16 bf16x2_t __attribute__((ext_vector_type(2)));
__device__ __forceinline__ unsigned cvt_pk_bf16(float lo, float hi) { f32x2 v = {lo, hi}; bf16x2_t b = __builtin_convertvector(v, bf16x2_t); return __builtin_bit_cast(unsigned, b); }
__device__ __forceinline__ bf16_t f2bf(float f) { return (bf16_t)(cvt_pk_bf16(f, 0.f) & 0xffffu); }
__device__ __forceinline__ float lo_bf(unsigned w) { return __uint_as_float(w << 16); }
__device__ __forceinline__ float hi_bf(unsigned w) { return __uint_as_float(w & 0xffff0000u); }
__device__ __forceinline__ float fast_exp(float x) { return __builtin_amdgcn_exp2f(x * 1.4426950408889634f); }
__device__ __forceinline__ float fast_rcp(float x) { return __builtin_amdgcn_rcpf(x); }
__device__ __forceinline__ float sigmoidf_(float x) { return fast_rcp(1.f + fast_exp(-x)); }
__device__ __forceinline__ float siluf_(float x) { return x * sigmoidf_(x); }
#define DPPF(x, CTRL) __int_as_float(__builtin_amdgcn_update_dpp(0, __float_as_int(x), CTRL, 0xf, 0xf, true))
__device__ __forceinline__ float wave_sum(float v) {
    v += DPPF(v, 0xB1);
    v += DPPF(v, 0x4E);
    v += DPPF(v, 0x141);
    v += DPPF(v, 0x140);
    const float r0 = __int_as_float(__builtin_amdgcn_readlane(__float_as_int(v), 0)), r1 = __int_as_float(__builtin_amdgcn_readlane(__float_as_int(v), 16));
    const float r2 = __int_as_float(__builtin_amdgcn_readlane(__float_as_int(v), 32)), r3 = __int_as_float(__builtin_amdgcn_readlane(__float_as_int(v), 48));
    return (r0 + r1) + (r2 + r3);
}
__device__ __forceinline__ float xor32f(float x, int lane) { auto rr = __builtin_amdgcn_permlane32_swap(__float_as_uint(x), __float_as_uint(x), false, false); return __uint_as_float(lane < 32 ? rr[1] : rr[0]); }
__device__ __forceinline__ float sum8f(float x) { x += DPPF(x, 0xB1); x += DPPF(x, 0x4E); x += DPPF(x, 0x141); return x; }
#define MK_COOP 1
#define CONV_IN_MIXERS 1
#define CONV_EVERY 5
namespace pg8 {
#define PG8_LAS __attribute__((address_space(3)))
typedef unsigned short bf16_t;
typedef short bf16x8 __attribute__((ext_vector_type(8)));
typedef float f32x4 __attribute__((ext_vector_type(4)));
typedef unsigned u32x4 __attribute__((ext_vector_type(4)));
constexpr int BM = 256, BK = 64, HALF = 128, HTB = HALF * BK * 2  , STAGE_BYTES = 8 * HTB, NXCD = 8, WGM = 8;

__host__ __device__ __forceinline__ int lds_byte(int r, int c) { const int st = (r >> 4) * 2 + (c >> 5), rr = r & 15, cc = c & 31, ob = rr * 64 + cc * 2; return st * 1024 + (ob ^ (((ob >> 9) & 1) << 5)); }
__host__ __device__ __forceinline__ void stage_rc(int b, int& R, int& C) { const int st = b / 1024, sb = b % 1024, swz = sb ^ (((sb >> 9) & 1) << 5); R = (st >> 1) * 16 + swz / 64; C = (st & 1) * 32 + (swz % 64) / 2; }
__host__ __device__ __forceinline__ int perm32(int rho) { const int n = rho >> 4, i = rho & 15; return 8 * (i >> 2) + 4 * n + (i & 3); }

struct Unit { int pm, pn; };
struct Gemm { const bf16_t* A; const bf16_t* Bt; int M, N, K, lda; };

struct StaticOrder {
    int nM, nN, nwg, G, c;
    __host__ __device__ void init(int M, int N, int G_, int c_) { nM = M / BM; nN = N / BM; nwg = nM * nN; G = G_; c = c_; }
    __host__ __device__ bool next(int i, Unit& u) const {
        const long L = (long)i * G + c; if (L >= nwg) return false;
        int wgid = (int)L; { const int q = nwg / NXCD, r = nwg % NXCD, xcd = wgid % NXCD, off = wgid / NXCD; wgid = (xcd < r ? xcd * (q + 1) : r * (q + 1) + (xcd - r) * q) + off; }
        const int nig = WGM * nN, gid = wgid / nig, fm = gid * WGM, gsz = (nM - fm) < WGM ? (nM - fm) : WGM;
        u.pm = fm + ((wgid % nig) % gsz); u.pn = (wgid % nig) / gsz; return true;
    }
    __device__ __forceinline__ void a_ready(const Unit&) const {}
    __device__ __forceinline__ void done(const Unit&) const {}
};

using ::cvt_pk_bf16;
typedef float f32x2 __attribute__((ext_vector_type(2)));

__device__ __forceinline__ float row_scale32(const float* part, int row) {
    const f32x4* p = (const f32x4*)(part + (size_t)row * 32);
    f32x4 a = p[0] + p[1], b = p[2] + p[3], c = p[4] + p[5], d = p[6] + p[7];
    a = (a + b) + (c + d);
    return 1.f / sqrtf(((a[0] + a[1]) + (a[2] + a[3])) * (1.f / 2048.f) + 1e-6f);
}
struct EpiScaleBf16 {
    static constexpr bool PERM = true, AFTER_DRAIN = false;
    bf16_t* O; const float* rs; int ldc; int ssq;
    __device__ __forceinline__ void operator()(const f32x4 (&acc)[2][2][4][2], const Unit& u, int wr, int wc, int fr_, int fq_) const {
        unsigned z_ = 0u; asm volatile("" : "+v"(z_)); const int ln_ = (int)__builtin_amdgcn_mbcnt_hi(~0u, __builtin_amdgcn_mbcnt_lo(~0u, z_)); const int fr = ln_ & 15, fq = ln_ >> 4; (void)fr_; (void)fq_;
        const int row0 = u.pm * BM + wr * 64 + fr, col0 = u.pn * BM + wc * 32 + 8 * fq;
        float scv[2][4];
#pragma unroll
        for (int ai = 0; ai < 2; ++ai)
#pragma unroll
            for (int m = 0; m < 4; ++m) scv[ai][m] = rs ? rs[row0 + ai * HALF + m * 16] : 1.f;
#pragma unroll
        for (int ai = 0; ai < 2; ++ai)
#pragma unroll
            for (int m = 0; m < 4; ++m) { const int row = row0 + ai * HALF + m * 16; const float sc = scv[ai][m]; bf16_t* rowp = O + (size_t)row * ldc + col0;
#pragma unroll
                for (int bj = 0; bj < 2; ++bj) { const f32x4 v0 = acc[ai][bj][m][0] * sc, v1 = acc[ai][bj][m][1] * sc;
                    u32x4 w; w.x = cvt_pk_bf16(v0[0], v0[1]); w.y = cvt_pk_bf16(v0[2], v0[3]); w.z = cvt_pk_bf16(v1[0], v1[1]); w.w = cvt_pk_bf16(v1[2], v1[3]);
                    *(u32x4*)(rowp + bj * HALF) = w; } }
    }
};
struct EpiPlainBf16 {
    static constexpr bool PERM = true, AFTER_DRAIN = false;
    bf16_t* O; int ldc; int pad_;
    __device__ __forceinline__ void operator()(const f32x4 (&acc)[2][2][4][2], const Unit& u, int wr, int wc, int fr, int fq) const {
        const int row0 = u.pm * BM + wr * 64 + fr, col0 = u.pn * BM + wc * 32 + 8 * fq;
#pragma unroll
        for (int ai = 0; ai < 2; ++ai)
#pragma unroll
            for (int m = 0; m < 4; ++m) { bf16_t* rowp = O + (size_t)(row0 + ai * HALF + m * 16) * ldc + col0;
#pragma unroll
                for (int bj = 0; bj < 2; ++bj) { const f32x4 v0 = acc[ai][bj][m][0], v1 = acc[ai][bj][m][1];
                    u32x4 w; w.x = cvt_pk_bf16(v0[0], v0[1]); w.y = cvt_pk_bf16(v0[2], v0[3]); w.z = cvt_pk_bf16(v1[0], v1[1]); w.w = cvt_pk_bf16(v1[2], v1[3]);
                    *(u32x4*)(rowp + bj * HALF) = w; } }
    }
};
struct EpiResid {
    static constexpr bool PERM = false, AFTER_DRAIN = false;
    float* X; int ldc; int pad_;
    __device__ __forceinline__ void operator()(const f32x4 (&acc)[2][2][4][2], const Unit& u, int wr, int wc, int fr_, int fq_) const {
        unsigned z_ = 0u; asm volatile("" : "+v"(z_)); const int ln_ = (int)__builtin_amdgcn_mbcnt_hi(~0u, __builtin_amdgcn_mbcnt_lo(~0u, z_)); const int fr = ln_ & 15, fq = ln_ >> 4; (void)fr_; (void)fq_;
        const int row0 = u.pm * BM + wr * 64 + fr, col0 = u.pn * BM + wc * 32 + 4 * fq;
#pragma unroll
        for (int ai = 0; ai < 2; ++ai)
#pragma unroll
            for (int m = 0; m < 4; ++m) { float* rowp = X + (size_t)(row0 + ai * HALF + m * 16) * ldc + col0;
                f32x4 xv[2][2];
#pragma unroll
                for (int bj = 0; bj < 2; ++bj)
#pragma unroll
                    for (int n = 0; n < 2; ++n) xv[bj][n] = *(const f32x4*)(rowp + bj * HALF + n * 16);
#pragma unroll
                for (int bj = 0; bj < 2; ++bj)
#pragma unroll
                    for (int n = 0; n < 2; ++n) *(f32x4*)(rowp + bj * HALF + n * 16) = xv[bj][n] + acc[ai][bj][m][n]; }
    }
};
struct EpiKV {
    static constexpr bool PERM = true, AFTER_DRAIN = false;
    bf16_t* O; const float* rs; const float* kg; PG8_LAS float* red; int ldc; int pad_;
    __device__ __forceinline__ void operator()(const f32x4 (&acc)[2][2][4][2], const Unit& u, int wr, int wc, int fr_, int fq_) const {
        unsigned z_ = 0u; asm volatile("" : "+v"(z_)); const int ln_ = (int)__builtin_amdgcn_mbcnt_hi(~0u, __builtin_amdgcn_mbcnt_lo(~0u, z_)); const int fr = ln_ & 15, fq = ln_ >> 4; (void)fr_; (void)fq_;
        const int rl0 = wr * 64 + fr;
        const int col0 = u.pn * BM + wc * 32 + 8 * fq;
#pragma unroll
        for (int ai = 0; ai < 2; ++ai)
#pragma unroll
            for (int m = 0; m < 4; ++m) { const f32x4 a = acc[ai][0][m][0], b = acc[ai][0][m][1];
                float s = ((a[0] * a[0] + a[1] * a[1]) + (a[2] * a[2] + a[3] * a[3])) + ((b[0] * b[0] + b[1] * b[1]) + (b[2] * b[2] + b[3] * b[3]));
                { auto r16 = __builtin_amdgcn_permlane16_swap(__float_as_uint(s), __float_as_uint(s), false, false); s = __uint_as_float(r16[0]) + __uint_as_float(r16[1]);
                  auto r32 = __builtin_amdgcn_permlane32_swap(__float_as_uint(s), __float_as_uint(s), false, false); s = __uint_as_float(r32[0]) + __uint_as_float(r32[1]); }
                if (fq == 0) red[(rl0 + ai * HALF + m * 16) * 4 + wc] = s;
                asm volatile("" ::: "memory"); }
        asm volatile("s_waitcnt lgkmcnt(0)" ::: "memory"); __builtin_amdgcn_s_barrier(); asm volatile("" ::: "memory");
        const unsigned go = (unsigned)(wc * 32 + 8 * fq) * 4u;
        const f32x4 g0 = *(const f32x4*)((const char*)kg + go), g1 = *(const f32x4*)((const char*)kg + go + 16);
#pragma unroll
        for (int ai = 0; ai < 2; ++ai) {
            float scv[4];
#pragma unroll
            for (int m = 0; m < 4; ++m) scv[m] = rs[u.pm * BM + rl0 + ai * HALF + m * 16];
#pragma unroll
            for (int m = 0; m < 4; ++m) { const int rl = rl0 + ai * HALF + m * 16, row = u.pm * BM + rl;
                const f32x4 r4 = *(const PG8_LAS f32x4*)(red + rl * 4);
                const float rk = 1.f / sqrtf(((r4[0] + r4[1]) + (r4[2] + r4[3])) * (1.f / 128.f) + 1e-6f), sc = scv[m];
                bf16_t* rowp = O + (size_t)row * ldc + col0;
                { const f32x4 v0 = acc[ai][0][m][0] * rk * g0, v1 = acc[ai][0][m][1] * rk * g1;
                  u32x4 w; w.x = cvt_pk_bf16(v0[0], v0[1]); w.y = cvt_pk_bf16(v0[2], v0[3]); w.z = cvt_pk_bf16(v1[0], v1[1]); w.w = cvt_pk_bf16(v1[2], v1[3]);
                  *(u32x4*)rowp = w; }
                { const f32x4 v0 = acc[ai][1][m][0] * sc, v1 = acc[ai][1][m][1] * sc;
                  u32x4 w; w.x = cvt_pk_bf16(v0[0], v0[1]); w.y = cvt_pk_bf16(v0[2], v0[3]); w.z = cvt_pk_bf16(v1[0], v1[1]); w.w = cvt_pk_bf16(v1[2], v1[3]);
                  *(u32x4*)(rowp + HALF) = w; }
                asm volatile("" ::: "memory"); } }
        asm volatile("s_waitcnt lgkmcnt(0)" ::: "memory"); __builtin_amdgcn_s_barrier(); asm volatile("" ::: "memory");
    }
};
struct EpiResidN {
    static constexpr bool PERM = false, AFTER_DRAIN = false;
    const float* Xin; float* Xout; bf16_t* xb; float* ssq; int ldc; int pad_;
    __device__ __forceinline__ void operator()(const f32x4 (&acc)[2][2][4][2], const Unit& u, int wr, int wc, int fr_, int fq_) const {
        unsigned z_ = 0u; asm volatile("" : "+v"(z_)); const int ln_ = (int)__builtin_amdgcn_mbcnt_hi(~0u, __builtin_amdgcn_mbcnt_lo(~0u, z_)); const int fr = ln_ & 15, fq = ln_ >> 4; (void)fr_; (void)fq_;
        const int row0 = u.pm * BM + wr * 64 + fr, col0 = u.pn * BM + wc * 32 + 4 * fq;
#pragma unroll
        for (int ai = 0; ai < 2; ++ai)
        {   f32x4 xv[4][2][2];
#pragma unroll
            for (int m = 0; m < 4; ++m)
#pragma unroll
                for (int bj = 0; bj < 2; ++bj)
#pragma unroll
                    for (int n = 0; n < 2; ++n) xv[m][bj][n] = *(const f32x4*)(Xin + (size_t)(row0 + ai * HALF + m * 16) * ldc + col0 + bj * HALF + n * 16);
#pragma unroll
            for (int m = 0; m < 4; ++m) { const int row = row0 + ai * HALF + m * 16; const size_t off = (size_t)row * ldc + col0;
                float s = 0.f;
#pragma unroll
                for (int bj = 0; bj < 2; ++bj)
#pragma unroll
                    for (int n = 0; n < 2; ++n) { const f32x4 v = xv[m][bj][n] + acc[ai][bj][m][n]; *(f32x4*)(Xout + off + bj * HALF + n * 16) = v;
                        u32x2 w; w.x = cvt_pk_bf16(v[0], v[1]); w.y = cvt_pk_bf16(v[2], v[3]); *(u32x2*)(xb + off + bj * HALF + n * 16) = w;
                        s += (v[0] * v[0] + v[1] * v[1]) + (v[2] * v[2] + v[3] * v[3]); }
                { auto r16 = __builtin_amdgcn_permlane16_swap(__float_as_uint(s), __float_as_uint(s), false, false); s = __uint_as_float(r16[0]) + __uint_as_float(r16[1]);
                  auto r32 = __builtin_amdgcn_permlane32_swap(__float_as_uint(s), __float_as_uint(s), false, false); s = __uint_as_float(r32[0]) + __uint_as_float(r32[1]); }
                if (fq == 0) ssq[(size_t)row * 32 + u.pn * 4 + wc] = s; }
        }
    }
};
struct EpiResidB {
    static constexpr bool PERM = true, AFTER_DRAIN = false;
    const float* XinF; float* OutF; bf16_t* xb; float* ssq; int ldc; int pad_;
    __device__ __forceinline__ void operator()(const f32x4 (&acc)[2][2][4][2], const Unit& u, int wr, int wc, int fr_, int fq_) const {
        unsigned z_ = 0u; asm volatile("" : "+v"(z_)); const int ln_ = (int)__builtin_amdgcn_mbcnt_hi(~0u, __builtin_amdgcn_mbcnt_lo(~0u, z_)); const int fr = ln_ & 15, fq = ln_ >> 4; (void)fr_; (void)fq_;
        const int row0 = u.pm * BM + wr * 64 + fr, col0 = u.pn * BM + wc * 32 + 8 * fq;
#pragma unroll
        for (int ai = 0; ai < 2; ++ai) {
            f32x4 r0[4][2], r1[4][2];
#pragma unroll
            for (int m = 0; m < 4; ++m)
#pragma unroll
                for (int bj = 0; bj < 2; ++bj) { const size_t off = (size_t)(row0 + ai * HALF + m * 16) * ldc + col0 + bj * HALF;
                    if (XinF) { r0[m][bj] = *(const f32x4*)(XinF + off); r1[m][bj] = *(const f32x4*)(XinF + off + 4); }
                    else { const u32x4 w = *(const u32x4*)(xb + off); r0[m][bj] = (f32x4){lo_bf(w.x), hi_bf(w.x), lo_bf(w.y), hi_bf(w.y)}; r1[m][bj] = (f32x4){lo_bf(w.z), hi_bf(w.z), lo_bf(w.w), hi_bf(w.w)}; } }
#pragma unroll
            for (int m = 0; m < 4; ++m) { const int row = row0 + ai * HALF + m * 16; float s = 0.f;
#pragma unroll
                for (int bj = 0; bj < 2; ++bj) { const size_t off = (size_t)row * ldc + col0 + bj * HALF;
                    const f32x4 v0 = r0[m][bj] + acc[ai][bj][m][0], v1 = r1[m][bj] + acc[ai][bj][m][1];
                    u32x4 w; w.x = cvt_pk_bf16(v0[0], v0[1]); w.y = cvt_pk_bf16(v0[2], v0[3]); w.z = cvt_pk_bf16(v1[0], v1[1]); w.w = cvt_pk_bf16(v1[2], v1[3]);
                    *(u32x4*)(xb + off) = w;
                    if (OutF) { *(f32x4*)(OutF + off) = v0; *(f32x4*)(OutF + off + 4) = v1; }
                    s += ((v0[0] * v0[0] + v0[1] * v0[1]) + (v0[2] * v0[2] + v0[3] * v0[3])) + ((v1[0] * v1[0] + v1[1] * v1[1]) + (v1[2] * v1[2] + v1[3] * v1[3])); }
                { auto r16 = __builtin_amdgcn_permlane16_swap(__float_as_uint(s), __float_as_uint(s), false, false); s = __uint_as_float(r16[0]) + __uint_as_float(r16[1]);
                  auto r32 = __builtin_amdgcn_permlane32_swap(__float_as_uint(s), __float_as_uint(s), false, false); s = __uint_as_float(r32[0]) + __uint_as_float(r32[1]); }
                if (fq == 0) ssq[(size_t)row * 32 + u.pn * 4 + wc] = s; }
        }
    }
};
struct EpiSwiGLU {
    static constexpr bool PERM = true, AFTER_DRAIN = false;
    bf16_t* O; const float* rs; int ldc; int pad_;
    __device__ __forceinline__ void operator()(const f32x4 (&acc)[2][2][4][2], const Unit& u, int wr, int wc, int fr_, int fq_) const {
        unsigned z_ = 0u; asm volatile("" : "+v"(z_)); const int ln_ = (int)__builtin_amdgcn_mbcnt_hi(~0u, __builtin_amdgcn_mbcnt_lo(~0u, z_)); const int fr = ln_ & 15, fq = ln_ >> 4; (void)fr_; (void)fq_;
        const int row0 = u.pm * BM + wr * 64 + fr, col0 = u.pn * HALF + wc * 32 + 8 * fq;
        float scv[2][4];
#pragma unroll
        for (int ai = 0; ai < 2; ++ai)
#pragma unroll
            for (int m = 0; m < 4; ++m) scv[ai][m] = rs[row0 + ai * HALF + m * 16];
#pragma unroll
        for (int ai = 0; ai < 2; ++ai)
#pragma unroll
            for (int m = 0; m < 4; ++m) { const int row = row0 + ai * HALF + m * 16; const float sc = scv[ai][m]; bf16_t* rowp = O + (size_t)row * ldc + col0;
                float o[8];
#pragma unroll
                for (int n = 0; n < 2; ++n)
#pragma unroll
                    for (int i = 0; i < 4; ++i) { const float g = acc[ai][0][m][n][i] * sc, up = acc[ai][1][m][n][i] * sc;
                        o[n * 4 + i] = g * __builtin_amdgcn_rcpf(1.f + __builtin_amdgcn_exp2f(g * -1.4426950408889634f)) * up; }
                u32x4 w; w.x = cvt_pk_bf16(o[0], o[1]); w.y = cvt_pk_bf16(o[2], o[3]); w.z = cvt_pk_bf16(o[4], o[5]); w.w = cvt_pk_bf16(o[6], o[7]);
                *(u32x4*)rowp = w; }
    }
};

template <class Sched>
__device__ __forceinline__ void prep_row_scales(const float* part, float* rs, const Sched& S, int tid) {
    Unit u; int last = -1;
    for (int i = 0; S.next(i, u); ++i) {
        if (u.pm == last) continue;
        last = u.pm;
        const int row = u.pm * BM + (tid >> 1);
        const f32x4* p = (const f32x4*)(part + (size_t)row * 32 + (tid & 1) * 16);
        f32x4 a = (p[0] + p[1]) + (p[2] + p[3]);
        float s = (a[0] + a[1]) + (a[2] + a[3]);
        s += DPPF(s, 0xB1);
        if ((tid & 1) == 0) rs[row] = 1.f / sqrtf(s * (1.f / 2048.f) + 1e-6f);
    }
    asm volatile("s_waitcnt vmcnt(0)" ::: "memory");
    __syncthreads();
}
template <class Epi, class Sched, bool ALIGN_EPI = false, bool SP2 = false>
__device__ __forceinline__ void gemm_phase(PG8_LAS unsigned char* lds, const Gemm g, const Sched& S, const Epi& E, const int wv__) {
    const int tid = TID(), wid = __builtin_amdgcn_readfirstlane(tid >> 6), lane = tid & 63, wr = wid >> 2, wc = wid & 3, fr = lane & 15, fq = lane >> 4;
    const int K = g.K, nt = K / BK;
    unsigned voffA[2], voffB[2];
#pragma unroll
    for (int i = 0; i < 2; ++i) { int R, C; stage_rc(tid * 16 + i * 8192, R, C); const int Rb = Epi::PERM ? ((R & ~31) + perm32(R & 31)) : R;
        voffA[i] = (unsigned)(R * g.lda + C) * 2u; voffB[i] = (unsigned)(Rb * K + C) * 2u; }
    const size_t kstep = (size_t)(BK * 2);
    const size_t hstepA = (size_t)HALF * g.lda * 2, hstepB = (size_t)HALF * K * 2;
    const size_t tstepA = 2 * hstepA, tstepB = 2 * hstepB;
    const unsigned ldsw = (unsigned)wid * 1024u;
    const int aoff = lds_byte(wr * 64 + fr, fq * 8), boff = lds_byte(wc * 32 + fr, fq * 8);
#define PG8_SA(b, h) (((b) * 2 + (h)) * HTB)
#define PG8_SB(b, h) ((4 + (b) * 2 + (h)) * HTB)
#define PG8_STAGE(bufoff, gbase, voff) do { _Pragma("unroll") for (int _i = 0; _i < 2; ++_i) \
        __builtin_amdgcn_global_load_lds((const unsigned*)((const char*)(gbase) + (voff)[_i]), (PG8_LAS unsigned*)(lds + (bufoff) + ldsw + _i * 8192), 16, 0, 0); } while (0)
#define PG8_LDA(dst, b, h) do { _Pragma("unroll") for (int m = 0; m < 4; ++m) _Pragma("unroll") for (int k = 0; k < 2; ++k) dst[m][k] = *(const PG8_LAS bf16x8*)(lds + PG8_SA(b, h) + aoff + m * 2048 + k * 1024); } while (0)
#define PG8_LDB(dst, b, h) do { _Pragma("unroll") for (int n = 0; n < 2; ++n) _Pragma("unroll") for (int k = 0; k < 2; ++k) dst[n][k] = *(const PG8_LAS bf16x8*)(lds + PG8_SB(b, h) + boff + n * 2048 + k * 1024); } while (0)
#define PG8_MMA(ai, bj, At, Bt) do { __builtin_amdgcn_s_setprio(1); _Pragma("unroll") for (int m = 0; m < 4; ++m) _Pragma("unroll") for (int n = 0; n < 2; ++n) _Pragma("unroll") for (int k = 0; k < 2; ++k) \
        acc[ai][bj][m][n] = __builtin_amdgcn_mfma_f32_16x16x32_bf16(Bt[n][k], At[m][k], acc[ai][bj][m][n], 0, 0, 0); __builtin_amdgcn_s_setprio(0); } while (0)
#define PG8_WAIT_V(n) asm volatile("s_waitcnt vmcnt(" #n ")" ::: "memory")
#define PG8_WAIT_L(n) asm volatile("s_waitcnt lgkmcnt(" #n ")" ::: "memory")
#define PG8_BAR __builtin_amdgcn_s_barrier()
#define PG8_SCHED __builtin_amdgcn_sched_barrier(0)
    Unit cur, nxt; int ui = 0;
    if (!S.next(0, cur)) return;
    f32x4 acc[2][2][4][2];
#pragma unroll
    for (int a = 0; a < 2; ++a)
#pragma unroll
        for (int b = 0; b < 2; ++b)
#pragma unroll
            for (int m = 0; m < 4; ++m)
#pragma unroll
                for (int n = 0; n < 2; ++n) acc[a][b][m][n] = (f32x4){0.f, 0.f, 0.f, 0.f};
    bf16x8 At[4][2], B0[2][2], B1[2][2];
    const char* cA = (const char*)g.A + (size_t)cur.pm * tstepA; const char* cB = (const char*)g.Bt + (size_t)cur.pn * tstepB;
    S.a_ready(cur);
    if constexpr (SP2) {
        PG8_STAGE(PG8_SB(0, 0), cB, voffB); PG8_STAGE(PG8_SB(0, 1), cB + hstepB, voffB); PG8_STAGE(PG8_SA(0, 0), cA, voffA); PG8_STAGE(PG8_SA(0, 1), cA + hstepA, voffA);
        if (wr == 1) PG8_BAR;
        PG8_WAIT_V(2); PG8_BAR;
        PG8_STAGE(PG8_SB(1, 0), cB + kstep, voffB); PG8_STAGE(PG8_SA(1, 0), cA + kstep, voffA); PG8_STAGE(PG8_SB(1, 1), cB + hstepB + kstep, voffB);
        PG8_WAIT_V(6); PG8_BAR;
    } else {
        PG8_STAGE(PG8_SB(0, 0), cB, voffB); PG8_STAGE(PG8_SA(0, 0), cA, voffA); PG8_STAGE(PG8_SB(0, 1), cB + hstepB, voffB); PG8_STAGE(PG8_SA(0, 1), cA + hstepA, voffA);
        if (wr == 1) PG8_BAR;
        PG8_WAIT_V(4); PG8_BAR;
        PG8_STAGE(PG8_SB(1, 0), cB + kstep, voffB); PG8_STAGE(PG8_SA(1, 0), cA + kstep, voffA); PG8_STAGE(PG8_SB(1, 1), cB + hstepB + kstep, voffB);
        PG8_WAIT_V(6); PG8_BAR;
    }
    for (;;) {
        const bool has_next = S.next(ui + 1, nxt);
        const char* nA = has_next ? (const char*)g.A + (size_t)nxt.pm * tstepA : cA; const char* nB = has_next ? (const char*)g.Bt + (size_t)nxt.pn * tstepB : cB;
        for (int t = 0; t < nt; t += 2) {
            const bool last = (t == nt - 2);
            const char* a1 = cA + (size_t)(t + 1) * kstep;
            const char* a2 = last ? nA : cA + (size_t)(t + 2) * kstep; const char* b2 = last ? nB : cB + (size_t)(t + 2) * kstep;
            const char* a3 = a2 + kstep; const char* b3 = b2 + kstep;
            if (last && has_next) S.a_ready(nxt);
            if constexpr (SP2) {
            PG8_LDB(B0, 0, 0); PG8_LDB(B1, 0, 1); PG8_SCHED; PG8_LDA(At, 0, 0); PG8_STAGE(PG8_SA(1, 1), a1 + hstepA, voffA);
            PG8_WAIT_V(8); PG8_WAIT_L(0); PG8_BAR; PG8_MMA(0, 0, At, B0); PG8_MMA(0, 1, At, B1); PG8_BAR; PG8_SCHED;
            PG8_LDA(At, 0, 1); PG8_STAGE(PG8_SB(0, 0), b2, voffB); PG8_STAGE(PG8_SB(0, 1), b2 + hstepB, voffB); PG8_STAGE(PG8_SA(0, 0), a2, voffA);
            PG8_WAIT_V(8); PG8_WAIT_L(0); PG8_BAR; PG8_MMA(1, 0, At, B0); PG8_MMA(1, 1, At, B1); PG8_BAR; PG8_SCHED;
            PG8_LDB(B0, 1, 0); PG8_LDB(B1, 1, 1); PG8_SCHED; PG8_LDA(At, 1, 0); PG8_STAGE(PG8_SA(0, 1), a2 + hstepA, voffA);
            PG8_WAIT_V(8); PG8_WAIT_L(0); PG8_BAR; PG8_MMA(0, 0, At, B0); PG8_MMA(0, 1, At, B1); PG8_BAR; PG8_SCHED;
            PG8_LDA(At, 1, 1); PG8_STAGE(PG8_SB(1, 0), b3, voffB); PG8_STAGE(PG8_SB(1, 1), b3 + hstepB, voffB); PG8_STAGE(PG8_SA(1, 0), a3, voffA);
            PG8_WAIT_V(8); PG8_WAIT_L(0); PG8_BAR; PG8_MMA(1, 0, At, B0); PG8_MMA(1, 1, At, B1); PG8_BAR; PG8_SCHED;
            } else {
            PG8_LDB(B0, 0, 0); PG8_SCHED; PG8_LDA(At, 0, 0); PG8_STAGE(PG8_SA(1, 1), a1 + hstepA, voffA);
            PG8_WAIT_L(8); PG8_BAR; PG8_WAIT_L(0); PG8_MMA(0, 0, At, B0); PG8_BAR; PG8_SCHED;
            PG8_LDB(B1, 0, 1); PG8_STAGE(PG8_SB(0, 0), b2, voffB);
            PG8_BAR; PG8_WAIT_L(0); PG8_MMA(0, 1, At, B1); PG8_BAR;
            PG8_LDA(At, 0, 1); PG8_STAGE(PG8_SA(0, 0), a2, voffA);
            PG8_BAR; PG8_WAIT_L(0); PG8_MMA(1, 0, At, B0); PG8_BAR; PG8_SCHED;
            PG8_STAGE(PG8_SB(0, 1), b2 + hstepB, voffB);
            PG8_WAIT_V(6); PG8_BAR; PG8_MMA(1, 1, At, B1); PG8_BAR;
            PG8_LDB(B0, 1, 0); PG8_SCHED; PG8_LDA(At, 1, 0); PG8_STAGE(PG8_SA(0, 1), a2 + hstepA, voffA);
            PG8_WAIT_L(8); PG8_BAR; PG8_WAIT_L(0); PG8_MMA(0, 0, At, B0); PG8_BAR; PG8_SCHED;
            PG8_LDB(B1, 1, 1); PG8_STAGE(PG8_SB(1, 0), b3, voffB);
            PG8_BAR; PG8_WAIT_L(0); PG8_MMA(0, 1, At, B1); PG8_BAR;
            PG8_LDA(At, 1, 1); PG8_STAGE(PG8_SA(1, 0), a3, voffA);
            PG8_BAR; PG8_WAIT_L(0); PG8_MMA(1, 0, At, B0); PG8_BAR; PG8_SCHED;
            PG8_STAGE(PG8_SB(1, 1), b3 + hstepB, voffB);
            PG8_WAIT_V(6); PG8_BAR; PG8_MMA(1, 1, At, B1); PG8_BAR;
            }
        }
        if constexpr (ALIGN_EPI) { if (wr == 0) PG8_BAR; }
        if constexpr (!Epi::AFTER_DRAIN) { E(acc, cur, wr, wc, fr, fq); S.done(cur); }
        if (!has_next) break;
#pragma unroll
        for (int a = 0; a < 2; ++a)
#pragma unroll
            for (int b = 0; b < 2; ++b)
#pragma unroll
                for (int m = 0; m < 4; ++m)
#pragma unroll
                    for (int n = 0; n < 2; ++n) acc[a][b][m][n] = (f32x4){0.f, 0.f, 0.f, 0.f};
        cur = nxt; cA = nA; cB = nB; ++ui;
        if constexpr (ALIGN_EPI) { if (wr == 1) PG8_BAR; }
    }
    PG8_WAIT_V(0);
    if constexpr (!ALIGN_EPI) { if (wr == 0) PG8_BAR; }
    PG8_BAR;
    if constexpr (Epi::AFTER_DRAIN) { E.fused(acc, cur, wr, wc, fr, fq, lds, wid, lane); S.done(cur); }
#undef PG8_SA
#undef PG8_SB
#undef PG8_STAGE
#undef PG8_LDA
#undef PG8_LDB
#undef PG8_MMA
#undef PG8_WAIT_V
#undef PG8_WAIT_L
#undef PG8_BAR
#undef PG8_SCHED
}
}
__device__ __forceinline__ void rope_cs(int pos, int j, float& c, float& s) {
    const float inv_freq = exp2f(-(float)j * (13.287712379549449f / 32.f));
    const float ang = (float)pos * inv_freq;
    float rev = ang * 0.15915494309189535f; rev = rev - floorf(rev);
    c = __builtin_amdgcn_cosf(rev); s = __builtin_amdgcn_sinf(rev);
}
namespace att {
constexpr int NW = 8, QBLK = 32, KVBLK = 64, QB = NW * QBLK;
constexpr int QS = QW, KS = KVW, KRS = 64, OS = DM;
constexpr int SHM_V = KVBLK * 128 * 2, SHM_K = KVBLK * 128 * 2, SHM_KR = KVBLK * 64 * 2;
constexpr int OFF_V = 0, OFF_K = 2 * SHM_V, OFF_KR = OFF_K + 2 * SHM_K, OFF_WS = OFF_KR + 2 * SHM_KR, OFF_QR = OFF_WS + NW * 64 * 4;
constexpr int LDS_BYTES = OFF_QR + NW * 8 * 64 * 16;
constexpr float SCALE = 0.07216878364870322f;
constexpr float THR = 8.f;
constexpr int NQB = SEQ / QB;

#define KSWZ(row, colB) ((row) * 256 + ((colB) ^ (((row) & 7) << 4)))
#define KRSWZ(row, colB) ((row) * 128 + ((colB) ^ ((((row) >> 1) & 7) << 4)))
#define SBAR() __builtin_amdgcn_sched_barrier(0)
__device__ __forceinline__ int v_st(int k, int c) { const int kk = (k & ~0xC) | ((k & 4) << 1) | ((k & 8) >> 1); return ((kk >> 3) * 4 + (c >> 5)) * 512 + ((kk & 7) * 32 + (c & 31)) * 2; }
__device__ __forceinline__ int v_rd_base(int lane) { return ((lane & 3) << 3) | (((lane >> 2) & 3) << 6) | (((lane >> 4) & 1) << 5) | (((lane >> 5) & 1) << 8); }
constexpr int v_rd_off(int d0, int ks, int half) { return d0 * 512 + ks * 4096 + half * 2048; }
__device__ __forceinline__ int crow(int r, int hi) { return (r & 3) + 8 * (r >> 2) + 4 * hi; }
__device__ __forceinline__ unsigned cvtpk(float lo, float hi) { return cvt_pk_bf16(lo, hi); }
__device__ __forceinline__ bf16x8 load8(const bf16_t* p) { return *reinterpret_cast<const bf16x8*>(p); }

__device__ __forceinline__ void mask_tile(f32x16& p0, f32x16& p1, int dq) {
    const float NEG = -__builtin_inff();
#pragma unroll
    for (int r = 0; r < 16; ++r) {
        const int c = (r & 3) + 8 * (r >> 2);
        if (dq - c < 0) p0[r] = NEG;
        if (dq - c - 32 < 0) p1[r] = NEG;
    }
}
__device__ __forceinline__ void partialSM(f32x16& p0, f32x16& p1, float& m_reg, float& mn, float& alpha) {
    float pmax = p0[0];
#pragma unroll
    for (int r = 1; r < 16; ++r) pmax = fmaxf(pmax, p0[r]);
#pragma unroll
    for (int r = 0; r < 16; ++r) pmax = fmaxf(pmax, p1[r]);
    { auto rr = __builtin_amdgcn_permlane32_swap(__float_as_uint(pmax), __float_as_uint(pmax), false, false);
      pmax = fmaxf(__uint_as_float(rr[0]), __uint_as_float(rr[1])); }
    constexpr float C2 = 1.4426950408889634f * SCALE;
    if (__builtin_expect(__all((pmax - m_reg) * SCALE <= THR), 1)) { mn = m_reg; alpha = 1.f; }
    else { mn = fmaxf(m_reg, pmax); alpha = __builtin_amdgcn_exp2f((m_reg - mn) * C2); m_reg = mn; }
    const float mnL = -mn * C2;
#pragma unroll
    for (int r = 0; r < 16; ++r) p0[r] = fmaf(p0[r], C2, mnL);
#pragma unroll
    for (int r = 0; r < 16; ++r) p1[r] = fmaf(p1[r], C2, mnL);
#pragma unroll
    for (int r = 0; r < 16; ++r) p0[r] = __builtin_amdgcn_exp2f(p0[r]);
}
__device__ __forceinline__ void finishSM(f32x16& p0, f32x16& p1, float alpha, float& l_reg, bf16x8& pa0, bf16x8& pa1, bf16x8& pa2, bf16x8& pa3) {
#pragma unroll
    for (int r = 0; r < 16; ++r) p1[r] = __builtin_amdgcn_exp2f(p1[r]);
    float ps = 0;
#pragma unroll
    for (int r = 0; r < 16; ++r) ps += p0[r];
#pragma unroll
    for (int r = 0; r < 16; ++r) ps += p1[r];
    { auto rr = __builtin_amdgcn_permlane32_swap(__float_as_uint(ps), __float_as_uint(ps), false, false);
      ps = __uint_as_float(rr[0]) + __uint_as_float(rr[1]); }
    l_reg = l_reg * alpha + ps;
#define PK4(P, B_, OUT) do { unsigned a0 = cvtpk(P[B_+0], P[B_+1]), a1 = cvtpk(P[B_+2], P[B_+3]);                          \
        unsigned b0 = cvtpk(P[B_+4], P[B_+5]), b1 = cvtpk(P[B_+6], P[B_+7]);                                             \
        auto r0 = __builtin_amdgcn_permlane32_swap(a0, b0, false, false); auto r1 = __builtin_amdgcn_permlane32_swap(a1, b1, false, false); \
        u32x4 w = {r0[0], r1[0], r0[1], r1[1]}; OUT = *reinterpret_cast<bf16x8*>(&w); } while (0)
    PK4(p0, 0, pa0); PK4(p0, 8, pa1); PK4(p1, 0, pa2); PK4(p1, 8, pa3);
#undef PK4
}
template <int KB>
__device__ __forceinline__ void qkt(f32x16& p0, f32x16& p1, const char* lds, int r32, int hi, const bf16x8* qr, int qro) {
    p0 = f32x16{}; p1 = f32x16{};
    const char* kb[4];
#pragma unroll
    for (int dd = 0; dd < 4; ++dd) kb[dd] = lds + OFF_K + KB * SHM_K + KSWZ(r32, (dd * 16 + hi * 8) * 2);
#pragma unroll
    for (int d0 = 0; d0 < 8; ++d0) { const char* a = kb[d0 & 3] + (d0 >> 2) * 128;
        bf16x8 b0 = *reinterpret_cast<const bf16x8*>(a);
        bf16x8 b1 = *reinterpret_cast<const bf16x8*>(a + 32 * 256);
        const bf16x8 qq = qr[d0];
        p0 = __builtin_amdgcn_mfma_f32_32x32x16_bf16(b0, qq, p0, 0, 0, 0);
        p1 = __builtin_amdgcn_mfma_f32_32x32x16_bf16(b1, qq, p1, 0, 0, 0); }
#pragma unroll
    for (int dd = 0; dd < 4; ++dd) { const char* a = lds + OFF_KR + KB * SHM_KR + KRSWZ(r32, (dd * 16 + hi * 8) * 2);
        bf16x8 b0 = *reinterpret_cast<const bf16x8*>(a);
        bf16x8 b1 = *reinterpret_cast<const bf16x8*>(a + 32 * 128);
        const bf16x8 qq = *reinterpret_cast<const bf16x8*>(lds + qro + dd * 1024);
        p0 = __builtin_amdgcn_mfma_f32_32x32x16_bf16(b0, qq, p0, 0, 0, 0);
        p1 = __builtin_amdgcn_mfma_f32_32x32x16_bf16(b1, qq, p1, 0, 0, 0); }
}
template <int VB>
__device__ __forceinline__ void pv_tile(f32x16* o, int vb0, bf16x8 pa0, bf16x8 pa1, bf16x8 pa2, bf16x8 pa3) {
#define TRRD(dst, off) asm volatile("ds_read_b64_tr_b16 %0, %1 offset:%2" : "=&v"(dst) : "v"(vb0), "i"(off) : "memory")
#define PV_D0(d0) do { s16x4 l0, l1, l2, l3, h0, h1, h2, h3; constexpr int b_ = OFF_V + VB * SHM_V + v_rd_off(d0, 0, 0);   \
        TRRD(l0, b_); TRRD(h0, b_ + 2048); TRRD(l1, b_ + 4096); TRRD(h1, b_ + 6144); TRRD(l2, b_ + 8192); TRRD(h2, b_ + 10240); TRRD(l3, b_ + 12288); TRRD(h3, b_ + 14336); \
        asm volatile("s_waitcnt lgkmcnt(0)" ::: "memory"); SBAR();   \
        o[d0] = __builtin_amdgcn_mfma_f32_32x32x16_bf16(pa0, (bf16x8){l0[0], l0[1], l0[2], l0[3], h0[0], h0[1], h0[2], h0[3]}, o[d0], 0, 0, 0);   \
        o[d0] = __builtin_amdgcn_mfma_f32_32x32x16_bf16(pa1, (bf16x8){l1[0], l1[1], l1[2], l1[3], h1[0], h1[1], h1[2], h1[3]}, o[d0], 0, 0, 0);   \
        o[d0] = __builtin_amdgcn_mfma_f32_32x32x16_bf16(pa2, (bf16x8){l2[0], l2[1], l2[2], l2[3], h2[0], h2[1], h2[2], h2[3]}, o[d0], 0, 0, 0);   \
        o[d0] = __builtin_amdgcn_mfma_f32_32x32x16_bf16(pa3, (bf16x8){l3[0], l3[1], l3[2], l3[3], h3[0], h3[1], h3[2], h3[3]}, o[d0], 0, 0, 0); } while (0)
    PV_D0(0); PV_D0(1); PV_D0(2); PV_D0(3);
#undef PV_D0
#undef TRRD
}

struct BlockRef { const bf16_t* Q; const bf16_t* K; const bf16_t* V; const bf16_t* KR; bf16_t* O; const int* POS; const float* QG; int P0; };
struct Seam { bf16x8 qr[8]; bf16x8 st_v0, st_v1, st_k0, st_k1, st_kr; };
#define VMW() asm volatile("s_waitcnt vmcnt(0)" ::: "memory")
#define VMWN(n) asm volatile("s_waitcnt vmcnt(%0)" :: "i"(n) : "memory")
#define LDG8(base, off) (*reinterpret_cast<const bf16x8*>((const char*)(base) + (off)))
#define SLOAD_H(R_, k0) do { const char* kb_ = (const char*)((R_).K + (size_t)(k0) * KS); const char* rb_ = (const char*)((R_).KR + (size_t)(k0) * KRS);  \
                             S.st_v0 = LDG8(kb_ + 256, offA); S.st_v1 = LDG8(kb_ + 32 * KS * 2 + 256, offA);              \
                             S.st_k0 = LDG8(kb_, offA); S.st_k1 = LDG8(kb_ + 32 * KS * 2, offA);              \
                             S.st_kr = LDG8(rb_, offR); } while (0)
#define SWRITE_HK(bf) do { *(bf16x8*)(lds + OFF_K + (bf) * SHM_K + kws) = S.st_k0; *(bf16x8*)(lds + OFF_K + (bf) * SHM_K + kws + 32 * 256) = S.st_k1; \
                           *(bf16x8*)(lds + OFF_KR + (bf) * SHM_KR + krws) = S.st_kr; } while (0)
#define SWRITE_HV(bf) do { *(bf16x8*)(lds + OFF_V + (bf) * SHM_V + vst0) = S.st_v0; *(bf16x8*)(lds + OFF_V + (bf) * SHM_V + vst1) = S.st_v1; } while (0)
#define SWRITE_H(bf) do { SWRITE_HV(bf); SWRITE_HK(bf); } while (0)
#define QLOAD(R_) do { _Pragma("unroll") for (int d0 = 0; d0 < 8; ++d0) S.qr[d0] = LDG8((const char*)(R_).Q + d0 * 32, offQ); } while (0)

__device__ __forceinline__ void attn_prime(const BlockRef& cur, char* lds, Seam& S, const int wv__) {
    const int tid = TID(), wid = __builtin_amdgcn_readfirstlane(tid >> 6), lane = tid & 63, r32 = lane & 31, hi = lane >> 5;
    const int sr = tid >> 4, sc = (tid & 15) * 8, kws = KSWZ(sr, sc * 2), krr = tid >> 3, krc = (tid & 7) * 8, krws = KRSWZ(krr, krc * 2);
    unsigned offA = (unsigned)(sr * KS + sc) * 2u, offR = (unsigned)(krr * KRS + krc) * 2u, offQ = (unsigned)((wid * QBLK + r32) * QS + hi * 8) * 2u;
    asm volatile("" : "+v"(offA), "+v"(offR), "+v"(offQ));
    QLOAD(cur);
    SLOAD_H(cur, 0); VMW(); SWRITE_HK(0);
    __syncthreads();
}
__device__ __forceinline__ void attn_block(const BlockRef& cur, char* lds, Seam& S, const int wv__) {
    const int tid = TID(), wid = __builtin_amdgcn_readfirstlane(tid >> 6), lane = tid & 63, r32 = lane & 31, hi = lane >> 5;
    const int NT = (cur.P0 + QB) / KVBLK;
    const int qlo = cur.P0 + wid * QBLK, qm = qlo + r32 - 4 * hi;
    float* ws = (float*)(lds + OFF_WS) + wid * 64; float* li_l = ws, * al_l = ws + 32;
    float m_reg = -1e30f, l_reg = 0; f32x16 o[4] = {};
    const int sr = tid >> 4, sc = (tid & 15) * 8, vst0 = v_st(sr, sc), vst1 = v_st(32 + sr, sc), kws = KSWZ(sr, sc * 2);
    const int krr = tid >> 3, krc = (tid & 7) * 8, krws = KRSWZ(krr, krc * 2);
    unsigned offA = (unsigned)(sr * KS + sc) * 2u, offR = (unsigned)(krr * KRS + krc) * 2u, offQ = (unsigned)((wid * QBLK + r32) * QS + hi * 8) * 2u;
    asm volatile("" : "+v"(offA), "+v"(offR), "+v"(offQ));
    const int vb0 = (int)(uintptr_t)lds + v_rd_base(lane);
#define RESC(a) do { if (__any((a) < 1.f)) { if (hi == 0) al_l[r32] = (a); asm volatile("s_waitcnt lgkmcnt(0)" ::: "memory");              \
                     for (int d_ = 0; d_ < 4; ++d_) for (int r = 0; r < 16; ++r) o[d_][r] *= al_l[crow(r, hi)]; } } while (0)
#define KBASE(t) ((t) * KVBLK)
#define MASKT(P0_, P1_, t) do { const int kb_ = KBASE(t); if (kb_ + KVBLK - 1 > qlo) mask_tile(P0_, P1_, qm - kb_); } while (0)
    f32x16 pA0, pA1, pB0, pB1; float mnA, mnB, alA, alB; bf16x8 pa0, pa1, pa2, pa3;
    const int qro = OFF_QR + (wid * 8 * 64 + lane) * 16;
    { bf16x8 tq[8];
#pragma unroll
      for (int dd = 4; dd < 8; ++dd) tq[dd] = LDG8((const char*)cur.Q + 128 + dd * 32, offQ);
      const int pos = cur.POS[wid * QBLK + r32];
      float sn = 0.f, sr = 0.f;
#define UNP(F, x) const u32x4 w_ = __builtin_bit_cast(u32x4, F); float x[8] = {lo_bf(w_.x), hi_bf(w_.x), lo_bf(w_.y), hi_bf(w_.y), lo_bf(w_.z), hi_bf(w_.z), lo_bf(w_.w), hi_bf(w_.w)};
#pragma unroll
      for (int f = 0; f < 8; ++f) { UNP(S.qr[f], x)
#pragma unroll
          for (int e = 0; e < 8; ++e) sn += x[e] * x[e]; }
#pragma unroll
      for (int f = 4; f < 8; ++f) { UNP(tq[f], x)
#pragma unroll
          for (int e = 0; e < 8; ++e) sr += x[e] * x[e]; }
      { auto r0 = __builtin_amdgcn_permlane32_swap(__float_as_uint(sn), __float_as_uint(sn), false, false); sn = __uint_as_float(r0[0]) + __uint_as_float(r0[1]);
        auto r1 = __builtin_amdgcn_permlane32_swap(__float_as_uint(sr), __float_as_uint(sr), false, false); sr = __uint_as_float(r1[0]) + __uint_as_float(r1[1]); }
      const float rn = 1.f / sqrtf(sn * (1.f / 128.f) + RMS_EPS), rr = 1.f / sqrtf(sr * (1.f / 64.f) + RMS_EPS);
#pragma unroll
      for (int f = 0; f < 8; ++f) { UNP(S.qr[f], x)
          const f32x4 g0 = *(const f32x4*)(cur.QG + f * 16 + hi * 8), g1 = *(const f32x4*)(cur.QG + f * 16 + hi * 8 + 4);
          const float g[8] = {g0.x, g0.y, g0.z, g0.w, g1.x, g1.y, g1.z, g1.w};
          u32x4 o; o.x = cvt_pk_bf16(x[0] * rn * g[0], x[1] * rn * g[1]); o.y = cvt_pk_bf16(x[2] * rn * g[2], x[3] * rn * g[3]);
          o.z = cvt_pk_bf16(x[4] * rn * g[4], x[5] * rn * g[5]); o.w = cvt_pk_bf16(x[6] * rn * g[6], x[7] * rn * g[7]);
          S.qr[f] = __builtin_bit_cast(bf16x8, o); }
#pragma unroll
      for (int dd = 0; dd < 2; ++dd) {
          float x1[8], x2[8];
          { UNP(tq[4 + dd], x) for (int e = 0; e < 8; ++e) x1[e] = x[e]; }
          { UNP(tq[6 + dd], x) for (int e = 0; e < 8; ++e) x2[e] = x[e]; }
          const f32x4 ga0 = *(const f32x4*)(cur.QG + 128 + dd * 16 + hi * 8), ga1 = *(const f32x4*)(cur.QG + 128 + dd * 16 + hi * 8 + 4);
          const f32x4 gb0 = *(const f32x4*)(cur.QG + 160 + dd * 16 + hi * 8), gb1 = *(const f32x4*)(cur.QG + 160 + dd * 16 + hi * 8 + 4);
          const float ga[8] = {ga0.x, ga0.y, ga0.z, ga0.w, ga1.x, ga1.y, ga1.z, ga1.w}, gb[8] = {gb0.x, gb0.y, gb0.z, gb0.w, gb1.x, gb1.y, gb1.z, gb1.w};
          float o1[8], o2[8];
#pragma unroll
          for (int e = 0; e < 8; ++e) { float c, s; rope_cs(pos, dd * 16 + hi * 8 + e, c, s);
              const float a = x1[e] * rr * ga[e], b = x2[e] * rr * gb[e]; o1[e] = a * c - b * s; o2[e] = b * c + a * s; }
          u32x4 w1, w2; w1.x = cvt_pk_bf16(o1[0], o1[1]); w1.y = cvt_pk_bf16(o1[2], o1[3]); w1.z = cvt_pk_bf16(o1[4], o1[5]); w1.w = cvt_pk_bf16(o1[6], o1[7]);
          w2.x = cvt_pk_bf16(o2[0], o2[1]); w2.y = cvt_pk_bf16(o2[2], o2[3]); w2.z = cvt_pk_bf16(o2[4], o2[5]); w2.w = cvt_pk_bf16(o2[6], o2[7]);
          tq[4 + dd] = __builtin_bit_cast(bf16x8, w1); tq[6 + dd] = __builtin_bit_cast(bf16x8, w2);
      }
#undef UNP
#pragma unroll
      for (int dd = 0; dd < 4; ++dd) *(bf16x8*)(lds + qro + dd * 1024) = tq[4 + dd]; }
    SWRITE_HV(0); SBAR();
    if (NT > 1) SLOAD_H(cur, KBASE(1));
    SBAR(); qkt<0>(pA0, pA1, lds, r32, hi, S.qr, qro);
    MASKT(pA0, pA1, 0); partialSM(pA0, pA1, m_reg, mnA, alA);
    if (NT > 1) { VMW(); SWRITE_H(1); }
    __syncthreads();
#define HALF_STEP(PX0, PX1, mnX, alX, PY0, PY1, alY, t, KB, VB, SB) do {                                                      \
        SBAR(); qkt<KB>(PX0, PX1, lds, r32, hi, S.qr, qro);                                             \
        finishSM(PY0, PY1, alY, l_reg, pa0, pa1, pa2, pa3); SBAR();                                                           \
        if ((t) + 1 < NT) { SLOAD_H(cur, KBASE((t) + 1)); SBAR(); }                                               \
        pv_tile<VB>(o, vb0, pa0, pa1, pa2, pa3); MASKT(PX0, PX1, (t)); partialSM(PX0, PX1, m_reg, mnX, alX);                                        \
        __syncthreads();                                                                                                      \
        if ((t) + 1 < NT) { VMW(); SWRITE_H(SB); }                                                                          \
        RESC(alX); __syncthreads(); } while (0)
    for (int t = 1; t + 1 < NT; t += 2) {
        HALF_STEP(pB0, pB1, mnB, alB, pA0, pA1, alA, t, 1, 0, 0);
        HALF_STEP(pA0, pA1, mnA, alA, pB0, pB1, alB, t + 1, 0, 1, 1);
    }
    SBAR(); qkt<1>(pB0, pB1, lds, r32, hi, S.qr, qro); SBAR();
    finishSM(pA0, pA1, alA, l_reg, pa0, pa1, pa2, pa3); SBAR();
    pv_tile<0>(o, vb0, pa0, pa1, pa2, pa3);
    MASKT(pB0, pB1, NT - 1); partialSM(pB0, pB1, m_reg, mnB, alB); __syncthreads(); RESC(alB);
    finishSM(pB0, pB1, alB, l_reg, pa0, pa1, pa2, pa3); SBAR(); pv_tile<1>(o, vb0, pa0, pa1, pa2, pa3);
    if (hi == 0) li_l[r32] = l_reg; asm volatile("s_waitcnt lgkmcnt(0)" ::: "memory");
    float rli[16];
#pragma unroll
    for (int r = 0; r < 16; ++r) rli[r] = __builtin_amdgcn_rcpf(li_l[crow(r, hi)]);
    unsigned obase = (unsigned)((wid * QBLK + 4 * hi) * OS + r32) * 2u; asm volatile("" : "+v"(obase));
#pragma unroll
    for (int r = 0; r < 16; ++r) { const unsigned orow_off = (unsigned)(((r & 3) + 8 * (r >> 2)) * OS) * 2u;
#pragma unroll
        for (int d0 = 0; d0 < 4; ++d0) { const float v = o[d0][r] * rli[r];
            const float vn = DPPF(v, 0xB1);
            if ((r32 & 1) == 0) *(unsigned*)((char*)cur.O + (obase + orow_off + (unsigned)(d0 * 64))) = cvtpk(v, vn); } }
    __syncthreads();
#undef RESC
#undef KBASE
#undef MASKT
#undef HALF_STEP
}
#undef VMW
#undef VMWN
#undef SLOAD_H
#undef SWRITE_HK
#undef SWRITE_HV
#undef SWRITE_H
#undef QLOAD
#undef LDG8

__device__ __forceinline__ BlockRef make_ref(int bh, int qb, const bf16_t* q, const bf16_t* kv, const bf16_t* kr, bf16_t* mixed, const int* pos, const float* qg) {
    const int b = bh >> 3, h = bh & 7; BlockRef r;
    r.Q = q + ((size_t)b * SEQ + (size_t)qb * QB) * QS + h * 192;
    r.K = kv + (size_t)b * SEQ * KS + h * 256; r.V = r.K + 128;
    r.KR = kr + (size_t)b * SEQ * KRS;
    r.O = mixed + ((size_t)b * SEQ + (size_t)qb * QB) * OS + 512 + h * 128; r.P0 = qb * QB;
    r.POS = pos + (size_t)b * SEQ + (size_t)qb * QB; r.QG = qg;
    return r;
}
constexpr int N_BLOCKS = BATCH * 8 * NQB;
__device__ __forceinline__ void attn_one(char* lds, const bf16_t* q, const bf16_t* kv, const bf16_t* kr, bf16_t* mixed, int i, const int* pos, const float* qg, const int wv__) {
    Seam S;
    const BlockRef cur = make_ref(i & 63, NQB - 1 - (i >> 6), q, kv, kr, mixed, pos, qg);
    attn_prime(cur, lds, S, wv__);
    attn_block(cur, lds, S, wv__);
}
#undef KSWZ
#undef KRSWZ
#undef SBAR
}
namespace tok {
constexpr int PT = 32;
constexpr int NTILES = T / PT;
constexpr int S_VM = 1040, S_XW = 144, S_XG = 272;
constexpr int O_VM = 0, O_XR = O_VM + PT * S_VM, O_XK = O_XR + PT * S_VM, O_XW = O_XK + PT * S_VM, O_XA = O_XW + PT * S_XW, O_XG = O_XA + PT * S_XW, O_PAR = O_XG + PT * S_XG, O_WB = O_PAR + 6 * 2048, O_END = O_WB + 8 * 2560;
constexpr int LDS_BYTES = O_END;
constexpr size_t WL_W2 = 0, WL_A2 = WL_W2 + 512 * 64, WL_G2 = WL_A2 + 512 * 64, WL_V1 = WL_G2 + 512 * 128, WL_V2 = WL_V1 + 32 * 512, WL_END = WL_V2 + 512 * 32;

struct Args {
    const bf16_t* p; const int* pos;
    const float *k_gain;
    const float *mu, *w0, *a0, *v0, *k_k, *k_a, *r_k;
    const bf16_t* wl;
    float *rs_q, *rs_kv; bf16_t* kr;
    bf16_t *R, *K, *V, *KK, *B, *G, *BON, *VFIRST; float* W; float *RIN, *BS;
};
__device__ __forceinline__ float4 ld4f(const float* p) { return *(const float4*)p; }
__device__ __forceinline__ void bf4(u32x2 w, float* o) { o[0] = lo_bf(w.x); o[1] = hi_bf(w.x); o[2] = lo_bf(w.y); o[3] = hi_bf(w.y); }
__device__ __forceinline__ u32x2 pk4(const float* v) { u32x2 w; w.x = cvt_pk_bf16(v[0], v[1]); w.y = cvt_pk_bf16(v[2], v[3]); return w; }

__device__ __forceinline__ void wave_store_bf16(LAS unsigned char* wb, const u32x2 (&v)[4], bf16_t* gbase, int r32, int hi, int lane) {
#pragma unroll
    for (int g = 0; g < 4; ++g) *(LAS u32x2*)(wb + r32 * 80 + 16 * g + 8 * hi) = v[g];
    asm volatile("" ::: "memory");
#pragma unroll
    for (int i = 0; i < 2; ++i) { const int tk_ = i * 16 + (lane >> 2); const u32x4 x = *(const LAS u32x4*)(wb + tk_ * 80 + (lane & 3) * 16);
        *(u32x4*)((char*)gbase + (size_t)tk_ * 1024 + (lane & 3) * 16) = x; }
    asm volatile("" ::: "memory");
}
__device__ __forceinline__ void wave_store_f32h(LAS unsigned char* wb, const f32x4 (&v)[2], float* gbase, int r32, int hi, int lane) {
#pragma unroll
    for (int j = 0; j < 2; ++j) *(LAS f32x4*)(wb + r32 * 80 + (8 * j + 4 * hi) * 4) = v[j];
    asm volatile("" ::: "memory");
#pragma unroll
    for (int i = 0; i < 2; ++i) { const int tk_ = i * 16 + (lane >> 2); const f32x4 x = *(const LAS f32x4*)(wb + tk_ * 80 + (lane & 3) * 16);
        *(f32x4*)((char*)gbase + (size_t)tk_ * 2048 + (lane & 3) * 16) = x; }
    asm volatile("" ::: "memory");
}
__device__ __forceinline__ void stage_params(const Args& A, LAS unsigned char* lds, int tid) {
    LAS float* P = (LAS float*)(lds + O_PAR);
    P[tid] = A.w0[tid]; P[512 + tid] = A.a0[tid]; P[1024 + tid] = A.v0[tid]; P[1536 + tid] = A.k_k[tid]; P[2048 + tid] = A.k_a[tid]; P[2560 + tid] = A.r_k[tid];
}
template <int LAYER>
__device__ __forceinline__ void tile(const Args& A, LAS unsigned char* lds, int tl, const int wv__, const int mode = 7) {
    const int tid = TID(), lane = tid & 63, wid = __builtin_amdgcn_readfirstlane(tid >> 6), r32 = lane & 31, hi = lane >> 5;
    const int tok0 = tl * PT;
    const bf16_t* p = A.p;
    if (mode & 1) {
        u32x2 k4v[4]; bf16_t krv[4]; int posv[4];
#pragma unroll
        for (int i = 0; i < 4; ++i) {
            const int tk = tok0 + wid + 8 * i; const bf16_t* pr = p + (size_t)tk * NP;
            k4v[i] = *(const u32x2*)(pr + C_MKV + lane * 4); krv[i] = pr[C_MKR + lane]; posv[i] = A.pos[tk];
        }
        const float kg = A.k_gain[128 + lane];
#pragma unroll
        for (int i = 0; i < 4; ++i) {
            const int tk = tok0 + wid + 8 * i;
            const u32x2 k4 = k4v[i];
            float sk = 0.f;
            { float a; a = lo_bf(k4.x); sk += a * a; a = hi_bf(k4.x); sk += a * a; a = lo_bf(k4.y); sk += a * a; a = hi_bf(k4.y); sk += a * a; }
            const float kr = bf2f(krv[i]);
            float skr = kr * kr;
            sk = wave_sum(sk); skr = wave_sum(skr);
            if (lane == 0) A.rs_kv[tk] = 1.f / sqrtf(sk * (1.f / 256.f) + RMS_EPS);
            const float krn = kr * (1.f / sqrtf(skr * (1.f / 64.f) + RMS_EPS)) * kg;
            const float other = xor32f(krn, lane);
            float c, s; rope_cs(posv[i], lane & 31, c, s);
            const float o = (lane < 32) ? (krn * c - other * s) : (krn * c + other * s);
            A.kr[(size_t)tk * 64 + lane] = f2bf(o);
        }
    }
    if (mode & 2) {
#pragma unroll 1
    for (int it = 0; it < 7; ++it) {
        u32x4 cu[2], pv[2]; f32x4 m0[2], m1[2]; int tt[2], jj[2];
#pragma unroll
        for (int u = 0; u < 2; ++u) {
            const int task = tid + (2 * it + u) * 512;
            const int t = task / 224, j = task - t * 224; tt[u] = t; jj[u] = j;
            const int tk = tok0 + t; const bool first = (tk & (SEQ - 1)) == 0;
            const bf16_t* pr = p + (size_t)tk * NP + C_RR + 8 * j;
            cu[u] = *(const u32x4*)pr;
            pv[u] = (u32x4){0u, 0u, 0u, 0u};
            if (!first) pv[u] = *(const u32x4*)(pr - NP);
            m0[u] = *(const f32x4*)(A.mu + 8 * j); m1[u] = *(const f32x4*)(A.mu + 8 * j + 4);
        }
#pragma unroll
        for (int u = 0; u < 2; ++u) {
            const int t = tt[u], j = jj[u];
            const float mu[8] = {m0[u].x, m0[u].y, m0[u].z, m0[u].w, m1[u].x, m1[u].y, m1[u].z, m1[u].w};
            const float c8[8] = {lo_bf(cu[u].x), hi_bf(cu[u].x), lo_bf(cu[u].y), hi_bf(cu[u].y), lo_bf(cu[u].z), hi_bf(cu[u].z), lo_bf(cu[u].w), hi_bf(cu[u].w)};
            const float p8[8] = {lo_bf(pv[u].x), hi_bf(pv[u].x), lo_bf(pv[u].y), hi_bf(pv[u].y), lo_bf(pv[u].z), hi_bf(pv[u].z), lo_bf(pv[u].w), hi_bf(pv[u].w)};
            float o[8];
#pragma unroll
            for (int i = 0; i < 8; ++i) o[i] = c8[i] + (p8[i] - c8[i]) * mu[i];
            if (j >= 192) {
#pragma unroll
                for (int i = 0; i < 8; ++i) { const float m = o[i]; const float e = fast_exp(j < 200 ? 2.f * m : -m); const float r = fast_rcp(e + 1.f);
                    o[i] = j < 200 ? 1.f - 2.f * r : (j < 208 ? m : r); }
            }
            u32x4 w; w.x = cvt_pk_bf16(o[0], o[1]); w.y = cvt_pk_bf16(o[2], o[3]); w.z = cvt_pk_bf16(o[4], o[5]); w.w = cvt_pk_bf16(o[6], o[7]);
            int off;
            if (j < 64) off = O_XR + t * S_VM + j * 16; else if (j < 128) off = O_XK + t * S_VM + (j - 64) * 16; else if (j < 192) off = O_VM + t * S_VM + (j - 128) * 16;
            else if (j < 200) off = O_XW + t * S_XW + (j - 192) * 16; else if (j < 208) off = O_XA + t * S_XW + (j - 200) * 16; else off = O_XG + t * S_XG + (j - 208) * 16;
            *(LAS u32x4*)(lds + off) = w;
        }
    }
    }
    __syncthreads();
    const int h = wid;
    unsigned wo64 = (unsigned)(r32 * 64 + hi * 8) * 2u, wo128 = (unsigned)(r32 * 128 + hi * 8) * 2u, wo32 = (unsigned)(r32 * 32 + hi * 8) * 2u, wo512 = (unsigned)(r32 * 512 + hi * 8) * 2u;
#define GLD8(base, off) (*(const bf16x8*)((const char*)(base) + (off)))
    const bf16_t* w2t = A.wl + WL_W2 + (size_t)(h * 64) * 64; const bf16_t* a2t = A.wl + WL_A2 + (size_t)(h * 64) * 64;
    const bf16_t* g2t = A.wl + WL_G2 + (size_t)(h * 64) * 128; const bf16_t* v2p = A.wl + WL_V2 + (size_t)(h * 64) * 32; const bf16_t* v1t = A.wl + WL_V1;
    if (mode & 4) {
        constexpr int nb = 0;
        asm volatile("" : "+v"(wo64), "+v"(wo128), "+v"(wo32), "+v"(wo512));
        const int trow = nb * 32 + r32;
        const int tk = tok0 + trow; const bool first = (tk & (SEQ - 1)) == 0;
        unsigned e512 = (unsigned)(trow * 512 + 4 * hi);
        asm volatile("" : "+v"(e512));
        const size_t t512 = (size_t)tok0 * 512;
#define CB (h * 64 + mb * 32 + 8 * g)
#define PL4(idx) (*(const LAS f32x4*)(lds + O_PAR + (idx) * 2048 + (CB + 4 * hi) * 4))
#define A2(ptr) ((char*)((ptr) + t512 + CB) + e512 * 2u)
#define A4(ptr) ((char*)((ptr) + t512 + CB) + e512 * 4u)
        bf16x8 vvf[2];
        if (LAYER > 0) {
            f32x16 vv = f32x16{};
#pragma unroll 16
            for (int ks = 0; ks < 32; ++ks) {
                const bf16x8 bv = *(const LAS bf16x8*)(lds + O_VM + trow * S_VM + (ks * 16 + hi * 8) * 2);
                const bf16x8 av = GLD8(v1t + ks * 16, wo512);
                vv = __builtin_amdgcn_mfma_f32_32x32x16_bf16(av, bv, vv, 0, 0, 0);
            }
#pragma unroll
            for (int s = 0; s < 2; ++s) {
                u32x4 bw; bw.x = cvt_pk_bf16(vv[8 * s + 0], vv[8 * s + 1]); bw.y = cvt_pk_bf16(vv[8 * s + 2], vv[8 * s + 3]); bw.z = cvt_pk_bf16(vv[8 * s + 4], vv[8 * s + 5]); bw.w = cvt_pk_bf16(vv[8 * s + 6], vv[8 * s + 7]);
                vvf[s] = __builtin_bit_cast(bf16x8, bw);
            }
        }
        float ss = 0.f, bs = 0.f;
#pragma unroll
        for (int mb = 0; mb < 2; ++mb) {
            f32x16 accW = f32x16{}, accA = f32x16{}, accG = f32x16{}, accV = f32x16{};
            u32x2 vfraw[4];
            if (LAYER > 0) {
#pragma unroll
                for (int g = 0; g < 4; ++g) vfraw[g] = *(const u32x2*)A2(A.VFIRST);
            }
#pragma unroll
            for (int ks = 0; ks < 4; ++ks) {
                const bf16x8 bw = *(const LAS bf16x8*)(lds + O_XW + trow * S_XW + (ks * 16 + hi * 8) * 2);
                const bf16x8 ba = *(const LAS bf16x8*)(lds + O_XA + trow * S_XW + (ks * 16 + hi * 8) * 2);
                const bf16x8 aw = GLD8(w2t + mb * 32 * 64 + ks * 16, wo64);
                const bf16x8 aa = GLD8(a2t + mb * 32 * 64 + ks * 16, wo64);
                accW = __builtin_amdgcn_mfma_f32_32x32x16_bf16(aw, bw, accW, 0, 0, 0);
                accA = __builtin_amdgcn_mfma_f32_32x32x16_bf16(aa, ba, accA, 0, 0, 0);
            }
#pragma unroll
            for (int ks = 0; ks < 8; ++ks) {
                const bf16x8 bg = *(const LAS bf16x8*)(lds + O_XG + trow * S_XG + (ks * 16 + hi * 8) * 2);
                const bf16x8 ag = GLD8(g2t + mb * 32 * 128 + ks * 16, wo128);
                accG = __builtin_amdgcn_mfma_f32_32x32x16_bf16(ag, bg, accG, 0, 0, 0);
            }
            if (LAYER > 0) {
#pragma unroll
                for (int s = 0; s < 2; ++s) {
                    const bf16x8 a2 = GLD8(v2p + mb * 32 * 32 + s * 16, wo32);
                    accV = __builtin_amdgcn_mfma_f32_32x32x16_bf16(a2, vvf[s], accV, 0, 0, 0);
                }
            }
            asm volatile("" ::: "memory");
            f32x4 oW[4]; u32x2 oG[4], oV[4], oR[4], oK[4], oKK[4], oB[4];
#pragma unroll
            for (int g = 0; g < 4; ++g) {
                const f32x4 w0 = PL4(0), a0 = PL4(1);
                const float w0a[4] = {w0.x, w0.y, w0.z, w0.w}, a0a[4] = {a0.x, a0.y, a0.z, a0.w};
                float dec[4], gt[4], av[4];
#pragma unroll
                for (int i = 0; i < 4; ++i) {
                    dec[i] = fast_exp(-0.6065306597126334f * sigmoidf_(accW[4 * g + i] + w0a[i]));
                    gt[i] = accG[4 * g + i];
                    av[i] = sigmoidf_(accA[4 * g + i] + a0a[i]);
                }
                oW[g] = (f32x4){dec[0], dec[1], dec[2], dec[3]};
                oG[g] = pk4(gt);
                float vm[4]; bf4(*(const LAS u32x2*)(lds + O_VM + trow * S_VM + (CB + 4 * hi) * 2), vm);
                float vf[4];
                if (LAYER > 0) {
                    const f32x4 v0 = PL4(2); const float v0a[4] = {v0.x, v0.y, v0.z, v0.w};
                    float vfi[4]; bf4(vfraw[g], vfi);
#pragma unroll
                    for (int i = 0; i < 4; ++i) vf[i] = vm[i] + (vfi[i] - vm[i]) * sigmoidf_(accV[4 * g + i] + v0a[i]);
                } else {
#pragma unroll
                    for (int i = 0; i < 4; ++i) vf[i] = vm[i];
                }
                oV[g] = pk4(vf);
                float xr[4], xk4[4];
                const u32x2 xrraw = *(const LAS u32x2*)(lds + O_XR + trow * S_VM + (CB + 4 * hi) * 2);
                bf4(xrraw, xr); bf4(*(const LAS u32x2*)(lds + O_XK + trow * S_VM + (CB + 4 * hi) * 2), xk4);
                const f32x4 kk4 = PL4(3), ka4 = PL4(4), rk4 = PL4(5);
                const float kka[4] = {kk4.x, kk4.y, kk4.z, kk4.w}, kaa[4] = {ka4.x, ka4.y, ka4.z, ka4.w}, rka[4] = {rk4.x, rk4.y, rk4.z, rk4.w};
                float k2[4], kkv[4], bn[4];
#pragma unroll
                for (int i = 0; i < 4; ++i) {
                    const float xk = xk4[i];
                    kkv[i] = xk * kka[i];
                    ss += kkv[i] * kkv[i];
                    k2[i] = xk * (1.f + (av[i] - 1.f) * kaa[i]);
                    bs += xr[i] * k2[i] * rka[i];
                    bn[i] = -kkv[i] * av[i];
                }
                oR[g] = xrraw; oK[g] = pk4(k2); oKK[g] = pk4(kkv); oB[g] = pk4(bn);
            }
#ifdef TOKPROBE
            if (mode & 8) { unsigned cs = 0u;
#pragma unroll
              for (int g = 0; g < 4; ++g) cs ^= oG[g].x ^ oG[g].y ^ oV[g].x ^ oV[g].y ^ oR[g].x ^ oR[g].y ^ oK[g].x ^ oK[g].y ^ oKK[g].x ^ oKK[g].y ^ oB[g].x ^ oB[g].y ^ __float_as_uint(oW[g].x) ^ __float_as_uint(oW[g].y) ^ __float_as_uint(oW[g].z) ^ __float_as_uint(oW[g].w);
              if (cs == 0x12345679u) A.G[(size_t)tok0 * 512 + lane] = 1; } else
#endif
            { LAS unsigned char* wb = lds + O_WB + wid * 2560;
              const size_t eb = (size_t)tok0 * 512 + h * 64 + mb * 32;
              wave_store_bf16(wb, oG, A.G + eb, r32, hi, lane);
              wave_store_bf16(wb, oV, A.V + eb, r32, hi, lane);
              if (LAYER == 0) wave_store_bf16(wb, oV, A.VFIRST + eb, r32, hi, lane);
              wave_store_bf16(wb, oR, A.R + eb, r32, hi, lane);
              wave_store_bf16(wb, oK, A.K + eb, r32, hi, lane);
              wave_store_bf16(wb, oKK, A.KK + eb, r32, hi, lane);
              wave_store_bf16(wb, oB, A.B + eb, r32, hi, lane);
              { const f32x4 w01[2] = {oW[0], oW[1]}, w23[2] = {oW[2], oW[3]};
                wave_store_f32h(wb, w01, A.W + eb, r32, hi, lane); wave_store_f32h(wb, w23, A.W + eb + 16, r32, hi, lane); } }
        }
        { auto r0 = __builtin_amdgcn_permlane32_swap(__float_as_uint(ss), __float_as_uint(ss), false, false); ss = __uint_as_float(r0[0]) + __uint_as_float(r0[1]);
          auto r1 = __builtin_amdgcn_permlane32_swap(__float_as_uint(bs), __float_as_uint(bs), false, false); bs = __uint_as_float(r1[0]) + __uint_as_float(r1[1]); }
        if (hi == 0) { A.RIN[(size_t)tk * 8 + h] = 1.f / fmaxf(sqrtf(ss), 1e-12f); A.BS[(size_t)tk * 8 + h] = bs; }
    }
#undef CB
#undef PL4
#undef A2
#undef A4
#undef GLD8
    __syncthreads();
}
__device__ __forceinline__ void lora_prep(const float* w2, const float* a2, const float* g2, const float* v1, const float* v2, bf16_t* wl, int gtid, int nthr) {
    for (int i = gtid; i < 512 * 64; i += nthr) { const int n = i >> 6, k = i & 63; wl[WL_W2 + i] = f2bf(w2[k * 512 + n]); wl[WL_A2 + i] = f2bf(a2[k * 512 + n]); }
    for (int i = gtid; i < 512 * 128; i += nthr) { const int n = i >> 7, k = i & 127; wl[WL_G2 + i] = f2bf(g2[k * 512 + n]); }
    if (v1) {
        for (int i = gtid; i < 32 * 512; i += nthr) { const int j = i >> 9, k = i & 511; wl[WL_V1 + i] = f2bf(v1[k * 32 + j]); }
        for (int i = gtid; i < 512 * 32; i += nthr) { const int n = i >> 5, q = i & 31, s = q >> 4, hh = (q >> 3) & 1, jj = q & 7;
            const int kidx = 16 * s + 8 * (jj >> 2) + 4 * hh + (jj & 3); wl[WL_V2 + i] = f2bf(v2[kidx * 512 + n]); }
    }
}
}
struct Ptrs {
    const float* in[30]; float* out; unsigned char* ws;
};
__device__ __forceinline__ void transpose_item(const float* W, int K, int N, bf16_t* WT, const float* gain, int mode, LAS float* scr, int item, int lane) {
    const int nblk = N / 64, kb = item / nblk, nb = item % nblk, k0 = 64 * kb, n0 = 64 * nb;
#pragma unroll 64
    for (int kk = 0; kk < 64; ++kk) { const float g = gain ? gain[k0 + kk] : 1.f; scr[kk * 65 + lane] = W[(size_t)(k0 + kk) * N + n0 + lane] * g; }
    asm volatile("s_waitcnt lgkmcnt(0)" ::: "memory");
    const int c = lane & 7;
#pragma unroll
    for (int j = 0; j < 8; ++j) { const int n = (lane >> 3) + 8 * j; const LAS float* s = scr + (8 * c) * 65 + n;
        u32x4 o; o.x = cvt_pk_bf16(s[0 * 65], s[1 * 65]); o.y = cvt_pk_bf16(s[2 * 65], s[3 * 65]); o.z = cvt_pk_bf16(s[4 * 65], s[5 * 65]); o.w = cvt_pk_bf16(s[6 * 65], s[7 * 65]);
        const int ng = n0 + n; int drow = ng;
        if (mode == 1) { if (ng < FF) drow = 256 * (ng >> 7) + (ng & 127); else { const int f = ng - FF; drow = 256 * (f >> 7) + 128 + (f & 127); } }
        *(u32x4*)(WT + (size_t)drow * K + k0 + 8 * c) = o; }
    asm volatile("s_waitcnt lgkmcnt(0)" ::: "memory");
}
typedef const Ptrs __attribute__((address_space(4)))* PtrTab;
constexpr int CV_IN = (DM / 64) * (INW / 64), CV_QB = (512 / 64) * (QW / 64), CV_KVB = (256 / 64) * (KVW / 64), CV_O = (DM / 64) * (DM / 64),
              CV_GU = (DM / 64) * (2 * FF / 64), CV_DN = (FF / 64) * (DM / 64);
constexpr int CV_NI = CV_IN + CV_QB + CV_KVB + CV_O + CV_GU + CV_DN;
__device__ __forceinline__ void convert_wave_item(PtrTab pt, int l, int it, LAS float* scr, int lane) {
    unsigned char* wl = pt->ws + WS_W + (size_t)l * W_LAYER;
    int r = it;
    if (r < CV_IN) { transpose_item(pt->in[3] + (size_t)l * DM * INW, DM, INW, (bf16_t*)(wl + WO_IN), pt->in[2] + l * DM, 0, scr, r, lane); return; } r -= CV_IN;
    if (r < CV_QB) { transpose_item(pt->in[7] + (size_t)l * 512 * QW, 512, QW, (bf16_t*)(wl + WO_QB), pt->in[6] + l * 512, 0, scr, r, lane); return; } r -= CV_QB;
    if (r < CV_KVB) { transpose_item(pt->in[9] + (size_t)l * 256 * KVW, 256, KVW, (bf16_t*)(wl + WO_KVB), pt->in[8] + l * 256, 0, scr, r, lane); return; } r -= CV_KVB;
    if (r < CV_O) { transpose_item(pt->in[26] + (size_t)l * DM * DM, DM, DM, (bf16_t*)(wl + WO_O), nullptr, 0, scr, r, lane); return; } r -= CV_O;
    if (r < CV_GU) { transpose_item(pt->in[28] + (size_t)l * DM * 2 * FF, DM, 2 * FF, (bf16_t*)(wl + WO_GU), pt->in[27] + l * DM, 1, scr, r, lane); return; } r -= CV_GU;
    transpose_item(pt->in[29] + (size_t)l * FF * DM, FF, DM, (bf16_t*)(wl + WO_DN), nullptr, 0, scr, r, lane);
}
__device__ __forceinline__ void convert_misc(PtrTab pt, int l, int gtid, int nthr) {
    unsigned char* wl = pt->ws + WS_W + (size_t)l * W_LAYER;
    { u32x4* z = (u32x4*)(wl + WO_IN + (size_t)INW * DM * 2); const int n16 = (NP - INW) * DM * 2 / 16;
      for (int i = gtid; i < n16; i += nthr) z[i] = (u32x4){0u, 0u, 0u, 0u}; }
    tok::lora_prep(pt->in[14] + (size_t)l * 64 * 512, pt->in[16] + (size_t)l * 64 * 512, pt->in[17] + (size_t)l * 128 * 512,
                   l > 0 ? pt->in[19] + (size_t)(l - 1) * 512 * 32 : nullptr, l > 0 ? pt->in[20] + (size_t)(l - 1) * 32 * 512 : nullptr,
                   (bf16_t*)(wl + WO_LORA), gtid, nthr);
}
constexpr int CV_TI = (CV_NI + 63) / 64, CV_MISC = 8, CV_ITEMS = CV_TI + CV_MISC;
constexpr int CV_EARLY = CV_IN + CV_QB + CV_KVB;
constexpr int CV_LATE0 = (CV_NI - CV_EARLY + 63) / 64;
__device__ __forceinline__ void convert_queue_item(PtrTab pt, int l, int ci, LAS float* scr, int wid, int lane) {
    asm volatile("" : "+s"(pt));
    if (ci < CV_TI) {
        for (int k = 0; k < 8; ++k) { const int it = ci * 64 + k * 8 + wid; if (it < CV_NI) convert_wave_item(pt, l, it, scr, lane); }
    } else if (ci < CV_ITEMS) convert_misc(pt, l, (ci - CV_TI) * 512 + wid * 64 + lane, CV_MISC * 512);
    else { for (int k = 0; k < 8; ++k) { const int it = CV_EARLY + (ci - CV_ITEMS) * 64 + k * 8 + wid; if (it < CV_NI) convert_wave_item(pt, 0, it, scr, lane); } }
}
__device__ __forceinline__ void prologue_phase(PtrTab pt, LAS float* scr, int gw, int ngw, int lane) {
#ifdef CONV_IN_MIXERS
    for (int it = gw; it < CV_NI; it += ngw) convert_wave_item(pt, 0, it, scr, lane);
    convert_misc(pt, 0, gw * 64 + lane, ngw * 64);
#else
    for (int l = 0; l < DEPTH; ++l) {
        for (int it = gw; it < CV_NI; it += ngw) convert_wave_item(pt, l, it, scr, lane);
        convert_misc(pt, l, gw * 64 + lane, ngw * 64);
    }
#endif
    const float* x_in = pt->in[0]; const float* hb_in = pt->in[4]; unsigned char* ws_ = pt->ws;
    { bf16_t* xb = (bf16_t*)(ws_ + WS_XB); float* ssa = (float*)(ws_ + WS_SSA);
      for (int m0 = gw; m0 < T; m0 += 2 * ngw) {
        f32x4 v[2][8];
#pragma unroll
        for (int u = 0; u < 2; ++u) { const f32x4* xr = (const f32x4*)(x_in + (size_t)(m0 + u * ngw) * DM) + lane;
#pragma unroll
          for (int j = 0; j < 8; ++j) v[u][j] = xr[64 * j]; }
#pragma unroll
        for (int u = 0; u < 2; ++u) {
          const int m = m0 + u * ngw; float s = 0.f;
#pragma unroll
          for (int j = 0; j < 8; ++j) s += (v[u][j].x * v[u][j].x + v[u][j].y * v[u][j].y) + (v[u][j].z * v[u][j].z + v[u][j].w * v[u][j].w);
          s = wave_sum(s);
          if (lane < 32) ssa[(size_t)m * 32 + lane] = lane == 0 ? s : 0.f;
          u32x2* o = (u32x2*)(xb + (size_t)m * DM) + lane;
#pragma unroll
          for (int j = 0; j < 8; ++j) { u32x2 w; w.x = cvt_pk_bf16(v[u][j].x, v[u][j].y); w.y = cvt_pk_bf16(v[u][j].z, v[u][j].w); o[64 * j] = w; }
        }
      } }
    { float* lb = (float*)(ws_ + WS_LB); const float* hb = hb_in;
      for (int c = gw * 64 + lane; c < 512; c += ngw * 64) {
          float v[DEPTH], mx = -1e30f, s = 0.f;
          for (int l = 0; l < DEPTH; ++l) { v[l] = hb[l * 512 + c]; mx = fmaxf(mx, v[l]); }
          for (int l = 0; l < DEPTH; ++l) { v[l] = expf(v[l] - mx); s += v[l]; }
          float cum = 0.f; const float inv = 1.f / s;
          for (int l = 0; l < DEPTH; ++l) { cum += v[l] * inv; lb[l * 512 + c] = cum - v[0] * inv; }
      } }
}

__device__ __forceinline__ void rownorm_phase(const float* x, bf16_t* xb, float* rs, int gw, int ngw, int lane) {
    for (int m = gw; m < T; m += ngw) {
        const f32x4* xr = (const f32x4*)(x + (size_t)m * DM) + lane;
        f32x4 v[8]; float s = 0.f;
#pragma unroll
        for (int j = 0; j < 8; ++j) { v[j] = xr[64 * j]; s += (v[j].x * v[j].x + v[j].y * v[j].y) + (v[j].z * v[j].z + v[j].w * v[j].w); }
        s = wave_sum(s);
        if (lane == 0) rs[m] = 1.f / sqrtf(s * (1.f / DM) + RMS_EPS);
        u32x2* o = (u32x2*)(xb + (size_t)m * DM) + lane;
#pragma unroll
        for (int j = 0; j < 8; ++j) { u32x2 w; w.x = cvt_pk_bf16(v[j].x, v[j].y); w.y = cvt_pk_bf16(v[j].z, v[j].w); o[64 * j] = w; }
    }
}

__device__ __forceinline__ void qknorm_phase(bf16_t* q, bf16_t* kv, const int* pos, const float* q_gain, const float* k_gain, int gw, int ngw, int lane, bf16_t* qo = nullptr, bf16_t* kvo = nullptr) {
    if (!qo) { qo = q; kvo = kv; }
    const float gk0 = k_gain[2 * lane], gk1 = k_gain[2 * lane + 1];
#pragma unroll 2
    for (int tk = gw; tk < T; tk += ngw) {
        bf16_t* qrow = q + (size_t)tk * QW; bf16_t* krow = kv + (size_t)tk * KVW; bf16_t* qorow = qo + (size_t)tk * QW; bf16_t* korow = kvo + (size_t)tk * KVW;
#pragma unroll
        for (int h = 0; h < 8; ++h) {
            const unsigned kn = *(const unsigned*)(krow + h * 256 + 2 * lane);
            const float b0 = lo_bf(kn), b1 = hi_bf(kn);
            const float sk = wave_sum(b0 * b0 + b1 * b1);
            const float rk = 1.f / sqrtf(sk * (1.f / 128.f) + RMS_EPS);
            *(unsigned*)(korow + h * 256 + 2 * lane) = cvt_pk_bf16(b0 * rk * gk0, b1 * rk * gk1);
        }
    }
}
namespace rwk {
constexpr int TC = 64;
constexpr int NCH = SEQ / TC;
constexpr int N_ITEMS = BATCH * 8 * 2;
constexpr int OPS = 320;
constexpr int VS = TC + 4;
constexpr int L_KK = 0, L_W = 64, L_BN = 128, L_KP = 192, L_R = 256, L_V = TC * OPS, L_Y = L_V + 32 * VS, L_DUM = L_Y + 32 * VS, L_END = L_DUM + 512 * 4;
constexpr int LDS_BYTES = L_END * 4;
struct Args { const bf16_t *R, *K, *KK, *B; bf16_t* V; const float* W; const float* RIN; bf16_t* Yout; };

__device__ __forceinline__ float dpp_xor1(float x) { return __int_as_float(__builtin_amdgcn_update_dpp(0, __float_as_int(x), 0xB1, 0xf, 0xf, true)); }
__device__ __forceinline__ float dpp_xor2(float x) { return __int_as_float(__builtin_amdgcn_update_dpp(0, __float_as_int(x), 0x4E, 0xf, 0xf, true)); }
__device__ __forceinline__ float dpp_hmir(float x) { return __int_as_float(__builtin_amdgcn_update_dpp(0, __float_as_int(x), 0x141, 0xf, 0xf, true)); }
__device__ __forceinline__ float red8(float x) { x += dpp_xor1(x); x += dpp_xor2(x); x += dpp_hmir(x); return x; }

struct Pre { u32x4 r, k, v, kk, b; f32x4 w0, w1; float rin; };
__device__ __forceinline__ void pre_load(Pre& q, const Args& A, size_t off, bool hasv) {
    q.r = *(const u32x4*)(A.R + off); q.k = *(const u32x4*)(A.K + off); q.kk = *(const u32x4*)(A.KK + off); q.b = *(const u32x4*)(A.B + off);
    if (hasv) q.v = *(const u32x4*)(A.V + off);
    q.w0 = *(const f32x4*)(A.W + off); q.w1 = *(const f32x4*)(A.W + off + 4);
    q.rin = A.RIN[(off >> 9) * 8 + ((off >> 6) & 7)];
}
__device__ __forceinline__ void st8(LAS float* d, u32x4 w, float sc = 1.f) {
    *(LAS f32x4*)d = (f32x4){lo_bf(w.x) * sc, hi_bf(w.x) * sc, lo_bf(w.y) * sc, hi_bf(w.y) * sc}; *(LAS f32x4*)(d + 4) = (f32x4){lo_bf(w.z) * sc, hi_bf(w.z) * sc, lo_bf(w.w) * sc, hi_bf(w.w) * sc};
}

template <int VAR = 0>
__device__ __forceinline__ void item(const Args& A, LAS float* lds, int it, const int wv__) {
    const int tid = TID(), bh = it >> 1, half = it & 1, b = bh >> 3, h = bh & 7;
    const int st = tid >> 3, sc8 = (tid & 7) * 8;
    const bool hasv = ((tid & 7) >> 2) == half;
    const int vc8 = sc8 - half * 32;
    const size_t base = (size_t)b * SEQ * 512 + h * 64;
    const int row = tid >> 3, kp = tid & 7;
    f32x2 s0[4];
#pragma unroll
    for (int i = 0; i < 4; ++i) s0[i] = (f32x2){0.f, 0.f};
    Pre pre; pre_load(pre, A, base + (size_t)st * 512 + sc8, hasv);
    for (int ck = 0; ck < NCH; ++ck) {
        { const int o = st * OPS + sc8;
          st8(lds + L_R + o, pre.r); st8(lds + L_KP + o, pre.k); st8(lds + L_KK + o, pre.kk, pre.rin); st8(lds + L_BN + o, pre.b, pre.rin);
          *(LAS f32x4*)(lds + L_W + o) = pre.w0; *(LAS f32x4*)(lds + L_W + o + 4) = pre.w1;
          if (hasv) { LAS float* vd = lds + L_V + vc8 * VS + st;
            vd[0 * VS] = lo_bf(pre.v.x); vd[1 * VS] = hi_bf(pre.v.x); vd[2 * VS] = lo_bf(pre.v.y); vd[3 * VS] = hi_bf(pre.v.y);
            vd[4 * VS] = lo_bf(pre.v.z); vd[5 * VS] = hi_bf(pre.v.z); vd[6 * VS] = lo_bf(pre.v.w); vd[7 * VS] = hi_bf(pre.v.w); } }
        __syncthreads();
        if (ck + 1 < NCH) pre_load(pre, A, base + (size_t)((ck + 1) * TC + st) * 512 + sc8, hasv);
        if (tid < 256) {
            const LAS float* pk = lds + 8 * kp;
            const LAS float* pv = lds + L_V + row * VS;
            LAS float* pyw = kp == 0 ? lds + L_Y + row * VS : lds + L_DUM + tid * 4;
            const int pyinc = kp == 0 ? 4 : 0;
#define RW_LOAD(P, t_) do { const LAS float* q_ = pk + (t_) * OPS; \
                P##kk0 = *(const LAS f32x4*)(q_ + L_KK); P##kk1 = *(const LAS f32x4*)(q_ + L_KK + 4); \
                P##w0 = *(const LAS f32x4*)(q_ + L_W); P##w1 = *(const LAS f32x4*)(q_ + L_W + 4); \
                P##b0 = *(const LAS f32x4*)(q_ + L_BN); P##b1 = *(const LAS f32x4*)(q_ + L_BN + 4); \
                P##k0 = *(const LAS f32x4*)(q_ + L_KP); P##k1 = *(const LAS f32x4*)(q_ + L_KP + 4); \
                P##r0 = *(const LAS f32x4*)(q_ + L_R); P##r1 = *(const LAS f32x4*)(q_ + L_R + 4); } while (0)
#define F2(v4, i) ((f32x2){(v4)[2 * (i)], (v4)[2 * (i) + 1]})
#define RW_DOT(S, A0, A1) ({ f32x2 p_ = S[0] * F2(A0, 0); p_ = __builtin_elementwise_fma(S[1], F2(A0, 1), p_); p_ = __builtin_elementwise_fma(S[2], F2(A1, 0), p_); p_ = __builtin_elementwise_fma(S[3], F2(A1, 1), p_); p_.x + p_.y; })
#define RW_STEP(P, v_, yo_) do { \
                float sa0 = RW_DOT(s0, P##kk0, P##kk1); \
                const f32x2 va = (f32x2){v_, v_}; \
                f32x2 ta[4]; \
                ta[0] = va * F2(P##k0, 0); ta[1] = va * F2(P##k0, 1); ta[2] = va * F2(P##k1, 0); ta[3] = va * F2(P##k1, 1); \
                sa0 = red8(sa0); \
                const f32x2 sA = (f32x2){sa0, sa0}; \
                ta[0] = __builtin_elementwise_fma(sA, F2(P##b0, 0), ta[0]); ta[1] = __builtin_elementwise_fma(sA, F2(P##b0, 1), ta[1]); \
                ta[2] = __builtin_elementwise_fma(sA, F2(P##b1, 0), ta[2]); ta[3] = __builtin_elementwise_fma(sA, F2(P##b1, 1), ta[3]); \
                s0[0] = __builtin_elementwise_fma(s0[0], F2(P##w0, 0), ta[0]); s0[1] = __builtin_elementwise_fma(s0[1], F2(P##w0, 1), ta[1]); \
                s0[2] = __builtin_elementwise_fma(s0[2], F2(P##w1, 0), ta[2]); s0[3] = __builtin_elementwise_fma(s0[3], F2(P##w1, 1), ta[3]); \
                float y0 = RW_DOT(s0, P##r0, P##r1); \
                yo_ = red8(y0); } while (0)
            f32x4 Akk0, Akk1, Aw0, Aw1, Ab0, Ab1, Ak0, Ak1, Ar0, Ar1;
            f32x4 Bkk0, Bkk1, Bw0, Bw1, Bb0, Bb1, Bk0, Bk1, Br0, Br1;
            RW_LOAD(A, 0);
            f32x4 v4 = *(const LAS f32x4*)pv;
#pragma unroll 1
            for (int t = 0; t < TC; t += 4) {
                const f32x4 vn = *(const LAS f32x4*)(pv + t + 4);
                f32x4 y4;
                RW_LOAD(B, t + 1); RW_STEP(A, v4.x, y4.x);
                RW_LOAD(A, t + 2); RW_STEP(B, v4.y, y4.y);
                RW_LOAD(B, t + 3); RW_STEP(A, v4.z, y4.z);
                RW_LOAD(A, t + 4); RW_STEP(B, v4.w, y4.w);
                *(LAS f32x4*)pyw = y4; pyw += pyinc;
                v4 = vn;
            }
#undef RW_LOAD
#undef RW_DOT
#undef RW_STEP
#undef F2
        }
        __syncthreads();
        if (tid >= 256) {
            const int t = (tid - 256) >> 2, c8 = (tid & 3) * 8;
            const LAS float* yr = lds + L_Y + c8 * VS + t;
            u32x4 w; w.x = cvt_pk_bf16(yr[0 * VS], yr[1 * VS]); w.y = cvt_pk_bf16(yr[2 * VS], yr[3 * VS]); w.z = cvt_pk_bf16(yr[4 * VS], yr[5 * VS]); w.w = cvt_pk_bf16(yr[6 * VS], yr[7 * VS]);
            *(u32x4*)(A.Yout + base + (size_t)(ck * TC + t) * 512 + half * 32 + c8) = w;
        }
    }
    __syncthreads();
}

struct PostArgs { const bf16_t *Y, *G, *BON; const float *ln_w, *ln_b, *BS; bf16_t* mixed; };
__device__ __forceinline__ void post_phase(const PostArgs& A, int gw, int ngw, int lane) {
    float lnw[8], lnb[8];
#pragma unroll
    for (int i = 0; i < 8; ++i) { lnw[i] = A.ln_w[lane * 8 + i]; lnb[i] = A.ln_b[lane * 8 + i]; }
    for (int tk = gw; tk < T; tk += ngw) {
        const size_t o = (size_t)tk * 512 + lane * 8;
        const u32x4 y4 = *(const u32x4*)(A.Y + o), g4 = *(const u32x4*)(A.G + o), b4 = *(const u32x4*)(A.BON + o);
        float y[8] = {lo_bf(y4.x), hi_bf(y4.x), lo_bf(y4.y), hi_bf(y4.y), lo_bf(y4.z), hi_bf(y4.z), lo_bf(y4.w), hi_bf(y4.w)};
        const float g[8] = {lo_bf(g4.x), hi_bf(g4.x), lo_bf(g4.y), hi_bf(g4.y), lo_bf(g4.z), hi_bf(g4.z), lo_bf(g4.w), hi_bf(g4.w)};
        const float bo[8] = {lo_bf(b4.x), hi_bf(b4.x), lo_bf(b4.y), hi_bf(b4.y), lo_bf(b4.z), hi_bf(b4.z), lo_bf(b4.w), hi_bf(b4.w)};
        const float bsc = A.BS[(size_t)tk * 8 + (lane >> 3)];
        float sm = 0.f;
#pragma unroll
        for (int i = 0; i < 8; ++i) sm += y[i];
        sm = red8(sm); const float mean = sm * (1.f / 64.f);
        float sv = 0.f;
#pragma unroll
        for (int i = 0; i < 8; ++i) { y[i] -= mean; sv += y[i] * y[i]; }
        sv = red8(sv); const float rstd = 1.f / sqrtf(sv * (1.f / 64.f) + 64e-5f);
        float ov[8];
#pragma unroll
        for (int i = 0; i < 8; ++i) ov[i] = (y[i] * rstd * lnw[i] + lnb[i] + bsc * bo[i]) * g[i];
        u32x4 w; w.x = cvt_pk_bf16(ov[0], ov[1]); w.y = cvt_pk_bf16(ov[2], ov[3]); w.z = cvt_pk_bf16(ov[4], ov[5]); w.w = cvt_pk_bf16(ov[6], ov[7]);
        *(u32x4*)(A.mixed + (size_t)tk * DM + 1536 + lane * 8) = w;
    }
}
}
namespace rwc {
constexpr int TB = 32;
constexpr int NB = SEQ / TB;
constexpr int OPS = 320;
constexpr int L_KK = 0, L_W = 64, L_BN = 128, L_KP = 192, L_R = 256;
constexpr int O_RAW = 0;
constexpr int O_VT = O_RAW + TB * OPS * 4;
constexpr int VT_ROW = 40, VT_BUF = 2 * 64 * VT_ROW;
constexpr int O_IMG = O_VT + 2 * VT_BUF;
constexpr int RS = 144;
constexpr int I_A = 0, I_R = I_A + 16 * RS, I_B = I_R + 16 * RS, I_K = I_B + 16 * RS, I_BKT = I_K + 16 * RS;
constexpr int SR = 80;
constexpr int I_LAK = I_BKT + 64 * SR, I_TP = I_LAK + 16 * SR, I_MM = I_TP + 16 * SR, I_GC = I_MM + 16 * SR, I_LAB = I_GC + 256, IMG_BYTES = I_LAB + 16 * SR;
constexpr int O_YB = O_IMG + 2 * IMG_BYTES;
constexpr int LDS_BYTES = O_YB + TB * 64 * 4;
struct Args { const bf16_t *R, *K, *KK, *B, *V; const float* W; const float* RIN; const bf16_t* G; const float *BS, *ln_w, *ln_b; bf16_t* mixed; };
typedef unsigned short u16;

struct Pre { u32x2 r, k, kk, b, v; f32x4 w; float rin; };
__device__ __forceinline__ void pre_load(Pre& q, const Args& A, size_t off) {
    q.r = *(const u32x2*)(A.R + off); q.k = *(const u32x2*)(A.K + off); q.kk = *(const u32x2*)(A.KK + off); q.b = *(const u32x2*)(A.B + off); q.v = *(const u32x2*)(A.V + off);
    q.w = *(const f32x4*)(A.W + off);
    q.rin = A.RIN[(off >> 9) * 8 + ((off >> 6) & 7)];
}
__device__ __forceinline__ float red16(float x) { x += DPPF(x, 0xB1); x += DPPF(x, 0x4E); x += DPPF(x, 0x141); x += DPPF(x, 0x140); return x; }
__device__ __forceinline__ void st4(LAS float* d, u32x2 w, float sc = 1.f) { *(LAS f32x4*)d = (f32x4){lo_bf(w.x) * sc, hi_bf(w.x) * sc, lo_bf(w.y) * sc, hi_bf(w.y) * sc}; }
__device__ __forceinline__ f32x4 mfma16(u32x4 a, u32x4 b, f32x4 c) { return __builtin_amdgcn_mfma_f32_16x16x32_bf16(__builtin_bit_cast(bf16x8, a), __builtin_bit_cast(bf16x8, b), c, 0, 0, 0); }

__device__ __forceinline__ void item(const Args& A, LAS unsigned char* lds, int bh, const int wv__) {
    const int tid = TID(), lane = tid & 63, wid = __builtin_amdgcn_readfirstlane(tid >> 6);
    const int b = bh >> 3, h = bh & 7;
    const size_t base = (size_t)b * SEQ * 512 + h * 64;
    const int st = tid >> 4, c4 = (tid & 15) * 4;
    const int n16 = lane & 15, g = lane >> 4;
    f32x4 Z[4];
#pragma unroll
    for (int i = 0; i < 4; ++i) Z[i] = (f32x4){0.f, 0.f, 0.f, 0.f};
    u32x4 Zq[2] = {(u32x4){0u, 0u, 0u, 0u}, (u32x4){0u, 0u, 0u, 0u}};
    Pre pre; pre_load(pre, A, base + (size_t)st * 512 + c4);
    LAS float* raw = (LAS float*)(lds + O_RAW);
    LAS float* yb = (LAS float*)(lds + O_YB);
    const f32x4 lnw = *(const f32x4*)(A.ln_w + h * 64 + c4), lnb = *(const f32x4*)(A.ln_b + h * 64 + c4);
    u32x2 vprev = (u32x2){0u, 0u}, gq = (u32x2){0u, 0u}; float bsq = 0.f;
#define RWC_POST(bprev) do { \
        const f32x4 y4 = *(const LAS f32x4*)(yb + st * 64 + c4); \
        float sm = (y4.x + y4.y) + (y4.z + y4.w); sm = red16(sm); const float mean = sm * (1.f / 64.f); \
        const float d0 = y4.x - mean, d1 = y4.y - mean, d2 = y4.z - mean, d3 = y4.w - mean; \
        float sv = (d0 * d0 + d1 * d1) + (d2 * d2 + d3 * d3); sv = red16(sv); const float rstd = 1.f / sqrtf(sv * (1.f / 64.f) + 64e-5f); \
        const float o0 = (d0 * rstd * lnw.x + lnb.x + bsq * lo_bf(vprev.x)) * lo_bf(gq.x), o1 = (d1 * rstd * lnw.y + lnb.y + bsq * hi_bf(vprev.x)) * hi_bf(gq.x); \
        const float o2 = (d2 * rstd * lnw.z + lnb.z + bsq * lo_bf(vprev.y)) * lo_bf(gq.y), o3 = (d3 * rstd * lnw.w + lnb.w + bsq * hi_bf(vprev.y)) * hi_bf(gq.y); \
        *(u32x2*)(A.mixed + ((size_t)b * SEQ + (bprev) * TB + st) * DM + 1536 + h * 64 + c4) = (u32x2){cvt_pk_bf16(o0, o1), cvt_pk_bf16(o2, o3)}; } while (0)
    for (int bt = 0; bt < NB; ++bt) {
        LAS unsigned char* vt = lds + O_VT + (bt & 1) * VT_BUF;
        { LAS float* d = raw + st * OPS + c4;
          st4(d + L_R, pre.r); st4(d + L_KP, pre.k); st4(d + L_KK, pre.kk, pre.rin); st4(d + L_BN, pre.b, pre.rin); *(LAS f32x4*)(d + L_W) = pre.w;
          LAS unsigned char* vd = vt + ((st >> 4) * 64 + c4) * VT_ROW + (st & 15) * 2;
          *(LAS u16*)(vd) = (u16)(pre.v.x & 0xffffu); *(LAS u16*)(vd + VT_ROW) = (u16)(pre.v.x >> 16); *(LAS u16*)(vd + 2 * VT_ROW) = (u16)(pre.v.y & 0xffffu); *(LAS u16*)(vd + 3 * VT_ROW) = (u16)(pre.v.y >> 16); }
        __syncthreads();
        if (bt > 0) RWC_POST(bt - 1);
        vprev = pre.v;
        { const size_t tk = (size_t)b * SEQ + bt * TB + st; gq = *(const u32x2*)(A.G + tk * 512 + h * 64 + c4); bsq = A.BS[tk * 8 + h]; }
        if (bt + 1 < NB) pre_load(pre, A, base + (size_t)((bt + 1) * TB + st) * 512 + c4);
        { const int c = wid >> 2, gg = wid & 3, j = lane;
          LAS unsigned char* img = lds + O_IMG + c * IMG_BYTES;
          const LAS float* rw = raw + (16 * c) * OPS + j;
          float G = 1.f;
          for (int tp = 0; tp < 4 * gg; ++tp) G *= rw[tp * OPS + L_W];
          float bq[4], kq[4];
#pragma unroll
          for (int e = 0; e < 4; ++e) {
              const int t = 4 * gg + e; const LAS float* q = rw + t * OPS;
              const float Gm1 = G; G *= q[L_W]; const float inv = 1.f / G;
              const float at = q[L_KK] * Gm1, rt = q[L_R] * G; bq[e] = q[L_BN] * inv; kq[e] = q[L_KP] * inv;
              LAS unsigned char* o = img + t * RS + j * 2;
              *(LAS u16*)(o + I_A) = f2bf(at); *(LAS u16*)(o + I_R) = f2bf(rt); *(LAS u16*)(o + I_B) = f2bf(bq[e]); *(LAS u16*)(o + I_K) = f2bf(kq[e]);
          }
          *(LAS u32x4*)(img + I_BKT + j * SR + gg * 16) = (u32x4){cvt_pk_bf16(bq[0], bq[1]), cvt_pk_bf16(bq[2], bq[3]), cvt_pk_bf16(kq[0], kq[1]), cvt_pk_bf16(kq[2], kq[3])};
          if (gg == 3) *(LAS float*)(img + I_GC + j * 4) = G;
        }
        __syncthreads();
        { const int c = wid >> 2, tt = wid & 3;
          LAS unsigned char* img = lds + O_IMG + c * IMG_BYTES;
          const LAS unsigned char* ia = img + (tt < 2 ? I_A : I_R) + n16 * RS + g * 16;
          const LAS unsigned char* ib = img + ((tt & 1) ? I_K : I_B) + n16 * RS + g * 16;
          f32x4 p = (f32x4){0.f, 0.f, 0.f, 0.f};
          p = mfma16(*(const LAS u32x4*)ia, *(const LAS u32x4*)ib, p);
          p = mfma16(*(const LAS u32x4*)(ia + 64), *(const LAS u32x4*)(ib + 64), p);
          const int s = n16;
          if (tt == 0) {
              LAS float* lab = (LAS float*)(img + I_LAB);
#pragma unroll
              for (int r = 0; r < 4; ++r) { const int t = 4 * g + r; lab[t * 20 + s] = t > s ? p[r] : 0.f; }
              asm volatile("s_waitcnt lgkmcnt(0)" ::: "memory");
              float T[16];
#pragma unroll
              for (int t = 0; t < 16; ++t) {
                  float acc = (s == t) ? 1.f : 0.f;
#pragma unroll
                  for (int q4 = 0; q4 * 4 < t; ++q4) {
                      const f32x4 l4 = *(const LAS f32x4*)(lab + t * 20 + 4 * q4);
#pragma unroll
                      for (int e = 0; e < 4; ++e) if (4 * q4 + e < t) acc += l4[e] * T[4 * q4 + e];
                  }
                  T[t] = acc;
              }
#pragma unroll
              for (int t = 0; t < 16; ++t) *(LAS u16*)(img + I_TP + t * SR + (s >> 2) * 16 + (s & 3) * 2) = f2bf(T[t] - ((s == t) ? 1.f : 0.f));
          } else {
              const int ofs = (tt == 1 ? I_LAK : I_MM) + (s >> 2) * 16 + (tt == 3 ? 8 : 0) + (s & 3) * 2;
#pragma unroll
              for (int r = 0; r < 4; ++r) { const int t = 4 * g + r; const bool keep = tt == 1 ? (t > s) : (t >= s); *(LAS u16*)(img + ofs + t * SR) = f2bf(keep ? p[r] : 0.f); }
          }
        }
        __syncthreads();
        if (wid < 4) {
            const int i = 16 * wid + n16;
#pragma unroll 1
            for (int c = 0; c < 2; ++c) {
                const LAS unsigned char* img = lds + O_IMG + c * IMG_BYTES;
                const LAS unsigned char* ra = img + n16 * RS + g * 8;
                f32x4 D1 = (f32x4){0.f, 0.f, 0.f, 0.f}, D2 = D1;
#pragma unroll
                for (int ks = 0; ks < 2; ++ks) {
                    const u32x2 a0 = *(const LAS u32x2*)(ra + I_A + ks * 64), a1 = *(const LAS u32x2*)(ra + I_A + ks * 64 + 32);
                    const u32x2 r0 = *(const LAS u32x2*)(ra + I_R + ks * 64), r1 = *(const LAS u32x2*)(ra + I_R + ks * 64 + 32);
                    D1 = mfma16((u32x4){a0.x, a0.y, a1.x, a1.y}, Zq[ks], D1);
                    D2 = mfma16((u32x4){r0.x, r0.y, r1.x, r1.y}, Zq[ks], D2);
                }
                const u32x2 vv = *(const LAS u32x2*)(vt + (c * 64 + i) * VT_ROW + g * 8);
                const u32x2 al = *(const LAS u32x2*)(img + I_LAK + n16 * SR + g * 16);
                D1 = mfma16((u32x4){al.x, al.y, 0u, 0u}, (u32x4){vv.x, vv.y, 0u, 0u}, D1);
                const u32x2 at = *(const LAS u32x2*)(img + I_TP + n16 * SR + g * 16);
                const f32x4 U = mfma16((u32x4){at.x, at.y, 0u, 0u}, (u32x4){cvt_pk_bf16(D1[0], D1[1]), cvt_pk_bf16(D1[2], D1[3]), 0u, 0u}, D1);
                const u32x4 buv = (u32x4){cvt_pk_bf16(U[0], U[1]), cvt_pk_bf16(U[2], U[3]), vv.x, vv.y};
                const f32x4 Y = mfma16(*(const LAS u32x4*)(img + I_MM + n16 * SR + g * 16), buv, D2);
#pragma unroll
                for (int jt = 0; jt < 4; ++jt) {
                    Z[jt] = mfma16(*(const LAS u32x4*)(img + I_BKT + (16 * jt + n16) * SR + g * 16), buv, Z[jt]);
                    const f32x4 gc = *(const LAS f32x4*)(img + I_GC + (16 * jt + 4 * g) * 4);
                    Z[jt] = Z[jt] * gc;
                }
                Zq[0] = (u32x4){cvt_pk_bf16(Z[0][0], Z[0][1]), cvt_pk_bf16(Z[0][2], Z[0][3]), cvt_pk_bf16(Z[1][0], Z[1][1]), cvt_pk_bf16(Z[1][2], Z[1][3])};
                Zq[1] = (u32x4){cvt_pk_bf16(Z[2][0], Z[2][1]), cvt_pk_bf16(Z[2][2], Z[2][3]), cvt_pk_bf16(Z[3][0], Z[3][1]), cvt_pk_bf16(Z[3][2], Z[3][3])};
                LAS float* yo = yb + (16 * c + 4 * g) * 64 + i;
#pragma unroll
                for (int r = 0; r < 4; ++r) yo[r * 64] = Y[r];
            }
        }
    }
    __syncthreads();
    RWC_POST(NB - 1);
    __syncthreads();
#undef RWC_POST
}
}
namespace hg {
constexpr int C = 64, NCH = SEQ / C, HD = 128;
constexpr int RS128 = 272, RS64 = 144;
constexpr int O_QM = 0, O_KM = O_QM + C * RS128, O_QE = O_KM + C * RS128, O_KET = O_QE + C * RS128, O_VT = O_KET + HD * RS64,
              O_STT = O_VT + HD * RS64, O_P = O_STT + HD * RS128, O_TOT = O_P + C * RS64, O_DEC = O_TOT + 4 * HD * 4, O_END = O_DEC + HD * 4;
constexpr int OB_STRIDE = 132;
static_assert(C * OB_STRIDE * 4 <= 2 * C * RS128, "OBUF alias");
constexpr int LDS_BYTES = O_END;
struct Args { const bf16_t* p; const float* lb; const float* out_gain; bf16_t* mixed; };

__device__ __forceinline__ bf16x8 lda8(const LAS unsigned char* base, int row, int rs, int colB) { return *(const LAS bf16x8*)(base + row * rs + colB); }

__device__ __forceinline__ void item(const Args& A, LAS unsigned char* lds, int bh, const int wv__) {
    const int tid = TID(), lane = tid & 63, wid = __builtin_amdgcn_readfirstlane(tid >> 6), r32 = lane & 31, hi = lane >> 5;
    const int b = bh >> 2, h = bh & 3;
    const int ch = tid & 127, part = tid >> 7;
    const float lbc = A.lb[h * HD + ch], omlb = 1.f - lbc;
    const bf16_t* pbase = A.p + (size_t)b * SEQ * NP + h * HD;
    f32x16 sacc[2]; sacc[0] = f32x16{}; sacc[1] = f32x16{};
    const int kb = wid >> 1, vb0 = 2 * (wid & 1);
    for (int i = tid; i < HD * RS128 / 16; i += 512) *(LAS u32x4*)(lds + O_STT + i * 16) = (u32x4){0u, 0u, 0u, 0u};
    LAS float* tot = (LAS float*)(lds + O_TOT);
    LAS float* dec = (LAS float*)(lds + O_DEC);
    LAS float* obuf = (LAS float*)(lds + O_QM);
    bf16_t rq[16], rf[16], ri[16];
    { const bf16_t* pc0 = pbase + (size_t)(part * 16) * NP + ch;
#pragma unroll
      for (int i = 0; i < 16; ++i) { rf[i] = pc0[(size_t)i * NP + C_HF]; rq[i] = pc0[(size_t)i * NP + C_HQ]; ri[i] = pc0[(size_t)i * NP + C_HI]; } }
    for (int ck = 0; ck < NCH; ++ck) {
        const size_t tk_e = (size_t)b * SEQ + ck * C + (tid >> 3);
        const bf16_t* gp_e = A.p + tk_e * NP + C_HG + h * HD + (tid & 7) * 16;
        const u32x4 g0 = *(const u32x4*)gp_e, g1 = *(const u32x4*)(gp_e + 8);
        float lf[16], qv[16], kv[16];
        float run = 0.f;
#pragma unroll
        for (int i = 0; i < 16; ++i) {
            const float z = bf2f(rf[i]);
            const float sg = sigmoidf_(z);
            const float f = lbc + omlb * sg;
            kv[i] = 1.f - f;
            run += __logf(f); lf[i] = run;
            qv[i] = siluf_(bf2f(rq[i]));
        }
        tot[part * HD + ch] = run;
        { unsigned w[8];
#pragma unroll
          for (int i = 0; i < 8; ++i) w[i] = (unsigned)ri[2 * i] | ((unsigned)ri[2 * i + 1] << 16);
          LAS u32x4* d = (LAS u32x4*)(lds + O_VT + ch * RS64 + part * 32);
          d[0] = (u32x4){w[0], w[1], w[2], w[3]}; d[1] = (u32x4){w[4], w[5], w[6], w[7]}; }
        __syncthreads();
        if (ck + 1 < NCH) { const bf16_t* pcn = pbase + (size_t)((ck + 1) * C + part * 16) * NP + ch;
#pragma unroll
            for (int i = 0; i < 16; ++i) { rf[i] = pcn[(size_t)i * NP + C_HF]; rq[i] = pcn[(size_t)i * NP + C_HQ]; ri[i] = pcn[(size_t)i * NP + C_HI]; } }
        float off = 0.f;
#pragma unroll
        for (int pp = 0; pp < 4; ++pp) off += (pp < part) ? tot[pp * HD + ch] : 0.f;
        const float bref = tot[ch] + tot[HD + ch];
        const float blast = bref + tot[2 * HD + ch] + tot[3 * HD + ch];
        const float c_blast = __expf(blast), c_bref = __expf(bref), c_nbref = fast_rcp(c_bref);
        if (part == 0) dec[ch] = c_blast;
        {
            unsigned wk[8];
#pragma unroll
            for (int i = 0; i < 16; ++i) {
                const float bt = off + lf[i];
                const int t = part * 16 + i;
                const float e1 = __expf(fmaxf(bt, -80.f)), e2 = fast_rcp(e1);
                const float qe = qv[i] * e1, qm = qe * c_nbref, km = kv[i] * e2 * c_bref, ke = kv[i] * e2 * c_blast;
                *(LAS bf16_t*)(lds + O_QM + t * RS128 + ch * 2) = f2bf(qm);
                *(LAS bf16_t*)(lds + O_KM + t * RS128 + ch * 2) = f2bf(km);
                *(LAS bf16_t*)(lds + O_QE + t * RS128 + ch * 2) = f2bf(qe);
                if (i & 1) wk[i >> 1] |= ((unsigned)f2bf(ke)) << 16; else wk[i >> 1] = (unsigned)f2bf(ke);
            }
            LAS u32x4* d = (LAS u32x4*)(lds + O_KET + ch * RS64 + part * 32);
            d[0] = (u32x4){wk[0], wk[1], wk[2], wk[3]}; d[1] = (u32x4){wk[4], wk[5], wk[6], wk[7]};
        }
        __syncthreads();
        if (wid < 3) {
            const int ti = wid == 0 ? 0 : 1, si = wid == 2 ? 1 : 0;
            f32x16 sc = f32x16{};
#pragma unroll
            for (int ks = 0; ks < 8; ++ks) {
                const bf16x8 a = lda8(lds + O_QM, ti * 32 + r32, RS128, (ks * 16 + hi * 8) * 2);
                const bf16x8 bb = lda8(lds + O_KM, si * 32 + r32, RS128, (ks * 16 + hi * 8) * 2);
                sc = __builtin_amdgcn_mfma_f32_32x32x16_bf16(a, bb, sc, 0, 0, 0);
            }
#pragma unroll
            for (int r = 0; r < 16; ++r) { const int tl = (r & 3) + 8 * (r >> 2) + 4 * hi; const int tg = ti * 32 + tl, sg = si * 32 + r32;
                const float v = (sg <= tg) ? sc[r] : 0.f;
                *(LAS bf16_t*)(lds + O_P + tg * RS64 + sg * 2) = f2bf(v); }
        } else if (wid == 3) {
#pragma unroll
            for (int r = 0; r < 16; ++r) { const int tl = (r & 3) + 8 * (r >> 2) + 4 * hi; *(LAS bf16_t*)(lds + O_P + tl * RS64 + (32 + r32) * 2) = (bf16_t)0; }
        }
        __syncthreads();
        {
            const int ti = wid >> 2, vj = wid & 3;
            f32x16 oc = f32x16{};
#pragma unroll
            for (int ks = 0; ks < 8; ++ks) {
                const bf16x8 a = lda8(lds + O_QE, ti * 32 + r32, RS128, (ks * 16 + hi * 8) * 2);
                const bf16x8 bb = lda8(lds + O_STT, vj * 32 + r32, RS128, (ks * 16 + hi * 8) * 2);
                oc = __builtin_amdgcn_mfma_f32_32x32x16_bf16(a, bb, oc, 0, 0, 0);
            }
#pragma unroll
            for (int ss = 0; ss < 4; ++ss) {
                const bf16x8 a = lda8(lds + O_P, ti * 32 + r32, RS64, (ss * 16 + hi * 8) * 2);
                const bf16x8 bb = lda8(lds + O_VT, vj * 32 + r32, RS64, (ss * 16 + hi * 8) * 2);
                oc = __builtin_amdgcn_mfma_f32_32x32x16_bf16(a, bb, oc, 0, 0, 0);
            }
#pragma unroll
            for (int r = 0; r < 16; ++r) { const int tl = (r & 3) + 8 * (r >> 2) + 4 * hi; obuf[(ti * 32 + tl) * OB_STRIDE + vj * 32 + r32] = oc[r]; }
        }
#pragma unroll
        for (int j = 0; j < 2; ++j) {
#pragma unroll
            for (int r = 0; r < 16; ++r) { const int kl = (r & 3) + 8 * (r >> 2) + 4 * hi; sacc[j][r] *= dec[kb * 32 + kl]; }
#pragma unroll
            for (int ss = 0; ss < 4; ++ss) {
                const bf16x8 a = lda8(lds + O_KET, kb * 32 + r32, RS64, (ss * 16 + hi * 8) * 2);
                const bf16x8 bb = lda8(lds + O_VT, (vb0 + j) * 32 + r32, RS64, (ss * 16 + hi * 8) * 2);
                sacc[j] = __builtin_amdgcn_mfma_f32_32x32x16_bf16(a, bb, sacc[j], 0, 0, 0);
            }
        }
        __syncthreads();
#pragma unroll
        for (int j = 0; j < 2; ++j)
#pragma unroll
            for (int g = 0; g < 4; ++g) {
                u32x2 w; w.x = cvt_pk_bf16(sacc[j][4 * g], sacc[j][4 * g + 1]); w.y = cvt_pk_bf16(sacc[j][4 * g + 2], sacc[j][4 * g + 3]);
                *(LAS u32x2*)(lds + O_STT + ((vb0 + j) * 32 + r32) * RS128 + (kb * 32 + 8 * g + 4 * hi) * 2) = w;
            }
        {
            const int t = tid >> 3, c0 = (tid & 7) * 16;
            const LAS float* orow = obuf + t * OB_STRIDE + c0;
            float o[16]; float ss = 0.f;
#pragma unroll
            for (int i = 0; i < 4; ++i) { const f32x4 x = *(const LAS f32x4*)(orow + 4 * i); o[4 * i] = x.x; o[4 * i + 1] = x.y; o[4 * i + 2] = x.z; o[4 * i + 3] = x.w; ss += x.x * x.x + x.y * x.y + x.z * x.z + x.w * x.w; }
            ss = sum8f(ss);
            const float rn = 1.f / sqrtf(ss * (1.f / 128.f) + RMS_EPS);
            const size_t tk = tk_e;
            const float gr[16] = {lo_bf(g0.x), hi_bf(g0.x), lo_bf(g0.y), hi_bf(g0.y), lo_bf(g0.z), hi_bf(g0.z), lo_bf(g0.w), hi_bf(g0.w),
                                  lo_bf(g1.x), hi_bf(g1.x), lo_bf(g1.y), hi_bf(g1.y), lo_bf(g1.z), hi_bf(g1.z), lo_bf(g1.w), hi_bf(g1.w)};
            float ov[16];
#pragma unroll
            for (int i = 0; i < 16; ++i) ov[i] = o[i] * rn * A.out_gain[c0 + i] * siluf_(gr[i]);
            u32x4 w0, w1;
            w0.x = cvt_pk_bf16(ov[0], ov[1]); w0.y = cvt_pk_bf16(ov[2], ov[3]); w0.z = cvt_pk_bf16(ov[4], ov[5]); w0.w = cvt_pk_bf16(ov[6], ov[7]);
            w1.x = cvt_pk_bf16(ov[8], ov[9]); w1.y = cvt_pk_bf16(ov[10], ov[11]); w1.z = cvt_pk_bf16(ov[12], ov[13]); w1.w = cvt_pk_bf16(ov[14], ov[15]);
            bf16_t* mp = A.mixed + tk * DM + h * HD + c0;
            *(u32x4*)mp = w0; *(u32x4*)(mp + 8) = w1;
        }
        __syncthreads();
    }
}
}
#define RLX_AGENT __ATOMIC_RELAXED, __HIP_MEMORY_SCOPE_AGENT
#define XB_TMO      128
#define XB_XCNT(j)  (256  + 64 * (j))
#define XB_XSUB(j)  (1280 + 64 * (j))
#define XB_XGEN(j)  (2304 + 64 * (j))
#define XB_TOP      3328
#define XB_TOPGEN   3392
#define XCD_BAR_WORDS 3456
#define XB_SPIN_CAP (1u << 18)

__device__ __forceinline__ unsigned xb_ld(unsigned* p)              { return __hip_atomic_load(p, __ATOMIC_RELAXED, __HIP_MEMORY_SCOPE_AGENT); }
__device__ __forceinline__ unsigned xb_add(unsigned* p, unsigned v) { return __hip_atomic_fetch_add(p, v, __ATOMIC_RELAXED, __HIP_MEMORY_SCOPE_AGENT); }
__device__ __forceinline__ unsigned xb_xcc_id() { return (unsigned)__builtin_amdgcn_s_getreg((3 << 11) | 20) & 0xFu; }
#define XB_SPIN(cond, bar) do { unsigned _sp = 0; while (cond) { __builtin_amdgcn_s_sleep(1); \
    if ((++_sp & 255u) == 0u) { if (xb_ld(&(bar)[XB_TMO])) break; if (_sp > XB_SPIN_CAP) { atomicAdd(&(bar)[XB_TMO], 1u); break; } } } } while (0)

struct XcdBarrier {
    unsigned* bar; unsigned x;
    volatile LAS unsigned* st;
};

__device__ __forceinline__ XcdBarrier xcd_barrier_post(unsigned* bar, volatile LAS unsigned* st, const int wv__) {
    XcdBarrier b; b.bar = bar; b.x = xb_xcc_id(); b.st = st;
    if (TID() == 0) (void)xb_add(&bar[XB_XCNT(b.x)], 1u);
    return b;
}
__device__ __forceinline__ void xcd_barrier_complete(unsigned* bar, unsigned x, unsigned& nloc, unsigned& nx) {
    const unsigned G = gridDim.x * gridDim.y * gridDim.z;
    unsigned sum, cnt, mine, sp = 0u;
    for (;;) {
        sum = 0u; cnt = 0u; mine = 0u;
#pragma unroll
        for (unsigned j = 0; j < 16; ++j) { const unsigned c = xb_ld(&bar[XB_XCNT(j)]); sum += c; cnt += (c > 0u) ? 1u : 0u; mine = (j == x) ? c : mine; }
        if (sum == G) break;
        __builtin_amdgcn_s_sleep(1);
        if ((++sp & 255u) == 0u) { if (xb_ld(&bar[XB_TMO])) break; if (sp > XB_SPIN_CAP) { atomicAdd(&bar[XB_TMO], 1u); break; } }
    }
    nloc = mine > 0u ? mine : 1u; nx = cnt > 0u ? cnt : 1u;
}

__device__ __forceinline__ void xcd_barrier(const XcdBarrier& b, const int wv__) {
    asm volatile("s_waitcnt vmcnt(0)" ::: "memory");
    __syncthreads();
    if (TID() == 0) {
        unsigned* bar = b.bar;
        __builtin_amdgcn_s_waitcnt(0);
        unsigned nloc = b.st[0], nx = b.st[1];
        if (nloc == 0u) { xcd_barrier_complete(bar, b.x, nloc, nx); b.st[0] = nloc; b.st[1] = nx; }
        const unsigned old = xb_add(&bar[XB_XSUB(b.x)], 1u);
        const unsigned gen = old / nloc;
        if (old + 1u == (gen + 1u) * nloc) {
            __builtin_amdgcn_fence(__ATOMIC_RELEASE, "agent");
            asm volatile("s_waitcnt vmcnt(0)" ::: "memory");
            const unsigned og = xb_add(&bar[XB_TOP], 1u);
            const unsigned tg = og / nx;
            if (og + 1u == (tg + 1u) * nx) xb_add(&bar[XB_TOPGEN], 1u);
            else XB_SPIN(xb_ld(&bar[XB_TOPGEN]) == tg, bar);
            __builtin_amdgcn_fence(__ATOMIC_ACQUIRE, "agent");
            xb_add(&bar[XB_XGEN(b.x)], 1u);
            asm volatile("s_waitcnt vmcnt(0)" ::: "memory");
        } else {
            XB_SPIN(xb_ld(&bar[XB_XGEN(b.x)]) == gen, bar);
            __builtin_amdgcn_fence(__ATOMIC_ACQUIRE, "agent");
            asm volatile("s_waitcnt vmcnt(0)" ::: "memory");
        }
    }
    __syncthreads();
}

constexpr int NTHREADS = 512, NWAVES = 8;
constexpr int LDS_ALL = 153600;
static_assert(LDS_ALL >= hg::LDS_BYTES && LDS_ALL >= tok::LDS_BYTES && LDS_ALL >= rwk::LDS_BYTES && LDS_ALL >= rwc::LDS_BYTES && LDS_ALL >= att::LDS_BYTES && LDS_ALL >= pg8::STAGE_BYTES, "LDS");
constexpr int CW_BAR = 4096;
constexpr int PH_PER_LAYER = 7, N_PHASES = 1 + DEPTH * PH_PER_LAYER;

struct KArgs { Ptrs P; int ph_lo, ph_hi, coop, pad; };

#ifdef DUP_TOKMODE
#define TOKMODE (rep ? DUP_TOKMODE : 7)
#else
#define TOKMODE 7
#endif
template <int ph>
__device__ __forceinline__ void run_phase(LAS unsigned char* lds, unsigned char* lds_raw, cg::grid_group& grid, const int G, const int bid, const int wv__) {
        const KArgs __attribute__((address_space(4)))* ka = (const KArgs __attribute__((address_space(4)))*)__builtin_amdgcn_kernarg_segment_ptr();
        asm volatile("" : "+s"(ka));
#define PIN(i) (ka->P.in[i])
        const int tid = TID(), lane = tid & 63, wid = __builtin_amdgcn_readfirstlane(tid >> 6);
        const int gw = bid * NWAVES + wid, ngw = G * NWAVES;
        unsigned char* ws = ka->P.ws;
        float* x = ka->P.out;
        bf16_t* xb = (bf16_t*)(ws + WS_XB); bf16_t* pbuf = (bf16_t*)(ws + WS_P); bf16_t* mixed = (bf16_t*)(ws + WS_MIX);
        bf16_t* qbuf = (bf16_t*)(ws + WS_Q); bf16_t* kvbuf = (bf16_t*)(ws + WS_KV); bf16_t* krbuf = (bf16_t*)(ws + WS_KR);
        bf16_t* act = (bf16_t*)(ws + WS_ACT);
        float* ssA = (float*)(ws + WS_SSA); float* ssB = (float*)(ws + WS_SSBP); float* rsb = (float*)(ws + WS_RS); float* rsq = (float*)(ws + WS_RSQ); float* rskv = (float*)(ws + WS_RSKV);
        const int* pos = (const int*)PIN(1);
        if constexpr (ph == 0) {
            prologue_phase(&ka->P, (LAS float*)lds + wid * (64 * 65), gw, ngw, lane);
#ifdef DUP_PRO
            __syncthreads(); prologue_phase(&ka->P, (LAS float*)lds + wid * (64 * 65), gw, ngw, lane);
#endif
        } else {
            constexpr int l = (ph - 1) / PH_PER_LAYER, sp = (ph - 1) % PH_PER_LAYER;
            unsigned char* wl = ws + WS_W + (size_t)l * W_LAYER;
#ifdef DUP_SP
            const int nrep = (sp == DUP_SP) ? 2 : 1;
#else
            const int nrep = 1;
#endif
            for (int rep = 0; rep < nrep; ++rep) {
            if (rep) { XcdBarrier xb; xb.bar = (unsigned*)(ws + WS_CTL) + CW_BAR; xb.x = xb_xcc_id(); xb.st = (volatile LAS unsigned*)(lds + LDS_ALL - 128); xcd_barrier(xb, wv__); }
            switch (sp) {
            case 0: {
                pg8::Gemm g{xb, (const bf16_t*)(wl + WO_IN), T, NP, DM, DM}; pg8::StaticOrder S; S.init(T, NP, G, bid);
                pg8::prep_row_scales(ssA, rsb, S, tid);
                pg8::EpiScaleBf16 E{pbuf, rsb, NP, 0};
                pg8::gemm_phase<pg8::EpiScaleBf16, pg8::StaticOrder, true, true>(lds, g, S, E, wv__);
            } break;
            case 1: {
                tok::Args A;
                A.p = pbuf; A.pos = pos; A.k_gain = PIN(11) + l * 192;
                A.mu = PIN(12) + l * 1792; A.w0 = PIN(13) + l * 512; A.a0 = PIN(15) + l * 512;
                constexpr int lm = l > 0 ? l - 1 : 0;
                A.v0 = PIN(18) + lm * 512;
                A.k_k = PIN(21) + l * 512; A.k_a = PIN(22) + l * 512; A.r_k = PIN(23) + l * 512;
                A.wl = (const bf16_t*)(wl + WO_LORA);
                A.rs_q = rsq; A.rs_kv = rskv; A.kr = krbuf;
                A.R = (bf16_t*)(ws + WS_RWR); A.K = (bf16_t*)(ws + WS_RWK); A.V = (bf16_t*)(ws + WS_RWV); A.KK = (bf16_t*)(ws + WS_RWKK); A.B = (bf16_t*)(ws + WS_RWB);
                A.G = (bf16_t*)((unsigned char*)x + 64 * MiB); A.BON = (bf16_t*)((unsigned char*)x + 96 * MiB); A.VFIRST = (bf16_t*)(ws + WS_VFIRST); A.W = (float*)((unsigned char*)x); A.RIN = (float*)(ws + WS_RIN); A.BS = (float*)(ws + WS_BS);
#ifdef TOKPROBE
                if (rep) { unsigned char* dq = ws + WS_Q; A.R = (bf16_t*)dq; A.K = (bf16_t*)(dq + 32 * MiB); A.V = (bf16_t*)(dq + 64 * MiB); A.KK = (bf16_t*)(dq + 96 * MiB); A.B = (bf16_t*)(dq + 128 * MiB);
                    A.G = (bf16_t*)(dq + 160 * MiB); A.VFIRST = l == 0 ? (bf16_t*)(dq + 192 * MiB) : A.VFIRST; A.W = (float*)(ws + WS_MIX); A.RIN = (float*)(ws + WS_MIX + 64 * MiB); A.BS = (float*)(ws + WS_MIX + 65 * MiB); }
#endif
                tok::stage_params(A, lds, tid);
                for (int tl = bid; tl < tok::NTILES; tl += G) tok::tile<l>(A, lds, tl, wv__, TOKMODE);
            } break;
            case 2: {
                { pg8::Gemm g{pbuf + C_MQ, (const bf16_t*)(wl + WO_QB), T, QW, 512, NP}; pg8::StaticOrder S; S.init(T, QW, G, bid);
                  pg8::EpiPlainBf16 E{qbuf, QW, 0};
                  pg8::gemm_phase<pg8::EpiPlainBf16, pg8::StaticOrder, true, true>(lds, g, S, E, wv__); }
                { pg8::Gemm g{pbuf + C_MKV, (const bf16_t*)(wl + WO_KVB), T, KVW, 256, NP}; pg8::StaticOrder S; S.init(T, KVW, G, bid);
                  pg8::EpiKV E{kvbuf, rskv, PIN(11) + l * 192, (LAS float*)(lds + pg8::STAGE_BYTES), KVW, 0};
                  pg8::gemm_phase<pg8::EpiKV, pg8::StaticOrder, true, true>(lds, g, S, E, wv__); }
            } break;
            case 3: {
                unsigned* ctr = (unsigned*)(ws + WS_CTL) + 64 * l + 16 * rep;
                LAS int* qslot = (LAS int*)(lds + LDS_ALL - 64);
                constexpr int NQ = 96 + att::N_BLOCKS;
#ifdef DUP_MIX
                const int qlo = rep ? (DUP_MIX == 1 ? 0 : DUP_MIX == 2 ? 64 : 96) : 0, qhi = rep ? (DUP_MIX == 1 ? 64 : DUP_MIX == 2 ? 96 : NQ) : NQ;
#else
                const int qlo = 0, qhi = NQ;
#endif
#ifdef CONV_IN_MIXERS
                if constexpr (l + 1 < DEPTH) {
                    if (!rep && bid % CONV_EVERY == 0) {
                        for (;;) {
                            __syncthreads();
                            if (tid == 0) *qslot = (int)__hip_atomic_fetch_add(ctr + 8, 1u, __ATOMIC_RELAXED, __HIP_MEMORY_SCOPE_AGENT);
                            __syncthreads();
                            const int ci = __builtin_amdgcn_readfirstlane(*qslot);
                            if (ci >= CV_ITEMS) break;
                            convert_queue_item(&ka->P, l + 1, ci, (LAS float*)lds + wid * (64 * 65), wid, lane);
                        }
                    }
                }
#endif
                for (;;) {
                    __syncthreads();
                    if (tid == 0) *qslot = (int)__hip_atomic_fetch_add(ctr, 1u, __ATOMIC_RELAXED, __HIP_MEMORY_SCOPE_AGENT);
                    __syncthreads();
                    const int it = qlo + __builtin_amdgcn_readfirstlane(*qslot);
                    if (it >= qhi) break;
                    if (it < 64) {
                        rwc::Args RA; RA.R = (const bf16_t*)(ws + WS_RWR); RA.K = (const bf16_t*)(ws + WS_RWK); RA.V = (const bf16_t*)(ws + WS_RWV); RA.KK = (const bf16_t*)(ws + WS_RWKK);
                        RA.B = (const bf16_t*)(ws + WS_RWB); RA.W = (const float*)((unsigned char*)x); RA.RIN = (const float*)(ws + WS_RIN);
                        RA.G = (const bf16_t*)((unsigned char*)x + 64 * MiB); RA.BS = (const float*)(ws + WS_BS); RA.ln_w = PIN(24) + l * 512; RA.ln_b = PIN(25) + l * 512;
                        RA.mixed = rep ? (bf16_t*)((unsigned char*)x + 128 * MiB) : mixed;
                        rwc::item(RA, lds, it, wv__);
                    } else if (it < 96) {
                        hg::Args HA; HA.p = pbuf; HA.lb = (const float*)(ws + WS_LB) + l * 512; HA.out_gain = PIN(5) + l * 128; HA.mixed = mixed;
                        hg::item(HA, lds, it - 64, wv__);
                    }
                    else att::attn_one((char*)lds_raw, qbuf, kvbuf, krbuf, mixed, it - 96, pos, PIN(10) + l * 192, wv__);
                }
            } break;
            case 4: {
                pg8::Gemm g{mixed, (const bf16_t*)(wl + WO_O), T, DM, DM, DM}; pg8::StaticOrder S; S.init(T, DM, G, bid);
                pg8::EpiResidB E{l == 0 ? PIN(0) : (const float*)nullptr, (float*)nullptr, xb, ssB, DM, 0};
                pg8::gemm_phase<pg8::EpiResidB, pg8::StaticOrder, true, true>(lds, g, S, E, wv__);
            } break;
            case 5: {
                pg8::Gemm g{xb, (const bf16_t*)(wl + WO_GU), T, 2 * FF, DM, DM}; pg8::StaticOrder S; S.init(T, 2 * FF, G, bid);
                pg8::prep_row_scales(ssB, rsb, S, tid);
                pg8::EpiSwiGLU E{act, rsb, FF, 0};
                pg8::gemm_phase<pg8::EpiSwiGLU, pg8::StaticOrder, true, true>(lds, g, S, E, wv__);
            } break;
            case 6: {
                pg8::Gemm g{act, (const bf16_t*)(wl + WO_DN), T, DM, FF, FF}; pg8::StaticOrder S; S.init(T, DM, G, bid);
                pg8::EpiResidB E{(const float*)nullptr, l == DEPTH - 1 ? x : (float*)nullptr, xb, ssA, DM, 0};
                pg8::gemm_phase<pg8::EpiResidB, pg8::StaticOrder, true, true>(lds, g, S, E, wv__);
            } break;
            }
            }
        }
}
template <int PH0, int PH1>
__device__ __forceinline__ void run_phases(LAS unsigned char* lds, unsigned char* lds_raw, cg::grid_group& grid, const int G, const int bid, const int wv__) {
    if constexpr (PH0 < PH1) {
        run_phase<PH0>(lds, lds_raw, grid, G, bid, wv__);
        if constexpr (PH0 + 1 < PH1) {
            const KArgs __attribute__((address_space(4)))* ka = (const KArgs __attribute__((address_space(4)))*)__builtin_amdgcn_kernarg_segment_ptr();
            XcdBarrier xb; xb.bar = (unsigned*)(ka->P.ws + WS_CTL) + CW_BAR; xb.x = xb_xcc_id(); xb.st = (volatile LAS unsigned*)(lds + LDS_ALL - 128);
            xcd_barrier(xb, wv__);
        }
        run_phases<PH0 + 1, PH1>(lds, lds_raw, grid, G, bid, wv__);
    }
}
__global__ void __launch_bounds__(NTHREADS, 2) mega(KArgs args) {
    extern __shared__ __attribute__((aligned(16))) unsigned char lds_raw[];
    LAS unsigned char* lds = (LAS unsigned char*)lds_raw;
    const int G = gridDim.x, bid = blockIdx.x;
    const int wv__ = __builtin_amdgcn_readfirstlane((int)threadIdx.x >> 6);
    cg::grid_group grid = cg::this_grid();
    {
        volatile LAS unsigned* st = (volatile LAS unsigned*)(lds + LDS_ALL - 128);
        if (threadIdx.x < 2) st[threadIdx.x] = 0u;
        __syncthreads();
        (void)xcd_barrier_post((unsigned*)(args.P.ws + WS_CTL) + CW_BAR, st, wv__);
        grid.sync();
    }
#ifdef DUP_SYNC
    for (int i = 0; i < DUP_SYNC; ++i) { XcdBarrier xb; xb.bar = (unsigned*)(args.P.ws + WS_CTL) + CW_BAR; xb.x = xb_xcc_id(); xb.st = (volatile LAS unsigned*)(lds + LDS_ALL - 128); xcd_barrier(xb, wv__); }
#endif
    run_phases<0, N_PHASES>(lds, lds_raw, grid, G, bid, wv__);
}

extern "C" void kernel_launch(void* const* d_in, const int* in_sizes, int n_in, void* d_out, int out_size, void* d_ws, size_t ws_size, hipStream_t stream) {
    static int grid = 0;
    if (grid == 0) {
        int dev = 0, cus = 0, per_cu = 0;
        hipGetDevice(&dev);
        hipDeviceGetAttribute(&cus, hipDeviceAttributeMultiprocessorCount, dev);
        hipFuncSetAttribute((const void*)mega, hipFuncAttributeMaxDynamicSharedMemorySize, LDS_ALL);
        hipOccupancyMaxActiveBlocksPerMultiprocessor(&per_cu, (const void*)mega, NTHREADS, LDS_ALL);
        if (per_cu < 1) { fprintf(stderr, "kernel_launch: occupancy query says %d blocks/CU\n", per_cu); per_cu = 1; }
        grid = cus * 1;
        if (ws_size < WS_END) fprintf(stderr, "kernel_launch: workspace too small: %zu < %zu\n", ws_size, (size_t)WS_END);
        (void)hipGetLastError();
    }
    hipMemsetAsync((char*)d_ws + WS_CTL, 0, CTL_BYTES, stream);
    KArgs a{};
    for (int i = 0; i < 30; ++i) a.P.in[i] = (const float*)d_in[i];
    a.P.out = (float*)d_out; a.P.ws = (unsigned char*)d_ws;
#if MK_COOP
    a.ph_lo = 0; a.ph_hi = N_PHASES; a.coop = 1;
    void* kargs[] = {&a};
    hipError_t e = hipLaunchCooperativeKernel((const void*)mega, dim3(grid), dim3(NTHREADS), kargs, LDS_ALL, stream);
    if (e != hipSuccess) fprintf(stderr, "cooperative launch failed: %s (grid %d)\n", hipGetErrorString(e), grid);
#else
    for (int ph = 0; ph < N_PHASES; ++ph) {
        a.ph_lo = ph; a.ph_hi = ph + 1; a.coop = 0;
        hipLaunchKernelGGL(mega, dim3(grid), dim3(NTHREADS), LDS_ALL, stream, a);
    }
#endif
}
```

```cpp
#include <hip/hip_runtime.h>
#include <hip/hip_bf16.h>
#include <hip/hip_cooperative_groups.h>
#include <cstdio>
#include <cstdint>
namespace cg = cooperative_groups;

constexpr int BATCH = 8, SEQ = 4096, DM = 2048, DEPTH = 4;
constexpr int T = BATCH * SEQ;
constexpr int NP = 4864;
constexpr int INW = 4672;
constexpr int FF = 5632;
constexpr int C_HQ = 0, C_HF = 512, C_HI = 1024, C_HG = 1536, C_MQ = 2048, C_MKV = 2560, C_MKR = 2816, C_RW = 2880;
constexpr int C_RR = C_RW, C_RK = C_RW + 512, C_RV = C_RW + 1024, C_RWD = C_RW + 1536, C_RAD = C_RW + 1600, C_RGD = C_RW + 1664;
constexpr int QW = 1536, KVW = 2048;
constexpr float RMS_EPS = 1e-6f;

typedef unsigned short bf16_t;
typedef short bf16x8 __attribute__((ext_vector_type(8)));
typedef short s16x4 __attribute__((ext_vector_type(4)));
typedef float f32x2 __attribute__((ext_vector_type(2)));
typedef float f32x4 __attribute__((ext_vector_type(4)));
typedef float f32x16 __attribute__((ext_vector_type(16)));
typedef unsigned u32x2 __attribute__((ext_vector_type(2)));
typedef unsigned u32x4 __attribute__((ext_vector_type(4)));
#define LAS __attribute__((address_space(3)))

constexpr size_t MiB = 1u << 20;
constexpr size_t WS_CTL = 0;
constexpr size_t CTL_BYTES = 65536;
constexpr size_t WS_RS = 1 * MiB;
constexpr size_t WS_SSB = WS_RS + 128 * 1024;
constexpr size_t WS_RSQ = WS_SSB;
constexpr size_t WS_RSKV = WS_RSQ + 128 * 1024;
constexpr size_t WS_LB = WS_RSKV + 128 * 1024;
constexpr size_t WS_RIN = 2 * MiB;
constexpr size_t WS_BS = 3 * MiB;
constexpr size_t WS_W = 4 * MiB;
constexpr size_t W_LAYER = 96 * MiB;
constexpr size_t WO_IN = 0;
constexpr size_t WO_QB = WO_IN + (size_t)NP * DM * 2;
constexpr size_t WO_KVB = WO_QB + (size_t)QW * 512 * 2;
constexpr size_t WO_O = WO_KVB + (size_t)KVW * 256 * 2;
constexpr size_t WO_GU = WO_O + (size_t)DM * DM * 2;
constexpr size_t WO_DN = WO_GU + (size_t)2 * FF * DM * 2;
constexpr size_t WO_LORA = WO_DN + (size_t)DM * FF * 2;
static_assert(WO_LORA + 163840 * 2 <= W_LAYER, "weight layer stride");
constexpr size_t WS_XB = WS_W + DEPTH * W_LAYER;
constexpr size_t WS_P = WS_XB + 128 * MiB;
constexpr size_t WS_MIX = WS_P + 304 * MiB;
constexpr size_t WS_D = WS_MIX + 128 * MiB;
constexpr size_t WS_Q = WS_D;
constexpr size_t WS_KV = WS_Q + 96 * MiB;
constexpr size_t WS_KR = WS_KV + 128 * MiB;
constexpr size_t WS_RWR = WS_KR + 4 * MiB;
constexpr size_t WS_RWK = WS_RWR + 32 * MiB;
constexpr size_t WS_RWV = WS_RWK + 32 * MiB;
constexpr size_t WS_RWKK = WS_RWV + 32 * MiB;
constexpr size_t WS_RWB = WS_RWKK + 32 * MiB;
constexpr size_t WS_VFIRST = WS_RWB + 32 * MiB;
constexpr size_t WS_SSA = WS_VFIRST + 32 * MiB;
constexpr size_t WS_SSBP = WS_SSA + 4 * MiB;
constexpr size_t WS_END = WS_SSBP + 4 * MiB;
constexpr size_t WS_ACT = WS_D;
static_assert(WS_ACT + (size_t)T * FF * 2 <= WS_VFIRST, "act overlay must not reach v_first");
constexpr size_t WS_RWW = WS_XB;
constexpr size_t WS_RWG = WS_XB + 64 * MiB;
constexpr size_t WS_RWBON = WS_XB + 96 * MiB;

__device__ __forceinline__ int tid_from(int wv) { unsigned z = 0u; asm volatile("" : "+v"(z)); return (wv << 6) | (int)__builtin_amdgcn_mbcnt_hi(~0u, __builtin_amdgcn_mbcnt_lo(~0u, z)); }
#define TID() tid_from(wv__)
__device__ __forceinline__ float bf2f(bf16_t v) { return __uint_as_float(((unsigned)v) << 16); }
typedef __bf16 bf16x2_t __attribute__((ext_vector_type(2)));
__device__ __forceinline__ unsigned cvt_pk_bf16(float lo, float hi) { f32x2 v = {lo, hi}; bf16x2_t b = __builtin_convertvector(v, bf16x2_t); return __builtin_bit_cast(unsigned, b); }
__device__ __forceinline__ bf16_t f2bf(float f) { return (bf16_t)(cvt_pk_bf16(f, 0.f) & 0xffffu); }
__device__ __forceinline__ float lo_bf(unsigned w) { return __uint_as_float(w << 16); }
__device__ __forceinline__ float hi_bf(unsigned w) { return __uint_as_float(w & 0xffff0000u); }
__device__ __forceinline__ float fast_exp(float x) { return __builtin_amdgcn_exp2f(x * 1.4426950408889634f); }
__device__ __forceinline__ float fast_rcp(float x) { return __builtin_amdgcn_rcpf(x); }
__device__ __forceinline__ float sigmoidf_(float x) { return fast_rcp(1.f + fast_exp(-x)); }
__device__ __forceinline__ float siluf_(float x) { return x * sigmoidf_(x); }
#define DPPF(x, CTRL) __int_as_float(__builtin_amdgcn_update_dpp(0, __float_as_int(x), CTRL, 0xf, 0xf, true))
__device__ __forceinline__ float wave_sum(float v) {
    v += DPPF(v, 0xB1);
    v += DPPF(v, 0x4E);
    v += DPPF(v, 0x141);
    v += DPPF(v, 0x140);
    const float r0 = __int_as_float(__builtin_amdgcn_readlane(__float_as_int(v), 0)), r1 = __int_as_float(__builtin_amdgcn_readlane(__float_as_int(v), 16));
    const float r2 = __int_as_float(__builtin_amdgcn_readlane(__float_as_int(v), 32)), r3 = __int_as_float(__builtin_amdgcn_readlane(__float_as_int(v), 48));
    return (r0 + r1) + (r2 + r3);
}
__device__ __forceinline__ float xor32f(float x, int lane) { auto rr = __builtin_amdgcn_permlane32_swap(__float_as_uint(x), __float_as_uint(x), false, false); return __uint_as_float(lane < 32 ? rr[1] : rr[0]); }
__device__ __forceinline__ float sum8f(float x) { x += DPPF(x, 0xB1); x += DPPF(x, 0x4E); x += DPPF(x, 0x141); return x; }
#define MK_COOP 1
#define CONV_IN_MIXERS 1
#define CONV_EVERY 5
namespace pg8 {
#define PG8_LAS __attribute__((address_space(3)))
typedef unsigned short bf16_t;
typedef short bf16x8 __attribute__((ext_vector_type(8)));
typedef float f32x4 __attribute__((ext_vector_type(4)));
typedef unsigned u32x4 __attribute__((ext_vector_type(4)));
constexpr int BM = 256, BK = 64, HALF = 128, HTB = HALF * BK * 2  , STAGE_BYTES = 8 * HTB, NXCD = 8, WGM = 8;

__host__ __device__ __forceinline__ int lds_byte(int r, int c) { const int st = (r >> 4) * 2 + (c >> 5), rr = r & 15, cc = c & 31, ob = rr * 64 + cc * 2; return st * 1024 + (ob ^ (((ob >> 9) & 1) << 5)); }
__host__ __device__ __forceinline__ void stage_rc(int b, int& R, int& C) { const int st = b / 1024, sb = b % 1024, swz = sb ^ (((sb >> 9) & 1) << 5); R = (st >> 1) * 16 + swz / 64; C = (st & 1) * 32 + (swz % 64) / 2; }
__host__ __device__ __forceinline__ int perm32(int rho) { const int n = rho >> 4, i = rho & 15; return 8 * (i >> 2) + 4 * n + (i & 3); }

struct Unit { int pm, pn; };
struct Gemm { const bf16_t* A; const bf16_t* Bt; int M, N, K, lda; };

struct StaticOrder {
    int nM, nN, nwg, G, c;
    __host__ __device__ void init(int M, int N, int G_, int c_) { nM = M / BM; nN = N / BM; nwg = nM * nN; G = G_; c = c_; }
    __host__ __device__ bool next(int i, Unit& u) const {
        const long L = (long)i * G + c; if (L >= nwg) return false;
        int wgid = (int)L; { const int q = nwg / NXCD, r = nwg % NXCD, xcd = wgid % NXCD, off = wgid / NXCD; wgid = (xcd < r ? xcd * (q + 1) : r * (q + 1) + (xcd - r) * q) + off; }
        const int nig = WGM * nN, gid = wgid / nig, fm = gid * WGM, gsz = (nM - fm) < WGM ? (nM - fm) : WGM;
        u.pm = fm + ((wgid % nig) % gsz); u.pn = (wgid % nig) / gsz; return true;
    }
    __device__ __forceinline__ void a_ready(const Unit&) const {}
    __device__ __forceinline__ void done(const Unit&) const {}
};

using ::cvt_pk_bf16;
typedef float f32x2 __attribute__((ext_vector_type(2)));

__device__ __forceinline__ float row_scale32(const float* part, int row) {
    const f32x4* p = (const f32x4*)(part + (size_t)row * 32);
    f32x4 a = p[0] + p[1], b = p[2] + p[3], c = p[4] + p[5], d = p[6] + p[7];
    a = (a + b) + (c + d);
    return 1.f / sqrtf(((a[0] + a[1]) + (a[2] + a[3])) * (1.f / 2048.f) + 1e-6f);
}
struct EpiScaleBf16 {
    static constexpr bool PERM = true, AFTER_DRAIN = false;
    bf16_t* O; const float* rs; int ldc; int ssq;
    __device__ __forceinline__ void operator()(const f32x4 (&acc)[2][2][4][2], const Unit& u, int wr, int wc, int fr_, int fq_) const {
        unsigned z_ = 0u; asm volatile("" : "+v"(z_)); const int ln_ = (int)__builtin_amdgcn_mbcnt_hi(~0u, __builtin_amdgcn_mbcnt_lo(~0u, z_)); const int fr = ln_ & 15, fq = ln_ >> 4; (void)fr_; (void)fq_;
        const int row0 = u.pm * BM + wr * 64 + fr, col0 = u.pn * BM + wc * 32 + 8 * fq;
        float scv[2][4];
#pragma unroll
        for (int ai = 0; ai < 2; ++ai)
#pragma unroll
            for (int m = 0; m < 4; ++m) scv[ai][m] = rs ? rs[row0 + ai * HALF + m * 16] : 1.f;
#pragma unroll
        for (int ai = 0; ai < 2; ++ai)
#pragma unroll
            for (int m = 0; m < 4; ++m) { const int row = row0 + ai * HALF + m * 16; const float sc = scv[ai][m]; bf16_t* rowp = O + (size_t)row * ldc + col0;
#pragma unroll
                for (int bj = 0; bj < 2; ++bj) { const f32x4 v0 = acc[ai][bj][m][0] * sc, v1 = acc[ai][bj][m][1] * sc;
                    u32x4 w; w.x = cvt_pk_bf16(v0[0], v0[1]); w.y = cvt_pk_bf16(v0[2], v0[3]); w.z = cvt_pk_bf16(v1[0], v1[1]); w.w = cvt_pk_bf16(v1[2], v1[3]);
                    *(u32x4*)(rowp + bj * HALF) = w; } }
    }
};
struct EpiPlainBf16 {
    static constexpr bool PERM = true, AFTER_DRAIN = false;
    bf16_t* O; int ldc; int pad_;
    __device__ __forceinline__ void operator()(const f32x4 (&acc)[2][2][4][2], const Unit& u, int wr, int wc, int fr, int fq) const {
        const int row0 = u.pm * BM + wr * 64 + fr, col0 = u.pn * BM + wc * 32 + 8 * fq;
#pragma unroll
        for (int ai = 0; ai < 2; ++ai)
#pragma unroll
            for (int m = 0; m < 4; ++m) { bf16_t* rowp = O + (size_t)(row0 + ai * HALF + m * 16) * ldc + col0;
#pragma unroll
                for (int bj = 0; bj < 2; ++bj) { const f32x4 v0 = acc[ai][bj][m][0], v1 = acc[ai][bj][m][1];
                    u32x4 w; w.x = cvt_pk_bf16(v0[0], v0[1]); w.y = cvt_pk_bf16(v0[2], v0[3]); w.z = cvt_pk_bf16(v1[0], v1[1]); w.w = cvt_pk_bf16(v1[2], v1[3]);
                    *(u32x4*)(rowp + bj * HALF) = w; } }
    }
};
struct EpiResid {
    static constexpr bool PERM = false, AFTER_DRAIN = false;
    float* X; int ldc; int pad_;
    __device__ __forceinline__ void operator()(const f32x4 (&acc)[2][2][4][2], const Unit& u, int wr, int wc, int fr_, int fq_) const {
        unsigned z_ = 0u; asm volatile("" : "+v"(z_)); const int ln_ = (int)__builtin_amdgcn_mbcnt_hi(~0u, __builtin_amdgcn_mbcnt_lo(~0u, z_)); const int fr = ln_ & 15, fq = ln_ >> 4; (void)fr_; (void)fq_;
        const int row0 = u.pm * BM + wr * 64 + fr, col0 = u.pn * BM + wc * 32 + 4 * fq;
#pragma unroll
        for (int ai = 0; ai < 2; ++ai)
#pragma unroll
            for (int m = 0; m < 4; ++m) { float* rowp = X + (size_t)(row0 + ai * HALF + m * 16) * ldc + col0;
                f32x4 xv[2][2];
#pragma unroll
                for (int bj = 0; bj < 2; ++bj)
#pragma unroll
                    for (int n = 0; n < 2; ++n) xv[bj][n] = *(const f32x4*)(rowp + bj * HALF + n * 16);
#pragma unroll
                for (int bj = 0; bj < 2; ++bj)
#pragma unroll
                    for (int n = 0; n < 2; ++n) *(f32x4*)(rowp + bj * HALF + n * 16) = xv[bj][n] + acc[ai][bj][m][n]; }
    }
};
struct EpiKV {
    static constexpr bool PERM = true, AFTER_DRAIN = false;
    bf16_t* O; const float* rs; const float* kg; PG8_LAS float* red; int ldc; int pad_;
    __device__ __forceinline__ void operator()(const f32x4 (&acc)[2][2][4][2], const Unit& u, int wr, int wc, int fr_, int fq_) const {
        unsigned z_ = 0u; asm volatile("" : "+v"(z_)); const int ln_ = (int)__builtin_amdgcn_mbcnt_hi(~0u, __builtin_amdgcn_mbcnt_lo(~0u, z_)); const int fr = ln_ & 15, fq = ln_ >> 4; (void)fr_; (void)fq_;
        const int rl0 = wr * 64 + fr;
        const int col0 = u.pn * BM + wc * 32 + 8 * fq;
#pragma unroll
        for (int ai = 0; ai < 2; ++ai)
#pragma unroll
            for (int m = 0; m < 4; ++m) { const f32x4 a = acc[ai][0][m][0], b = acc[ai][0][m][1];
                float s = ((a[0] * a[0] + a[1] * a[1]) + (a[2] * a[2] + a[3] * a[3])) + ((b[0] * b[0] + b[1] * b[1]) + (b[2] * b[2] + b[3] * b[3]));
                { auto r16 = __builtin_amdgcn_permlane16_swap(__float_as_uint(s), __float_as_uint(s), false, false); s = __uint_as_float(r16[0]) + __uint_as_float(r16[1]);
                  auto r32 = __builtin_amdgcn_permlane32_swap(__float_as_uint(s), __float_as_uint(s), false, false); s = __uint_as_float(r32[0]) + __uint_as_float(r32[1]); }
                if (fq == 0) red[(rl0 + ai * HALF + m * 16) * 4 + wc] = s;
                asm volatile("" ::: "memory"); }
        asm volatile("s_waitcnt lgkmcnt(0)" ::: "memory"); __builtin_amdgcn_s_barrier(); asm volatile("" ::: "memory");
        const unsigned go = (unsigned)(wc * 32 + 8 * fq) * 4u;
        const f32x4 g0 = *(const f32x4*)((const char*)kg + go), g1 = *(const f32x4*)((const char*)kg + go + 16);
#pragma unroll
        for (int ai = 0; ai < 2; ++ai) {
            float scv[4];
#pragma unroll
            for (int m = 0; m < 4; ++m) scv[m] = rs[u.pm * BM + rl0 + ai * HALF + m * 16];
#pragma unroll
            for (int m = 0; m < 4; ++m) { const int rl = rl0 + ai * HALF + m * 16, row = u.pm * BM + rl;
                const f32x4 r4 = *(const PG8_LAS f32x4*)(red + rl * 4);
                const float rk = 1.f / sqrtf(((r4[0] + r4[1]) + (r4[2] + r4[3])) * (1.f / 128.f) + 1e-6f), sc = scv[m];
                bf16_t* rowp = O + (size_t)row * ldc + col0;
                { const f32x4 v0 = acc[ai][0][m][0] * rk * g0, v1 = acc[ai][0][m][1] * rk * g1;
                  u32x4 w; w.x = cvt_pk_bf16(v0[0], v0[1]); w.y = cvt_pk_bf16(v0[2], v0[3]); w.z = cvt_pk_bf16(v1[0], v1[1]); w.w = cvt_pk_bf16(v1[2], v1[3]);
                  *(u32x4*)rowp = w; }
                { const f32x4 v0 = acc[ai][1][m][0] * sc, v1 = acc[ai][1][m][1] * sc;
                  u32x4 w; w.x = cvt_pk_bf16(v0[0], v0[1]); w.y = cvt_pk_bf16(v0[2], v0[3]); w.z = cvt_pk_bf16(v1[0], v1[1]); w.w = cvt_pk_bf16(v1[2], v1[3]);
                  *(u32x4*)(rowp + HALF) = w; }
                asm volatile("" ::: "memory"); } }
        asm volatile("s_waitcnt lgkmcnt(0)" ::: "memory"); __builtin_amdgcn_s_barrier(); asm volatile("" ::: "memory");
    }
};
struct EpiResidN {
    static constexpr bool PERM = false, AFTER_DRAIN = false;
    const float* Xin; float* Xout; bf16_t* xb; float* ssq; int ldc; int pad_;
    __device__ __forceinline__ void operator()(const f32x4 (&acc)[2][2][4][2], const Unit& u, int wr, int wc, int fr_, int fq_) const {
        unsigned z_ = 0u; asm volatile("" : "+v"(z_)); const int ln_ = (int)__builtin_amdgcn_mbcnt_hi(~0u, __builtin_amdgcn_mbcnt_lo(~0u, z_)); const int fr = ln_ & 15, fq = ln_ >> 4; (void)fr_; (void)fq_;
        const int row0 = u.pm * BM + wr * 64 + fr, col0 = u.pn * BM + wc * 32 + 4 * fq;
#pragma unroll
        for (int ai = 0; ai < 2; ++ai)
        {   f32x4 xv[4][2][2];
#pragma unroll
            for (int m = 0; m < 4; ++m)
#pragma unroll
                for (int bj = 0; bj < 2; ++bj)
#pragma unroll
                    for (int n = 0; n < 2; ++n) xv[m][bj][n] = *(const f32x4*)(Xin + (size_t)(row0 + ai * HALF + m * 16) * ldc + col0 + bj * HALF + n * 16);
#pragma unroll
            for (int m = 0; m < 4; ++m) { const int row = row0 + ai * HALF + m * 16; const size_t off = (size_t)row * ldc + col0;
                float s = 0.f;
#pragma unroll
                for (int bj = 0; bj < 2; ++bj)
#pragma unroll
                    for (int n = 0; n < 2; ++n) { const f32x4 v = xv[m][bj][n] + acc[ai][bj][m][n]; *(f32x4*)(Xout + off + bj * HALF + n * 16) = v;
                        u32x2 w; w.x = cvt_pk_bf16(v[0], v[1]); w.y = cvt_pk_bf16(v[2], v[3]); *(u32x2*)(xb + off + bj * HALF + n * 16) = w;
                        s += (v[0] * v[0] + v[1] * v[1]) + (v[2] * v[2] + v[3] * v[3]); }
                { auto r16 = __builtin_amdgcn_permlane16_swap(__float_as_uint(s), __float_as_uint(s), false, false); s = __uint_as_float(r16[0]) + __uint_as_float(r16[1]);
                  auto r32 = __builtin_amdgcn_permlane32_swap(__float_as_uint(s), __float_as_uint(s), false, false); s = __uint_as_float(r32[0]) + __uint_as_float(r32[1]); }
                if (fq == 0) ssq[(size_t)row * 32 + u.pn * 4 + wc] = s; }
        }
    }
};
struct EpiResidB {
    static constexpr bool PERM = true, AFTER_DRAIN = false;
    const float* XinF; float* OutF; bf16_t* xb; float* ssq; int ldc; int pad_;
    __device__ __forceinline__ void operator()(const f32x4 (&acc)[2][2][4][2], const Unit& u, int wr, int wc, int fr_, int fq_) const {
        unsigned z_ = 0u; asm volatile("" : "+v"(z_)); const int ln_ = (int)__builtin_amdgcn_mbcnt_hi(~0u, __builtin_amdgcn_mbcnt_lo(~0u, z_)); const int fr = ln_ & 15, fq = ln_ >> 4; (void)fr_; (void)fq_;
        const int row0 = u.pm * BM + wr * 64 + fr, col0 = u.pn * BM + wc * 32 + 8 * fq;
#pragma unroll
        for (int ai = 0; ai < 2; ++ai) {
            f32x4 r0[4][2], r1[4][2];
#pragma unroll
            for (int m = 0; m < 4; ++m)
#pragma unroll
                for (int bj = 0; bj < 2; ++bj) { const size_t off = (size_t)(row0 + ai * HALF + m * 16) * ldc + col0 + bj * HALF;
                    if (XinF) { r0[m][bj] = *(const f32x4*)(XinF + off); r1[m][bj] = *(const f32x4*)(XinF + off + 4); }
                    else { const u32x4 w = *(const u32x4*)(xb + off); r0[m][bj] = (f32x4){lo_bf(w.x), hi_bf(w.x), lo_bf(w.y), hi_bf(w.y)}; r1[m][bj] = (f32x4){lo_bf(w.z), hi_bf(w.z), lo_bf(w.w), hi_bf(w.w)}; } }
#pragma unroll
            for (int m = 0; m < 4; ++m) { const int row = row0 + ai * HALF + m * 16; float s = 0.f;
#pragma unroll
                for (int bj = 0; bj < 2; ++bj) { const size_t off = (size_t)row * ldc + col0 + bj * HALF;
                    const f32x4 v0 = r0[m][bj] + acc[ai][bj][m][0], v1 = r1[m][bj] + acc[ai][bj][m][1];
                    u32x4 w; w.x = cvt_pk_bf16(v0[0], v0[1]); w.y = cvt_pk_bf16(v0[2], v0[3]); w.z = cvt_pk_bf16(v1[0], v1[1]); w.w = cvt_pk_bf16(v1[2], v1[3]);
                    *(u32x4*)(xb + off) = w;
                    if (OutF) { *(f32x4*)(OutF + off) = v0; *(f32x4*)(OutF + off + 4) = v1; }
                    s += ((v0[0] * v0[0] + v0[1] * v0[1]) + (v0[2] * v0[2] + v0[3] * v0[3])) + ((v1[0] * v1[0] + v1[1] * v1[1]) + (v1[2] * v1[2] + v1[3] * v1[3])); }
                { auto r16 = __builtin_amdgcn_permlane16_swap(__float_as_uint(s), __float_as_uint(s), false, false); s = __uint_as_float(r16[0]) + __uint_as_float(r16[1]);
                  auto r32 = __builtin_amdgcn_permlane32_swap(__float_as_uint(s), __float_as_uint(s), false, false); s = __uint_as_float(r32[0]) + __uint_as_float(r32[1]); }
                if (fq == 0) ssq[(size_t)row * 32 + u.pn * 4 + wc] = s; }
        }
    }
};
struct EpiSwiGLU {
    static constexpr bool PERM = true, AFTER_DRAIN = false;
    bf16_t* O; const float* rs; int ldc; int pad_;
    __device__ __forceinline__ void operator()(const f32x4 (&acc)[2][2][4][2], const Unit& u, int wr, int wc, int fr_, int fq_) const {
        unsigned z_ = 0u; asm volatile("" : "+v"(z_)); const int ln_ = (int)__builtin_amdgcn_mbcnt_hi(~0u, __builtin_amdgcn_mbcnt_lo(~0u, z_)); const int fr = ln_ & 15, fq = ln_ >> 4; (void)fr_; (void)fq_;
        const int row0 = u.pm * BM + wr * 64 + fr, col0 = u.pn * HALF + wc * 32 + 8 * fq;
        float scv[2][4];
#pragma unroll
        for (int ai = 0; ai < 2; ++ai)
#pragma unroll
            for (int m = 0; m < 4; ++m) scv[ai][m] = rs[row0 + ai * HALF + m * 16];
#pragma unroll
        for (int ai = 0; ai < 2; ++ai)
#pragma unroll
            for (int m = 0; m < 4; ++m) { const int row = row0 + ai * HALF + m * 16; const float sc = scv[ai][m]; bf16_t* rowp = O + (size_t)row * ldc + col0;
                float o[8];
#pragma unroll
                for (int n = 0; n < 2; ++n)
#pragma unroll
                    for (int i = 0; i < 4; ++i) { const float g = acc[ai][0][m][n][i] * sc, up = acc[ai][1][m][n][i] * sc;
                        o[n * 4 + i] = g * __builtin_amdgcn_rcpf(1.f + __builtin_amdgcn_exp2f(g * -1.4426950408889634f)) * up; }
                u32x4 w; w.x = cvt_pk_bf16(o[0], o[1]); w.y = cvt_pk_bf16(o[2], o[3]); w.z = cvt_pk_bf16(o[4], o[5]); w.w = cvt_pk_bf16(o[6], o[7]);
                *(u32x4*)rowp = w; }
    }
};

template <class Sched>
__device__ __forceinline__ void prep_row_scales(const float* part, float* rs, const Sched& S, int tid) {
    Unit u; int last = -1;
    for (int i = 0; S.next(i, u); ++i) {
        if (u.pm == last) continue;
        last = u.pm;
        const int row = u.pm * BM + (tid >> 1);
        const f32x4* p = (const f32x4*)(part + (size_t)row * 32 + (tid & 1) * 16);
        f32x4 a = (p[0] + p[1]) + (p[2] + p[3]);
        float s = (a[0] + a[1]) + (a[2] + a[3]);
        s += DPPF(s, 0xB1);
        if ((tid & 1) == 0) rs[row] = 1.f / sqrtf(s * (1.f / 2048.f) + 1e-6f);
    }
    asm volatile("s_waitcnt vmcnt(0)" ::: "memory");
    __syncthreads();
}
template <class Epi, class Sched, bool ALIGN_EPI = false, bool SP2 = false>
__device__ __forceinline__ void gemm_phase(PG8_LAS unsigned char* lds, const Gemm g, const Sched& S, const Epi& E, const int wv__) {
    const int tid = TID(), wid = __builtin_amdgcn_readfirstlane(tid >> 6), lane = tid & 63, wr = wid >> 2, wc = wid & 3, fr = lane & 15, fq = lane >> 4;
    const int K = g.K, nt = K / BK;
    unsigned voffA[2], voffB[2];
#pragma unroll
    for (int i = 0; i < 2; ++i) { int R, C; stage_rc(tid * 16 + i * 8192, R, C); const int Rb = Epi::PERM ? ((R & ~31) + perm32(R & 31)) : R;
        voffA[i] = (unsigned)(R * g.lda + C) * 2u; voffB[i] = (unsigned)(Rb * K + C) * 2u; }
    const size_t kstep = (size_t)(BK * 2);
    const size_t hstepA = (size_t)HALF * g.lda * 2, hstepB = (size_t)HALF * K * 2;
    const size_t tstepA = 2 * hstepA, tstepB = 2 * hstepB;
    const unsigned ldsw = (unsigned)wid * 1024u;
    const int aoff = lds_byte(wr * 64 + fr, fq * 8), boff = lds_byte(wc * 32 + fr, fq * 8);
#define PG8_SA(b, h) (((b) * 2 + (h)) * HTB)
#define PG8_SB(b, h) ((4 + (b) * 2 + (h)) * HTB)
#define PG8_STAGE(bufoff, gbase, voff) do { _Pragma("unroll") for (int _i = 0; _i < 2; ++_i) \
        __builtin_amdgcn_global_load_lds((const unsigned*)((const char*)(gbase) + (voff)[_i]), (PG8_LAS unsigned*)(lds + (bufoff) + ldsw + _i * 8192), 16, 0, 0); } while (0)
#define PG8_LDA(dst, b, h) do { _Pragma("unroll") for (int m = 0; m < 4; ++m) _Pragma("unroll") for (int k = 0; k < 2; ++k) dst[m][k] = *(const PG8_LAS bf16x8*)(lds + PG8_SA(b, h) + aoff + m * 2048 + k * 1024); } while (0)
#define PG8_LDB(dst, b, h) do { _Pragma("unroll") for (int n = 0; n < 2; ++n) _Pragma("unroll") for (int k = 0; k < 2; ++k) dst[n][k] = *(const PG8_LAS bf16x8*)(lds + PG8_SB(b, h) + boff + n * 2048 + k * 1024); } while (0)
#define PG8_MMA(ai, bj, At, Bt) do { __builtin_amdgcn_s_setprio(1); _Pragma("unroll") for (int m = 0; m < 4; ++m) _Pragma("unroll") for (int n = 0; n < 2; ++n) _Pragma("unroll") for (int k = 0; k < 2; ++k) \
        acc[ai][bj][m][n] = __builtin_amdgcn_mfma_f32_16x16x32_bf16(Bt[n][k], At[m][k], acc[ai][bj][m][n], 0, 0, 0); __builtin_amdgcn_s_setprio(0); } while (0)
#define PG8_WAIT_V(n) asm volatile("s_waitcnt vmcnt(" #n ")" ::: "memory")
#define PG8_WAIT_L(n) asm volatile("s_waitcnt lgkmcnt(" #n ")" ::: "memory")
#define PG8_BAR __builtin_amdgcn_s_barrier()
#define PG8_SCHED __builtin_amdgcn_sched_barrier(0)
    Unit cur, nxt; int ui = 0;
    if (!S.next(0, cur)) return;
    f32x4 acc[2][2][4][2];
#pragma unroll
    for (int a = 0; a < 2; ++a)
#pragma unroll
        for (int b = 0; b < 2; ++b)
#pragma unroll
            for (int m = 0; m < 4; ++m)
#pragma unroll
                for (int n = 0; n < 2; ++n) acc[a][b][m][n] = (f32x4){0.f, 0.f, 0.f, 0.f};
    bf16x8 At[4][2], B0[2][2], B1[2][2];
    const char* cA = (const char*)g.A + (size_t)cur.pm * tstepA; const char* cB = (const char*)g.Bt + (size_t)cur.pn * tstepB;
    S.a_ready(cur);
    if constexpr (SP2) {
        PG8_STAGE(PG8_SB(0, 0), cB, voffB); PG8_STAGE(PG8_SB(0, 1), cB + hstepB, voffB); PG8_STAGE(PG8_SA(0, 0), cA, voffA); PG8_STAGE(PG8_SA(0, 1), cA + hstepA, voffA);
        if (wr == 1) PG8_BAR;
        PG8_WAIT_V(2); PG8_BAR;
        PG8_STAGE(PG8_SB(1, 0), cB + kstep, voffB); PG8_STAGE(PG8_SA(1, 0), cA + kstep, voffA); PG8_STAGE(PG8_SB(1, 1), cB + hstepB + kstep, voffB);
        PG8_WAIT_V(6); PG8_BAR;
    } else {
        PG8_STAGE(PG8_SB(0, 0), cB, voffB); PG8_STAGE(PG8_SA(0, 0), cA, voffA); PG8_STAGE(PG8_SB(0, 1), cB + hstepB, voffB); PG8_STAGE(PG8_SA(0, 1), cA + hstepA, voffA);
        if (wr == 1) PG8_BAR;
        PG8_WAIT_V(4); PG8_BAR;
        PG8_STAGE(PG8_SB(1, 0), cB + kstep, voffB); PG8_STAGE(PG8_SA(1, 0), cA + kstep, voffA); PG8_STAGE(PG8_SB(1, 1), cB + hstepB + kstep, voffB);
        PG8_WAIT_V(6); PG8_BAR;
    }
    for (;;) {
        const bool has_next = S.next(ui + 1, nxt);
        const char* nA = has_next ? (const char*)g.A + (size_t)nxt.pm * tstepA : cA; const char* nB = has_next ? (const char*)g.Bt + (size_t)nxt.pn * tstepB : cB;
        for (int t = 0; t < nt; t += 2) {
            const bool last = (t == nt - 2);
            const char* a1 = cA + (size_t)(t + 1) * kstep;
            const char* a2 = last ? nA : cA + (size_t)(t + 2) * kstep; const char* b2 = last ? nB : cB + (size_t)(t + 2) * kstep;
            const char* a3 = a2 + kstep; const char* b3 = b2 + kstep;
            if (last && has_next) S.a_ready(nxt);
            if constexpr (SP2) {
            PG8_LDB(B0, 0, 0); PG8_LDB(B1, 0, 1); PG8_SCHED; PG8_LDA(At, 0, 0); PG8_STAGE(PG8_SA(1, 1), a1 + hstepA, voffA);
            PG8_WAIT_V(8); PG8_WAIT_L(0); PG8_BAR; PG8_MMA(0, 0, At, B0); PG8_MMA(0, 1, At, B1); PG8_BAR; PG8_SCHED;
            PG8_LDA(At, 0, 1); PG8_STAGE(PG8_SB(0, 0), b2, voffB); PG8_STAGE(PG8_SB(0, 1), b2 + hstepB, voffB); PG8_STAGE(PG8_SA(0, 0), a2, voffA);
            PG8_WAIT_V(8); PG8_WAIT_L(0); PG8_BAR; PG8_MMA(1, 0, At, B0); PG8_MMA(1, 1, At, B1); PG8_BAR; PG8_SCHED;
            PG8_LDB(B0, 1, 0); PG8_LDB(B1, 1, 1); PG8_SCHED; PG8_LDA(At, 1, 0); PG8_STAGE(PG8_SA(0, 1), a2 + hstepA, voffA);
            PG8_WAIT_V(8); PG8_WAIT_L(0); PG8_BAR; PG8_MMA(0, 0, At, B0); PG8_MMA(0, 1, At, B1); PG8_BAR; PG8_SCHED;
            PG8_LDA(At, 1, 1); PG8_STAGE(PG8_SB(1, 0), b3, voffB); PG8_STAGE(PG8_SB(1, 1), b3 + hstepB, voffB); PG8_STAGE(PG8_SA(1, 0), a3, voffA);
            PG8_WAIT_V(8); PG8_WAIT_L(0); PG8_BAR; PG8_MMA(1, 0, At, B0); PG8_MMA(1, 1, At, B1); PG8_BAR; PG8_SCHED;
            } else {
            PG8_LDB(B0, 0, 0); PG8_SCHED; PG8_LDA(At, 0, 0); PG8_STAGE(PG8_SA(1, 1), a1 + hstepA, voffA);
            PG8_WAIT_L(8); PG8_BAR; PG8_WAIT_L(0); PG8_MMA(0, 0, At, B0); PG8_BAR; PG8_SCHED;
            PG8_LDB(B1, 0, 1); PG8_STAGE(PG8_SB(0, 0), b2, voffB);
            PG8_BAR; PG8_WAIT_L(0); PG8_MMA(0, 1, At, B1); PG8_BAR;
            PG8_LDA(At, 0, 1); PG8_STAGE(PG8_SA(0, 0), a2, voffA);
            PG8_BAR; PG8_WAIT_L(0); PG8_MMA(1, 0, At, B0); PG8_BAR; PG8_SCHED;
            PG8_STAGE(PG8_SB(0, 1), b2 + hstepB, voffB);
            PG8_WAIT_V(6); PG8_BAR; PG8_MMA(1, 1, At, B1); PG8_BAR;
            PG8_LDB(B0, 1, 0); PG8_SCHED; PG8_LDA(At, 1, 0); PG8_STAGE(PG8_SA(0, 1), a2 + hstepA, voffA);
            PG8_WAIT_L(8); PG8_BAR; PG8_WAIT_L(0); PG8_MMA(0, 0, At, B0); PG8_BAR; PG8_SCHED;
            PG8_LDB(B1, 1, 1); PG8_STAGE(PG8_SB(1, 0), b3, voffB);
            PG8_BAR; PG8_WAIT_L(0); PG8_MMA(0, 1, At, B1); PG8_BAR;
            PG8_LDA(At, 1, 1); PG8_STAGE(PG8_SA(1, 0), a3, voffA);
            PG8_BAR; PG8_WAIT_L(0); PG8_MMA(1, 0, At, B0); PG8_BAR; PG8_SCHED;
            PG8_STAGE(PG8_SB(1, 1), b3 + hstepB, voffB);
            PG8_WAIT_V(6); PG8_BAR; PG8_MMA(1, 1, At, B1); PG8_BAR;
            }
        }
        if constexpr (ALIGN_EPI) { if (wr == 0) PG8_BAR; }
        if constexpr (!Epi::AFTER_DRAIN) { E(acc, cur, wr, wc, fr, fq); S.done(cur); }
        if (!has_next) break;
#pragma unroll
        for (int a = 0; a < 2; ++a)
#pragma unroll
            for (int b = 0; b < 2; ++b)
#pragma unroll
                for (int m = 0; m < 4; ++m)
#pragma unroll
                    for (int n = 0; n < 2; ++n) acc[a][b][m][n] = (f32x4){0.f, 0.f, 0.f, 0.f};
        cur = nxt; cA = nA; cB = nB; ++ui;
        if constexpr (ALIGN_EPI) { if (wr == 1) PG8_BAR; }
    }
    PG8_WAIT_V(0);
    if constexpr (!ALIGN_EPI) { if (wr == 0) PG8_BAR; }
    PG8_BAR;
    if constexpr (Epi::AFTER_DRAIN) { E.fused(acc, cur, wr, wc, fr, fq, lds, wid, lane); S.done(cur); }
#undef PG8_SA
#undef PG8_SB
#undef PG8_STAGE
#undef PG8_LDA
#undef PG8_LDB
#undef PG8_MMA
#undef PG8_WAIT_V
#undef PG8_WAIT_L
#undef PG8_BAR
#undef PG8_SCHED
}
}
__device__ __forceinline__ void rope_cs(int pos, int j, float& c, float& s) {
    const float inv_freq = exp2f(-(float)j * (13.287712379549449f / 32.f));
    const float ang = (float)pos * inv_freq;
    float rev = ang * 0.15915494309189535f; rev = rev - floorf(rev);
    c = __builtin_amdgcn_cosf(rev); s = __builtin_amdgcn_sinf(rev);
}
namespace att {
constexpr int NW = 8, QBLK = 32, KVBLK = 64, QB = NW * QBLK;
constexpr int QS = QW, KS = KVW, KRS = 64, OS = DM;
constexpr int SHM_V = KVBLK * 128 * 2, SHM_K = KVBLK * 128 * 2, SHM_KR = KVBLK * 64 * 2;
constexpr int OFF_V = 0, OFF_K = 2 * SHM_V, OFF_KR = OFF_K + 2 * SHM_K, OFF_WS = OFF_KR + 2 * SHM_KR, OFF_QR = OFF_WS + NW * 64 * 4;
constexpr int LDS_BYTES = OFF_QR + NW * 8 * 64 * 16;
constexpr float SCALE = 0.07216878364870322f;
constexpr float THR = 8.f;
constexpr int NQB = SEQ / QB;

#define KSWZ(row, colB) ((row) * 256 + ((colB) ^ (((row) & 7) << 4)))
#define KRSWZ(row, colB) ((row) * 128 + ((colB) ^ ((((row) >> 1) & 7) << 4)))
#define SBAR() __builtin_amdgcn_sched_barrier(0)
__device__ __forceinline__ int v_st(int k, int c) { const int kk = (k & ~0xC) | ((k & 4) << 1) | ((k & 8) >> 1); return ((kk >> 3) * 4 + (c >> 5)) * 512 + ((kk & 7) * 32 + (c & 31)) * 2; }
__device__ __forceinline__ int v_rd_base(int lane) { return ((lane & 3) << 3) | (((lane >> 2) & 3) << 6) | (((lane >> 4) & 1) << 5) | (((lane >> 5) & 1) << 8); }
constexpr int v_rd_off(int d0, int ks, int half) { return d0 * 512 + ks * 4096 + half * 2048; }
__device__ __forceinline__ int crow(int r, int hi) { return (r & 3) + 8 * (r >> 2) + 4 * hi; }
__device__ __forceinline__ unsigned cvtpk(float lo, float hi) { return cvt_pk_bf16(lo, hi); }
__device__ __forceinline__ bf16x8 load8(const bf16_t* p) { return *reinterpret_cast<const bf16x8*>(p); }

__device__ __forceinline__ void mask_tile(f32x16& p0, f32x16& p1, int dq) {
    const float NEG = -__builtin_inff();
#pragma unroll
    for (int r = 0; r < 16; ++r) {
        const int c = (r & 3) + 8 * (r >> 2);
        if (dq - c < 0) p0[r] = NEG;
        if (dq - c - 32 < 0) p1[r] = NEG;
    }
}
__device__ __forceinline__ void partialSM(f32x16& p0, f32x16& p1, float& m_reg, float& mn, float& alpha) {
    float pmax = p0[0];
#pragma unroll
    for (int r = 1; r < 16; ++r) pmax = fmaxf(pmax, p0[r]);
#pragma unroll
    for (int r = 0; r < 16; ++r) pmax = fmaxf(pmax, p1[r]);
    { auto rr = __builtin_amdgcn_permlane32_swap(__float_as_uint(pmax), __float_as_uint(pmax), false, false);
      pmax = fmaxf(__uint_as_float(rr[0]), __uint_as_float(rr[1])); }
    constexpr float C2 = 1.4426950408889634f * SCALE;
    if (__builtin_expect(__all((pmax - m_reg) * SCALE <= THR), 1)) { mn = m_reg; alpha = 1.f; }
    else { mn = fmaxf(m_reg, pmax); alpha = __builtin_amdgcn_exp2f((m_reg - mn) * C2); m_reg = mn; }
    const float mnL = -mn * C2;
#pragma unroll
    for (int r = 0; r < 16; ++r) p0[r] = fmaf(p0[r], C2, mnL);
#pragma unroll
    for (int r = 0; r < 16; ++r) p1[r] = fmaf(p1[r], C2, mnL);
#pragma unroll
    for (int r = 0; r < 16; ++r) p0[r] = __builtin_amdgcn_exp2f(p0[r]);
}
__device__ __forceinline__ void finishSM(f32x16& p0, f32x16& p1, float alpha, float& l_reg, bf16x8& pa0, bf16x8& pa1, bf16x8& pa2, bf16x8& pa3) {
#pragma unroll
    for (int r = 0; r < 16; ++r) p1[r] = __builtin_amdgcn_exp2f(p1[r]);
    float ps = 0;
#pragma unroll
    for (int r = 0; r < 16; ++r) ps += p0[r];
#pragma unroll
    for (int r = 0; r < 16; ++r) ps += p1[r];
    { auto rr = __builtin_amdgcn_permlane32_swap(__float_as_uint(ps), __float_as_uint(ps), false, false);
      ps = __uint_as_float(rr[0]) + __uint_as_float(rr[1]); }
    l_reg = l_reg * alpha + ps;
#define PK4(P, B_, OUT) do { unsigned a0 = cvtpk(P[B_+0], P[B_+1]), a1 = cvtpk(P[B_+2], P[B_+3]);                          \
        unsigned b0 = cvtpk(P[B_+4], P[B_+5]), b1 = cvtpk(P[B_+6], P[B_+7]);                                             \
        auto r0 = __builtin_amdgcn_permlane32_swap(a0, b0, false, false); auto r1 = __builtin_amdgcn_permlane32_swap(a1, b1, false, false); \
        u32x4 w = {r0[0], r1[0], r0[1], r1[1]}; OUT = *reinterpret_cast<bf16x8*>(&w); } while (0)
    PK4(p0, 0, pa0); PK4(p0, 8, pa1); PK4(p1, 0, pa2); PK4(p1, 8, pa3);
#undef PK4
}
template <int KB>
__device__ __forceinline__ void qkt(f32x16& p0, f32x16& p1, const char* lds, int r32, int hi, const bf16x8* qr, int qro) {
    p0 = f32x16{}; p1 = f32x16{};
    const char* kb[4];
#pragma unroll
    for (int dd = 0; dd < 4; ++dd) kb[dd] = lds + OFF_K + KB * SHM_K + KSWZ(r32, (dd * 16 + hi * 8) * 2);
#pragma unroll
    for (int d0 = 0; d0 < 8; ++d0) { const char* a = kb[d0 & 3] + (d0 >> 2) * 128;
        bf16x8 b0 = *reinterpret_cast<const bf16x8*>(a);
        bf16x8 b1 = *reinterpret_cast<const bf16x8*>(a + 32 * 256);
        const bf16x8 qq = qr[d0];
        p0 = __builtin_amdgcn_mfma_f32_32x32x16_bf16(b0, qq, p0, 0, 0, 0);
        p1 = __builtin_amdgcn_mfma_f32_32x32x16_bf16(b1, qq, p1, 0, 0, 0); }
#pragma unroll
    for (int dd = 0; dd < 4; ++dd) { const char* a = lds + OFF_KR + KB * SHM_KR + KRSWZ(r32, (dd * 16 + hi * 8) * 2);
        bf16x8 b0 = *reinterpret_cast<const bf16x8*>(a);
        bf16x8 b1 = *reinterpret_cast<const bf16x8*>(a + 32 * 128);
        const bf16x8 qq = *reinterpret_cast<const bf16x8*>(lds + qro + dd * 1024);
        p0 = __builtin_amdgcn_mfma_f32_32x32x16_bf16(b0, qq, p0, 0, 0, 0);
        p1 = __builtin_amdgcn_mfma_f32_32x32x16_bf16(b1, qq, p1, 0, 0, 0); }
}
template <int VB>
__device__ __forceinline__ void pv_tile(f32x16* o, int vb0, bf16x8 pa0, bf16x8 pa1, bf16x8 pa2, bf16x8 pa3) {
#define TRRD(dst, off) asm volatile("ds_read_b64_tr_b16 %0, %1 offset:%2" : "=&v"(dst) : "v"(vb0), "i"(off) : "memory")
#define PV_D0(d0) do { s16x4 l0, l1, l2, l3, h0, h1, h2, h3; constexpr int b_ = OFF_V + VB * SHM_V + v_rd_off(d0, 0, 0);   \
        TRRD(l0, b_); TRRD(h0, b_ + 2048); TRRD(l1, b_ + 4096); TRRD(h1, b_ + 6144); TRRD(l2, b_ + 8192); TRRD(h2, b_ + 10240); TRRD(l3, b_ + 12288); TRRD(h3, b_ + 14336); \
        asm volatile("s_waitcnt lgkmcnt(0)" ::: "memory"); SBAR();   \
        o[d0] = __builtin_amdgcn_mfma_f32_32x32x16_bf16(pa0, (bf16x8){l0[0], l0[1], l0[2], l0[3], h0[0], h0[1], h0[2], h0[3]}, o[d0], 0, 0, 0);   \
        o[d0] = __builtin_amdgcn_mfma_f32_32x32x16_bf16(pa1, (bf16x8){l1[0], l1[1], l1[2], l1[3], h1[0], h1[1], h1[2], h1[3]}, o[d0], 0, 0, 0);   \
        o[d0] = __builtin_amdgcn_mfma_f32_32x32x16_bf16(pa2, (bf16x8){l2[0], l2[1], l2[2], l2[3], h2[0], h2[1], h2[2], h2[3]}, o[d0], 0, 0, 0);   \
        o[d0] = __builtin_amdgcn_mfma_f32_32x32x16_bf16(pa3, (bf16x8){l3[0], l3[1], l3[2], l3[3], h3[0], h3[1], h3[2], h3[3]}, o[d0], 0, 0, 0); } while (0)
    PV_D0(0); PV_D0(1); PV_D0(2); PV_D0(3);
#undef PV_D0
#undef TRRD
}

struct BlockRef { const bf16_t* Q; const bf16_t* K; const bf16_t* V; const bf16_t* KR; bf16_t* O; const int* POS; const float* QG; int P0; };
struct Seam { bf16x8 qr[8]; bf16x8 st_v0, st_v1, st_k0, st_k1, st_kr; };
#define VMW() asm volatile("s_waitcnt vmcnt(0)" ::: "memory")
#define VMWN(n) asm volatile("s_waitcnt vmcnt(%0)" :: "i"(n) : "memory")
#define LDG8(base, off) (*reinterpret_cast<const bf16x8*>((const char*)(base) + (off)))
#define SLOAD_H(R_, k0) do { const char* kb_ = (const char*)((R_).K + (size_t)(k0) * KS); const char* rb_ = (const char*)((R_).KR + (size_t)(k0) * KRS);  \
                             S.st_v0 = LDG8(kb_ + 256, offA); S.st_v1 = LDG8(kb_ + 32 * KS * 2 + 256, offA);              \
                             S.st_k0 = LDG8(kb_, offA); S.st_k1 = LDG8(kb_ + 32 * KS * 2, offA);              \
                             S.st_kr = LDG8(rb_, offR); } while (0)
#define SWRITE_HK(bf) do { *(bf16x8*)(lds + OFF_K + (bf) * SHM_K + kws) = S.st_k0; *(bf16x8*)(lds + OFF_K + (bf) * SHM_K + kws + 32 * 256) = S.st_k1; \
                           *(bf16x8*)(lds + OFF_KR + (bf) * SHM_KR + krws) = S.st_kr; } while (0)
#define SWRITE_HV(bf) do { *(bf16x8*)(lds + OFF_V + (bf) * SHM_V + vst0) = S.st_v0; *(bf16x8*)(lds + OFF_V + (bf) * SHM_V + vst1) = S.st_v1; } while (0)
#define SWRITE_H(bf) do { SWRITE_HV(bf); SWRITE_HK(bf); } while (0)
#define QLOAD(R_) do { _Pragma("unroll") for (int d0 = 0; d0 < 8; ++d0) S.qr[d0] = LDG8((const char*)(R_).Q + d0 * 32, offQ); } while (0)

__device__ __forceinline__ void attn_prime(const BlockRef& cur, char* lds, Seam& S, const int wv__) {
    const int tid = TID(), wid = __builtin_amdgcn_readfirstlane(tid >> 6), lane = tid & 63, r32 = lane & 31, hi = lane >> 5;
    const int sr = tid >> 4, sc = (tid & 15) * 8, kws = KSWZ(sr, sc * 2), krr = tid >> 3, krc = (tid & 7) * 8, krws = KRSWZ(krr, krc * 2);
    unsigned offA = (unsigned)(sr * KS + sc) * 2u, offR = (unsigned)(krr * KRS + krc) * 2u, offQ = (unsigned)((wid * QBLK + r32) * QS + hi * 8) * 2u;
    asm volatile("" : "+v"(offA), "+v"(offR), "+v"(offQ));
    QLOAD(cur);
    SLOAD_H(cur, 0); VMW(); SWRITE_HK(0);
    __syncthreads();
}
__device__ __forceinline__ void attn_block(const BlockRef& cur, char* lds, Seam& S, const int wv__) {
    const int tid = TID(), wid = __builtin_amdgcn_readfirstlane(tid >> 6), lane = tid & 63, r32 = lane & 31, hi = lane >> 5;
    const int NT = (cur.P0 + QB) / KVBLK;
    const int qlo = cur.P0 + wid * QBLK, qm = qlo + r32 - 4 * hi;
    float* ws = (float*)(lds + OFF_WS) + wid * 64; float* li_l = ws, * al_l = ws + 32;
    float m_reg = -1e30f, l_reg = 0; f32x16 o[4] = {};
    const int sr = tid >> 4, sc = (tid & 15) * 8, vst0 = v_st(sr, sc), vst1 = v_st(32 + sr, sc), kws = KSWZ(sr, sc * 2);
    const int krr = tid >> 3, krc = (tid & 7) * 8, krws = KRSWZ(krr, krc * 2);
    unsigned offA = (unsigned)(sr * KS + sc) * 2u, offR = (unsigned)(krr * KRS + krc) * 2u, offQ = (unsigned)((wid * QBLK + r32) * QS + hi * 8) * 2u;
    asm volatile("" : "+v"(offA), "+v"(offR), "+v"(offQ));
    const int vb0 = (int)(uintptr_t)lds + v_rd_base(lane);
#define RESC(a) do { if (__any((a) < 1.f)) { if (hi == 0) al_l[r32] = (a); asm volatile("s_waitcnt lgkmcnt(0)" ::: "memory");              \
                     for (int d_ = 0; d_ < 4; ++d_) for (int r = 0; r < 16; ++r) o[d_][r] *= al_l[crow(r, hi)]; } } while (0)
#define KBASE(t) ((t) * KVBLK)
#define MASKT(P0_, P1_, t) do { const int kb_ = KBASE(t); if (kb_ + KVBLK - 1 > qlo) mask_tile(P0_, P1_, qm - kb_); } while (0)
    f32x16 pA0, pA1, pB0, pB1; float mnA, mnB, alA, alB; bf16x8 pa0, pa1, pa2, pa3;
    const int qro = OFF_QR + (wid * 8 * 64 + lane) * 16;
    { bf16x8 tq[8];
#pragma unroll
      for (int dd = 4; dd < 8; ++dd) tq[dd] = LDG8((const char*)cur.Q + 128 + dd * 32, offQ);
      const int pos = cur.POS[wid * QBLK + r32];
      float sn = 0.f, sr = 0.f;
#define UNP(F, x) const u32x4 w_ = __builtin_bit_cast(u32x4, F); float x[8] = {lo_bf(w_.x), hi_bf(w_.x), lo_bf(w_.y), hi_bf(w_.y), lo_bf(w_.z), hi_bf(w_.z), lo_bf(w_.w), hi_bf(w_.w)};
#pragma unroll
      for (int f = 0; f < 8; ++f) { UNP(S.qr[f], x)
#pragma unroll
          for (int e = 0; e < 8; ++e) sn += x[e] * x[e]; }
#pragma unroll
      for (int f = 4; f < 8; ++f) { UNP(tq[f], x)
#pragma unroll
          for (int e = 0; e < 8; ++e) sr += x[e] * x[e]; }
      { auto r0 = __builtin_amdgcn_permlane32_swap(__float_as_uint(sn), __float_as_uint(sn), false, false); sn = __uint_as_float(r0[0]) + __uint_as_float(r0[1]);
        auto r1 = __builtin_amdgcn_permlane32_swap(__float_as_uint(sr), __float_as_uint(sr), false, false); sr = __uint_as_float(r1[0]) + __uint_as_float(r1[1]); }
      const float rn = 1.f / sqrtf(sn * (1.f / 128.f) + RMS_EPS), rr = 1.f / sqrtf(sr * (1.f / 64.f) + RMS_EPS);
#pragma unroll
      for (int f = 0; f < 8; ++f) { UNP(S.qr[f], x)
          const f32x4 g0 = *(const f32x4*)(cur.QG + f * 16 + hi * 8), g1 = *(const f32x4*)(cur.QG + f * 16 + hi * 8 + 4);
          const float g[8] = {g0.x, g0.y, g0.z, g0.w, g1.x, g1.y, g1.z, g1.w};
          u32x4 o; o.x = cvt_pk_bf16(x[0] * rn * g[0], x[1] * rn * g[1]); o.y = cvt_pk_bf16(x[2] * rn * g[2], x[3] * rn * g[3]);
          o.z = cvt_pk_bf16(x[4] * rn * g[4], x[5] * rn * g[5]); o.w = cvt_pk_bf16(x[6] * rn * g[6], x[7] * rn * g[7]);
          S.qr[f] = __builtin_bit_cast(bf16x8, o); }
#pragma unroll
      for (int dd = 0; dd < 2; ++dd) {
          float x1[8], x2[8];
          { UNP(tq[4 + dd], x) for (int e = 0; e < 8; ++e) x1[e] = x[e]; }
          { UNP(tq[6 + dd], x) for (int e = 0; e < 8; ++e) x2[e] = x[e]; }
          const f32x4 ga0 = *(const f32x4*)(cur.QG + 128 + dd * 16 + hi * 8), ga1 = *(const f32x4*)(cur.QG + 128 + dd * 16 + hi * 8 + 4);
          const f32x4 gb0 = *(const f32x4*)(cur.QG + 160 + dd * 16 + hi * 8), gb1 = *(const f32x4*)(cur.QG + 160 + dd * 16 + hi * 8 + 4);
          const float ga[8] = {ga0.x, ga0.y, ga0.z, ga0.w, ga1.x, ga1.y, ga1.z, ga1.w}, gb[8] = {gb0.x, gb0.y, gb0.z, gb0.w, gb1.x, gb1.y, gb1.z, gb1.w};
          float o1[8], o2[8];
#pragma unroll
          for (int e = 0; e < 8; ++e) { float c, s; rope_cs(pos, dd * 16 + hi * 8 + e, c, s);
              const float a = x1[e] * rr * ga[e], b = x2[e] * rr * gb[e]; o1[e] = a * c - b * s; o2[e] = b * c + a * s; }
          u32x4 w1, w2; w1.x = cvt_pk_bf16(o1[0], o1[1]); w1.y = cvt_pk_bf16(o1[2], o1[3]); w1.z = cvt_pk_bf16(o1[4], o1[5]); w1.w = cvt_pk_bf16(o1[6], o1[7]);
          w2.x = cvt_pk_bf16(o2[0], o2[1]); w2.y = cvt_pk_bf16(o2[2], o2[3]); w2.z = cvt_pk_bf16(o2[4], o2[5]); w2.w = cvt_pk_bf16(o2[6], o2[7]);
          tq[4 + dd] = __builtin_bit_cast(bf16x8, w1); tq[6 + dd] = __builtin_bit_cast(bf16x8, w2);
      }
#undef UNP
#pragma unroll
      for (int dd = 0; dd < 4; ++dd) *(bf16x8*)(lds + qro + dd * 1024) = tq[4 + dd]; }
    SWRITE_HV(0); SBAR();
    if (NT > 1) SLOAD_H(cur, KBASE(1));
    SBAR(); qkt<0>(pA0, pA1, lds, r32, hi, S.qr, qro);
    MASKT(pA0, pA1, 0); partialSM(pA0, pA1, m_reg, mnA, alA);
    if (NT > 1) { VMW(); SWRITE_H(1); }
    __syncthreads();
#define HALF_STEP(PX0, PX1, mnX, alX, PY0, PY1, alY, t, KB, VB, SB) do {                                                      \
        SBAR(); qkt<KB>(PX0, PX1, lds, r32, hi, S.qr, qro);                                             \
        finishSM(PY0, PY1, alY, l_reg, pa0, pa1, pa2, pa3); SBAR();                                                           \
        if ((t) + 1 < NT) { SLOAD_H(cur, KBASE((t) + 1)); SBAR(); }                                               \
        pv_tile<VB>(o, vb0, pa0, pa1, pa2, pa3); MASKT(PX0, PX1, (t)); partialSM(PX0, PX1, m_reg, mnX, alX);                                        \
        __syncthreads();                                                                                                      \
        if ((t) + 1 < NT) { VMW(); SWRITE_H(SB); }                                                                          \
        RESC(alX); __syncthreads(); } while (0)
    for (int t = 1; t + 1 < NT; t += 2) {
        HALF_STEP(pB0, pB1, mnB, alB, pA0, pA1, alA, t, 1, 0, 0);
        HALF_STEP(pA0, pA1, mnA, alA, pB0, pB1, alB, t + 1, 0, 1, 1);
    }
    SBAR(); qkt<1>(pB0, pB1, lds, r32, hi, S.qr, qro); SBAR();
    finishSM(pA0, pA1, alA, l_reg, pa0, pa1, pa2, pa3); SBAR();
    pv_tile<0>(o, vb0, pa0, pa1, pa2, pa3);
    MASKT(pB0, pB1, NT - 1); partialSM(pB0, pB1, m_reg, mnB, alB); __syncthreads(); RESC(alB);
    finishSM(pB0, pB1, alB, l_reg, pa0, pa1, pa2, pa3); SBAR(); pv_tile<1>(o, vb0, pa0, pa1, pa2, pa3);
    if (hi == 0) li_l[r32] = l_reg; asm volatile("s_waitcnt lgkmcnt(0)" ::: "memory");
    float rli[16];
#pragma unroll
    for (int r = 0; r < 16; ++r) rli[r] = __builtin_amdgcn_rcpf(li_l[crow(r, hi)]);
    unsigned obase = (unsigned)((wid * QBLK + 4 * hi) * OS + r32) * 2u; asm volatile("" : "+v"(obase));
#pragma unroll
    for (int r = 0; r < 16; ++r) { const unsigned orow_off = (unsigned)(((r & 3) + 8 * (r >> 2)) * OS) * 2u;
#pragma unroll
        for (int d0 = 0; d0 < 4; ++d0) { const float v = o[d0][r] * rli[r];
            const float vn = DPPF(v, 0xB1);
            if ((r32 & 1) == 0) *(unsigned*)((char*)cur.O + (obase + orow_off + (unsigned)(d0 * 64))) = cvtpk(v, vn); } }
    __syncthreads();
#undef RESC
#undef KBASE
#undef MASKT
#undef HALF_STEP
}
#undef VMW
#undef VMWN
#undef SLOAD_H
#undef SWRITE_HK
#undef SWRITE_HV
#undef SWRITE_H
#undef QLOAD
#undef LDG8

__device__ __forceinline__ BlockRef make_ref(int bh, int qb, const bf16_t* q, const bf16_t* kv, const bf16_t* kr, bf16_t* mixed, const int* pos, const float* qg) {
    const int b = bh >> 3, h = bh & 7; BlockRef r;
    r.Q = q + ((size_t)b * SEQ + (size_t)qb * QB) * QS + h * 192;
    r.K = kv + (size_t)b * SEQ * KS + h * 256; r.V = r.K + 128;
    r.KR = kr + (size_t)b * SEQ * KRS;
    r.O = mixed + ((size_t)b * SEQ + (size_t)qb * QB) * OS + 512 + h * 128; r.P0 = qb * QB;
    r.POS = pos + (size_t)b * SEQ + (size_t)qb * QB; r.QG = qg;
    return r;
}
constexpr int N_BLOCKS = BATCH * 8 * NQB;
__device__ __forceinline__ void attn_one(char* lds, const bf16_t* q, const bf16_t* kv, const bf16_t* kr, bf16_t* mixed, int i, const int* pos, const float* qg, const int wv__) {
    Seam S;
    const BlockRef cur = make_ref(i & 63, NQB - 1 - (i >> 6), q, kv, kr, mixed, pos, qg);
    attn_prime(cur, lds, S, wv__);
    attn_block(cur, lds, S, wv__);
}
#undef KSWZ
#undef KRSWZ
#undef SBAR
}
namespace tok {
constexpr int PT = 32;
constexpr int NTILES = T / PT;
constexpr int S_VM = 1040, S_XW = 144, S_XG = 272;
constexpr int O_VM = 0, O_XR = O_VM + PT * S_VM, O_XK = O_XR + PT * S_VM, O_XW = O_XK + PT * S_VM, O_XA = O_XW + PT * S_XW, O_XG = O_XA + PT * S_XW, O_PAR = O_XG + PT * S_XG, O_WB = O_PAR + 6 * 2048, O_END = O_WB + 8 * 2560;
constexpr int LDS_BYTES = O_END;
constexpr size_t WL_W2 = 0, WL_A2 = WL_W2 + 512 * 64, WL_G2 = WL_A2 + 512 * 64, WL_V1 = WL_G2 + 512 * 128, WL_V2 = WL_V1 + 32 * 512, WL_END = WL_V2 + 512 * 32;

struct Args {
    const bf16_t* p; const int* pos;
    const float *k_gain;
    const float *mu, *w0, *a0, *v0, *k_k, *k_a, *r_k;
    const bf16_t* wl;
    float *rs_q, *rs_kv; bf16_t* kr;
    bf16_t *R, *K, *V, *KK, *B, *G, *BON, *VFIRST; float* W; float *RIN, *BS;
};
__device__ __forceinline__ float4 ld4f(const float* p) { return *(const float4*)p; }
__device__ __forceinline__ void bf4(u32x2 w, float* o) { o[0] = lo_bf(w.x); o[1] = hi_bf(w.x); o[2] = lo_bf(w.y); o[3] = hi_bf(w.y); }
__device__ __forceinline__ u32x2 pk4(const float* v) { u32x2 w; w.x = cvt_pk_bf16(v[0], v[1]); w.y = cvt_pk_bf16(v[2], v[3]); return w; }

__device__ __forceinline__ void wave_store_bf16(LAS unsigned char* wb, const u32x2 (&v)[4], bf16_t* gbase, int r32, int hi, int lane) {
#pragma unroll
    for (int g = 0; g < 4; ++g) *(LAS u32x2*)(wb + r32 * 80 + 16 * g + 8 * hi) = v[g];
    asm volatile("" ::: "memory");
#pragma unroll
    for (int i = 0; i < 2; ++i) { const int tk_ = i * 16 + (lane >> 2); const u32x4 x = *(const LAS u32x4*)(wb + tk_ * 80 + (lane & 3) * 16);
        *(u32x4*)((char*)gbase + (size_t)tk_ * 1024 + (lane & 3) * 16) = x; }
    asm volatile("" ::: "memory");
}
__device__ __forceinline__ void wave_store_f32h(LAS unsigned char* wb, const f32x4 (&v)[2], float* gbase, int r32, int hi, int lane) {
#pragma unroll
    for (int j = 0; j < 2; ++j) *(LAS f32x4*)(wb + r32 * 80 + (8 * j + 4 * hi) * 4) = v[j];
    asm volatile("" ::: "memory");
#pragma unroll
    for (int i = 0; i < 2; ++i) { const int tk_ = i * 16 + (lane >> 2); const f32x4 x = *(const LAS f32x4*)(wb + tk_ * 80 + (lane & 3) * 16);
        *(f32x4*)((char*)gbase + (size_t)tk_ * 2048 + (lane & 3) * 16) = x; }
    asm volatile("" ::: "memory");
}
__device__ __forceinline__ void stage_params(const Args& A, LAS unsigned char* lds, int tid) {
    LAS float* P = (LAS float*)(lds + O_PAR);
    P[tid] = A.w0[tid]; P[512 + tid] = A.a0[tid]; P[1024 + tid] = A.v0[tid]; P[1536 + tid] = A.k_k[tid]; P[2048 + tid] = A.k_a[tid]; P[2560 + tid] = A.r_k[tid];
}
template <int LAYER>
__device__ __forceinline__ void tile(const Args& A, LAS unsigned char* lds, int tl, const int wv__, const int mode = 7) {
    const int tid = TID(), lane = tid & 63, wid = __builtin_amdgcn_readfirstlane(tid >> 6), r32 = lane & 31, hi = lane >> 5;
    const int tok0 = tl * PT;
    const bf16_t* p = A.p;
    if (mode & 1) {
        u32x2 k4v[4]; bf16_t krv[4]; int posv[4];
#pragma unroll
        for (int i = 0; i < 4; ++i) {
            const int tk = tok0 + wid + 8 * i; const bf16_t* pr = p + (size_t)tk * NP;
            k4v[i] = *(const u32x2*)(pr + C_MKV + lane * 4); krv[i] = pr[C_MKR + lane]; posv[i] = A.pos[tk];
        }
        const float kg = A.k_gain[128 + lane];
#pragma unroll
        for (int i = 0; i < 4; ++i) {
            const int tk = tok0 + wid + 8 * i;
            const u32x2 k4 = k4v[i];
            float sk = 0.f;
            { float a; a = lo_bf(k4.x); sk += a * a; a = hi_bf(k4.x); sk += a * a; a = lo_bf(k4.y); sk += a * a; a = hi_bf(k4.y); sk += a * a; }
            const float kr = bf2f(krv[i]);
            float skr = kr * kr;
            sk = wave_sum(sk); skr = wave_sum(skr);
            if (lane == 0) A.rs_kv[tk] = 1.f / sqrtf(sk * (1.f / 256.f) + RMS_EPS);
            const float krn = kr * (1.f / sqrtf(skr * (1.f / 64.f) + RMS_EPS)) * kg;
            const float other = xor32f(krn, lane);
            float c, s; rope_cs(posv[i], lane & 31, c, s);
            const float o = (lane < 32) ? (krn * c - other * s) : (krn * c + other * s);
            A.kr[(size_t)tk * 64 + lane] = f2bf(o);
        }
    }
    if (mode & 2) {
#pragma unroll 1
    for (int it = 0; it < 7; ++it) {
        u32x4 cu[2], pv[2]; f32x4 m0[2], m1[2]; int tt[2], jj[2];
#pragma unroll
        for (int u = 0; u < 2; ++u) {
            const int task = tid + (2 * it + u) * 512;
            const int t = task / 224, j = task - t * 224; tt[u] = t; jj[u] = j;
            const int tk = tok0 + t; const bool first = (tk & (SEQ - 1)) == 0;
            const bf16_t* pr = p + (size_t)tk * NP + C_RR + 8 * j;
            cu[u] = *(const u32x4*)pr;
            pv[u] = (u32x4){0u, 0u, 0u, 0u};
            if (!first) pv[u] = *(const u32x4*)(pr - NP);
            m0[u] = *(const f32x4*)(A.mu + 8 * j); m1[u] = *(const f32x4*)(A.mu + 8 * j + 4);
        }
#pragma unroll
        for (int u = 0; u < 2; ++u) {
            const int t = tt[u], j = jj[u];
            const float mu[8] = {m0[u].x, m0[u].y, m0[u].z, m0[u].w, m1[u].x, m1[u].y, m1[u].z, m1[u].w};
            const float c8[8] = {lo_bf(cu[u].x), hi_bf(cu[u].x), lo_bf(cu[u].y), hi_bf(cu[u].y), lo_bf(cu[u].z), hi_bf(cu[u].z), lo_bf(cu[u].w), hi_bf(cu[u].w)};
            const float p8[8] = {lo_bf(pv[u].x), hi_bf(pv[u].x), lo_bf(pv[u].y), hi_bf(pv[u].y), lo_bf(pv[u].z), hi_bf(pv[u].z), lo_bf(pv[u].w), hi_bf(pv[u].w)};
            float o[8];
#pragma unroll
            for (int i = 0; i < 8; ++i) o[i] = c8[i] + (p8[i] - c8[i]) * mu[i];
            if (j >= 192) {
#pragma unroll
                for (int i = 0; i < 8; ++i) { const float m = o[i]; const float e = fast_exp(j < 200 ? 2.f * m : -m); const float r = fast_rcp(e + 1.f);
                    o[i] = j < 200 ? 1.f - 2.f * r : (j < 208 ? m : r); }
            }
            u32x4 w; w.x = cvt_pk_bf16(o[0], o[1]); w.y = cvt_pk_bf16(o[2], o[3]); w.z = cvt_pk_bf16(o[4], o[5]); w.w = cvt_pk_bf16(o[6], o[7]);
            int off;
            if (j < 64) off = O_XR + t * S_VM + j * 16; else if (j < 128) off = O_XK + t * S_VM + (j - 64) * 16; else if (j < 192) off = O_VM + t * S_VM + (j - 128) * 16;
            else if (j < 200) off = O_XW + t * S_XW + (j - 192) * 16; else if (j < 208) off = O_XA + t * S_XW + (j - 200) * 16; else off = O_XG + t * S_XG + (j - 208) * 16;
            *(LAS u32x4*)(lds + off) = w;
        }
    }
    }
    __syncthreads();
    const int h = wid;
    unsigned wo64 = (unsigned)(r32 * 64 + hi * 8) * 2u, wo128 = (unsigned)(r32 * 128 + hi * 8) * 2u, wo32 = (unsigned)(r32 * 32 + hi * 8) * 2u, wo512 = (unsigned)(r32 * 512 + hi * 8) * 2u;
#define GLD8(base, off) (*(const bf16x8*)((const char*)(base) + (off)))
    const bf16_t* w2t = A.wl + WL_W2 + (size_t)(h * 64) * 64; const bf16_t* a2t = A.wl + WL_A2 + (size_t)(h * 64) * 64;
    const bf16_t* g2t = A.wl + WL_G2 + (size_t)(h * 64) * 128; const bf16_t* v2p = A.wl + WL_V2 + (size_t)(h * 64) * 32; const bf16_t* v1t = A.wl + WL_V1;
    if (mode & 4) {
        constexpr int nb = 0;
        asm volatile("" : "+v"(wo64), "+v"(wo128), "+v"(wo32), "+v"(wo512));
        const int trow = nb * 32 + r32;
        const int tk = tok0 + trow; const bool first = (tk & (SEQ - 1)) == 0;
        unsigned e512 = (unsigned)(trow * 512 + 4 * hi);
        asm volatile("" : "+v"(e512));
        const size_t t512 = (size_t)tok0 * 512;
#define CB (h * 64 + mb * 32 + 8 * g)
#define PL4(idx) (*(const LAS f32x4*)(lds + O_PAR + (idx) * 2048 + (CB + 4 * hi) * 4))
#define A2(ptr) ((char*)((ptr) + t512 + CB) + e512 * 2u)
#define A4(ptr) ((char*)((ptr) + t512 + CB) + e512 * 4u)
        bf16x8 vvf[2];
        if (LAYER > 0) {
            f32x16 vv = f32x16{};
#pragma unroll 16
            for (int ks = 0; ks < 32; ++ks) {
                const bf16x8 bv = *(const LAS bf16x8*)(lds + O_VM + trow * S_VM + (ks * 16 + hi * 8) * 2);
                const bf16x8 av = GLD8(v1t + ks * 16, wo512);
                vv = __builtin_amdgcn_mfma_f32_32x32x16_bf16(av, bv, vv, 0, 0, 0);
            }
#pragma unroll
            for (int s = 0; s < 2; ++s) {
                u32x4 bw; bw.x = cvt_pk_bf16(vv[8 * s + 0], vv[8 * s + 1]); bw.y = cvt_pk_bf16(vv[8 * s + 2], vv[8 * s + 3]); bw.z = cvt_pk_bf16(vv[8 * s + 4], vv[8 * s + 5]); bw.w = cvt_pk_bf16(vv[8 * s + 6], vv[8 * s + 7]);
                vvf[s] = __builtin_bit_cast(bf16x8, bw);
            }
        }
        float ss = 0.f, bs = 0.f;
#pragma unroll
        for (int mb = 0; mb < 2; ++mb) {
            f32x16 accW = f32x16{}, accA = f32x16{}, accG = f32x16{}, accV = f32x16{};
            u32x2 vfraw[4];
            if (LAYER > 0) {
#pragma unroll
                for (int g = 0; g < 4; ++g) vfraw[g] = *(const u32x2*)A2(A.VFIRST);
            }
#pragma unroll
            for (int ks = 0; ks < 4; ++ks) {
                const bf16x8 bw = *(const LAS bf16x8*)(lds + O_XW + trow * S_XW + (ks * 16 + hi * 8) * 2);
                const bf16x8 ba = *(const LAS bf16x8*)(lds + O_XA + trow * S_XW + (ks * 16 + hi * 8) * 2);
                const bf16x8 aw = GLD8(w2t + mb * 32 * 64 + ks * 16, wo64);
                const bf16x8 aa = GLD8(a2t + mb * 32 * 64 + ks * 16, wo64);
                accW = __builtin_amdgcn_mfma_f32_32x32x16_bf16(aw, bw, accW, 0, 0, 0);
                accA = __builtin_amdgcn_mfma_f32_32x32x16_bf16(aa, ba, accA, 0, 0, 0);
            }
#pragma unroll
            for (int ks = 0; ks < 8; ++ks) {
                const bf16x8 bg = *(const LAS bf16x8*)(lds + O_XG + trow * S_XG + (ks * 16 + hi * 8) * 2);
                const bf16x8 ag = GLD8(g2t + mb * 32 * 128 + ks * 16, wo128);
                accG = __builtin_amdgcn_mfma_f32_32x32x16_bf16(ag, bg, accG, 0, 0, 0);
            }
            if (LAYER > 0) {
#pragma unroll
                for (int s = 0; s < 2; ++s) {
                    const bf16x8 a2 = GLD8(v2p + mb * 32 * 32 + s * 16, wo32);
                    accV = __builtin_amdgcn_mfma_f32_32x32x16_bf16(a2, vvf[s], accV, 0, 0, 0);
                }
            }
            asm volatile("" ::: "memory");
            f32x4 oW[4]; u32x2 oG[4], oV[4], oR[4], oK[4], oKK[4], oB[4];
#pragma unroll
            for (int g = 0; g < 4; ++g) {
                const f32x4 w0 = PL4(0), a0 = PL4(1);
                const float w0a[4] = {w0.x, w0.y, w0.z, w0.w}, a0a[4] = {a0.x, a0.y, a0.z, a0.w};
                float dec[4], gt[4], av[4];
#pragma unroll
                for (int i = 0; i < 4; ++i) {
                    dec[i] = fast_exp(-0.6065306597126334f * sigmoidf_(accW[4 * g + i] + w0a[i]));
                    gt[i] = accG[4 * g + i];
                    av[i] = sigmoidf_(accA[4 * g + i] + a0a[i]);
                }
                oW[g] = (f32x4){dec[0], dec[1], dec[2], dec[3]};
                oG[g] = pk4(gt);
                float vm[4]; bf4(*(const LAS u32x2*)(lds + O_VM + trow * S_VM + (CB + 4 * hi) * 2), vm);
                float vf[4];
                if (LAYER > 0) {
                    const f32x4 v0 = PL4(2); const float v0a[4] = {v0.x, v0.y, v0.z, v0.w};
                    float vfi[4]; bf4(vfraw[g], vfi);
#pragma unroll
                    for (int i = 0; i < 4; ++i) vf[i] = vm[i] + (vfi[i] - vm[i]) * sigmoidf_(accV[4 * g + i] + v0a[i]);
                } else {
#pragma unroll
                    for (int i = 0; i < 4; ++i) vf[i] = vm[i];
                }
                oV[g] = pk4(vf);
                float xr[4], xk4[4];
                const u32x2 xrraw = *(const LAS u32x2*)(lds + O_XR + trow * S_VM + (CB + 4 * hi) * 2);
                bf4(xrraw, xr); bf4(*(const LAS u32x2*)(lds + O_XK + trow * S_VM + (CB + 4 * hi) * 2), xk4);
                const f32x4 kk4 = PL4(3), ka4 = PL4(4), rk4 = PL4(5);
                const float kka[4] = {kk4.x, kk4.y, kk4.z, kk4.w}, kaa[4] = {ka4.x, ka4.y, ka4.z, ka4.w}, rka[4] = {rk4.x, rk4.y, rk4.z, rk4.w};
                float k2[4], kkv[4], bn[4];
#pragma unroll
                for (int i = 0; i < 4; ++i) {
                    const float xk = xk4[i];
                    kkv[i] = xk * kka[i];
                    ss += kkv[i] * kkv[i];
                    k2[i] = xk * (1.f + (av[i] - 1.f) * kaa[i]);
                    bs += xr[i] * k2[i] * rka[i];
                    bn[i] = -kkv[i] * av[i];
                }
                oR[g] = xrraw; oK[g] = pk4(k2); oKK[g] = pk4(kkv); oB[g] = pk4(bn);
            }
#ifdef TOKPROBE
            if (mode & 8) { unsigned cs = 0u;
#pragma unroll
              for (int g = 0; g < 4; ++g) cs ^= oG[g].x ^ oG[g].y ^ oV[g].x ^ oV[g].y ^ oR[g].x ^ oR[g].y ^ oK[g].x ^ oK[g].y ^ oKK[g].x ^ oKK[g].y ^ oB[g].x ^ oB[g].y ^ __float_as_uint(oW[g].x) ^ __float_as_uint(oW[g].y) ^ __float_as_uint(oW[g].z) ^ __float_as_uint(oW[g].w);
              if (cs == 0x12345679u) A.G[(size_t)tok0 * 512 + lane] = 1; } else
#endif
            { LAS unsigned char* wb = lds + O_WB + wid * 2560;
              const size_t eb = (size_t)tok0 * 512 + h * 64 + mb * 32;
              wave_store_bf16(wb, oG, A.G + eb, r32, hi, lane);
              wave_store_bf16(wb, oV, A.V + eb, r32, hi, lane);
              if (LAYER == 0) wave_store_bf16(wb, oV, A.VFIRST + eb, r32, hi, lane);
              wave_store_bf16(wb, oR, A.R + eb, r32, hi, lane);
              wave_store_bf16(wb, oK, A.K + eb, r32, hi, lane);
              wave_store_bf16(wb, oKK, A.KK + eb, r32, hi, lane);
              wave_store_bf16(wb, oB, A.B + eb, r32, hi, lane);
              { const f32x4 w01[2] = {oW[0], oW[1]}, w23[2] = {oW[2], oW[3]};
                wave_store_f32h(wb, w01, A.W + eb, r32, hi, lane); wave_store_f32h(wb, w23, A.W + eb + 16, r32, hi, lane); } }
        }
        { auto r0 = __builtin_amdgcn_permlane32_swap(__float_as_uint(ss), __float_as_uint(ss), false, false); ss = __uint_as_float(r0[0]) + __uint_as_float(r0[1]);
          auto r1 = __builtin_amdgcn_permlane32_swap(__float_as_uint(bs), __float_as_uint(bs), false, false); bs = __uint_as_float(r1[0]) + __uint_as_float(r1[1]); }
        if (hi == 0) { A.RIN[(size_t)tk * 8 + h] = 1.f / fmaxf(sqrtf(ss), 1e-12f); A.BS[(size_t)tk * 8 + h] = bs; }
    }
#undef CB
#undef PL4
#undef A2
#undef A4
#undef GLD8
    __syncthreads();
}
__device__ __forceinline__ void lora_prep(const float* w2, const float* a2, const float* g2, const float* v1, const float* v2, bf16_t* wl, int gtid, int nthr) {
    for (int i = gtid; i < 512 * 64; i += nthr) { const int n = i >> 6, k = i & 63; wl[WL_W2 + i] = f2bf(w2[k * 512 + n]); wl[WL_A2 + i] = f2bf(a2[k * 512 + n]); }
    for (int i = gtid; i < 512 * 128; i += nthr) { const int n = i >> 7, k = i & 127; wl[WL_G2 + i] = f2bf(g2[k * 512 + n]); }
    if (v1) {
        for (int i = gtid; i < 32 * 512; i += nthr) { const int j = i >> 9, k = i & 511; wl[WL_V1 + i] = f2bf(v1[k * 32 + j]); }
        for (int i = gtid; i < 512 * 32; i += nthr) { const int n = i >> 5, q = i & 31, s = q >> 4, hh = (q >> 3) & 1, jj = q & 7;
            const int kidx = 16 * s + 8 * (jj >> 2) + 4 * hh + (jj & 3); wl[WL_V2 + i] = f2bf(v2[kidx * 512 + n]); }
    }
}
}
struct Ptrs {
    const float* in[30]; float* out; unsigned char* ws;
};
__device__ __forceinline__ void transpose_item(const float* W, int K, int N, bf16_t* WT, const float* gain, int mode, LAS float* scr, int item, int lane) {
    const int nblk = N / 64, kb = item / nblk, nb = item % nblk, k0 = 64 * kb, n0 = 64 * nb;
#pragma unroll 64
    for (int kk = 0; kk < 64; ++kk) { const float g = gain ? gain[k0 + kk] : 1.f; scr[kk * 65 + lane] = W[(size_t)(k0 + kk) * N + n0 + lane] * g; }
    asm volatile("s_waitcnt lgkmcnt(0)" ::: "memory");
    const int c = lane & 7;
#pragma unroll
    for (int j = 0; j < 8; ++j) { const int n = (lane >> 3) + 8 * j; const LAS float* s = scr + (8 * c) * 65 + n;
        u32x4 o; o.x = cvt_pk_bf16(s[0 * 65], s[1 * 65]); o.y = cvt_pk_bf16(s[2 * 65], s[3 * 65]); o.z = cvt_pk_bf16(s[4 * 65], s[5 * 65]); o.w = cvt_pk_bf16(s[6 * 65], s[7 * 65]);
        const int ng = n0 + n; int drow = ng;
        if (mode == 1) { if (ng < FF) drow = 256 * (ng >> 7) + (ng & 127); else { const int f = ng - FF; drow = 256 * (f >> 7) + 128 + (f & 127); } }
        *(u32x4*)(WT + (size_t)drow * K + k0 + 8 * c) = o; }
    asm volatile("s_waitcnt lgkmcnt(0)" ::: "memory");
}
typedef const Ptrs __attribute__((address_space(4)))* PtrTab;
constexpr int CV_IN = (DM / 64) * (INW / 64), CV_QB = (512 / 64) * (QW / 64), CV_KVB = (256 / 64) * (KVW / 64), CV_O = (DM / 64) * (DM / 64),
              CV_GU = (DM / 64) * (2 * FF / 64), CV_DN = (FF / 64) * (DM / 64);
constexpr int CV_NI = CV_IN + CV_QB + CV_KVB + CV_O + CV_GU + CV_DN;
__device__ __forceinline__ void convert_wave_item(PtrTab pt, int l, int it, LAS float* scr, int lane) {
    unsigned char* wl = pt->ws + WS_W + (size_t)l * W_LAYER;
    int r = it;
    if (r < CV_IN) { transpose_item(pt->in[3] + (size_t)l * DM * INW, DM, INW, (bf16_t*)(wl + WO_IN), pt->in[2] + l * DM, 0, scr, r, lane); return; } r -= CV_IN;
    if (r < CV_QB) { transpose_item(pt->in[7] + (size_t)l * 512 * QW, 512, QW, (bf16_t*)(wl + WO_QB), pt->in[6] + l * 512, 0, scr, r, lane); return; } r -= CV_QB;
    if (r < CV_KVB) { transpose_item(pt->in[9] + (size_t)l * 256 * KVW, 256, KVW, (bf16_t*)(wl + WO_KVB), pt->in[8] + l * 256, 0, scr, r, lane); return; } r -= CV_KVB;
    if (r < CV_O) { transpose_item(pt->in[26] + (size_t)l * DM * DM, DM, DM, (bf16_t*)(wl + WO_O), nullptr, 0, scr, r, lane); return; } r -= CV_O;
    if (r < CV_GU) { transpose_item(pt->in[28] + (size_t)l * DM * 2 * FF, DM, 2 * FF, (bf16_t*)(wl + WO_GU), pt->in[27] + l * DM, 1, scr, r, lane); return; } r -= CV_GU;
    transpose_item(pt->in[29] + (size_t)l * FF * DM, FF, DM, (bf16_t*)(wl + WO_DN), nullptr, 0, scr, r, lane);
}
__device__ __forceinline__ void convert_misc(PtrTab pt, int l, int gtid, int nthr) {
    unsigned char* wl = pt->ws + WS_W + (size_t)l * W_LAYER;
    { u32x4* z = (u32x4*)(wl + WO_IN + (size_t)INW * DM * 2); const int n16 = (NP - INW) * DM * 2 / 16;
      for (int i = gtid; i < n16; i += nthr) z[i] = (u32x4){0u, 0u, 0u, 0u}; }
    tok::lora_prep(pt->in[14] + (size_t)l * 64 * 512, pt->in[16] + (size_t)l * 64 * 512, pt->in[17] + (size_t)l * 128 * 512,
                   l > 0 ? pt->in[19] + (size_t)(l - 1) * 512 * 32 : nullptr, l > 0 ? pt->in[20] + (size_t)(l - 1) * 32 * 512 : nullptr,
                   (bf16_t*)(wl + WO_LORA), gtid, nthr);
}
constexpr int CV_TI = (CV_NI + 63) / 64, CV_MISC = 8, CV_ITEMS = CV_TI + CV_MISC;
constexpr int CV_EARLY = CV_IN + CV_QB + CV_KVB;
constexpr int CV_LATE0 = (CV_NI - CV_EARLY + 63) / 64;
__device__ __forceinline__ void convert_queue_item(PtrTab pt, int l, int ci, LAS float* scr, int wid, int lane) {
    asm volatile("" : "+s"(pt));
    if (ci < CV_TI) {
        for (int k = 0; k < 8; ++k) { const int it = ci * 64 + k * 8 + wid; if (it < CV_NI) convert_wave_item(pt, l, it, scr, lane); }
    } else if (ci < CV_ITEMS) convert_misc(pt, l, (ci - CV_TI) * 512 + wid * 64 + lane, CV_MISC * 512);
    else { for (int k = 0; k < 8; ++k) { const int it = CV_EARLY + (ci - CV_ITEMS) * 64 + k * 8 + wid; if (it < CV_NI) convert_wave_item(pt, 0, it, scr, lane); } }
}
__device__ __forceinline__ void prologue_phase(PtrTab pt, LAS float* scr, int gw, int ngw, int lane) {
#ifdef CONV_IN_MIXERS
    for (int it = gw; it < CV_NI; it += ngw) convert_wave_item(pt, 0, it, scr, lane);
    convert_misc(pt, 0, gw * 64 + lane, ngw * 64);
#else
    for (int l = 0; l < DEPTH; ++l) {
        for (int it = gw; it < CV_NI; it += ngw) convert_wave_item(pt, l, it, scr, lane);
        convert_misc(pt, l, gw * 64 + lane, ngw * 64);
    }
#endif
    const float* x_in = pt->in[0]; const float* hb_in = pt->in[4]; unsigned char* ws_ = pt->ws;
    { bf16_t* xb = (bf16_t*)(ws_ + WS_XB); float* ssa = (float*)(ws_ + WS_SSA);
      for (int m0 = gw; m0 < T; m0 += 2 * ngw) {
        f32x4 v[2][8];
#pragma unroll
        for (int u = 0; u < 2; ++u) { const f32x4* xr = (const f32x4*)(x_in + (size_t)(m0 + u * ngw) * DM) + lane;
#pragma unroll
          for (int j = 0; j < 8; ++j) v[u][j] = xr[64 * j]; }
#pragma unroll
        for (int u = 0; u < 2; ++u) {
          const int m = m0 + u * ngw; float s = 0.f;
#pragma unroll
          for (int j = 0; j < 8; ++j) s += (v[u][j].x * v[u][j].x + v[u][j].y * v[u][j].y) + (v[u][j].z * v[u][j].z + v[u][j].w * v[u][j].w);
          s = wave_sum(s);
          if (lane < 32) ssa[(size_t)m * 32 + lane] = lane == 0 ? s : 0.f;
          u32x2* o = (u32x2*)(xb + (size_t)m * DM) + lane;
#pragma unroll
          for (int j = 0; j < 8; ++j) { u32x2 w; w.x = cvt_pk_bf16(v[u][j].x, v[u][j].y); w.y = cvt_pk_bf16(v[u][j].z, v[u][j].w); o[64 * j] = w; }
        }
      } }
    { float* lb = (float*)(ws_ + WS_LB); const float* hb = hb_in;
      for (int c = gw * 64 + lane; c < 512; c += ngw * 64) {
          float v[DEPTH], mx = -1e30f, s = 0.f;
          for (int l = 0; l < DEPTH; ++l) { v[l] = hb[l * 512 + c]; mx = fmaxf(mx, v[l]); }
          for (int l = 0; l < DEPTH; ++l) { v[l] = expf(v[l] - mx); s += v[l]; }
          float cum = 0.f; const float inv = 1.f / s;
          for (int l = 0; l < DEPTH; ++l) { cum += v[l] * inv; lb[l * 512 + c] = cum - v[0] * inv; }
      } }
}

__device__ __forceinline__ void rownorm_phase(const float* x, bf16_t* xb, float* rs, int gw, int ngw, int lane) {
    for (int m = gw; m < T; m += ngw) {
        const f32x4* xr = (const f32x4*)(x + (size_t)m * DM) + lane;
        f32x4 v[8]; float s = 0.f;
#pragma unroll
        for (int j = 0; j < 8; ++j) { v[j] = xr[64 * j]; s += (v[j].x * v[j].x + v[j].y * v[j].y) + (v[j].z * v[j].z + v[j].w * v[j].w); }
        s = wave_sum(s);
        if (lane == 0) rs[m] = 1.f / sqrtf(s * (1.f / DM) + RMS_EPS);
        u32x2* o = (u32x2*)(xb + (size_t)m * DM) + lane;
#pragma unroll
        for (int j = 0; j < 8; ++j) { u32x2 w; w.x = cvt_pk_bf16(v[j].x, v[j].y); w.y = cvt_pk_bf16(v[j].z, v[j].w); o[64 * j] = w; }
    }
}

__device__ __forceinline__ void qknorm_phase(bf16_t* q, bf16_t* kv, const int* pos, const float* q_gain, const float* k_gain, int gw, int ngw, int lane, bf16_t* qo = nullptr, bf16_t* kvo = nullptr) {
    if (!qo) { qo = q; kvo = kv; }
    const float gk0 = k_gain[2 * lane], gk1 = k_gain[2 * lane + 1];
#pragma unroll 2
    for (int tk = gw; tk < T; tk += ngw) {
        bf16_t* qrow = q + (size_t)tk * QW; bf16_t* krow = kv + (size_t)tk * KVW; bf16_t* qorow = qo + (size_t)tk * QW; bf16_t* korow = kvo + (size_t)tk * KVW;
#pragma unroll
        for (int h = 0; h < 8; ++h) {
            const unsigned kn = *(const unsigned*)(krow + h * 256 + 2 * lane);
            const float b0 = lo_bf(kn), b1 = hi_bf(kn);
            const float sk = wave_sum(b0 * b0 + b1 * b1);
            const float rk = 1.f / sqrtf(sk * (1.f / 128.f) + RMS_EPS);
            *(unsigned*)(korow + h * 256 + 2 * lane) = cvt_pk_bf16(b0 * rk * gk0, b1 * rk * gk1);
        }
    }
}
namespace rwk {
constexpr int TC = 64;
constexpr int NCH = SEQ / TC;
constexpr int N_ITEMS = BATCH * 8 * 2;
constexpr int OPS = 320;
constexpr int VS = TC + 4;
constexpr int L_KK = 0, L_W = 64, L_BN = 128, L_KP = 192, L_R = 256, L_V = TC * OPS, L_Y = L_V + 32 * VS, L_DUM = L_Y + 32 * VS, L_END = L_DUM + 512 * 4;
constexpr int LDS_BYTES = L_END * 4;
struct Args { const bf16_t *R, *K, *KK, *B; bf16_t* V; const float* W; const float* RIN; bf16_t* Yout; };

__device__ __forceinline__ float dpp_xor1(float x) { return __int_as_float(__builtin_amdgcn_update_dpp(0, __float_as_int(x), 0xB1, 0xf, 0xf, true)); }
__device__ __forceinline__ float dpp_xor2(float x) { return __int_as_float(__builtin_amdgcn_update_dpp(0, __float_as_int(x), 0x4E, 0xf, 0xf, true)); }
__device__ __forceinline__ float dpp_hmir(float x) { return __int_as_float(__builtin_amdgcn_update_dpp(0, __float_as_int(x), 0x141, 0xf, 0xf, true)); }
__device__ __forceinline__ float red8(float x) { x += dpp_xor1(x); x += dpp_xor2(x); x += dpp_hmir(x); return x; }

struct Pre { u32x4 r, k, v, kk, b; f32x4 w0, w1; float rin; };
__device__ __forceinline__ void pre_load(Pre& q, const Args& A, size_t off, bool hasv) {
    q.r = *(const u32x4*)(A.R + off); q.k = *(const u32x4*)(A.K + off); q.kk = *(const u32x4*)(A.KK + off); q.b = *(const u32x4*)(A.B + off);
    if (hasv) q.v = *(const u32x4*)(A.V + off);
    q.w0 = *(const f32x4*)(A.W + off); q.w1 = *(const f32x4*)(A.W + off + 4);
    q.rin = A.RIN[(off >> 9) * 8 + ((off >> 6) & 7)];
}
__device__ __forceinline__ void st8(LAS float* d, u32x4 w, float sc = 1.f) {
    *(LAS f32x4*)d = (f32x4){lo_bf(w.x) * sc, hi_bf(w.x) * sc, lo_bf(w.y) * sc, hi_bf(w.y) * sc}; *(LAS f32x4*)(d + 4) = (f32x4){lo_bf(w.z) * sc, hi_bf(w.z) * sc, lo_bf(w.w) * sc, hi_bf(w.w) * sc};
}

template <int VAR = 0>
__device__ __forceinline__ void item(const Args& A, LAS float* lds, int it, const int wv__) {
    const int tid = TID(), bh = it >> 1, half = it & 1, b = bh >> 3, h = bh & 7;
    const int st = tid >> 3, sc8 = (tid & 7) * 8;
    const bool hasv = ((tid & 7) >> 2) == half;
    const int vc8 = sc8 - half * 32;
    const size_t base = (size_t)b * SEQ * 512 + h * 64;
    const int row = tid >> 3, kp = tid & 7;
    f32x2 s0[4];
#pragma unroll
    for (int i = 0; i < 4; ++i) s0[i] = (f32x2){0.f, 0.f};
    Pre pre; pre_load(pre, A, base + (size_t)st * 512 + sc8, hasv);
    for (int ck = 0; ck < NCH; ++ck) {
        { const int o = st * OPS + sc8;
          st8(lds + L_R + o, pre.r); st8(lds + L_KP + o, pre.k); st8(lds + L_KK + o, pre.kk, pre.rin); st8(lds + L_BN + o, pre.b, pre.rin);
          *(LAS f32x4*)(lds + L_W + o) = pre.w0; *(LAS f32x4*)(lds + L_W + o + 4) = pre.w1;
          if (hasv) { LAS float* vd = lds + L_V + vc8 * VS + st;
            vd[0 * VS] = lo_bf(pre.v.x); vd[1 * VS] = hi_bf(pre.v.x); vd[2 * VS] = lo_bf(pre.v.y); vd[3 * VS] = hi_bf(pre.v.y);
            vd[4 * VS] = lo_bf(pre.v.z); vd[5 * VS] = hi_bf(pre.v.z); vd[6 * VS] = lo_bf(pre.v.w); vd[7 * VS] = hi_bf(pre.v.w); } }
        __syncthreads();
        if (ck + 1 < NCH) pre_load(pre, A, base + (size_t)((ck + 1) * TC + st) * 512 + sc8, hasv);
        if (tid < 256) {
            const LAS float* pk = lds + 8 * kp;
            const LAS float* pv = lds + L_V + row * VS;
            LAS float* pyw = kp == 0 ? lds + L_Y + row * VS : lds + L_DUM + tid * 4;
            const int pyinc = kp == 0 ? 4 : 0;
#define RW_LOAD(P, t_) do { const LAS float* q_ = pk + (t_) * OPS; \
                P##kk0 = *(const LAS f32x4*)(q_ + L_KK); P##kk1 = *(const LAS f32x4*)(q_ + L_KK + 4); \
                P##w0 = *(const LAS f32x4*)(q_ + L_W); P##w1 = *(const LAS f32x4*)(q_ + L_W + 4); \
                P##b0 = *(const LAS f32x4*)(q_ + L_BN); P##b1 = *(const LAS f32x4*)(q_ + L_BN + 4); \
                P##k0 = *(const LAS f32x4*)(q_ + L_KP); P##k1 = *(const LAS f32x4*)(q_ + L_KP + 4); \
                P##r0 = *(const LAS f32x4*)(q_ + L_R); P##r1 = *(const LAS f32x4*)(q_ + L_R + 4); } while (0)
#define F2(v4, i) ((f32x2){(v4)[2 * (i)], (v4)[2 * (i) + 1]})
#define RW_DOT(S, A0, A1) ({ f32x2 p_ = S[0] * F2(A0, 0); p_ = __builtin_elementwise_fma(S[1], F2(A0, 1), p_); p_ = __builtin_elementwise_fma(S[2], F2(A1, 0), p_); p_ = __builtin_elementwise_fma(S[3], F2(A1, 1), p_); p_.x + p_.y; })
#define RW_STEP(P, v_, yo_) do { \
                float sa0 = RW_DOT(s0, P##kk0, P##kk1); \
                const f32x2 va = (f32x2){v_, v_}; \
                f32x2 ta[4]; \
                ta[0] = va * F2(P##k0, 0); ta[1] = va * F2(P##k0, 1); ta[2] = va * F2(P##k1, 0); ta[3] = va * F2(P##k1, 1); \
                sa0 = red8(sa0); \
                const f32x2 sA = (f32x2){sa0, sa0}; \
                ta[0] = __builtin_elementwise_fma(sA, F2(P##b0, 0), ta[0]); ta[1] = __builtin_elementwise_fma(sA, F2(P##b0, 1), ta[1]); \
                ta[2] = __builtin_elementwise_fma(sA, F2(P##b1, 0), ta[2]); ta[3] = __builtin_elementwise_fma(sA, F2(P##b1, 1), ta[3]); \
                s0[0] = __builtin_elementwise_fma(s0[0], F2(P##w0, 0), ta[0]); s0[1] = __builtin_elementwise_fma(s0[1], F2(P##w0, 1), ta[1]); \
                s0[2] = __builtin_elementwise_fma(s0[2], F2(P##w1, 0), ta[2]); s0[3] = __builtin_elementwise_fma(s0[3], F2(P##w1, 1), ta[3]); \
                float y0 = RW_DOT(s0, P##r0, P##r1); \
                yo_ = red8(y0); } while (0)
            f32x4 Akk0, Akk1, Aw0, Aw1, Ab0, Ab1, Ak0, Ak1, Ar0, Ar1;
            f32x4 Bkk0, Bkk1, Bw0, Bw1, Bb0, Bb1, Bk0, Bk1, Br0, Br1;
            RW_LOAD(A, 0);
            f32x4 v4 = *(const LAS f32x4*)pv;
#pragma unroll 1
            for (int t = 0; t < TC; t += 4) {
                const f32x4 vn = *(const LAS f32x4*)(pv + t + 4);
                f32x4 y4;
                RW_LOAD(B, t + 1); RW_STEP(A, v4.x, y4.x);
                RW_LOAD(A, t + 2); RW_STEP(B, v4.y, y4.y);
                RW_LOAD(B, t + 3); RW_STEP(A, v4.z, y4.z);
                RW_LOAD(A, t + 4); RW_STEP(B, v4.w, y4.w);
                *(LAS f32x4*)pyw = y4; pyw += pyinc;
                v4 = vn;
            }
#undef RW_LOAD
#undef RW_DOT
#undef RW_STEP
#undef F2
        }
        __syncthreads();
        if (tid >= 256) {
            const int t = (tid - 256) >> 2, c8 = (tid & 3) * 8;
            const LAS float* yr = lds + L_Y + c8 * VS + t;
            u32x4 w; w.x = cvt_pk_bf16(yr[0 * VS], yr[1 * VS]); w.y = cvt_pk_bf16(yr[2 * VS], yr[3 * VS]); w.z = cvt_pk_bf16(yr[4 * VS], yr[5 * VS]); w.w = cvt_pk_bf16(yr[6 * VS], yr[7 * VS]);
            *(u32x4*)(A.Yout + base + (size_t)(ck * TC + t) * 512 + half * 32 + c8) = w;
        }
    }
    __syncthreads();
}

struct PostArgs { const bf16_t *Y, *G, *BON; const float *ln_w, *ln_b, *BS; bf16_t* mixed; };
__device__ __forceinline__ void post_phase(const PostArgs& A, int gw, int ngw, int lane) {
    float lnw[8], lnb[8];
#pragma unroll
    for (int i = 0; i < 8; ++i) { lnw[i] = A.ln_w[lane * 8 + i]; lnb[i] = A.ln_b[lane * 8 + i]; }
    for (int tk = gw; tk < T; tk += ngw) {
        const size_t o = (size_t)tk * 512 + lane * 8;
        const u32x4 y4 = *(const u32x4*)(A.Y + o), g4 = *(const u32x4*)(A.G + o), b4 = *(const u32x4*)(A.BON + o);
        float y[8] = {lo_bf(y4.x), hi_bf(y4.x), lo_bf(y4.y), hi_bf(y4.y), lo_bf(y4.z), hi_bf(y4.z), lo_bf(y4.w), hi_bf(y4.w)};
        const float g[8] = {lo_bf(g4.x), hi_bf(g4.x), lo_bf(g4.y), hi_bf(g4.y), lo_bf(g4.z), hi_bf(g4.z), lo_bf(g4.w), hi_bf(g4.w)};
        const float bo[8] = {lo_bf(b4.x), hi_bf(b4.x), lo_bf(b4.y), hi_bf(b4.y), lo_bf(b4.z), hi_bf(b4.z), lo_bf(b4.w), hi_bf(b4.w)};
        const float bsc = A.BS[(size_t)tk * 8 + (lane >> 3)];
        float sm = 0.f;
#pragma unroll
        for (int i = 0; i < 8; ++i) sm += y[i];
        sm = red8(sm); const float mean = sm * (1.f / 64.f);
        float sv = 0.f;
#pragma unroll
        for (int i = 0; i < 8; ++i) { y[i] -= mean; sv += y[i] * y[i]; }
        sv = red8(sv); const float rstd = 1.f / sqrtf(sv * (1.f / 64.f) + 64e-5f);
        float ov[8];
#pragma unroll
        for (int i = 0; i < 8; ++i) ov[i] = (y[i] * rstd * lnw[i] + lnb[i] + bsc * bo[i]) * g[i];
        u32x4 w; w.x = cvt_pk_bf16(ov[0], ov[1]); w.y = cvt_pk_bf16(ov[2], ov[3]); w.z = cvt_pk_bf16(ov[4], ov[5]); w.w = cvt_pk_bf16(ov[6], ov[7]);
        *(u32x4*)(A.mixed + (size_t)tk * DM + 1536 + lane * 8) = w;
    }
}
}
namespace rwc {
constexpr int TB = 32;
constexpr int NB = SEQ / TB;
constexpr int OPS = 320;
constexpr int L_KK = 0, L_W = 64, L_BN = 128, L_KP = 192, L_R = 256;
constexpr int O_RAW = 0;
constexpr int O_VT = O_RAW + TB * OPS * 4;
constexpr int VT_ROW = 40, VT_BUF = 2 * 64 * VT_ROW;
constexpr int O_IMG = O_VT + 2 * VT_BUF;
constexpr int RS = 144;
constexpr int I_A = 0, I_R = I_A + 16 * RS, I_B = I_R + 16 * RS, I_K = I_B + 16 * RS, I_BKT = I_K + 16 * RS;
constexpr int SR = 80;
constexpr int I_LAK = I_BKT + 64 * SR, I_TP = I_LAK + 16 * SR, I_MM = I_TP + 16 * SR, I_GC = I_MM + 16 * SR, I_LAB = I_GC + 256, IMG_BYTES = I_LAB + 16 * SR;
constexpr int O_YB = O_IMG + 2 * IMG_BYTES;
constexpr int LDS_BYTES = O_YB + TB * 64 * 4;
struct Args { const bf16_t *R, *K, *KK, *B, *V; const float* W; const float* RIN; const bf16_t* G; const float *BS, *ln_w, *ln_b; bf16_t* mixed; };
typedef unsigned short u16;

struct Pre { u32x2 r, k, kk, b, v; f32x4 w; float rin; };
__device__ __forceinline__ void pre_load(Pre& q, const Args& A, size_t off) {
    q.r = *(const u32x2*)(A.R + off); q.k = *(const u32x2*)(A.K + off); q.kk = *(const u32x2*)(A.KK + off); q.b = *(const u32x2*)(A.B + off); q.v = *(const u32x2*)(A.V + off);
    q.w = *(const f32x4*)(A.W + off);
    q.rin = A.RIN[(off >> 9) * 8 + ((off >> 6) & 7)];
}
__device__ __forceinline__ float red16(float x) { x += DPPF(x, 0xB1); x += DPPF(x, 0x4E); x += DPPF(x, 0x141); x += DPPF(x, 0x140); return x; }
__device__ __forceinline__ void st4(LAS float* d, u32x2 w, float sc = 1.f) { *(LAS f32x4*)d = (f32x4){lo_bf(w.x) * sc, hi_bf(w.x) * sc, lo_bf(w.y) * sc, hi_bf(w.y) * sc}; }
__device__ __forceinline__ f32x4 mfma16(u32x4 a, u32x4 b, f32x4 c) { return __builtin_amdgcn_mfma_f32_16x16x32_bf16(__builtin_bit_cast(bf16x8, a), __builtin_bit_cast(bf16x8, b), c, 0, 0, 0); }

__device__ __forceinline__ void item(const Args& A, LAS unsigned char* lds, int bh, const int wv__) {
    const int tid = TID(), lane = tid & 63, wid = __builtin_amdgcn_readfirstlane(tid >> 6);
    const int b = bh >> 3, h = bh & 7;
    const size_t base = (size_t)b * SEQ * 512 + h * 64;
    const int st = tid >> 4, c4 = (tid & 15) * 4;
    const int n16 = lane & 15, g = lane >> 4;
    f32x4 Z[4];
#pragma unroll
    for (int i = 0; i < 4; ++i) Z[i] = (f32x4){0.f, 0.f, 0.f, 0.f};
    u32x4 Zq[2] = {(u32x4){0u, 0u, 0u, 0u}, (u32x4){0u, 0u, 0u, 0u}};
    Pre pre; pre_load(pre, A, base + (size_t)st * 512 + c4);
    LAS float* raw = (LAS float*)(lds + O_RAW);
    LAS float* yb = (LAS float*)(lds + O_YB);
    const f32x4 lnw = *(const f32x4*)(A.ln_w + h * 64 + c4), lnb = *(const f32x4*)(A.ln_b + h * 64 + c4);
    u32x2 vprev = (u32x2){0u, 0u}, gq = (u32x2){0u, 0u}; float bsq = 0.f;
#define RWC_POST(bprev) do { \
        const f32x4 y4 = *(const LAS f32x4*)(yb + st * 64 + c4); \
        float sm = (y4.x + y4.y) + (y4.z + y4.w); sm = red16(sm); const float mean = sm * (1.f / 64.f); \
        const float d0 = y4.x - mean, d1 = y4.y - mean, d2 = y4.z - mean, d3 = y4.w - mean; \
        float sv = (d0 * d0 + d1 * d1) + (d2 * d2 + d3 * d3); sv = red16(sv); const float rstd = 1.f / sqrtf(sv * (1.f / 64.f) + 64e-5f); \
        const float o0 = (d0 * rstd * lnw.x + lnb.x + bsq * lo_bf(vprev.x)) * lo_bf(gq.x), o1 = (d1 * rstd * lnw.y + lnb.y + bsq * hi_bf(vprev.x)) * hi_bf(gq.x); \
        const float o2 = (d2 * rstd * lnw.z + lnb.z + bsq * lo_bf(vprev.y)) * lo_bf(gq.y), o3 = (d3 * rstd * lnw.w + lnb.w + bsq * hi_bf(vprev.y)) * hi_bf(gq.y); \
        *(u32x2*)(A.mixed + ((size_t)b * SEQ + (bprev) * TB + st) * DM + 1536 + h * 64 + c4) = (u32x2){cvt_pk_bf16(o0, o1), cvt_pk_bf16(o2, o3)}; } while (0)
    for (int bt = 0; bt < NB; ++bt) {
        LAS unsigned char* vt = lds + O_VT + (bt & 1) * VT_BUF;
        { LAS float* d = raw + st * OPS + c4;
          st4(d + L_R, pre.r); st4(d + L_KP, pre.k); st4(d + L_KK, pre.kk, pre.rin); st4(d + L_BN, pre.b, pre.rin); *(LAS f32x4*)(d + L_W) = pre.w;
          LAS unsigned char* vd = vt + ((st >> 4) * 64 + c4) * VT_ROW + (st & 15) * 2;
          *(LAS u16*)(vd) = (u16)(pre.v.x & 0xffffu); *(LAS u16*)(vd + VT_ROW) = (u16)(pre.v.x >> 16); *(LAS u16*)(vd + 2 * VT_ROW) = (u16)(pre.v.y & 0xffffu); *(LAS u16*)(vd + 3 * VT_ROW) = (u16)(pre.v.y >> 16); }
        __syncthreads();
        if (bt > 0) RWC_POST(bt - 1);
        vprev = pre.v;
        { const size_t tk = (size_t)b * SEQ + bt * TB + st; gq = *(const u32x2*)(A.G + tk * 512 + h * 64 + c4); bsq = A.BS[tk * 8 + h]; }
        if (bt + 1 < NB) pre_load(pre, A, base + (size_t)((bt + 1) * TB + st) * 512 + c4);
        { const int c = wid >> 2, gg = wid & 3, j = lane;
          LAS unsigned char* img = lds + O_IMG + c * IMG_BYTES;
          const LAS float* rw = raw + (16 * c) * OPS + j;
          float G = 1.f;
          for (int tp = 0; tp < 4 * gg; ++tp) G *= rw[tp * OPS + L_W];
          float bq[4], kq[4];
#pragma unroll
          for (int e = 0; e < 4; ++e) {
              const int t = 4 * gg + e; const LAS float* q = rw + t * OPS;
              const float Gm1 = G; G *= q[L_W]; const float inv = 1.f / G;
              const float at = q[L_KK] * Gm1, rt = q[L_R] * G; bq[e] = q[L_BN] * inv; kq[e] = q[L_KP] * inv;
              LAS unsigned char* o = img + t * RS + j * 2;
              *(LAS u16*)(o + I_A) = f2bf(at); *(LAS u16*)(o + I_R) = f2bf(rt); *(LAS u16*)(o + I_B) = f2bf(bq[e]); *(LAS u16*)(o + I_K) = f2bf(kq[e]);
          }
          *(LAS u32x4*)(img + I_BKT + j * SR + gg * 16) = (u32x4){cvt_pk_bf16(bq[0], bq[1]), cvt_pk_bf16(bq[2], bq[3]), cvt_pk_bf16(kq[0], kq[1]), cvt_pk_bf16(kq[2], kq[3])};
          if (gg == 3) *(LAS float*)(img + I_GC + j * 4) = G;
        }
        __syncthreads();
        { const int c = wid >> 2, tt = wid & 3;
          LAS unsigned char* img = lds + O_IMG + c * IMG_BYTES;
          const LAS unsigned char* ia = img + (tt < 2 ? I_A : I_R) + n16 * RS + g * 16;
          const LAS unsigned char* ib = img + ((tt & 1) ? I_K : I_B) + n16 * RS + g * 16;
          f32x4 p = (f32x4){0.f, 0.f, 0.f, 0.f};
          p = mfma16(*(const LAS u32x4*)ia, *(const LAS u32x4*)ib, p);
          p = mfma16(*(const LAS u32x4*)(ia + 64), *(const LAS u32x4*)(ib + 64), p);
          const int s = n16;
          if (tt == 0) {
              LAS float* lab = (LAS float*)(img + I_LAB);
#pragma unroll
              for (int r = 0; r < 4; ++r) { const int t = 4 * g + r; lab[t * 20 + s] = t > s ? p[r] : 0.f; }
              asm volatile("s_waitcnt lgkmcnt(0)" ::: "memory");
              float T[16];
#pragma unroll
              for (int t = 0; t < 16; ++t) {
                  float a4[4] = {(s == t) ? 1.f : 0.f, 0.f, 0.f, 0.f};
#pragma unroll
                  for (int q4 = 0; q4 * 4 < t; ++q4) {
                      const f32x4 l4 = *(const LAS f32x4*)(lab + t * 20 + 4 * q4);
#pragma unroll
                      for (int e = 0; e < 4; ++e) if (4 * q4 + e < t) a4[e] += l4[e] * T[4 * q4 + e];
                  }
                  T[t] = (a4[0] + a4[1]) + (a4[2] + a4[3]);
              }
#pragma unroll
              for (int t = 0; t < 16; ++t) *(LAS u16*)(img + I_TP + t * SR + (s >> 2) * 16 + (s & 3) * 2) = f2bf(T[t] - ((s == t) ? 1.f : 0.f));
          } else {
              const int ofs = (tt == 1 ? I_LAK : I_MM) + (s >> 2) * 16 + (tt == 3 ? 8 : 0) + (s & 3) * 2;
#pragma unroll
              for (int r = 0; r < 4; ++r) { const int t = 4 * g + r; const bool keep = tt == 1 ? (t > s) : (t >= s); *(LAS u16*)(img + ofs + t * SR) = f2bf(keep ? p[r] : 0.f); }
          }
        }
        __syncthreads();
        if (wid < 4) {
            const int i = 16 * wid + n16;
#pragma unroll 1
            for (int c = 0; c < 2; ++c) {
                const LAS unsigned char* img = lds + O_IMG + c * IMG_BYTES;
                const LAS unsigned char* ra = img + n16 * RS + g * 8;
                f32x4 D1 = (f32x4){0.f, 0.f, 0.f, 0.f}, D2 = D1;
#pragma unroll
                for (int ks = 0; ks < 2; ++ks) {
                    const u32x2 a0 = *(const LAS u32x2*)(ra + I_A + ks * 64), a1 = *(const LAS u32x2*)(ra + I_A + ks * 64 + 32);
                    const u32x2 r0 = *(const LAS u32x2*)(ra + I_R + ks * 64), r1 = *(const LAS u32x2*)(ra + I_R + ks * 64 + 32);
                    D1 = mfma16((u32x4){a0.x, a0.y, a1.x, a1.y}, Zq[ks], D1);
                    D2 = mfma16((u32x4){r0.x, r0.y, r1.x, r1.y}, Zq[ks], D2);
                }
                const u32x2 vv = *(const LAS u32x2*)(vt + (c * 64 + i) * VT_ROW + g * 8);
                const u32x2 al = *(const LAS u32x2*)(img + I_LAK + n16 * SR + g * 16);
                D1 = mfma16((u32x4){al.x, al.y, 0u, 0u}, (u32x4){vv.x, vv.y, 0u, 0u}, D1);
                const u32x2 at = *(const LAS u32x2*)(img + I_TP + n16 * SR + g * 16);
                const f32x4 U = mfma16((u32x4){at.x, at.y, 0u, 0u}, (u32x4){cvt_pk_bf16(D1[0], D1[1]), cvt_pk_bf16(D1[2], D1[3]), 0u, 0u}, D1);
                const u32x4 buv = (u32x4){cvt_pk_bf16(U[0], U[1]), cvt_pk_bf16(U[2], U[3]), vv.x, vv.y};
                const f32x4 Y = mfma16(*(const LAS u32x4*)(img + I_MM + n16 * SR + g * 16), buv, D2);
#pragma unroll
                for (int jt = 0; jt < 4; ++jt) {
                    Z[jt] = mfma16(*(const LAS u32x4*)(img + I_BKT + (16 * jt + n16) * SR + g * 16), buv, Z[jt]);
                    const f32x4 gc = *(const LAS f32x4*)(img + I_GC + (16 * jt + 4 * g) * 4);
                    Z[jt] = Z[jt] * gc;
                }
                Zq[0] = (u32x4){cvt_pk_bf16(Z[0][0], Z[0][1]), cvt_pk_bf16(Z[0][2], Z[0][3]), cvt_pk_bf16(Z[1][0], Z[1][1]), cvt_pk_bf16(Z[1][2], Z[1][3])};
                Zq[1] = (u32x4){cvt_pk_bf16(Z[2][0], Z[2][1]), cvt_pk_bf16(Z[2][2], Z[2][3]), cvt_pk_bf16(Z[3][0], Z[3][1]), cvt_pk_bf16(Z[3][2], Z[3][3])};
                LAS float* yo = yb + (16 * c + 4 * g) * 64 + i;
#pragma unroll
                for (int r = 0; r < 4; ++r) yo[r * 64] = Y[r];
            }
        }
    }
    __syncthreads();
    RWC_POST(NB - 1);
    __syncthreads();
#undef RWC_POST
}
}
namespace hg {
constexpr int C = 64, NCH = SEQ / C, HD = 128;
constexpr int RS128 = 272, RS64 = 144;
constexpr int O_QM = 0, O_KM = O_QM + C * RS128, O_QE = O_KM + C * RS128, O_KET = O_QE + C * RS128, O_VT = O_KET + HD * RS64,
              O_STT = O_VT + HD * RS64, O_P = O_STT + HD * RS128, O_TOT = O_P + C * RS64, O_DEC = O_TOT + 4 * HD * 4, O_END = O_DEC + HD * 4;
constexpr int OB_STRIDE = 132;
static_assert(C * OB_STRIDE * 4 <= 2 * C * RS128, "OBUF alias");
constexpr int LDS_BYTES = O_END;
struct Args { const bf16_t* p; const float* lb; const float* out_gain; bf16_t* mixed; };

__device__ __forceinline__ bf16x8 lda8(const LAS unsigned char* base, int row, int rs, int colB) { return *(const LAS bf16x8*)(base + row * rs + colB); }

__device__ __forceinline__ void item(const Args& A, LAS unsigned char* lds, int bh, const int wv__) {
    const int tid = TID(), lane = tid & 63, wid = __builtin_amdgcn_readfirstlane(tid >> 6), r32 = lane & 31, hi = lane >> 5;
    const int b = bh >> 2, h = bh & 3;
    const int ch = tid & 127, part = tid >> 7;
    const float lbc = A.lb[h * HD + ch], omlb = 1.f - lbc;
    const bf16_t* pbase = A.p + (size_t)b * SEQ * NP + h * HD;
    f32x16 sacc[2]; sacc[0] = f32x16{}; sacc[1] = f32x16{};
    const int kb = wid >> 1, vb0 = 2 * (wid & 1);
    for (int i = tid; i < HD * RS128 / 16; i += 512) *(LAS u32x4*)(lds + O_STT + i * 16) = (u32x4){0u, 0u, 0u, 0u};
    LAS float* tot = (LAS float*)(lds + O_TOT);
    LAS float* dec = (LAS float*)(lds + O_DEC);
    LAS float* obuf = (LAS float*)(lds + O_QM);
    bf16_t rq[16], rf[16], ri[16];
    { const bf16_t* pc0 = pbase + (size_t)(part * 16) * NP + ch;
#pragma unroll
      for (int i = 0; i < 16; ++i) { rf[i] = pc0[(size_t)i * NP + C_HF]; rq[i] = pc0[(size_t)i * NP + C_HQ]; ri[i] = pc0[(size_t)i * NP + C_HI]; } }
    for (int ck = 0; ck < NCH; ++ck) {
        const size_t tk_e = (size_t)b * SEQ + ck * C + (tid >> 3);
        const bf16_t* gp_e = A.p + tk_e * NP + C_HG + h * HD + (tid & 7) * 16;
        const u32x4 g0 = *(const u32x4*)gp_e, g1 = *(const u32x4*)(gp_e + 8);
        float lf[16], qv[16], kv[16];
        float run = 0.f;
#pragma unroll
        for (int i = 0; i < 16; ++i) {
            const float z = bf2f(rf[i]);
            const float sg = sigmoidf_(z);
            const float f = lbc + omlb * sg;
            kv[i] = 1.f - f;
            run += __logf(f); lf[i] = run;
            qv[i] = siluf_(bf2f(rq[i]));
        }
        tot[part * HD + ch] = run;
        { unsigned w[8];
#pragma unroll
          for (int i = 0; i < 8; ++i) w[i] = (unsigned)ri[2 * i] | ((unsigned)ri[2 * i + 1] << 16);
          LAS u32x4* d = (LAS u32x4*)(lds + O_VT + ch * RS64 + part * 32);
          d[0] = (u32x4){w[0], w[1], w[2], w[3]}; d[1] = (u32x4){w[4], w[5], w[6], w[7]}; }
        __syncthreads();
        if (ck + 1 < NCH) { const bf16_t* pcn = pbase + (size_t)((ck + 1) * C + part * 16) * NP + ch;
#pragma unroll
            for (int i = 0; i < 16; ++i) { rf[i] = pcn[(size_t)i * NP + C_HF]; rq[i] = pcn[(size_t)i * NP + C_HQ]; ri[i] = pcn[(size_t)i * NP + C_HI]; } }
        float off = 0.f;
#pragma unroll
        for (int pp = 0; pp < 4; ++pp) off += (pp < part) ? tot[pp * HD + ch] : 0.f;
        const float bref = tot[ch] + tot[HD + ch];
        const float blast = bref + tot[2 * HD + ch] + tot[3 * HD + ch];
        const float c_blast = __expf(blast), c_bref = __expf(bref), c_nbref = fast_rcp(c_bref);
        if (part == 0) dec[ch] = c_blast;
        {
            unsigned wk[8];
#pragma unroll
            for (int i = 0; i < 16; ++i) {
                const float bt = off + lf[i];
                const int t = part * 16 + i;
                const float e1 = __expf(fmaxf(bt, -80.f)), e2 = fast_rcp(e1);
                const float qe = qv[i] * e1, qm = qe * c_nbref, km = kv[i] * e2 * c_bref, ke = kv[i] * e2 * c_blast;
                *(LAS bf16_t*)(lds + O_QM + t * RS128 + ch * 2) = f2bf(qm);
                *(LAS bf16_t*)(lds + O_KM + t * RS128 + ch * 2) = f2bf(km);
                *(LAS bf16_t*)(lds + O_QE + t * RS128 + ch * 2) = f2bf(qe);
                if (i & 1) wk[i >> 1] |= ((unsigned)f2bf(ke)) << 16; else wk[i >> 1] = (unsigned)f2bf(ke);
            }
            LAS u32x4* d = (LAS u32x4*)(lds + O_KET + ch * RS64 + part * 32);
            d[0] = (u32x4){wk[0], wk[1], wk[2], wk[3]}; d[1] = (u32x4){wk[4], wk[5], wk[6], wk[7]};
        }
        __syncthreads();
        if (wid < 3) {
            const int ti = wid == 0 ? 0 : 1, si = wid == 2 ? 1 : 0;
            f32x16 sc = f32x16{};
#pragma unroll
            for (int ks = 0; ks < 8; ++ks) {
                const bf16x8 a = lda8(lds + O_QM, ti * 32 + r32, RS128, (ks * 16 + hi * 8) * 2);
                const bf16x8 bb = lda8(lds + O_KM, si * 32 + r32, RS128, (ks * 16 + hi * 8) * 2);
                sc = __builtin_amdgcn_mfma_f32_32x32x16_bf16(a, bb, sc, 0, 0, 0);
            }
#pragma unroll
            for (int r = 0; r < 16; ++r) { const int tl = (r & 3) + 8 * (r >> 2) + 4 * hi; const int tg = ti * 32 + tl, sg = si * 32 + r32;
                const float v = (sg <= tg) ? sc[r] : 0.f;
                *(LAS bf16_t*)(lds + O_P + tg * RS64 + sg * 2) = f2bf(v); }
        } else if (wid == 3) {
#pragma unroll
            for (int r = 0; r < 16; ++r) { const int tl = (r & 3) + 8 * (r >> 2) + 4 * hi; *(LAS bf16_t*)(lds + O_P + tl * RS64 + (32 + r32) * 2) = (bf16_t)0; }
        }
        __syncthreads();
        {
            const int ti = wid >> 2, vj = wid & 3;
            f32x16 oc = f32x16{};
#pragma unroll
            for (int ks = 0; ks < 8; ++ks) {
                const bf16x8 a = lda8(lds + O_QE, ti * 32 + r32, RS128, (ks * 16 + hi * 8) * 2);
                const bf16x8 bb = lda8(lds + O_STT, vj * 32 + r32, RS128, (ks * 16 + hi * 8) * 2);
                oc = __builtin_amdgcn_mfma_f32_32x32x16_bf16(a, bb, oc, 0, 0, 0);
            }
#pragma unroll
            for (int ss = 0; ss < 4; ++ss) {
                const bf16x8 a = lda8(lds + O_P, ti * 32 + r32, RS64, (ss * 16 + hi * 8) * 2);
                const bf16x8 bb = lda8(lds + O_VT, vj * 32 + r32, RS64, (ss * 16 + hi * 8) * 2);
                oc = __builtin_amdgcn_mfma_f32_32x32x16_bf16(a, bb, oc, 0, 0, 0);
            }
#pragma unroll
            for (int r = 0; r < 16; ++r) { const int tl = (r & 3) + 8 * (r >> 2) + 4 * hi; obuf[(ti * 32 + tl) * OB_STRIDE + vj * 32 + r32] = oc[r]; }
        }
#pragma unroll
        for (int j = 0; j < 2; ++j) {
#pragma unroll
            for (int r = 0; r < 16; ++r) { const int kl = (r & 3) + 8 * (r >> 2) + 4 * hi; sacc[j][r] *= dec[kb * 32 + kl]; }
#pragma unroll
            for (int ss = 0; ss < 4; ++ss) {
                const bf16x8 a = lda8(lds + O_KET, kb * 32 + r32, RS64, (ss * 16 + hi * 8) * 2);
                const bf16x8 bb = lda8(lds + O_VT, (vb0 + j) * 32 + r32, RS64, (ss * 16 + hi * 8) * 2);
                sacc[j] = __builtin_amdgcn_mfma_f32_32x32x16_bf16(a, bb, sacc[j], 0, 0, 0);
            }
        }
        __syncthreads();
#pragma unroll
        for (int j = 0; j < 2; ++j)
#pragma unroll
            for (int g = 0; g < 4; ++g) {
                u32x2 w; w.x = cvt_pk_bf16(sacc[j][4 * g], sacc[j][4 * g + 1]); w.y = cvt_pk_bf16(sacc[j][4 * g + 2], sacc[j][4 * g + 3]);
                *(LAS u32x2*)(lds + O_STT + ((vb0 + j) * 32 + r32) * RS128 + (kb * 32 + 8 * g + 4 * hi) * 2) = w;
            }
        {
            const int t = tid >> 3, c0 = (tid & 7) * 16;
            const LAS float* orow = obuf + t * OB_STRIDE + c0;
            float o[16]; float ss = 0.f;
#pragma unroll
            for (int i = 0; i < 4; ++i) { const f32x4 x = *(const LAS f32x4*)(orow + 4 * i); o[4 * i] = x.x; o[4 * i + 1] = x.y; o[4 * i + 2] = x.z; o[4 * i + 3] = x.w; ss += x.x * x.x + x.y * x.y + x.z * x.z + x.w * x.w; }
            ss = sum8f(ss);
            const float rn = 1.f / sqrtf(ss * (1.f / 128.f) + RMS_EPS);
            const size_t tk = tk_e;
            const float gr[16] = {lo_bf(g0.x), hi_bf(g0.x), lo_bf(g0.y), hi_bf(g0.y), lo_bf(g0.z), hi_bf(g0.z), lo_bf(g0.w), hi_bf(g0.w),
                                  lo_bf(g1.x), hi_bf(g1.x), lo_bf(g1.y), hi_bf(g1.y), lo_bf(g1.z), hi_bf(g1.z), lo_bf(g1.w), hi_bf(g1.w)};
            float ov[16];
#pragma unroll
            for (int i = 0; i < 16; ++i) ov[i] = o[i] * rn * A.out_gain[c0 + i] * siluf_(gr[i]);
            u32x4 w0, w1;
            w0.x = cvt_pk_bf16(ov[0], ov[1]); w0.y = cvt_pk_bf16(ov[2], ov[3]); w0.z = cvt_pk_bf16(ov[4], ov[5]); w0.w = cvt_pk_bf16(ov[6], ov[7]);
            w1.x = cvt_pk_bf16(ov[8], ov[9]); w1.y = cvt_pk_bf16(ov[10], ov[11]); w1.z = cvt_pk_bf16(ov[12], ov[13]); w1.w = cvt_pk_bf16(ov[14], ov[15]);
            bf16_t* mp = A.mixed + tk * DM + h * HD + c0;
            *(u32x4*)mp = w0; *(u32x4*)(mp + 8) = w1;
        }
        __syncthreads();
    }
}
}
#define RLX_AGENT __ATOMIC_RELAXED, __HIP_MEMORY_SCOPE_AGENT
#define XB_TMO      128
#define XB_XCNT(j)  (256  + 64 * (j))
#define XB_XSUB(j)  (1280 + 64 * (j))
#define XB_XGEN(j)  (2304 + 64 * (j))
#define XB_TOP      3328
#define XB_TOPGEN   3392
#define XCD_BAR_WORDS 3456
#define XB_SPIN_CAP (1u << 18)

__device__ __forceinline__ unsigned xb_ld(unsigned* p)              { return __hip_atomic_load(p, __ATOMIC_RELAXED, __HIP_MEMORY_SCOPE_AGENT); }
__device__ __forceinline__ unsigned xb_add(unsigned* p, unsigned v) { return __hip_atomic_fetch_add(p, v, __ATOMIC_RELAXED, __HIP_MEMORY_SCOPE_AGENT); }
__device__ __forceinline__ unsigned xb_xcc_id() { return (unsigned)__builtin_amdgcn_s_getreg((3 << 11) | 20) & 0xFu; }
#define XB_SPIN(cond, bar) do { unsigned _sp = 0; while (cond) { __builtin_amdgcn_s_sleep(1); \
    if ((++_sp & 255u) == 0u) { if (xb_ld(&(bar)[XB_TMO])) break; if (_sp > XB_SPIN_CAP) { atomicAdd(&(bar)[XB_TMO], 1u); break; } } } } while (0)

struct XcdBarrier {
    unsigned* bar; unsigned x;
    volatile LAS unsigned* st;
};

__device__ __forceinline__ XcdBarrier xcd_barrier_post(unsigned* bar, volatile LAS unsigned* st, const int wv__) {
    XcdBarrier b; b.bar = bar; b.x = xb_xcc_id(); b.st = st;
    if (TID() == 0) (void)xb_add(&bar[XB_XCNT(b.x)], 1u);
    return b;
}
__device__ __forceinline__ void xcd_barrier_complete(unsigned* bar, unsigned x, unsigned& nloc, unsigned& nx) {
    const unsigned G = gridDim.x * gridDim.y * gridDim.z;
    unsigned sum, cnt, mine, sp = 0u;
    for (;;) {
        sum = 0u; cnt = 0u; mine = 0u;
#pragma unroll
        for (unsigned j = 0; j < 16; ++j) { const unsigned c = xb_ld(&bar[XB_XCNT(j)]); sum += c; cnt += (c > 0u) ? 1u : 0u; mine = (j == x) ? c : mine; }
        if (sum == G) break;
        __builtin_amdgcn_s_sleep(1);
        if ((++sp & 255u) == 0u) { if (xb_ld(&bar[XB_TMO])) break; if (sp > XB_SPIN_CAP) { atomicAdd(&bar[XB_TMO], 1u); break; } }
    }
    nloc = mine > 0u ? mine : 1u; nx = cnt > 0u ? cnt : 1u;
}

__device__ __forceinline__ void xcd_barrier(const XcdBarrier& b, const int wv__) {
    asm volatile("s_waitcnt vmcnt(0)" ::: "memory");
    __syncthreads();
    if (TID() == 0) {
        unsigned* bar = b.bar;
        __builtin_amdgcn_s_waitcnt(0);
        unsigned nloc = b.st[0], nx = b.st[1];
        if (nloc == 0u) { xcd_barrier_complete(bar, b.x, nloc, nx); b.st[0] = nloc; b.st[1] = nx; }
        const unsigned old = xb_add(&bar[XB_XSUB(b.x)], 1u);
        const unsigned gen = old / nloc;
        if (old + 1u == (gen + 1u) * nloc) {
            __builtin_amdgcn_fence(__ATOMIC_RELEASE, "agent");
            asm volatile("s_waitcnt vmcnt(0)" ::: "memory");
            const unsigned og = xb_add(&bar[XB_TOP], 1u);
            const unsigned tg = og / nx;
            if (og + 1u == (tg + 1u) * nx) xb_add(&bar[XB_TOPGEN], 1u);
            else XB_SPIN(xb_ld(&bar[XB_TOPGEN]) == tg, bar);
            __builtin_amdgcn_fence(__ATOMIC_ACQUIRE, "agent");
            xb_add(&bar[XB_XGEN(b.x)], 1u);
            asm volatile("s_waitcnt vmcnt(0)" ::: "memory");
        } else {
            XB_SPIN(xb_ld(&bar[XB_XGEN(b.x)]) == gen, bar);
            __builtin_amdgcn_fence(__ATOMIC_ACQUIRE, "agent");
            asm volatile("s_waitcnt vmcnt(0)" ::: "memory");
        }
    }
    __syncthreads();
}

constexpr int NTHREADS = 512, NWAVES = 8;
constexpr int LDS_ALL = 153600;
static_assert(LDS_ALL >= hg::LDS_BYTES && LDS_ALL >= tok::LDS_BYTES && LDS_ALL >= rwk::LDS_BYTES && LDS_ALL >= rwc::LDS_BYTES && LDS_ALL >= att::LDS_BYTES && LDS_ALL >= pg8::STAGE_BYTES, "LDS");
constexpr int CW_BAR = 4096;
constexpr int PH_PER_LAYER = 7, N_PHASES = 1 + DEPTH * PH_PER_LAYER;

struct KArgs { Ptrs P; int ph_lo, ph_hi, coop, pad; };

#ifdef DUP_TOKMODE
#define TOKMODE (rep ? DUP_TOKMODE : 7)
#else
#define TOKMODE 7
#endif
template <int ph>
__device__ __forceinline__ void run_phase(LAS unsigned char* lds, unsigned char* lds_raw, cg::grid_group& grid, const int G, const int bid, const int wv__) {
        const KArgs __attribute__((address_space(4)))* ka = (const KArgs __attribute__((address_space(4)))*)__builtin_amdgcn_kernarg_segment_ptr();
        asm volatile("" : "+s"(ka));
#define PIN(i) (ka->P.in[i])
        const int tid = TID(), lane = tid & 63, wid = __builtin_amdgcn_readfirstlane(tid >> 6);
        const int gw = bid * NWAVES + wid, ngw = G * NWAVES;
        unsigned char* ws = ka->P.ws;
        float* x = ka->P.out;
        bf16_t* xb = (bf16_t*)(ws + WS_XB); bf16_t* pbuf = (bf16_t*)(ws + WS_P); bf16_t* mixed = (bf16_t*)(ws + WS_MIX);
        bf16_t* qbuf = (bf16_t*)(ws + WS_Q); bf16_t* kvbuf = (bf16_t*)(ws + WS_KV); bf16_t* krbuf = (bf16_t*)(ws + WS_KR);
        bf16_t* act = (bf16_t*)(ws + WS_ACT);
        float* ssA = (float*)(ws + WS_SSA); float* ssB = (float*)(ws + WS_SSBP); float* rsb = (float*)(ws + WS_RS); float* rsq = (float*)(ws + WS_RSQ); float* rskv = (float*)(ws + WS_RSKV);
        const int* pos = (const int*)PIN(1);
        if constexpr (ph == 0) {
            prologue_phase(&ka->P, (LAS float*)lds + wid * (64 * 65), gw, ngw, lane);
#ifdef DUP_PRO
            __syncthreads(); prologue_phase(&ka->P, (LAS float*)lds + wid * (64 * 65), gw, ngw, lane);
#endif
        } else {
            constexpr int l = (ph - 1) / PH_PER_LAYER, sp = (ph - 1) % PH_PER_LAYER;
            unsigned char* wl = ws + WS_W + (size_t)l * W_LAYER;
#ifdef DUP_SP
            const int nrep = (sp == DUP_SP) ? 2 : 1;
#else
            const int nrep = 1;
#endif
            for (int rep = 0; rep < nrep; ++rep) {
            if (rep) { XcdBarrier xb; xb.bar = (unsigned*)(ws + WS_CTL) + CW_BAR; xb.x = xb_xcc_id(); xb.st = (volatile LAS unsigned*)(lds + LDS_ALL - 128); xcd_barrier(xb, wv__); }
            switch (sp) {
            case 0: {
                pg8::Gemm g{xb, (const bf16_t*)(wl + WO_IN), T, NP, DM, DM}; pg8::StaticOrder S; S.init(T, NP, G, bid);
                pg8::prep_row_scales(ssA, rsb, S, tid);
                pg8::EpiScaleBf16 E{pbuf, rsb, NP, 0};
                pg8::gemm_phase<pg8::EpiScaleBf16, pg8::StaticOrder, true, true>(lds, g, S, E, wv__);
            } break;
            case 1: {
                tok::Args A;
                A.p = pbuf; A.pos = pos; A.k_gain = PIN(11) + l * 192;
                A.mu = PIN(12) + l * 1792; A.w0 = PIN(13) + l * 512; A.a0 = PIN(15) + l * 512;
                constexpr int lm = l > 0 ? l - 1 : 0;
                A.v0 = PIN(18) + lm * 512;
                A.k_k = PIN(21) + l * 512; A.k_a = PIN(22) + l * 512; A.r_k = PIN(23) + l * 512;
                A.wl = (const bf16_t*)(wl + WO_LORA);
                A.rs_q = rsq; A.rs_kv = rskv; A.kr = krbuf;
                A.R = (bf16_t*)(ws + WS_RWR); A.K = (bf16_t*)(ws + WS_RWK); A.V = (bf16_t*)(ws + WS_RWV); A.KK = (bf16_t*)(ws + WS_RWKK); A.B = (bf16_t*)(ws + WS_RWB);
                A.G = (bf16_t*)((unsigned char*)x + 64 * MiB); A.BON = (bf16_t*)((unsigned char*)x + 96 * MiB); A.VFIRST = (bf16_t*)(ws + WS_VFIRST); A.W = (float*)((unsigned char*)x); A.RIN = (float*)(ws + WS_RIN); A.BS = (float*)(ws + WS_BS);
#ifdef TOKPROBE
                if (rep) { unsigned char* dq = ws + WS_Q; A.R = (bf16_t*)dq; A.K = (bf16_t*)(dq + 32 * MiB); A.V = (bf16_t*)(dq + 64 * MiB); A.KK = (bf16_t*)(dq + 96 * MiB); A.B = (bf16_t*)(dq + 128 * MiB);
                    A.G = (bf16_t*)(dq + 160 * MiB); A.VFIRST = l == 0 ? (bf16_t*)(dq + 192 * MiB) : A.VFIRST; A.W = (float*)(ws + WS_MIX); A.RIN = (float*)(ws + WS_MIX + 64 * MiB); A.BS = (float*)(ws + WS_MIX + 65 * MiB); }
#endif
                tok::stage_params(A, lds, tid);
                for (int tl = bid; tl < tok::NTILES; tl += G) tok::tile<l>(A, lds, tl, wv__, TOKMODE);
            } break;
            case 2: {
                { pg8::Gemm g{pbuf + C_MQ, (const bf16_t*)(wl + WO_QB), T, QW, 512, NP}; pg8::StaticOrder S; S.init(T, QW, G, bid);
                  pg8::EpiPlainBf16 E{qbuf, QW, 0};
                  pg8::gemm_phase<pg8::EpiPlainBf16, pg8::StaticOrder, true, true>(lds, g, S, E, wv__); }
                { pg8::Gemm g{pbuf + C_MKV, (const bf16_t*)(wl + WO_KVB), T, KVW, 256, NP}; pg8::StaticOrder S; S.init(T, KVW, G, bid);
                  pg8::EpiKV E{kvbuf, rskv, PIN(11) + l * 192, (LAS float*)(lds + pg8::STAGE_BYTES), KVW, 0};
                  pg8::gemm_phase<pg8::EpiKV, pg8::StaticOrder, true, true>(lds, g, S, E, wv__); }
            } break;
            case 3: {
                unsigned* ctr = (unsigned*)(ws + WS_CTL) + 64 * l + 16 * rep;
                LAS int* qslot = (LAS int*)(lds + LDS_ALL - 64);
                constexpr int NQ = 96 + att::N_BLOCKS;
#ifdef DUP_MIX
                const int qlo = rep ? (DUP_MIX == 1 ? 0 : DUP_MIX == 2 ? 64 : 96) : 0, qhi = rep ? (DUP_MIX == 1 ? 64 : DUP_MIX == 2 ? 96 : NQ) : NQ;
#else
                const int qlo = 0, qhi = NQ;
#endif
#ifdef CONV_IN_MIXERS
                if constexpr (l + 1 < DEPTH) {
                    if (!rep && bid % CONV_EVERY == 0) {
                        for (;;) {
                            __syncthreads();
                            if (tid == 0) *qslot = (int)__hip_atomic_fetch_add(ctr + 8, 1u, __ATOMIC_RELAXED, __HIP_MEMORY_SCOPE_AGENT);
                            __syncthreads();
                            const int ci = __builtin_amdgcn_readfirstlane(*qslot);
                            if (ci >= CV_ITEMS) break;
                            convert_queue_item(&ka->P, l + 1, ci, (LAS float*)lds + wid * (64 * 65), wid, lane);
                        }
                    }
                }
#endif
                for (;;) {
                    __syncthreads();
                    if (tid == 0) *qslot = (int)__hip_atomic_fetch_add(ctr, 1u, __ATOMIC_RELAXED, __HIP_MEMORY_SCOPE_AGENT);
                    __syncthreads();
                    const int it = qlo + __builtin_amdgcn_readfirstlane(*qslot);
                    if (it >= qhi) break;
                    if (it < 64) {
                        rwc::Args RA; RA.R = (const bf16_t*)(ws + WS_RWR); RA.K = (const bf16_t*)(ws + WS_RWK); RA.V = (const bf16_t*)(ws + WS_RWV); RA.KK = (const bf16_t*)(ws + WS_RWKK);
                        RA.B = (const bf16_t*)(ws + WS_RWB); RA.W = (const float*)((unsigned char*)x); RA.RIN = (const float*)(ws + WS_RIN);
                        RA.G = (const bf16_t*)((unsigned char*)x + 64 * MiB); RA.BS = (const float*)(ws + WS_BS); RA.ln_w = PIN(24) + l * 512; RA.ln_b = PIN(25) + l * 512;
                        RA.mixed = rep ? (bf16_t*)((unsigned char*)x + 128 * MiB) : mixed;
                        rwc::item(RA, lds, it, wv__);
                    } else if (it < 96) {
                        hg::Args HA; HA.p = pbuf; HA.lb = (const float*)(ws + WS_LB) + l * 512; HA.out_gain = PIN(5) + l * 128; HA.mixed = mixed;
                        hg::item(HA, lds, it - 64, wv__);
                    }
                    else att::attn_one((char*)lds_raw, qbuf, kvbuf, krbuf, mixed, it - 96, pos, PIN(10) + l * 192, wv__);
                }
            } break;
            case 4: {
                pg8::Gemm g{mixed, (const bf16_t*)(wl + WO_O), T, DM, DM, DM}; pg8::StaticOrder S; S.init(T, DM, G, bid);
                pg8::EpiResidB E{l == 0 ? PIN(0) : (const float*)nullptr, (float*)nullptr, xb, ssB, DM, 0};
                pg8::gemm_phase<pg8::EpiResidB, pg8::StaticOrder, true, true>(lds, g, S, E, wv__);
            } break;
            case 5: {
                pg8::Gemm g{xb, (const bf16_t*)(wl + WO_GU), T, 2 * FF, DM, DM}; pg8::StaticOrder S; S.init(T, 2 * FF, G, bid);
                pg8::prep_row_scales(ssB, rsb, S, tid);
                pg8::EpiSwiGLU E{act, rsb, FF, 0};
                pg8::gemm_phase<pg8::EpiSwiGLU, pg8::StaticOrder, true, true>(lds, g, S, E, wv__);
            } break;
            case 6: {
                pg8::Gemm g{act, (const bf16_t*)(wl + WO_DN), T, DM, FF, FF}; pg8::StaticOrder S; S.init(T, DM, G, bid);
                pg8::EpiResidB E{(const float*)nullptr, l == DEPTH - 1 ? x : (float*)nullptr, xb, ssA, DM, 0};
                pg8::gemm_phase<pg8::EpiResidB, pg8::StaticOrder, true, true>(lds, g, S, E, wv__);
            } break;
            }
            }
        }
}
template <int PH0, int PH1>
__device__ __forceinline__ void run_phases(LAS unsigned char* lds, unsigned char* lds_raw, cg::grid_group& grid, const int G, const int bid, const int wv__) {
    if constexpr (PH0 < PH1) {
        run_phase<PH0>(lds, lds_raw, grid, G, bid, wv__);
        if constexpr (PH0 + 1 < PH1) {
            const KArgs __attribute__((address_space(4)))* ka = (const KArgs __attribute__((address_space(4)))*)__builtin_amdgcn_kernarg_segment_ptr();
            XcdBarrier xb; xb.bar = (unsigned*)(ka->P.ws + WS_CTL) + CW_BAR; xb.x = xb_xcc_id(); xb.st = (volatile LAS unsigned*)(lds + LDS_ALL - 128);
            xcd_barrier(xb, wv__);
        }
        run_phases<PH0 + 1, PH1>(lds, lds_raw, grid, G, bid, wv__);
    }
}
__global__ void __launch_bounds__(NTHREADS, 2) mega(KArgs args) {
    extern __shared__ __attribute__((aligned(16))) unsigned char lds_raw[];
    LAS unsigned char* lds = (LAS unsigned char*)lds_raw;
    const int G = gridDim.x, bid = blockIdx.x;
    const int wv__ = __builtin_amdgcn_readfirstlane((int)threadIdx.x >> 6);
    cg::grid_group grid = cg::this_grid();
    {
        volatile LAS unsigned* st = (volatile LAS unsigned*)(lds + LDS_ALL - 128);
        if (threadIdx.x < 2) st[threadIdx.x] = 0u;
        __syncthreads();
        (void)xcd_barrier_post((unsigned*)(args.P.ws + WS_CTL) + CW_BAR, st, wv__);
        grid.sync();
    }
#ifdef DUP_SYNC
    for (int i = 0; i < DUP_SYNC; ++i) { XcdBarrier xb; xb.bar = (unsigned*)(args.P.ws + WS_CTL) + CW_BAR; xb.x = xb_xcc_id(); xb.st = (volatile LAS unsigned*)(lds + LDS_ALL - 128); xcd_barrier(xb, wv__); }
#endif
    run_phases<0, N_PHASES>(lds, lds_raw, grid, G, bid, wv__);
}

extern "C" void kernel_launch(void* const* d_in, const int* in_sizes, int n_in, void* d_out, int out_size, void* d_ws, size_t ws_size, hipStream_t stream) {
    static int grid = 0;
    if (grid == 0) {
        int dev = 0, cus = 0, per_cu = 0;
        hipGetDevice(&dev);
        hipDeviceGetAttribute(&cus, hipDeviceAttributeMultiprocessorCount, dev);
        hipFuncSetAttribute((const void*)mega, hipFuncAttributeMaxDynamicSharedMemorySize, LDS_ALL);
        hipOccupancyMaxActiveBlocksPerMultiprocessor(&per_cu, (const void*)mega, NTHREADS, LDS_ALL);
        if (per_cu < 1) { fprintf(stderr, "kernel_launch: occupancy query says %d blocks/CU\n", per_cu); per_cu = 1; }
        grid = cus * 1;
        if (ws_size < WS_END) fprintf(stderr, "kernel_launch: workspace too small: %zu < %zu\n", ws_size, (size_t)WS_END);
        (void)hipGetLastError();
    }
    hipMemsetAsync((char*)d_ws + WS_CTL, 0, CTL_BYTES, stream);
    KArgs a{};
    for (int i = 0; i < 30; ++i) a.P.in[i] = (const float*)d_in[i];
    a.P.out = (float*)d_out; a.P.ws = (unsigned char*)d_ws;
#if MK_COOP
    a.ph_lo = 0; a.ph_hi = N_PHASES; a.coop = 1;
    void* kargs[] = {&a};
    hipError_t e = hipLaunchCooperativeKernel((const void*)mega, dim3(grid), dim3(NTHREADS), kargs, LDS_ALL, stream);
    if (e != hipSuccess) fprintf(stderr, "cooperative launch failed: %s (grid %d)\n", hipGetErrorString(e), grid);
#else
    for (int ph = 0; ph < N_PHASES; ++ph) {
        a.ph_lo = ph; a.ph_hi = ph + 1; a.coop = 0;
        hipLaunchKernelGGL(mega, dim3(grid), dim3(NTHREADS), LDS_ALL, stream, a);
    }
#endif
}
```

```cpp
#include <hip/hip_runtime.h>
#include <hip/hip_bf16.h>
#include <hip/hip_cooperative_groups.h>
#include <cstdio>
#include <cstdint>
namespace cg = cooperative_groups;

constexpr int BATCH = 8, SEQ = 4096, DM = 2048, DEPTH = 4;
constexpr int T = BATCH * SEQ;
constexpr int NP = 4864;
constexpr int INW = 4672;
constexpr int FF = 5632;
constexpr int C_HQ = 0, C_HF = 512, C_HI = 1024, C_HG = 1536, C_MQ = 2048, C_MKV = 2560, C_MKR = 2816, C_RW = 2880;
constexpr int C_RR = C_RW, C_RK = C_RW + 512, C_RV = C_RW + 1024, C_RWD = C_RW + 1536, C_RAD = C_RW + 1600, C_RGD = C_RW + 1664;
constexpr int QW = 1536, KVW = 2048;
constexpr float RMS_EPS = 1e-6f;

typedef unsigned short bf16_t;
typedef short bf16x8 __attribute__((ext_vector_type(8)));
typedef short s16x4 __attribute__((ext_vector_type(4)));
typedef float f32x2 __attribute__((ext_vector_type(2)));
typedef float f32x4 __attribute__((ext_vector_type(4)));
typedef float f32x16 __attribute__((ext_vector_type(16)));
typedef unsigned u32x2 __attribute__((ext_vector_type(2)));
typedef unsigned u32x4 __attribute__((ext_vector_type(4)));
#define LAS __attribute__((address_space(3)))

constexpr size_t MiB = 1u << 20;
constexpr size_t WS_CTL = 0;
constexpr size_t CTL_BYTES = 65536;
constexpr size_t WS_RS = 1 * MiB;
constexpr size_t WS_SSB = WS_RS + 128 * 1024;
constexpr size_t WS_RSQ = WS_SSB;
constexpr size_t WS_RSKV = WS_RSQ + 128 * 1024;
constexpr size_t WS_LB = WS_RSKV + 128 * 1024;
constexpr size_t WS_RIN = 2 * MiB;
constexpr size_t WS_BS = 3 * MiB;
constexpr size_t WS_W = 4 * MiB;
constexpr size_t W_LAYER = 96 * MiB;
constexpr size_t WO_IN = 0;
constexpr size_t WO_QB = WO_IN + (size_t)NP * DM * 2;
constexpr size_t WO_KVB = WO_QB + (size_t)QW * 512 * 2;
constexpr size_t WO_O = WO_KVB + (size_t)KVW * 256 * 2;
constexpr size_t WO_GU = WO_O + (size_t)DM * DM * 2;
constexpr size_t WO_DN = WO_GU + (size_t)2 * FF * DM * 2;
constexpr size_t WO_LORA = WO_DN + (size_t)DM * FF * 2;
static_assert(WO_LORA + 163840 * 2 <= W_LAYER, "weight layer stride");
constexpr size_t WS_XB = WS_W + DEPTH * W_LAYER;
constexpr size_t WS_P = WS_XB + 128 * MiB;
constexpr size_t WS_MIX = WS_P + 304 * MiB;
constexpr size_t WS_D = WS_MIX + 128 * MiB;
constexpr size_t WS_Q = WS_D;
constexpr size_t WS_KV = WS_Q + 96 * MiB;
constexpr size_t WS_KR = WS_KV + 128 * MiB;
constexpr size_t WS_RWR = WS_KR + 4 * MiB;
constexpr size_t WS_RWK = WS_RWR + 32 * MiB;
constexpr size_t WS_RWV = WS_RWK + 32 * MiB;
constexpr size_t WS_RWKK = WS_RWV + 32 * MiB;
constexpr size_t WS_RWB = WS_RWKK + 32 * MiB;
constexpr size_t WS_VFIRST = WS_RWB + 32 * MiB;
constexpr size_t WS_SSA = WS_VFIRST + 32 * MiB;
constexpr size_t WS_SSBP = WS_SSA + 4 * MiB;
constexpr size_t WS_END = WS_SSBP + 4 * MiB;
constexpr size_t WS_ACT = WS_D;
static_assert(WS_ACT + (size_t)T * FF * 2 <= WS_VFIRST, "act overlay must not reach v_first");
constexpr size_t WS_RWW = WS_XB;
constexpr size_t WS_RWG = WS_XB + 64 * MiB;
constexpr size_t WS_RWBON = WS_XB + 96 * MiB;

__device__ __forceinline__ int tid_from(int wv) { unsigned z = 0u; asm volatile("" : "+v"(z)); return (wv << 6) | (int)__builtin_amdgcn_mbcnt_hi(~0u, __builtin_amdgcn_mbcnt_lo(~0u, z)); }
#define TID() tid_from(wv__)
__device__ __forceinline__ float bf2f(bf16_t v) { return __uint_as_float(((unsigned)v) << 16); }
typedef __bf16 bf16x2_t __attribute__((ext_vector_type(2)));
__device__ __forceinline__ unsigned cvt_pk_bf16(float lo, float hi) { f32x2 v = {lo, hi}; bf16x2_t b = __builtin_convertvector(v, bf16x2_t); return __builtin_bit_cast(unsigned, b); }
__device__ __forceinline__ bf16_t f2bf(float f) { return (bf16_t)(cvt_pk_bf16(f, 0.f) & 0xffffu); }
__device__ __forceinline__ float lo_bf(unsigned w) { return __uint_as_float(w << 16); }
__device__ __forceinline__ float hi_bf(unsigned w) { return __uint_as_float(w & 0xffff0000u); }
__device__ __forceinline__ float fast_exp(float x) { return __builtin_amdgcn_exp2f(x * 1.4426950408889634f); }
__device__ __forceinline__ float fast_rcp(float x) { return __builtin_amdgcn_rcpf(x); }
__device__ __forceinline__ float sigmoidf_(float x) { return fast_rcp(1.f + fast_exp(-x)); }
__device__ __forceinline__ float siluf_(float x) { return x * sigmoidf_(x); }
#define DPPF(x, CTRL) __int_as_float(__builtin_amdgcn_update_dpp(0, __float_as_int(x), CTRL, 0xf, 0xf, true))
__device__ __forceinline__ float wave_sum(float v) {
    v += DPPF(v, 0xB1);
    v += DPPF(v, 0x4E);
    v += DPPF(v, 0x141);
    v += DPPF(v, 0x140);
    const float r0 = __int_as_float(__builtin_amdgcn_readlane(__float_as_int(v), 0)), r1 = __int_as_float(__builtin_amdgcn_readlane(__float_as_int(v), 16));
    const float r2 = __int_as_float(__builtin_amdgcn_readlane(__float_as_int(v), 32)), r3 = __int_as_float(__builtin_amdgcn_readlane(__float_as_int(v), 48));
    return (r0 + r1) + (r2 + r3);
}
__device__ __forceinline__ float xor32f(float x, int lane) { auto rr = __builtin_amdgcn_permlane32_swap(__float_as_uint(x), __float_as_uint(x), false, false); return __uint_as_float(lane < 32 ? rr[1] : rr[0]); }
__device__ __forceinline__ float sum8f(float x) { x += DPPF(x, 0xB1); x += DPPF(x, 0x4E); x += DPPF(x, 0x141); return x; }
#define MK_COOP 1
#define CONV_IN_MIXERS 1
#define CONV_EVERY 5
namespace pg8 {
#define PG8_LAS __attribute__((address_space(3)))
typedef unsigned short bf16_t;
typedef short bf16x8 __attribute__((ext_vector_type(8)));
typedef float f32x4 __attribute__((ext_vector_type(4)));
typedef unsigned u32x4 __attribute__((ext_vector_type(4)));
constexpr int BM = 256, BK = 64, HALF = 128, HTB = HALF * BK * 2  , STAGE_BYTES = 8 * HTB, NXCD = 8, WGM = 8;

__host__ __device__ __forceinline__ int lds_byte(int r, int c) { const int st = (r >> 4) * 2 + (c >> 5), rr = r & 15, cc = c & 31, ob = rr * 64 + cc * 2; return st * 1024 + (ob ^ (((ob >> 9) & 1) << 5)); }
__host__ __device__ __forceinline__ void stage_rc(int b, int& R, int& C) { const int st = b / 1024, sb = b % 1024, swz = sb ^ (((sb >> 9) & 1) << 5); R = (st >> 1) * 16 + swz / 64; C = (st & 1) * 32 + (swz % 64) / 2; }
__host__ __device__ __forceinline__ int perm32(int rho) { const int n = rho >> 4, i = rho & 15; return 8 * (i >> 2) + 4 * n + (i & 3); }

struct Unit { int pm, pn; };
struct Gemm { const bf16_t* A; const bf16_t* Bt; int M, N, K, lda; };

struct StaticOrder {
    int nM, nN, nwg, G, c;
    __host__ __device__ void init(int M, int N, int G_, int c_) { nM = M / BM; nN = N / BM; nwg = nM * nN; G = G_; c = c_; }
    __host__ __device__ bool next(int i, Unit& u) const {
        const long L = (long)i * G + c; if (L >= nwg) return false;
        int wgid = (int)L; { const int q = nwg / NXCD, r = nwg % NXCD, xcd = wgid % NXCD, off = wgid / NXCD; wgid = (xcd < r ? xcd * (q + 1) : r * (q + 1) + (xcd - r) * q) + off; }
        const int nig = WGM * nN, gid = wgid / nig, fm = gid * WGM, gsz = (nM - fm) < WGM ? (nM - fm) : WGM;
        u.pm = fm + ((wgid % nig) % gsz); u.pn = (wgid % nig) / gsz; return true;
    }
    __device__ __forceinline__ void a_ready(const Unit&) const {}
    __device__ __forceinline__ void done(const Unit&) const {}
};

using ::cvt_pk_bf16;
typedef float f32x2 __attribute__((ext_vector_type(2)));

__device__ __forceinline__ float row_scale32(const float* part, int row) {
    const f32x4* p = (const f32x4*)(part + (size_t)row * 32);
    f32x4 a = p[0] + p[1], b = p[2] + p[3], c = p[4] + p[5], d = p[6] + p[7];
    a = (a + b) + (c + d);
    return 1.f / sqrtf(((a[0] + a[1]) + (a[2] + a[3])) * (1.f / 2048.f) + 1e-6f);
}
struct EpiScaleBf16 {
    static constexpr bool PERM = true, AFTER_DRAIN = false;
    bf16_t* O; const float* rs; int ldc; int ssq;
    __device__ __forceinline__ void operator()(const f32x4 (&acc)[2][2][4][2], const Unit& u, int wr, int wc, int fr_, int fq_) const {
        unsigned z_ = 0u; asm volatile("" : "+v"(z_)); const int ln_ = (int)__builtin_amdgcn_mbcnt_hi(~0u, __builtin_amdgcn_mbcnt_lo(~0u, z_)); const int fr = ln_ & 15, fq = ln_ >> 4; (void)fr_; (void)fq_;
        const int row0 = u.pm * BM + wr * 64 + fr, col0 = u.pn * BM + wc * 32 + 8 * fq;
        float scv[2][4];
#pragma unroll
        for (int ai = 0; ai < 2; ++ai)
#pragma unroll
            for (int m = 0; m < 4; ++m) scv[ai][m] = rs ? rs[row0 + ai * HALF + m * 16] : 1.f;
#pragma unroll
        for (int ai = 0; ai < 2; ++ai)
#pragma unroll
            for (int m = 0; m < 4; ++m) { const int row = row0 + ai * HALF + m * 16; const float sc = scv[ai][m]; bf16_t* rowp = O + (size_t)row * ldc + col0;
#pragma unroll
                for (int bj = 0; bj < 2; ++bj) { const f32x4 v0 = acc[ai][bj][m][0] * sc, v1 = acc[ai][bj][m][1] * sc;
                    u32x4 w; w.x = cvt_pk_bf16(v0[0], v0[1]); w.y = cvt_pk_bf16(v0[2], v0[3]); w.z = cvt_pk_bf16(v1[0], v1[1]); w.w = cvt_pk_bf16(v1[2], v1[3]);
                    *(u32x4*)(rowp + bj * HALF) = w; } }
    }
};
struct EpiPlainBf16 {
    static constexpr bool PERM = true, AFTER_DRAIN = false;
    bf16_t* O; int ldc; int pad_;
    __device__ __forceinline__ void operator()(const f32x4 (&acc)[2][2][4][2], const Unit& u, int wr, int wc, int fr, int fq) const {
        const int row0 = u.pm * BM + wr * 64 + fr, col0 = u.pn * BM + wc * 32 + 8 * fq;
#pragma unroll
        for (int ai = 0; ai < 2; ++ai)
#pragma unroll
            for (int m = 0; m < 4; ++m) { bf16_t* rowp = O + (size_t)(row0 + ai * HALF + m * 16) * ldc + col0;
#pragma unroll
                for (int bj = 0; bj < 2; ++bj) { const f32x4 v0 = acc[ai][bj][m][0], v1 = acc[ai][bj][m][1];
                    u32x4 w; w.x = cvt_pk_bf16(v0[0], v0[1]); w.y = cvt_pk_bf16(v0[2], v0[3]); w.z = cvt_pk_bf16(v1[0], v1[1]); w.w = cvt_pk_bf16(v1[2], v1[3]);
                    *(u32x4*)(rowp + bj * HALF) = w; } }
    }
};
struct EpiResid {
    static constexpr bool PERM = false, AFTER_DRAIN = false;
    float* X; int ldc; int pad_;
    __device__ __forceinline__ void operator()(const f32x4 (&acc)[2][2][4][2], const Unit& u, int wr, int wc, int fr_, int fq_) const {
        unsigned z_ = 0u; asm volatile("" : "+v"(z_)); const int ln_ = (int)__builtin_amdgcn_mbcnt_hi(~0u, __builtin_amdgcn_mbcnt_lo(~0u, z_)); const int fr = ln_ & 15, fq = ln_ >> 4; (void)fr_; (void)fq_;
        const int row0 = u.pm * BM + wr * 64 + fr, col0 = u.pn * BM + wc * 32 + 4 * fq;
#pragma unroll
        for (int ai = 0; ai < 2; ++ai)
#pragma unroll
            for (int m = 0; m < 4; ++m) { float* rowp = X + (size_t)(row0 + ai * HALF + m * 16) * ldc + col0;
                f32x4 xv[2][2];
#pragma unroll
                for (int bj = 0; bj < 2; ++bj)
#pragma unroll
                    for (int n = 0; n < 2; ++n) xv[bj][n] = *(const f32x4*)(rowp + bj * HALF + n * 16);
#pragma unroll
                for (int bj = 0; bj < 2; ++bj)
#pragma unroll
                    for (int n = 0; n < 2; ++n) *(f32x4*)(rowp + bj * HALF + n * 16) = xv[bj][n] + acc[ai][bj][m][n]; }
    }
};
struct EpiKV {
    static constexpr bool PERM = true, AFTER_DRAIN = false;
    bf16_t* O; const float* rs; const float* kg; PG8_LAS float* red; int ldc; int pad_;
    __device__ __forceinline__ void operator()(const f32x4 (&acc)[2][2][4][2], const Unit& u, int wr, int wc, int fr_, int fq_) const {
        unsigned z_ = 0u; asm volatile("" : "+v"(z_)); const int ln_ = (int)__builtin_amdgcn_mbcnt_hi(~0u, __builtin_amdgcn_mbcnt_lo(~0u, z_)); const int fr = ln_ & 15, fq = ln_ >> 4; (void)fr_; (void)fq_;
        const int rl0 = wr * 64 + fr;
        const int col0 = u.pn * BM + wc * 32 + 8 * fq;
#pragma unroll
        for (int ai = 0; ai < 2; ++ai)
#pragma unroll
            for (int m = 0; m < 4; ++m) { const f32x4 a = acc[ai][0][m][0], b = acc[ai][0][m][1];
                float s = ((a[0] * a[0] + a[1] * a[1]) + (a[2] * a[2] + a[3] * a[3])) + ((b[0] * b[0] + b[1] * b[1]) + (b[2] * b[2] + b[3] * b[3]));
                { auto r16 = __builtin_amdgcn_permlane16_swap(__float_as_uint(s), __float_as_uint(s), false, false); s = __uint_as_float(r16[0]) + __uint_as_float(r16[1]);
                  auto r32 = __builtin_amdgcn_permlane32_swap(__float_as_uint(s), __float_as_uint(s), false, false); s = __uint_as_float(r32[0]) + __uint_as_float(r32[1]); }
                if (fq == 0) red[(rl0 + ai * HALF + m * 16) * 4 + wc] = s;
                asm volatile("" ::: "memory"); }
        asm volatile("s_waitcnt lgkmcnt(0)" ::: "memory"); __builtin_amdgcn_s_barrier(); asm volatile("" ::: "memory");
        const unsigned go = (unsigned)(wc * 32 + 8 * fq) * 4u;
        const f32x4 g0 = *(const f32x4*)((const char*)kg + go), g1 = *(const f32x4*)((const char*)kg + go + 16);
#pragma unroll
        for (int ai = 0; ai < 2; ++ai) {
            float scv[4];
#pragma unroll
            for (int m = 0; m < 4; ++m) scv[m] = rs[u.pm * BM + rl0 + ai * HALF + m * 16];
#pragma unroll
            for (int m = 0; m < 4; ++m) { const int rl = rl0 + ai * HALF + m * 16, row = u.pm * BM + rl;
                const f32x4 r4 = *(const PG8_LAS f32x4*)(red + rl * 4);
                const float rk = 1.f / sqrtf(((r4[0] + r4[1]) + (r4[2] + r4[3])) * (1.f / 128.f) + 1e-6f), sc = scv[m];
                bf16_t* rowp = O + (size_t)row * ldc + col0;
                { const f32x4 v0 = acc[ai][0][m][0] * rk * g0, v1 = acc[ai][0][m][1] * rk * g1;
                  u32x4 w; w.x = cvt_pk_bf16(v0[0], v0[1]); w.y = cvt_pk_bf16(v0[2], v0[3]); w.z = cvt_pk_bf16(v1[0], v1[1]); w.w = cvt_pk_bf16(v1[2], v1[3]);
                  *(u32x4*)rowp = w; }
                { const f32x4 v0 = acc[ai][1][m][0] * sc, v1 = acc[ai][1][m][1] * sc;
                  u32x4 w; w.x = cvt_pk_bf16(v0[0], v0[1]); w.y = cvt_pk_bf16(v0[2], v0[3]); w.z = cvt_pk_bf16(v1[0], v1[1]); w.w = cvt_pk_bf16(v1[2], v1[3]);
                  *(u32x4*)(rowp + HALF) = w; }
                asm volatile("" ::: "memory"); } }
        asm volatile("s_waitcnt lgkmcnt(0)" ::: "memory"); __builtin_amdgcn_s_barrier(); asm volatile("" ::: "memory");
    }
};
struct EpiResidN {
    static constexpr bool PERM = false, AFTER_DRAIN = false;
    const float* Xin; float* Xout; bf16_t* xb; float* ssq; int ldc; int pad_;
    __device__ __forceinline__ void operator()(const f32x4 (&acc)[2][2][4][2], const Unit& u, int wr, int wc, int fr_, int fq_) const {
        unsigned z_ = 0u; asm volatile("" : "+v"(z_)); const int ln_ = (int)__builtin_amdgcn_mbcnt_hi(~0u, __builtin_amdgcn_mbcnt_lo(~0u, z_)); const int fr = ln_ & 15, fq = ln_ >> 4; (void)fr_; (void)fq_;
        const int row0 = u.pm * BM + wr * 64 + fr, col0 = u.pn * BM + wc * 32 + 4 * fq;
#pragma unroll
        for (int ai = 0; ai < 2; ++ai)
        {   f32x4 xv[4][2][2];
#pragma unroll
            for (int m = 0; m < 4; ++m)
#pragma unroll
                for (int bj = 0; bj < 2; ++bj)
#pragma unroll
                    for (int n = 0; n < 2; ++n) xv[m][bj][n] = *(const f32x4*)(Xin + (size_t)(row0 + ai * HALF + m * 16) * ldc + col0 + bj * HALF + n * 16);
#pragma unroll
            for (int m = 0; m < 4; ++m) { const int row = row0 + ai * HALF + m * 16; const size_t off = (size_t)row * ldc + col0;
                float s = 0.f;
#pragma unroll
                for (int bj = 0; bj < 2; ++bj)
#pragma unroll
                    for (int n = 0; n < 2; ++n) { const f32x4 v = xv[m][bj][n] + acc[ai][bj][m][n]; *(f32x4*)(Xout + off + bj * HALF + n * 16) = v;
                        u32x2 w; w.x = cvt_pk_bf16(v[0], v[1]); w.y = cvt_pk_bf16(v[2], v[3]); *(u32x2*)(xb + off + bj * HALF + n * 16) = w;
                        s += (v[0] * v[0] + v[1] * v[1]) + (v[2] * v[2] + v[3] * v[3]); }
                { auto r16 = __builtin_amdgcn_permlane16_swap(__float_as_uint(s), __float_as_uint(s), false, false); s = __uint_as_float(r16[0]) + __uint_as_float(r16[1]);
                  auto r32 = __builtin_amdgcn_permlane32_swap(__float_as_uint(s), __float_as_uint(s), false, false); s = __uint_as_float(r32[0]) + __uint_as_float(r32[1]); }
                if (fq == 0) ssq[(size_t)row * 32 + u.pn * 4 + wc] = s; }
        }
    }
};
struct EpiResidB {
    static constexpr bool PERM = true, AFTER_DRAIN = false;
    const float* XinF; float* OutF; bf16_t* xb; float* ssq; int ldc; int pad_;
    __device__ __forceinline__ void operator()(const f32x4 (&acc)[2][2][4][2], const Unit& u, int wr, int wc, int fr_, int fq_) const {
        unsigned z_ = 0u; asm volatile("" : "+v"(z_)); const int ln_ = (int)__builtin_amdgcn_mbcnt_hi(~0u, __builtin_amdgcn_mbcnt_lo(~0u, z_)); const int fr = ln_ & 15, fq = ln_ >> 4; (void)fr_; (void)fq_;
        const int row0 = u.pm * BM + wr * 64 + fr, col0 = u.pn * BM + wc * 32 + 8 * fq;
#pragma unroll
        for (int ai = 0; ai < 2; ++ai) {
            f32x4 r0[4][2], r1[4][2];
#pragma unroll
            for (int m = 0; m < 4; ++m)
#pragma unroll
                for (int bj = 0; bj < 2; ++bj) { const size_t off = (size_t)(row0 + ai * HALF + m * 16) * ldc + col0 + bj * HALF;
                    if (XinF) { r0[m][bj] = *(const f32x4*)(XinF + off); r1[m][bj] = *(const f32x4*)(XinF + off + 4); }
                    else { const u32x4 w = *(const u32x4*)(xb + off); r0[m][bj] = (f32x4){lo_bf(w.x), hi_bf(w.x), lo_bf(w.y), hi_bf(w.y)}; r1[m][bj] = (f32x4){lo_bf(w.z), hi_bf(w.z), lo_bf(w.w), hi_bf(w.w)}; } }
#pragma unroll
            for (int m = 0; m < 4; ++m) { const int row = row0 + ai * HALF + m * 16; float s = 0.f;
#pragma unroll
                for (int bj = 0; bj < 2; ++bj) { const size_t off = (size_t)row * ldc + col0 + bj * HALF;
                    const f32x4 v0 = r0[m][bj] + acc[ai][bj][m][0], v1 = r1[m][bj] + acc[ai][bj][m][1];
                    u32x4 w; w.x = cvt_pk_bf16(v0[0], v0[1]); w.y = cvt_pk_bf16(v0[2], v0[3]); w.z = cvt_pk_bf16(v1[0], v1[1]); w.w = cvt_pk_bf16(v1[2], v1[3]);
                    *(u32x4*)(xb + off) = w;
                    if (OutF) { *(f32x4*)(OutF + off) = v0; *(f32x4*)(OutF + off + 4) = v1; }
                    s += ((v0[0] * v0[0] + v0[1] * v0[1]) + (v0[2] * v0[2] + v0[3] * v0[3])) + ((v1[0] * v1[0] + v1[1] * v1[1]) + (v1[2] * v1[2] + v1[3] * v1[3])); }
                { auto r16 = __builtin_amdgcn_permlane16_swap(__float_as_uint(s), __float_as_uint(s), false, false); s = __uint_as_float(r16[0]) + __uint_as_float(r16[1]);
                  auto r32 = __builtin_amdgcn_permlane32_swap(__float_as_uint(s), __float_as_uint(s), false, false); s = __uint_as_float(r32[0]) + __uint_as_float(r32[1]); }
                if (fq == 0) ssq[(size_t)row * 32 + u.pn * 4 + wc] = s; }
        }
    }
};
struct EpiSwiGLU {
    static constexpr bool PERM = true, AFTER_DRAIN = false;
    bf16_t* O; const float* rs; int ldc; int pad_;
    __device__ __forceinline__ void operator()(const f32x4 (&acc)[2][2][4][2], const Unit& u, int wr, int wc, int fr_, int fq_) const {
        unsigned z_ = 0u; asm volatile("" : "+v"(z_)); const int ln_ = (int)__builtin_amdgcn_mbcnt_hi(~0u, __builtin_amdgcn_mbcnt_lo(~0u, z_)); const int fr = ln_ & 15, fq = ln_ >> 4; (void)fr_; (void)fq_;
        const int row0 = u.pm * BM + wr * 64 + fr, col0 = u.pn * HALF + wc * 32 + 8 * fq;
        float scv[2][4];
#pragma unroll
        for (int ai = 0; ai < 2; ++ai)
#pragma unroll
            for (int m = 0; m < 4; ++m) scv[ai][m] = rs[row0 + ai * HALF + m * 16];
#pragma unroll
        for (int ai = 0; ai < 2; ++ai)
#pragma unroll
            for (int m = 0; m < 4; ++m) { const int row = row0 + ai * HALF + m * 16; const float sc = scv[ai][m]; bf16_t* rowp = O + (size_t)row * ldc + col0;
                float o[8];
#pragma unroll
                for (int n = 0; n < 2; ++n)
#pragma unroll
                    for (int i = 0; i < 4; ++i) { const float g = acc[ai][0][m][n][i] * sc, up = acc[ai][1][m][n][i] * sc;
                        o[n * 4 + i] = g * __builtin_amdgcn_rcpf(1.f + __builtin_amdgcn_exp2f(g * -1.4426950408889634f)) * up; }
                u32x4 w; w.x = cvt_pk_bf16(o[0], o[1]); w.y = cvt_pk_bf16(o[2], o[3]); w.z = cvt_pk_bf16(o[4], o[5]); w.w = cvt_pk_bf16(o[6], o[7]);
                *(u32x4*)rowp = w; }
    }
};

template <class Sched>
__device__ __forceinline__ void prep_row_scales(const float* part, float* rs, const Sched& S, int tid) {
    Unit u; int last = -1;
    for (int i = 0; S.next(i, u); ++i) {
        if (u.pm == last) continue;
        last = u.pm;
        const int row = u.pm * BM + (tid >> 1);
        const f32x4* p = (const f32x4*)(part + (size_t)row * 32 + (tid & 1) * 16);
        f32x4 a = (p[0] + p[1]) + (p[2] + p[3]);
        float s = (a[0] + a[1]) + (a[2] + a[3]);
        s += DPPF(s, 0xB1);
        if ((tid & 1) == 0) rs[row] = 1.f / sqrtf(s * (1.f / 2048.f) + 1e-6f);
    }
    asm volatile("s_waitcnt vmcnt(0)" ::: "memory");
    __syncthreads();
}
template <class Epi, class Sched, bool ALIGN_EPI = false, bool SP2 = false>
__device__ __forceinline__ void gemm_phase(PG8_LAS unsigned char* lds, const Gemm g, const Sched& S, const Epi& E, const int wv__) {
    const int tid = TID(), wid = __builtin_amdgcn_readfirstlane(tid >> 6), lane = tid & 63, wr = wid >> 2, wc = wid & 3, fr = lane & 15, fq = lane >> 4;
    const int K = g.K, nt = K / BK;
    unsigned voffA[2], voffB[2];
#pragma unroll
    for (int i = 0; i < 2; ++i) { int R, C; stage_rc(tid * 16 + i * 8192, R, C); const int Rb = Epi::PERM ? ((R & ~31) + perm32(R & 31)) : R;
        voffA[i] = (unsigned)(R * g.lda + C) * 2u; voffB[i] = (unsigned)(Rb * K + C) * 2u; }
    const size_t kstep = (size_t)(BK * 2);
    const size_t hstepA = (size_t)HALF * g.lda * 2, hstepB = (size_t)HALF * K * 2;
    const size_t tstepA = 2 * hstepA, tstepB = 2 * hstepB;
    const unsigned ldsw = (unsigned)wid * 1024u;
    const int aoff = lds_byte(wr * 64 + fr, fq * 8), boff = lds_byte(wc * 32 + fr, fq * 8);
#define PG8_SA(b, h) (((b) * 2 + (h)) * HTB)
#define PG8_SB(b, h) ((4 + (b) * 2 + (h)) * HTB)
#define PG8_STAGE(bufoff, gbase, voff) do { _Pragma("unroll") for (int _i = 0; _i < 2; ++_i) \
        __builtin_amdgcn_global_load_lds((const unsigned*)((const char*)(gbase) + (voff)[_i]), (PG8_LAS unsigned*)(lds + (bufoff) + ldsw + _i * 8192), 16, 0, 0); } while (0)
#define PG8_LDA(dst, b, h) do { _Pragma("unroll") for (int m = 0; m < 4; ++m) _Pragma("unroll") for (int k = 0; k < 2; ++k) dst[m][k] = *(const PG8_LAS bf16x8*)(lds + PG8_SA(b, h) + aoff + m * 2048 + k * 1024); } while (0)
#define PG8_LDB(dst, b, h) do { _Pragma("unroll") for (int n = 0; n < 2; ++n) _Pragma("unroll") for (int k = 0; k < 2; ++k) dst[n][k] = *(const PG8_LAS bf16x8*)(lds + PG8_SB(b, h) + boff + n * 2048 + k * 1024); } while (0)
#define PG8_MMA(ai, bj, At, Bt) do { __builtin_amdgcn_s_setprio(1); _Pragma("unroll") for (int m = 0; m < 4; ++m) _Pragma("unroll") for (int n = 0; n < 2; ++n) _Pragma("unroll") for (int k = 0; k < 2; ++k) \
        acc[ai][bj][m][n] = __builtin_amdgcn_mfma_f32_16x16x32_bf16(Bt[n][k], At[m][k], acc[ai][bj][m][n], 0, 0, 0); __builtin_amdgcn_s_setprio(0); } while (0)
#define PG8_WAIT_V(n) asm volatile("s_waitcnt vmcnt(" #n ")" ::: "memory")
#define PG8_WAIT_L(n) asm volatile("s_waitcnt lgkmcnt(" #n ")" ::: "memory")
#define PG8_BAR __builtin_amdgcn_s_barrier()
#define PG8_SCHED __builtin_amdgcn_sched_barrier(0)
    Unit cur, nxt; int ui = 0;
    if (!S.next(0, cur)) return;
    f32x4 acc[2][2][4][2];
#pragma unroll
    for (int a = 0; a < 2; ++a)
#pragma unroll
        for (int b = 0; b < 2; ++b)
#pragma unroll
            for (int m = 0; m < 4; ++m)
#pragma unroll
                for (int n = 0; n < 2; ++n) acc[a][b][m][n] = (f32x4){0.f, 0.f, 0.f, 0.f};
    bf16x8 At[4][2], B0[2][2], B1[2][2];
    const char* cA = (const char*)g.A + (size_t)cur.pm * tstepA; const char* cB = (const char*)g.Bt + (size_t)cur.pn * tstepB;
    S.a_ready(cur);
    if constexpr (SP2) {
        PG8_STAGE(PG8_SB(0, 0), cB, voffB); PG8_STAGE(PG8_SB(0, 1), cB + hstepB, voffB); PG8_STAGE(PG8_SA(0, 0), cA, voffA); PG8_STAGE(PG8_SA(0, 1), cA + hstepA, voffA);
        if (wr == 1) PG8_BAR;
        PG8_WAIT_V(2); PG8_BAR;
        PG8_STAGE(PG8_SB(1, 0), cB + kstep, voffB); PG8_STAGE(PG8_SA(1, 0), cA + kstep, voffA); PG8_STAGE(PG8_SB(1, 1), cB + hstepB + kstep, voffB);
        PG8_WAIT_V(6); PG8_BAR;
    } else {
        PG8_STAGE(PG8_SB(0, 0), cB, voffB); PG8_STAGE(PG8_SA(0, 0), cA, voffA); PG8_STAGE(PG8_SB(0, 1), cB + hstepB, voffB); PG8_STAGE(PG8_SA(0, 1), cA + hstepA, voffA);
        if (wr == 1) PG8_BAR;
        PG8_WAIT_V(4); PG8_BAR;
        PG8_STAGE(PG8_SB(1, 0), cB + kstep, voffB); PG8_STAGE(PG8_SA(1, 0), cA + kstep, voffA); PG8_STAGE(PG8_SB(1, 1), cB + hstepB + kstep, voffB);
        PG8_WAIT_V(6); PG8_BAR;
    }
    for (;;) {
        const bool has_next = S.next(ui + 1, nxt);
        const char* nA = has_next ? (const char*)g.A + (size_t)nxt.pm * tstepA : cA; const char* nB = has_next ? (const char*)g.Bt + (size_t)nxt.pn * tstepB : cB;
        for (int t = 0; t < nt; t += 2) {
            const bool last = (t == nt - 2);
            const char* a1 = cA + (size_t)(t + 1) * kstep;
            const char* a2 = last ? nA : cA + (size_t)(t + 2) * kstep; const char* b2 = last ? nB : cB + (size_t)(t + 2) * kstep;
            const char* a3 = a2 + kstep; const char* b3 = b2 + kstep;
            if (last && has_next) S.a_ready(nxt);
            if constexpr (SP2) {
            PG8_LDB(B0, 0, 0); PG8_LDB(B1, 0, 1); PG8_SCHED; PG8_LDA(At, 0, 0); PG8_STAGE(PG8_SA(1, 1), a1 + hstepA, voffA);
            PG8_WAIT_V(8); PG8_WAIT_L(0); PG8_BAR; PG8_MMA(0, 0, At, B0); PG8_MMA(0, 1, At, B1); PG8_BAR; PG8_SCHED;
            PG8_LDA(At, 0, 1); PG8_STAGE(PG8_SB(0, 0), b2, voffB); PG8_STAGE(PG8_SB(0, 1), b2 + hstepB, voffB); PG8_STAGE(PG8_SA(0, 0), a2, voffA);
            PG8_WAIT_V(8); PG8_WAIT_L(0); PG8_BAR; PG8_MMA(1, 0, At, B0); PG8_MMA(1, 1, At, B1); PG8_BAR; PG8_SCHED;
            PG8_LDB(B0, 1, 0); PG8_LDB(B1, 1, 1); PG8_SCHED; PG8_LDA(At, 1, 0); PG8_STAGE(PG8_SA(0, 1), a2 + hstepA, voffA);
            PG8_WAIT_V(8); PG8_WAIT_L(0); PG8_BAR; PG8_MMA(0, 0, At, B0); PG8_MMA(0, 1, At, B1); PG8_BAR; PG8_SCHED;
            PG8_LDA(At, 1, 1); PG8_STAGE(PG8_SB(1, 0), b3, voffB); PG8_STAGE(PG8_SB(1, 1), b3 + hstepB, voffB); PG8_STAGE(PG8_SA(1, 0), a3, voffA);
            PG8_WAIT_V(8); PG8_WAIT_L(0); PG8_BAR; PG8_MMA(1, 0, At, B0); PG8_MMA(1, 1, At, B1); PG8_BAR; PG8_SCHED;
            } else {
            PG8_LDB(B0, 0, 0); PG8_SCHED; PG8_LDA(At, 0, 0); PG8_STAGE(PG8_SA(1, 1), a1 + hstepA, voffA);
            PG8_WAIT_L(8); PG8_BAR; PG8_WAIT_L(0); PG8_MMA(0, 0, At, B0); PG8_BAR; PG8_SCHED;
            PG8_LDB(B1, 0, 1); PG8_STAGE(PG8_SB(0, 0), b2, voffB);
            PG8_BAR; PG8_WAIT_L(0); PG8_MMA(0, 1, At, B1); PG8_BAR;
            PG8_LDA(At, 0, 1); PG8_STAGE(PG8_SA(0, 0), a2, voffA);
            PG8_BAR; PG8_WAIT_L(0); PG8_MMA(1, 0, At, B0); PG8_BAR; PG8_SCHED;
            PG8_STAGE(PG8_SB(0, 1), b2 + hstepB, voffB);
            PG8_WAIT_V(6); PG8_BAR; PG8_MMA(1, 1, At, B1); PG8_BAR;
            PG8_LDB(B0, 1, 0); PG8_SCHED; PG8_LDA(At, 1, 0); PG8_STAGE(PG8_SA(0, 1), a2 + hstepA, voffA);
            PG8_WAIT_L(8); PG8_BAR; PG8_WAIT_L(0); PG8_MMA(0, 0, At, B0); PG8_BAR; PG8_SCHED;
            PG8_LDB(B1, 1, 1); PG8_STAGE(PG8_SB(1, 0), b3, voffB);
            PG8_BAR; PG8_WAIT_L(0); PG8_MMA(0, 1, At, B1); PG8_BAR;
            PG8_LDA(At, 1, 1); PG8_STAGE(PG8_SA(1, 0), a3, voffA);
            PG8_BAR; PG8_WAIT_L(0); PG8_MMA(1, 0, At, B0); PG8_BAR; PG8_SCHED;
            PG8_STAGE(PG8_SB(1, 1), b3 + hstepB, voffB);
            PG8_WAIT_V(6); PG8_BAR; PG8_MMA(1, 1, At, B1); PG8_BAR;
            }
        }
        if constexpr (ALIGN_EPI) { if (wr == 0) PG8_BAR; }
        if constexpr (!Epi::AFTER_DRAIN) { E(acc, cur, wr, wc, fr, fq); S.done(cur); }
        if (!has_next) break;
#pragma unroll
        for (int a = 0; a < 2; ++a)
#pragma unroll
            for (int b = 0; b < 2; ++b)
#pragma unroll
                for (int m = 0; m < 4; ++m)
#pragma unroll
                    for (int n = 0; n < 2; ++n) acc[a][b][m][n] = (f32x4){0.f, 0.f, 0.f, 0.f};
        cur = nxt; cA = nA; cB = nB; ++ui;
        if constexpr (ALIGN_EPI) { if (wr == 1) PG8_BAR; }
    }
    PG8_WAIT_V(0);
    if constexpr (!ALIGN_EPI) { if (wr == 0) PG8_BAR; }
    PG8_BAR;
    if constexpr (Epi::AFTER_DRAIN) { E.fused(acc, cur, wr, wc, fr, fq, lds, wid, lane); S.done(cur); }
#undef PG8_SA
#undef PG8_SB
#undef PG8_STAGE
#undef PG8_LDA
#undef PG8_LDB
#undef PG8_MMA
#undef PG8_WAIT_V
#undef PG8_WAIT_L
#undef PG8_BAR
#undef PG8_SCHED
}
}
__device__ __forceinline__ void rope_cs(int pos, int j, float& c, float& s) {
    const float inv_freq = exp2f(-(float)j * (13.287712379549449f / 32.f));
    const float ang = (float)pos * inv_freq;
    float rev = ang * 0.15915494309189535f; rev = rev - floorf(rev);
    c = __builtin_amdgcn_cosf(rev); s = __builtin_amdgcn_sinf(rev);
}
namespace att {
constexpr int NW = 8, QBLK = 32, KVBLK = 64, QB = NW * QBLK;
constexpr int QS = QW, KS = KVW, KRS = 64, OS = DM;
constexpr int SHM_V = KVBLK * 128 * 2, SHM_K = KVBLK * 128 * 2, SHM_KR = KVBLK * 64 * 2;
constexpr int OFF_V = 0, OFF_K = 2 * SHM_V, OFF_KR = OFF_K + 2 * SHM_K, OFF_WS = OFF_KR + 2 * SHM_KR, OFF_QR = OFF_WS + NW * 64 * 4;
constexpr int LDS_BYTES = OFF_QR + NW * 8 * 64 * 16;
constexpr float SCALE = 0.07216878364870322f;
constexpr float THR = 8.f;
constexpr int NQB = SEQ / QB;

#define KSWZ(row, colB) ((row) * 256 + ((colB) ^ (((row) & 7) << 4)))
#define KRSWZ(row, colB) ((row) * 128 + ((colB) ^ ((((row) >> 1) & 7) << 4)))
#define SBAR() __builtin_amdgcn_sched_barrier(0)
__device__ __forceinline__ int v_st(int k, int c) { const int kk = (k & ~0xC) | ((k & 4) << 1) | ((k & 8) >> 1); return ((kk >> 3) * 4 + (c >> 5)) * 512 + ((kk & 7) * 32 + (c & 31)) * 2; }
__device__ __forceinline__ int v_rd_base(int lane) { return ((lane & 3) << 3) | (((lane >> 2) & 3) << 6) | (((lane >> 4) & 1) << 5) | (((lane >> 5) & 1) << 8); }
constexpr int v_rd_off(int d0, int ks, int half) { return d0 * 512 + ks * 4096 + half * 2048; }
__device__ __forceinline__ int crow(int r, int hi) { return (r & 3) + 8 * (r >> 2) + 4 * hi; }
__device__ __forceinline__ unsigned cvtpk(float lo, float hi) { return cvt_pk_bf16(lo, hi); }
__device__ __forceinline__ bf16x8 load8(const bf16_t* p) { return *reinterpret_cast<const bf16x8*>(p); }

__device__ __forceinline__ void mask_tile(f32x16& p0, f32x16& p1, int dq) {
    const float NEG = -__builtin_inff();
#pragma unroll
    for (int r = 0; r < 16; ++r) {
        const int c = (r & 3) + 8 * (r >> 2);
        if (dq - c < 0) p0[r] = NEG;
        if (dq - c - 32 < 0) p1[r] = NEG;
    }
}
__device__ __forceinline__ void partialSM(f32x16& p0, f32x16& p1, float& m_reg, float& mn, float& alpha) {
    float pmax = p0[0];
#pragma unroll
    for (int r = 1; r < 16; ++r) pmax = fmaxf(pmax, p0[r]);
#pragma unroll
    for (int r = 0; r < 16; ++r) pmax = fmaxf(pmax, p1[r]);
    { auto rr = __builtin_amdgcn_permlane32_swap(__float_as_uint(pmax), __float_as_uint(pmax), false, false);
      pmax = fmaxf(__uint_as_float(rr[0]), __uint_as_float(rr[1])); }
    constexpr float C2 = 1.4426950408889634f * SCALE;
    if (__builtin_expect(__all((pmax - m_reg) * SCALE <= THR), 1)) { mn = m_reg; alpha = 1.f; }
    else { mn = fmaxf(m_reg, pmax); alpha = __builtin_amdgcn_exp2f((m_reg - mn) * C2); m_reg = mn; }
    const float mnL = -mn * C2;
#pragma unroll
    for (int r = 0; r < 16; ++r) p0[r] = fmaf(p0[r], C2, mnL);
#pragma unroll
    for (int r = 0; r < 16; ++r) p1[r] = fmaf(p1[r], C2, mnL);
#pragma unroll
    for (int r = 0; r < 16; ++r) p0[r] = __builtin_amdgcn_exp2f(p0[r]);
}
__device__ __forceinline__ void finishSM(f32x16& p0, f32x16& p1, float alpha, float& l_reg, bf16x8& pa0, bf16x8& pa1, bf16x8& pa2, bf16x8& pa3) {
#pragma unroll
    for (int r = 0; r < 16; ++r) p1[r] = __builtin_amdgcn_exp2f(p1[r]);
    float ps = 0;
#pragma unroll
    for (int r = 0; r < 16; ++r) ps += p0[r];
#pragma unroll
    for (int r = 0; r < 16; ++r) ps += p1[r];
    { auto rr = __builtin_amdgcn_permlane32_swap(__float_as_uint(ps), __float_as_uint(ps), false, false);
      ps = __uint_as_float(rr[0]) + __uint_as_float(rr[1]); }
    l_reg = l_reg * alpha + ps;
#define PK4(P, B_, OUT) do { unsigned a0 = cvtpk(P[B_+0], P[B_+1]), a1 = cvtpk(P[B_+2], P[B_+3]);                          \
        unsigned b0 = cvtpk(P[B_+4], P[B_+5]), b1 = cvtpk(P[B_+6], P[B_+7]);                                             \
        auto r0 = __builtin_amdgcn_permlane32_swap(a0, b0, false, false); auto r1 = __builtin_amdgcn_permlane32_swap(a1, b1, false, false); \
        u32x4 w = {r0[0], r1[0], r0[1], r1[1]}; OUT = *reinterpret_cast<bf16x8*>(&w); } while (0)
    PK4(p0, 0, pa0); PK4(p0, 8, pa1); PK4(p1, 0, pa2); PK4(p1, 8, pa3);
#undef PK4
}
template <int KB>
__device__ __forceinline__ void qkt(f32x16& p0, f32x16& p1, const char* lds, int r32, int hi, const bf16x8* qr, int qro) {
    p0 = f32x16{}; p1 = f32x16{};
    const char* kb[4];
#pragma unroll
    for (int dd = 0; dd < 4; ++dd) kb[dd] = lds + OFF_K + KB * SHM_K + KSWZ(r32, (dd * 16 + hi * 8) * 2);
#pragma unroll
    for (int d0 = 0; d0 < 8; ++d0) { const char* a = kb[d0 & 3] + (d0 >> 2) * 128;
        bf16x8 b0 = *reinterpret_cast<const bf16x8*>(a);
        bf16x8 b1 = *reinterpret_cast<const bf16x8*>(a + 32 * 256);
        const bf16x8 qq = qr[d0];
        p0 = __builtin_amdgcn_mfma_f32_32x32x16_bf16(b0, qq, p0, 0, 0, 0);
        p1 = __builtin_amdgcn_mfma_f32_32x32x16_bf16(b1, qq, p1, 0, 0, 0); }
#pragma unroll
    for (int dd = 0; dd < 4; ++dd) { const char* a = lds + OFF_KR + KB * SHM_KR + KRSWZ(r32, (dd * 16 + hi * 8) * 2);
        bf16x8 b0 = *reinterpret_cast<const bf16x8*>(a);
        bf16x8 b1 = *reinterpret_cast<const bf16x8*>(a + 32 * 128);
        const bf16x8 qq = *reinterpret_cast<const bf16x8*>(lds + qro + dd * 1024);
        p0 = __builtin_amdgcn_mfma_f32_32x32x16_bf16(b0, qq, p0, 0, 0, 0);
        p1 = __builtin_amdgcn_mfma_f32_32x32x16_bf16(b1, qq, p1, 0, 0, 0); }
}
template <int VB>
__device__ __forceinline__ void pv_tile(f32x16* o, int vb0, bf16x8 pa0, bf16x8 pa1, bf16x8 pa2, bf16x8 pa3) {
#define TRRD(dst, off) asm volatile("ds_read_b64_tr_b16 %0, %1 offset:%2" : "=&v"(dst) : "v"(vb0), "i"(off) : "memory")
#define PV_D0(d0) do { s16x4 l0, l1, l2, l3, h0, h1, h2, h3; constexpr int b_ = OFF_V + VB * SHM_V + v_rd_off(d0, 0, 0);   \
        TRRD(l0, b_); TRRD(h0, b_ + 2048); TRRD(l1, b_ + 4096); TRRD(h1, b_ + 6144); TRRD(l2, b_ + 8192); TRRD(h2, b_ + 10240); TRRD(l3, b_ + 12288); TRRD(h3, b_ + 14336); \
        asm volatile("s_waitcnt lgkmcnt(0)" ::: "memory"); SBAR();   \
        o[d0] = __builtin_amdgcn_mfma_f32_32x32x16_bf16(pa0, (bf16x8){l0[0], l0[1], l0[2], l0[3], h0[0], h0[1], h0[2], h0[3]}, o[d0], 0, 0, 0);   \
        o[d0] = __builtin_amdgcn_mfma_f32_32x32x16_bf16(pa1, (bf16x8){l1[0], l1[1], l1[2], l1[3], h1[0], h1[1], h1[2], h1[3]}, o[d0], 0, 0, 0);   \
        o[d0] = __builtin_amdgcn_mfma_f32_32x32x16_bf16(pa2, (bf16x8){l2[0], l2[1], l2[2], l2[3], h2[0], h2[1], h2[2], h2[3]}, o[d0], 0, 0, 0);   \
        o[d0] = __builtin_amdgcn_mfma_f32_32x32x16_bf16(pa3, (bf16x8){l3[0], l3[1], l3[2], l3[3], h3[0], h3[1], h3[2], h3[3]}, o[d0], 0, 0, 0); } while (0)
    PV_D0(0); PV_D0(1); PV_D0(2); PV_D0(3);
#undef PV_D0
#undef TRRD
}

struct BlockRef { const bf16_t* Q; const bf16_t* K; const bf16_t* V; const bf16_t* KR; bf16_t* O; const int* POS; const float* QG; int P0; };
struct Seam { bf16x8 qr[8]; bf16x8 st_v0, st_v1, st_k0, st_k1, st_kr; };
#define VMW() asm volatile("s_waitcnt vmcnt(0)" ::: "memory")
#define VMWN(n) asm volatile("s_waitcnt vmcnt(%0)" :: "i"(n) : "memory")
#define LDG8(base, off) (*reinterpret_cast<const bf16x8*>((const char*)(base) + (off)))
#define SLOAD_H(R_, k0) do { const char* kb_ = (const char*)((R_).K + (size_t)(k0) * KS); const char* rb_ = (const char*)((R_).KR + (size_t)(k0) * KRS);  \
                             S.st_v0 = LDG8(kb_ + 256, offA); S.st_v1 = LDG8(kb_ + 32 * KS * 2 + 256, offA);              \
                             S.st_k0 = LDG8(kb_, offA); S.st_k1 = LDG8(kb_ + 32 * KS * 2, offA);              \
                             S.st_kr = LDG8(rb_, offR); } while (0)
#define SWRITE_HK(bf) do { *(bf16x8*)(lds + OFF_K + (bf) * SHM_K + kws) = S.st_k0; *(bf16x8*)(lds + OFF_K + (bf) * SHM_K + kws + 32 * 256) = S.st_k1; \
                           *(bf16x8*)(lds + OFF_KR + (bf) * SHM_KR + krws) = S.st_kr; } while (0)
#define SWRITE_HV(bf) do { *(bf16x8*)(lds + OFF_V + (bf) * SHM_V + vst0) = S.st_v0; *(bf16x8*)(lds + OFF_V + (bf) * SHM_V + vst1) = S.st_v1; } while (0)
#define SWRITE_H(bf) do { SWRITE_HV(bf); SWRITE_HK(bf); } while (0)
#define QLOAD(R_) do { _Pragma("unroll") for (int d0 = 0; d0 < 8; ++d0) S.qr[d0] = LDG8((const char*)(R_).Q + d0 * 32, offQ); } while (0)

__device__ __forceinline__ void attn_prime(const BlockRef& cur, char* lds, Seam& S, const int wv__) {
    const int tid = TID(), wid = __builtin_amdgcn_readfirstlane(tid >> 6), lane = tid & 63, r32 = lane & 31, hi = lane >> 5;
    const int sr = tid >> 4, sc = (tid & 15) * 8, kws = KSWZ(sr, sc * 2), krr = tid >> 3, krc = (tid & 7) * 8, krws = KRSWZ(krr, krc * 2);
    unsigned offA = (unsigned)(sr * KS + sc) * 2u, offR = (unsigned)(krr * KRS + krc) * 2u, offQ = (unsigned)((wid * QBLK + r32) * QS + hi * 8) * 2u;
    asm volatile("" : "+v"(offA), "+v"(offR), "+v"(offQ));
    QLOAD(cur);
    SLOAD_H(cur, 0); VMW(); SWRITE_HK(0);
    __syncthreads();
}
__device__ __forceinline__ void attn_block(const BlockRef& cur, char* lds, Seam& S, const int wv__) {
    const int tid = TID(), wid = __builtin_amdgcn_readfirstlane(tid >> 6), lane = tid & 63, r32 = lane & 31, hi = lane >> 5;
    const int NT = (cur.P0 + QB) / KVBLK;
    const int qlo = cur.P0 + wid * QBLK, qm = qlo + r32 - 4 * hi;
    float* ws = (float*)(lds + OFF_WS) + wid * 64; float* li_l = ws, * al_l = ws + 32;
    float m_reg = -1e30f, l_reg = 0; f32x16 o[4] = {};
    const int sr = tid >> 4, sc = (tid & 15) * 8, vst0 = v_st(sr, sc), vst1 = v_st(32 + sr, sc), kws = KSWZ(sr, sc * 2);
    const int krr = tid >> 3, krc = (tid & 7) * 8, krws = KRSWZ(krr, krc * 2);
    unsigned offA = (unsigned)(sr * KS + sc) * 2u, offR = (unsigned)(krr * KRS + krc) * 2u, offQ = (unsigned)((wid * QBLK + r32) * QS + hi * 8) * 2u;
    asm volatile("" : "+v"(offA), "+v"(offR), "+v"(offQ));
    const int vb0 = (int)(uintptr_t)lds + v_rd_base(lane);
#define RESC(a) do { if (__any((a) < 1.f)) { if (hi == 0) al_l[r32] = (a); asm volatile("s_waitcnt lgkmcnt(0)" ::: "memory");              \
                     for (int d_ = 0; d_ < 4; ++d_) for (int r = 0; r < 16; ++r) o[d_][r] *= al_l[crow(r, hi)]; } } while (0)
#define KBASE(t) ((t) * KVBLK)
#define MASKT(P0_, P1_, t) do { const int kb_ = KBASE(t); if (kb_ + KVBLK - 1 > qlo) mask_tile(P0_, P1_, qm - kb_); } while (0)
    f32x16 pA0, pA1, pB0, pB1; float mnA, mnB, alA, alB; bf16x8 pa0, pa1, pa2, pa3;
    const int qro = OFF_QR + (wid * 8 * 64 + lane) * 16;
    { bf16x8 tq[8];
#pragma unroll
      for (int dd = 4; dd < 8; ++dd) tq[dd] = LDG8((const char*)cur.Q + 128 + dd * 32, offQ);
      const int pos = cur.POS[wid * QBLK + r32];
      float sn = 0.f, sr = 0.f;
#define UNP(F, x) const u32x4 w_ = __builtin_bit_cast(u32x4, F); float x[8] = {lo_bf(w_.x), hi_bf(w_.x), lo_bf(w_.y), hi_bf(w_.y), lo_bf(w_.z), hi_bf(w_.z), lo_bf(w_.w), hi_bf(w_.w)};
#pragma unroll
      for (int f = 0; f < 8; ++f) { UNP(S.qr[f], x)
#pragma unroll
          for (int e = 0; e < 8; ++e) sn += x[e] * x[e]; }
#pragma unroll
      for (int f = 4; f < 8; ++f) { UNP(tq[f], x)
#pragma unroll
          for (int e = 0; e < 8; ++e) sr += x[e] * x[e]; }
      { auto r0 = __builtin_amdgcn_permlane32_swap(__float_as_uint(sn), __float_as_uint(sn), false, false); sn = __uint_as_float(r0[0]) + __uint_as_float(r0[1]);
        auto r1 = __builtin_amdgcn_permlane32_swap(__float_as_uint(sr), __float_as_uint(sr), false, false); sr = __uint_as_float(r1[0]) + __uint_as_float(r1[1]); }
      const float rn = 1.f / sqrtf(sn * (1.f / 128.f) + RMS_EPS), rr = 1.f / sqrtf(sr * (1.f / 64.f) + RMS_EPS);
#pragma unroll
      for (int f = 0; f < 8; ++f) { UNP(S.qr[f], x)
          const f32x4 g0 = *(const f32x4*)(cur.QG + f * 16 + hi * 8), g1 = *(const f32x4*)(cur.QG + f * 16 + hi * 8 + 4);
          const float g[8] = {g0.x, g0.y, g0.z, g0.w, g1.x, g1.y, g1.z, g1.w};
          u32x4 o; o.x = cvt_pk_bf16(x[0] * rn * g[0], x[1] * rn * g[1]); o.y = cvt_pk_bf16(x[2] * rn * g[2], x[3] * rn * g[3]);
          o.z = cvt_pk_bf16(x[4] * rn * g[4], x[5] * rn * g[5]); o.w = cvt_pk_bf16(x[6] * rn * g[6], x[7] * rn * g[7]);
          S.qr[f] = __builtin_bit_cast(bf16x8, o); }
#pragma unroll
      for (int dd = 0; dd < 2; ++dd) {
          float x1[8], x2[8];
          { UNP(tq[4 + dd], x) for (int e = 0; e < 8; ++e) x1[e] = x[e]; }
          { UNP(tq[6 + dd], x) for (int e = 0; e < 8; ++e) x2[e] = x[e]; }
          const f32x4 ga0 = *(const f32x4*)(cur.QG + 128 + dd * 16 + hi * 8), ga1 = *(const f32x4*)(cur.QG + 128 + dd * 16 + hi * 8 + 4);
          const f32x4 gb0 = *(const f32x4*)(cur.QG + 160 + dd * 16 + hi * 8), gb1 = *(const f32x4*)(cur.QG + 160 + dd * 16 + hi * 8 + 4);
          const float ga[8] = {ga0.x, ga0.y, ga0.z, ga0.w, ga1.x, ga1.y, ga1.z, ga1.w}, gb[8] = {gb0.x, gb0.y, gb0.z, gb0.w, gb1.x, gb1.y, gb1.z, gb1.w};
          float o1[8], o2[8];
#pragma unroll
          for (int e = 0; e < 8; ++e) { float c, s; rope_cs(pos, dd * 16 + hi * 8 + e, c, s);
              const float a = x1[e] * rr * ga[e], b = x2[e] * rr * gb[e]; o1[e] = a * c - b * s; o2[e] = b * c + a * s; }
          u32x4 w1, w2; w1.x = cvt_pk_bf16(o1[0], o1[1]); w1.y = cvt_pk_bf16(o1[2], o1[3]); w1.z = cvt_pk_bf16(o1[4], o1[5]); w1.w = cvt_pk_bf16(o1[6], o1[7]);
          w2.x = cvt_pk_bf16(o2[0], o2[1]); w2.y = cvt_pk_bf16(o2[2], o2[3]); w2.z = cvt_pk_bf16(o2[4], o2[5]); w2.w = cvt_pk_bf16(o2[6], o2[7]);
          tq[4 + dd] = __builtin_bit_cast(bf16x8, w1); tq[6 + dd] = __builtin_bit_cast(bf16x8, w2);
      }
#undef UNP
#pragma unroll
      for (int dd = 0; dd < 4; ++dd) *(bf16x8*)(lds + qro + dd * 1024) = tq[4 + dd]; }
    SWRITE_HV(0); SBAR();
    if (NT > 1) SLOAD_H(cur, KBASE(1));
    SBAR(); qkt<0>(pA0, pA1, lds, r32, hi, S.qr, qro);
    MASKT(pA0, pA1, 0); partialSM(pA0, pA1, m_reg, mnA, alA);
    if (NT > 1) { VMW(); SWRITE_H(1); }
    __syncthreads();
#define HALF_STEP(PX0, PX1, mnX, alX, PY0, PY1, alY, t, KB, VB, SB) do {                                                      \
        SBAR(); qkt<KB>(PX0, PX1, lds, r32, hi, S.qr, qro);                                             \
        finishSM(PY0, PY1, alY, l_reg, pa0, pa1, pa2, pa3); SBAR();                                                           \
        if ((t) + 1 < NT) { SLOAD_H(cur, KBASE((t) + 1)); SBAR(); }                                               \
        pv_tile<VB>(o, vb0, pa0, pa1, pa2, pa3); MASKT(PX0, PX1, (t)); partialSM(PX0, PX1, m_reg, mnX, alX);                                        \
        __syncthreads();                                                                                                      \
        if ((t) + 1 < NT) { VMW(); SWRITE_H(SB); }                                                                          \
        RESC(alX); __syncthreads(); } while (0)
    for (int t = 1; t + 1 < NT; t += 2) {
        HALF_STEP(pB0, pB1, mnB, alB, pA0, pA1, alA, t, 1, 0, 0);
        HALF_STEP(pA0, pA1, mnA, alA, pB0, pB1, alB, t + 1, 0, 1, 1);
    }
    SBAR(); qkt<1>(pB0, pB1, lds, r32, hi, S.qr, qro); SBAR();
    finishSM(pA0, pA1, alA, l_reg, pa0, pa1, pa2, pa3); SBAR();
    pv_tile<0>(o, vb0, pa0, pa1, pa2, pa3);
    MASKT(pB0, pB1, NT - 1); partialSM(pB0, pB1, m_reg, mnB, alB); __syncthreads(); RESC(alB);
    finishSM(pB0, pB1, alB, l_reg, pa0, pa1, pa2, pa3); SBAR(); pv_tile<1>(o, vb0, pa0, pa1, pa2, pa3);
    if (hi == 0) li_l[r32] = l_reg; asm volatile("s_waitcnt lgkmcnt(0)" ::: "memory");
    float rli[16];
#pragma unroll
    for (int r = 0; r < 16; ++r) rli[r] = __builtin_amdgcn_rcpf(li_l[crow(r, hi)]);
    unsigned obase = (unsigned)((wid * QBLK + 4 * hi) * OS + r32) * 2u; asm volatile("" : "+v"(obase));
#pragma unroll
    for (int r = 0; r < 16; ++r) { const unsigned orow_off = (unsigned)(((r & 3) + 8 * (r >> 2)) * OS) * 2u;
#pragma unroll
        for (int d0 = 0; d0 < 4; ++d0) { const float v = o[d0][r] * rli[r];
            const float vn = DPPF(v, 0xB1);
            if ((r32 & 1) == 0) *(unsigned*)((char*)cur.O + (obase + orow_off + (unsigned)(d0 * 64))) = cvtpk(v, vn); } }
    __syncthreads();
#undef RESC
#undef KBASE
#undef MASKT
#undef HALF_STEP
}
#undef VMW
#undef VMWN
#undef SLOAD_H
#undef SWRITE_HK
#undef SWRITE_HV
#undef SWRITE_H
#undef QLOAD
#undef LDG8

__device__ __forceinline__ BlockRef make_ref(int bh, int qb, const bf16_t* q, const bf16_t* kv, const bf16_t* kr, bf16_t* mixed, const int* pos, const float* qg) {
    const int b = bh >> 3, h = bh & 7; BlockRef r;
    r.Q = q + ((size_t)b * SEQ + (size_t)qb * QB) * QS + h * 192;
    r.K = kv + (size_t)b * SEQ * KS + h * 256; r.V = r.K + 128;
    r.KR = kr + (size_t)b * SEQ * KRS;
    r.O = mixed + ((size_t)b * SEQ + (size_t)qb * QB) * OS + 512 + h * 128; r.P0 = qb * QB;
    r.POS = pos + (size_t)b * SEQ + (size_t)qb * QB; r.QG = qg;
    return r;
}
constexpr int N_BLOCKS = BATCH * 8 * NQB;
__device__ __forceinline__ void attn_one(char* lds, const bf16_t* q, const bf16_t* kv, const bf16_t* kr, bf16_t* mixed, int i, const int* pos, const float* qg, const int wv__) {
    Seam S;
    const BlockRef cur = make_ref(i & 63, NQB - 1 - (i >> 6), q, kv, kr, mixed, pos, qg);
    attn_prime(cur, lds, S, wv__);
    attn_block(cur, lds, S, wv__);
}
#undef KSWZ
#undef KRSWZ
#undef SBAR
}
namespace tok {
constexpr int PT = 32;
constexpr int NTILES = T / PT;
constexpr int S_VM = 1040, S_XW = 144, S_XG = 272;
constexpr int O_VM = 0, O_XR = O_VM + PT * S_VM, O_XK = O_XR + PT * S_VM, O_XW = O_XK + PT * S_VM, O_XA = O_XW + PT * S_XW, O_XG = O_XA + PT * S_XW, O_PAR = O_XG + PT * S_XG, O_WB = O_PAR + 6 * 2048, O_END = O_WB + 8 * 2560;
constexpr int LDS_BYTES = O_END;
constexpr size_t WL_W2 = 0, WL_A2 = WL_W2 + 512 * 64, WL_G2 = WL_A2 + 512 * 64, WL_V1 = WL_G2 + 512 * 128, WL_V2 = WL_V1 + 32 * 512, WL_END = WL_V2 + 512 * 32;

struct Args {
    const bf16_t* p; const int* pos;
    const float *k_gain;
    const float *mu, *w0, *a0, *v0, *k_k, *k_a, *r_k;
    const bf16_t* wl;
    float *rs_q, *rs_kv; bf16_t* kr;
    bf16_t *R, *K, *V, *KK, *B, *G, *BON, *VFIRST; float* W; float *RIN, *BS;
};
__device__ __forceinline__ float4 ld4f(const float* p) { return *(const float4*)p; }
__device__ __forceinline__ void bf4(u32x2 w, float* o) { o[0] = lo_bf(w.x); o[1] = hi_bf(w.x); o[2] = lo_bf(w.y); o[3] = hi_bf(w.y); }
__device__ __forceinline__ u32x2 pk4(const float* v) { u32x2 w; w.x = cvt_pk_bf16(v[0], v[1]); w.y = cvt_pk_bf16(v[2], v[3]); return w; }

__device__ __forceinline__ void wave_store_bf16(LAS unsigned char* wb, const u32x2 (&v)[4], bf16_t* gbase, int r32, int hi, int lane) {
#pragma unroll
    for (int g = 0; g < 4; ++g) *(LAS u32x2*)(wb + r32 * 80 + 16 * g + 8 * hi) = v[g];
    asm volatile("" ::: "memory");
#pragma unroll
    for (int i = 0; i < 2; ++i) { const int tk_ = i * 16 + (lane >> 2); const u32x4 x = *(const LAS u32x4*)(wb + tk_ * 80 + (lane & 3) * 16);
        *(u32x4*)((char*)gbase + (size_t)tk_ * 1024 + (lane & 3) * 16) = x; }
    asm volatile("" ::: "memory");
}
__device__ __forceinline__ void wave_store_f32h(LAS unsigned char* wb, const f32x4 (&v)[2], float* gbase, int r32, int hi, int lane) {
#pragma unroll
    for (int j = 0; j < 2; ++j) *(LAS f32x4*)(wb + r32 * 80 + (8 * j + 4 * hi) * 4) = v[j];
    asm volatile("" ::: "memory");
#pragma unroll
    for (int i = 0; i < 2; ++i) { const int tk_ = i * 16 + (lane >> 2); const f32x4 x = *(const LAS f32x4*)(wb + tk_ * 80 + (lane & 3) * 16);
        *(f32x4*)((char*)gbase + (size_t)tk_ * 2048 + (lane & 3) * 16) = x; }
    asm volatile("" ::: "memory");
}
__device__ __forceinline__ void stage_params(const Args& A, LAS unsigned char* lds, int tid) {
    LAS float* P = (LAS float*)(lds + O_PAR);
    P[tid] = A.w0[tid]; P[512 + tid] = A.a0[tid]; P[1024 + tid] = A.v0[tid]; P[1536 + tid] = A.k_k[tid]; P[2048 + tid] = A.k_a[tid]; P[2560 + tid] = A.r_k[tid];
}
template <int LAYER>
__device__ __forceinline__ void tile(const Args& A, LAS unsigned char* lds, int tl, const int wv__, const int mode = 7) {
    const int tid = TID(), lane = tid & 63, wid = __builtin_amdgcn_readfirstlane(tid >> 6), r32 = lane & 31, hi = lane >> 5;
    const int tok0 = tl * PT;
    const bf16_t* p = A.p;
    if (mode & 1) {
        u32x2 k4v[4]; bf16_t krv[4]; int posv[4];
#pragma unroll
        for (int i = 0; i < 4; ++i) {
            const int tk = tok0 + wid + 8 * i; const bf16_t* pr = p + (size_t)tk * NP;
            k4v[i] = *(const u32x2*)(pr + C_MKV + lane * 4); krv[i] = pr[C_MKR + lane]; posv[i] = A.pos[tk];
        }
        const float kg = A.k_gain[128 + lane];
#pragma unroll
        for (int i = 0; i < 4; ++i) {
            const int tk = tok0 + wid + 8 * i;
            const u32x2 k4 = k4v[i];
            float sk = 0.f;
            { float a; a = lo_bf(k4.x); sk += a * a; a = hi_bf(k4.x); sk += a * a; a = lo_bf(k4.y); sk += a * a; a = hi_bf(k4.y); sk += a * a; }
            const float kr = bf2f(krv[i]);
            float skr = kr * kr;
            sk = wave_sum(sk); skr = wave_sum(skr);
            if (lane == 0) A.rs_kv[tk] = 1.f / sqrtf(sk * (1.f / 256.f) + RMS_EPS);
            const float krn = kr * (1.f / sqrtf(skr * (1.f / 64.f) + RMS_EPS)) * kg;
            const float other = xor32f(krn, lane);
            float c, s; rope_cs(posv[i], lane & 31, c, s);
            const float o = (lane < 32) ? (krn * c - other * s) : (krn * c + other * s);
            A.kr[(size_t)tk * 64 + lane] = f2bf(o);
        }
    }
    if (mode & 2) {
#pragma unroll 1
    for (int it = 0; it < 7; ++it) {
        u32x4 cu[2], pv[2]; f32x4 m0[2], m1[2]; int tt[2], jj[2];
#pragma unroll
        for (int u = 0; u < 2; ++u) {
            const int task = tid + (2 * it + u) * 512;
            const int t = task / 224, j = task - t * 224; tt[u] = t; jj[u] = j;
            const int tk = tok0 + t; const bool first = (tk & (SEQ - 1)) == 0;
            const bf16_t* pr = p + (size_t)tk * NP + C_RR + 8 * j;
            cu[u] = *(const u32x4*)pr;
            pv[u] = (u32x4){0u, 0u, 0u, 0u};
            if (!first) pv[u] = *(const u32x4*)(pr - NP);
            m0[u] = *(const f32x4*)(A.mu + 8 * j); m1[u] = *(const f32x4*)(A.mu + 8 * j + 4);
        }
#pragma unroll
        for (int u = 0; u < 2; ++u) {
            const int t = tt[u], j = jj[u];
            const float mu[8] = {m0[u].x, m0[u].y, m0[u].z, m0[u].w, m1[u].x, m1[u].y, m1[u].z, m1[u].w};
            const float c8[8] = {lo_bf(cu[u].x), hi_bf(cu[u].x), lo_bf(cu[u].y), hi_bf(cu[u].y), lo_bf(cu[u].z), hi_bf(cu[u].z), lo_bf(cu[u].w), hi_bf(cu[u].w)};
            const float p8[8] = {lo_bf(pv[u].x), hi_bf(pv[u].x), lo_bf(pv[u].y), hi_bf(pv[u].y), lo_bf(pv[u].z), hi_bf(pv[u].z), lo_bf(pv[u].w), hi_bf(pv[u].w)};
            float o[8];
#pragma unroll
            for (int i = 0; i < 8; ++i) o[i] = c8[i] + (p8[i] - c8[i]) * mu[i];
            if (j >= 192) {
#pragma unroll
                for (int i = 0; i < 8; ++i) { const float m = o[i]; const float e = fast_exp(j < 200 ? 2.f * m : -m); const float r = fast_rcp(e + 1.f);
                    o[i] = j < 200 ? 1.f - 2.f * r : (j < 208 ? m : r); }
            }
            u32x4 w; w.x = cvt_pk_bf16(o[0], o[1]); w.y = cvt_pk_bf16(o[2], o[3]); w.z = cvt_pk_bf16(o[4], o[5]); w.w = cvt_pk_bf16(o[6], o[7]);
            int off;
            if (j < 64) off = O_XR + t * S_VM + j * 16; else if (j < 128) off = O_XK + t * S_VM + (j - 64) * 16; else if (j < 192) off = O_VM + t * S_VM + (j - 128) * 16;
            else if (j < 200) off = O_XW + t * S_XW + (j - 192) * 16; else if (j < 208) off = O_XA + t * S_XW + (j - 200) * 16; else off = O_XG + t * S_XG + (j - 208) * 16;
            *(LAS u32x4*)(lds + off) = w;
        }
    }
    }
    __syncthreads();
    const int h = wid;
    unsigned wo64 = (unsigned)(r32 * 64 + hi * 8) * 2u, wo128 = (unsigned)(r32 * 128 + hi * 8) * 2u, wo32 = (unsigned)(r32 * 32 + hi * 8) * 2u, wo512 = (unsigned)(r32 * 512 + hi * 8) * 2u;
#define GLD8(base, off) (*(const bf16x8*)((const char*)(base) + (off)))
    const bf16_t* w2t = A.wl + WL_W2 + (size_t)(h * 64) * 64; const bf16_t* a2t = A.wl + WL_A2 + (size_t)(h * 64) * 64;
    const bf16_t* g2t = A.wl + WL_G2 + (size_t)(h * 64) * 128; const bf16_t* v2p = A.wl + WL_V2 + (size_t)(h * 64) * 32; const bf16_t* v1t = A.wl + WL_V1;
    if (mode & 4) {
        constexpr int nb = 0;
        asm volatile("" : "+v"(wo64), "+v"(wo128), "+v"(wo32), "+v"(wo512));
        const int trow = nb * 32 + r32;
        const int tk = tok0 + trow; const bool first = (tk & (SEQ - 1)) == 0;
        unsigned e512 = (unsigned)(trow * 512 + 4 * hi);
        asm volatile("" : "+v"(e512));
        const size_t t512 = (size_t)tok0 * 512;
#define CB (h * 64 + mb * 32 + 8 * g)
#define PL4(idx) (*(const LAS f32x4*)(lds + O_PAR + (idx) * 2048 + (CB + 4 * hi) * 4))
#define A2(ptr) ((char*)((ptr) + t512 + CB) + e512 * 2u)
#define A4(ptr) ((char*)((ptr) + t512 + CB) + e512 * 4u)
        bf16x8 vvf[2];
        if (LAYER > 0) {
            f32x16 vv = f32x16{};
#pragma unroll 16
            for (int ks = 0; ks < 32; ++ks) {
                const bf16x8 bv = *(const LAS bf16x8*)(lds + O_VM + trow * S_VM + (ks * 16 + hi * 8) * 2);
                const bf16x8 av = GLD8(v1t + ks * 16, wo512);
                vv = __builtin_amdgcn_mfma_f32_32x32x16_bf16(av, bv, vv, 0, 0, 0);
            }
#pragma unroll
            for (int s = 0; s < 2; ++s) {
                u32x4 bw; bw.x = cvt_pk_bf16(vv[8 * s + 0], vv[8 * s + 1]); bw.y = cvt_pk_bf16(vv[8 * s + 2], vv[8 * s + 3]); bw.z = cvt_pk_bf16(vv[8 * s + 4], vv[8 * s + 5]); bw.w = cvt_pk_bf16(vv[8 * s + 6], vv[8 * s + 7]);
                vvf[s] = __builtin_bit_cast(bf16x8, bw);
            }
        }
        float ss = 0.f, bs = 0.f;
#pragma unroll
        for (int mb = 0; mb < 2; ++mb) {
            f32x16 accW = f32x16{}, accA = f32x16{}, accG = f32x16{}, accV = f32x16{};
            u32x2 vfraw[4];
            if (LAYER > 0) {
#pragma unroll
                for (int g = 0; g < 4; ++g) vfraw[g] = *(const u32x2*)A2(A.VFIRST);
            }
#pragma unroll
            for (int ks = 0; ks < 4; ++ks) {
                const bf16x8 bw = *(const LAS bf16x8*)(lds + O_XW + trow * S_XW + (ks * 16 + hi * 8) * 2);
                const bf16x8 ba = *(const LAS bf16x8*)(lds + O_XA + trow * S_XW + (ks * 16 + hi * 8) * 2);
                const bf16x8 aw = GLD8(w2t + mb * 32 * 64 + ks * 16, wo64);
                const bf16x8 aa = GLD8(a2t + mb * 32 * 64 + ks * 16, wo64);
                accW = __builtin_amdgcn_mfma_f32_32x32x16_bf16(aw, bw, accW, 0, 0, 0);
                accA = __builtin_amdgcn_mfma_f32_32x32x16_bf16(aa, ba, accA, 0, 0, 0);
            }
#pragma unroll
            for (int ks = 0; ks < 8; ++ks) {
                const bf16x8 bg = *(const LAS bf16x8*)(lds + O_XG + trow * S_XG + (ks * 16 + hi * 8) * 2);
                const bf16x8 ag = GLD8(g2t + mb * 32 * 128 + ks * 16, wo128);
                accG = __builtin_amdgcn_mfma_f32_32x32x16_bf16(ag, bg, accG, 0, 0, 0);
            }
            if (LAYER > 0) {
#pragma unroll
                for (int s = 0; s < 2; ++s) {
                    const bf16x8 a2 = GLD8(v2p + mb * 32 * 32 + s * 16, wo32);
                    accV = __builtin_amdgcn_mfma_f32_32x32x16_bf16(a2, vvf[s], accV, 0, 0, 0);
                }
            }
            asm volatile("" ::: "memory");
            f32x4 oW[4]; u32x2 oG[4], oV[4], oR[4], oK[4], oKK[4], oB[4];
#pragma unroll
            for (int g = 0; g < 4; ++g) {
                const f32x4 w0 = PL4(0), a0 = PL4(1);
                const float w0a[4] = {w0.x, w0.y, w0.z, w0.w}, a0a[4] = {a0.x, a0.y, a0.z, a0.w};
                float dec[4], gt[4], av[4];
#pragma unroll
                for (int i = 0; i < 4; ++i) {
                    dec[i] = fast_exp(-0.6065306597126334f * sigmoidf_(accW[4 * g + i] + w0a[i]));
                    gt[i] = accG[4 * g + i];
                    av[i] = sigmoidf_(accA[4 * g + i] + a0a[i]);
                }
                oW[g] = (f32x4){dec[0], dec[1], dec[2], dec[3]};
                oG[g] = pk4(gt);
                float vm[4]; bf4(*(const LAS u32x2*)(lds + O_VM + trow * S_VM + (CB + 4 * hi) * 2), vm);
                float vf[4];
                if (LAYER > 0) {
                    const f32x4 v0 = PL4(2); const float v0a[4] = {v0.x, v0.y, v0.z, v0.w};
                    float vfi[4]; bf4(vfraw[g], vfi);
#pragma unroll
                    for (int i = 0; i < 4; ++i) vf[i] = vm[i] + (vfi[i] - vm[i]) * sigmoidf_(accV[4 * g + i] + v0a[i]);
                } else {
#pragma unroll
                    for (int i = 0; i < 4; ++i) vf[i] = vm[i];
                }
                oV[g] = pk4(vf);
                float xr[4], xk4[4];
                const u32x2 xrraw = *(const LAS u32x2*)(lds + O_XR + trow * S_VM + (CB + 4 * hi) * 2);
                bf4(xrraw, xr); bf4(*(const LAS u32x2*)(lds + O_XK + trow * S_VM + (CB + 4 * hi) * 2), xk4);
                const f32x4 kk4 = PL4(3), ka4 = PL4(4), rk4 = PL4(5);
                const float kka[4] = {kk4.x, kk4.y, kk4.z, kk4.w}, kaa[4] = {ka4.x, ka4.y, ka4.z, ka4.w}, rka[4] = {rk4.x, rk4.y, rk4.z, rk4.w};
                float k2[4], kkv[4], bn[4];
#pragma unroll
                for (int i = 0; i < 4; ++i) {
                    const float xk = xk4[i];
                    kkv[i] = xk * kka[i];
                    ss += kkv[i] * kkv[i];
                    k2[i] = xk * (1.f + (av[i] - 1.f) * kaa[i]);
                    bs += xr[i] * k2[i] * rka[i];
                    bn[i] = -kkv[i] * av[i];
                }
                oR[g] = xrraw; oK[g] = pk4(k2); oKK[g] = pk4(kkv); oB[g] = pk4(bn);
            }
#ifdef TOKPROBE
            if (mode & 8) { unsigned cs = 0u;
#pragma unroll
              for (int g = 0; g < 4; ++g) cs ^= oG[g].x ^ oG[g].y ^ oV[g].x ^ oV[g].y ^ oR[g].x ^ oR[g].y ^ oK[g].x ^ oK[g].y ^ oKK[g].x ^ oKK[g].y ^ oB[g].x ^ oB[g].y ^ __float_as_uint(oW[g].x) ^ __float_as_uint(oW[g].y) ^ __float_as_uint(oW[g].z) ^ __float_as_uint(oW[g].w);
              if (cs == 0x12345679u) A.G[(size_t)tok0 * 512 + lane] = 1; } else
#endif
            { LAS unsigned char* wb = lds + O_WB + wid * 2560;
              const size_t eb = (size_t)tok0 * 512 + h * 64 + mb * 32;
              wave_store_bf16(wb, oG, A.G + eb, r32, hi, lane);
              wave_store_bf16(wb, oV, A.V + eb, r32, hi, lane);
              if (LAYER == 0) wave_store_bf16(wb, oV, A.VFIRST + eb, r32, hi, lane);
              wave_store_bf16(wb, oR, A.R + eb, r32, hi, lane);
              wave_store_bf16(wb, oK, A.K + eb, r32, hi, lane);
              wave_store_bf16(wb, oKK, A.KK + eb, r32, hi, lane);
              wave_store_bf16(wb, oB, A.B + eb, r32, hi, lane);
              { const f32x4 w01[2] = {oW[0], oW[1]}, w23[2] = {oW[2], oW[3]};
                wave_store_f32h(wb, w01, A.W + eb, r32, hi, lane); wave_store_f32h(wb, w23, A.W + eb + 16, r32, hi, lane); } }
        }
        { auto r0 = __builtin_amdgcn_permlane32_swap(__float_as_uint(ss), __float_as_uint(ss), false, false); ss = __uint_as_float(r0[0]) + __uint_as_float(r0[1]);
          auto r1 = __builtin_amdgcn_permlane32_swap(__float_as_uint(bs), __float_as_uint(bs), false, false); bs = __uint_as_float(r1[0]) + __uint_as_float(r1[1]); }
        if (hi == 0) { A.RIN[(size_t)tk * 8 + h] = 1.f / fmaxf(sqrtf(ss), 1e-12f); A.BS[(size_t)tk * 8 + h] = bs; }
    }
#undef CB
#undef PL4
#undef A2
#undef A4
#undef GLD8
    __syncthreads();
}
__device__ __forceinline__ void lora_prep(const float* w2, const float* a2, const float* g2, const float* v1, const float* v2, bf16_t* wl, int gtid, int nthr) {
    for (int i = gtid; i < 512 * 64; i += nthr) { const int n = i >> 6, k = i & 63; wl[WL_W2 + i] = f2bf(w2[k * 512 + n]); wl[WL_A2 + i] = f2bf(a2[k * 512 + n]); }
    for (int i = gtid; i < 512 * 128; i += nthr) { const int n = i >> 7, k = i & 127; wl[WL_G2 + i] = f2bf(g2[k * 512 + n]); }
    if (v1) {
        for (int i = gtid; i < 32 * 512; i += nthr) { const int j = i >> 9, k = i & 511; wl[WL_V1 + i] = f2bf(v1[k * 32 + j]); }
        for (int i = gtid; i < 512 * 32; i += nthr) { const int n = i >> 5, q = i & 31, s = q >> 4, hh = (q >> 3) & 1, jj = q & 7;
            const int kidx = 16 * s + 8 * (jj >> 2) + 4 * hh + (jj & 3); wl[WL_V2 + i] = f2bf(v2[kidx * 512 + n]); }
    }
}
}
struct Ptrs {
    const float* in[30]; float* out; unsigned char* ws;
};
__device__ __forceinline__ void transpose_item(const float* W, int K, int N, bf16_t* WT, const float* gain, int mode, LAS float* scr, int item, int lane) {
    const int nblk = N / 64, kb = item / nblk, nb = item % nblk, k0 = 64 * kb, n0 = 64 * nb;
#pragma unroll 64
    for (int kk = 0; kk < 64; ++kk) { const float g = gain ? gain[k0 + kk] : 1.f; scr[kk * 65 + lane] = W[(size_t)(k0 + kk) * N + n0 + lane] * g; }
    asm volatile("s_waitcnt lgkmcnt(0)" ::: "memory");
    const int c = lane & 7;
#pragma unroll
    for (int j = 0; j < 8; ++j) { const int n = (lane >> 3) + 8 * j; const LAS float* s = scr + (8 * c) * 65 + n;
        u32x4 o; o.x = cvt_pk_bf16(s[0 * 65], s[1 * 65]); o.y = cvt_pk_bf16(s[2 * 65], s[3 * 65]); o.z = cvt_pk_bf16(s[4 * 65], s[5 * 65]); o.w = cvt_pk_bf16(s[6 * 65], s[7 * 65]);
        const int ng = n0 + n; int drow = ng;
        if (mode == 1) { if (ng < FF) drow = 256 * (ng >> 7) + (ng & 127); else { const int f = ng - FF; drow = 256 * (f >> 7) + 128 + (f & 127); } }
        *(u32x4*)(WT + (size_t)drow * K + k0 + 8 * c) = o; }
    asm volatile("s_waitcnt lgkmcnt(0)" ::: "memory");
}
typedef const Ptrs __attribute__((address_space(4)))* PtrTab;
constexpr int CV_IN = (DM / 64) * (INW / 64), CV_QB = (512 / 64) * (QW / 64), CV_KVB = (256 / 64) * (KVW / 64), CV_O = (DM / 64) * (DM / 64),
              CV_GU = (DM / 64) * (2 * FF / 64), CV_DN = (FF / 64) * (DM / 64);
constexpr int CV_NI = CV_IN + CV_QB + CV_KVB + CV_O + CV_GU + CV_DN;
__device__ __forceinline__ void convert_wave_item(PtrTab pt, int l, int it, LAS float* scr, int lane) {
    unsigned char* wl = pt->ws + WS_W + (size_t)l * W_LAYER;
    int r = it;
    if (r < CV_IN) { transpose_item(pt->in[3] + (size_t)l * DM * INW, DM, INW, (bf16_t*)(wl + WO_IN), pt->in[2] + l * DM, 0, scr, r, lane); return; } r -= CV_IN;
    if (r < CV_QB) { transpose_item(pt->in[7] + (size_t)l * 512 * QW, 512, QW, (bf16_t*)(wl + WO_QB), pt->in[6] + l * 512, 0, scr, r, lane); return; } r -= CV_QB;
    if (r < CV_KVB) { transpose_item(pt->in[9] + (size_t)l * 256 * KVW, 256, KVW, (bf16_t*)(wl + WO_KVB), pt->in[8] + l * 256, 0, scr, r, lane); return; } r -= CV_KVB;
    if (r < CV_O) { transpose_item(pt->in[26] + (size_t)l * DM * DM, DM, DM, (bf16_t*)(wl + WO_O), nullptr, 0, scr, r, lane); return; } r -= CV_O;
    if (r < CV_GU) { transpose_item(pt->in[28] + (size_t)l * DM * 2 * FF, DM, 2 * FF, (bf16_t*)(wl + WO_GU), pt->in[27] + l * DM, 1, scr, r, lane); return; } r -= CV_GU;
    transpose_item(pt->in[29] + (size_t)l * FF * DM, FF, DM, (bf16_t*)(wl + WO_DN), nullptr, 0, scr, r, lane);
}
__device__ __forceinline__ void convert_misc(PtrTab pt, int l, int gtid, int nthr) {
    unsigned char* wl = pt->ws + WS_W + (size_t)l * W_LAYER;
    { u32x4* z = (u32x4*)(wl + WO_IN + (size_t)INW * DM * 2); const int n16 = (NP - INW) * DM * 2 / 16;
      for (int i = gtid; i < n16; i += nthr) z[i] = (u32x4){0u, 0u, 0u, 0u}; }
    tok::lora_prep(pt->in[14] + (size_t)l * 64 * 512, pt->in[16] + (size_t)l * 64 * 512, pt->in[17] + (size_t)l * 128 * 512,
                   l > 0 ? pt->in[19] + (size_t)(l - 1) * 512 * 32 : nullptr, l > 0 ? pt->in[20] + (size_t)(l - 1) * 32 * 512 : nullptr,
                   (bf16_t*)(wl + WO_LORA), gtid, nthr);
}
constexpr int CV_TI = (CV_NI + 63) / 64, CV_MISC = 8, CV_ITEMS = CV_TI + CV_MISC;
constexpr int CV_EARLY = CV_IN + CV_QB + CV_KVB;
constexpr int CV_LATE0 = (CV_NI - CV_EARLY + 63) / 64;
__device__ __forceinline__ void convert_queue_item(PtrTab pt, int l, int ci, LAS float* scr, int wid, int lane) {
    asm volatile("" : "+s"(pt));
    if (ci < CV_TI) {
        for (int k = 0; k < 8; ++k) { const int it = ci * 64 + k * 8 + wid; if (it < CV_NI) convert_wave_item(pt, l, it, scr, lane); }
    } else if (ci < CV_ITEMS) convert_misc(pt, l, (ci - CV_TI) * 512 + wid * 64 + lane, CV_MISC * 512);
    else { for (int k = 0; k < 8; ++k) { const int it = CV_EARLY + (ci - CV_ITEMS) * 64 + k * 8 + wid; if (it < CV_NI) convert_wave_item(pt, 0, it, scr, lane); } }
}
__device__ __forceinline__ void prologue_phase(PtrTab pt, LAS float* scr, int gw, int ngw, int lane) {
#ifdef CONV_IN_MIXERS
    for (int it = gw; it < CV_NI; it += ngw) convert_wave_item(pt, 0, it, scr, lane);
    convert_misc(pt, 0, gw * 64 + lane, ngw * 64);
#else
    for (int l = 0; l < DEPTH; ++l) {
        for (int it = gw; it < CV_NI; it += ngw) convert_wave_item(pt, l, it, scr, lane);
        convert_misc(pt, l, gw * 64 + lane, ngw * 64);
    }
#endif
    const float* x_in = pt->in[0]; const float* hb_in = pt->in[4]; unsigned char* ws_ = pt->ws;
    { bf16_t* xb = (bf16_t*)(ws_ + WS_XB); float* ssa = (float*)(ws_ + WS_SSA);
      for (int m0 = gw; m0 < T; m0 += 2 * ngw) {
        f32x4 v[2][8];
#pragma unroll
        for (int u = 0; u < 2; ++u) { const f32x4* xr = (const f32x4*)(x_in + (size_t)(m0 + u * ngw) * DM) + lane;
#pragma unroll
          for (int j = 0; j < 8; ++j) v[u][j] = xr[64 * j]; }
#pragma unroll
        for (int u = 0; u < 2; ++u) {
          const int m = m0 + u * ngw; float s = 0.f;
#pragma unroll
          for (int j = 0; j < 8; ++j) s += (v[u][j].x * v[u][j].x + v[u][j].y * v[u][j].y) + (v[u][j].z * v[u][j].z + v[u][j].w * v[u][j].w);
          s = wave_sum(s);
          if (lane < 32) ssa[(size_t)m * 32 + lane] = lane == 0 ? s : 0.f;
          u32x2* o = (u32x2*)(xb + (size_t)m * DM) + lane;
#pragma unroll
          for (int j = 0; j < 8; ++j) { u32x2 w; w.x = cvt_pk_bf16(v[u][j].x, v[u][j].y); w.y = cvt_pk_bf16(v[u][j].z, v[u][j].w); o[64 * j] = w; }
        }
      } }
    { float* lb = (float*)(ws_ + WS_LB); const float* hb = hb_in;
      for (int c = gw * 64 + lane; c < 512; c += ngw * 64) {
          float v[DEPTH], mx = -1e30f, s = 0.f;
          for (int l = 0; l < DEPTH; ++l) { v[l] = hb[l * 512 + c]; mx = fmaxf(mx, v[l]); }
          for (int l = 0; l < DEPTH; ++l) { v[l] = expf(v[l] - mx); s += v[l]; }
          float cum = 0.f; const float inv = 1.f / s;
          for (int l = 0; l < DEPTH; ++l) { cum += v[l] * inv; lb[l * 512 + c] = cum - v[0] * inv; }
      } }
}

__device__ __forceinline__ void rownorm_phase(const float* x, bf16_t* xb, float* rs, int gw, int ngw, int lane) {
    for (int m = gw; m < T; m += ngw) {
        const f32x4* xr = (const f32x4*)(x + (size_t)m * DM) + lane;
        f32x4 v[8]; float s = 0.f;
#pragma unroll
        for (int j = 0; j < 8; ++j) { v[j] = xr[64 * j]; s += (v[j].x * v[j].x + v[j].y * v[j].y) + (v[j].z * v[j].z + v[j].w * v[j].w); }
        s = wave_sum(s);
        if (lane == 0) rs[m] = 1.f / sqrtf(s * (1.f / DM) + RMS_EPS);
        u32x2* o = (u32x2*)(xb + (size_t)m * DM) + lane;
#pragma unroll
        for (int j = 0; j < 8; ++j) { u32x2 w; w.x = cvt_pk_bf16(v[j].x, v[j].y); w.y = cvt_pk_bf16(v[j].z, v[j].w); o[64 * j] = w; }
    }
}

__device__ __forceinline__ void qknorm_phase(bf16_t* q, bf16_t* kv, const int* pos, const float* q_gain, const float* k_gain, int gw, int ngw, int lane, bf16_t* qo = nullptr, bf16_t* kvo = nullptr) {
    if (!qo) { qo = q; kvo = kv; }
    const float gk0 = k_gain[2 * lane], gk1 = k_gain[2 * lane + 1];
#pragma unroll 2
    for (int tk = gw; tk < T; tk += ngw) {
        bf16_t* qrow = q + (size_t)tk * QW; bf16_t* krow = kv + (size_t)tk * KVW; bf16_t* qorow = qo + (size_t)tk * QW; bf16_t* korow = kvo + (size_t)tk * KVW;
#pragma unroll
        for (int h = 0; h < 8; ++h) {
            const unsigned kn = *(const unsigned*)(krow + h * 256 + 2 * lane);
            const float b0 = lo_bf(kn), b1 = hi_bf(kn);
            const float sk = wave_sum(b0 * b0 + b1 * b1);
            const float rk = 1.f / sqrtf(sk * (1.f / 128.f) + RMS_EPS);
            *(unsigned*)(korow + h * 256 + 2 * lane) = cvt_pk_bf16(b0 * rk * gk0, b1 * rk * gk1);
        }
    }
}
namespace rwk {
constexpr int TC = 64;
constexpr int NCH = SEQ / TC;
constexpr int N_ITEMS = BATCH * 8 * 2;
constexpr int OPS = 320;
constexpr int VS = TC + 4;
constexpr int L_KK = 0, L_W = 64, L_BN = 128, L_KP = 192, L_R = 256, L_V = TC * OPS, L_Y = L_V + 32 * VS, L_DUM = L_Y + 32 * VS, L_END = L_DUM + 512 * 4;
constexpr int LDS_BYTES = L_END * 4;
struct Args { const bf16_t *R, *K, *KK, *B; bf16_t* V; const float* W; const float* RIN; bf16_t* Yout; };

__device__ __forceinline__ float dpp_xor1(float x) { return __int_as_float(__builtin_amdgcn_update_dpp(0, __float_as_int(x), 0xB1, 0xf, 0xf, true)); }
__device__ __forceinline__ float dpp_xor2(float x) { return __int_as_float(__builtin_amdgcn_update_dpp(0, __float_as_int(x), 0x4E, 0xf, 0xf, true)); }
__device__ __forceinline__ float dpp_hmir(float x) { return __int_as_float(__builtin_amdgcn_update_dpp(0, __float_as_int(x), 0x141, 0xf, 0xf, true)); }
__device__ __forceinline__ float red8(float x) { x += dpp_xor1(x); x += dpp_xor2(x); x += dpp_hmir(x); return x; }

struct Pre { u32x4 r, k, v, kk, b; f32x4 w0, w1; float rin; };
__device__ __forceinline__ void pre_load(Pre& q, const Args& A, size_t off, bool hasv) {
    q.r = *(const u32x4*)(A.R + off); q.k = *(const u32x4*)(A.K + off); q.kk = *(const u32x4*)(A.KK + off); q.b = *(const u32x4*)(A.B + off);
    if (hasv) q.v = *(const u32x4*)(A.V + off);
    q.w0 = *(const f32x4*)(A.W + off); q.w1 = *(const f32x4*)(A.W + off + 4);
    q.rin = A.RIN[(off >> 9) * 8 + ((off >> 6) & 7)];
}
__device__ __forceinline__ void st8(LAS float* d, u32x4 w, float sc = 1.f) {
    *(LAS f32x4*)d = (f32x4){lo_bf(w.x) * sc, hi_bf(w.x) * sc, lo_bf(w.y) * sc, hi_bf(w.y) * sc}; *(LAS f32x4*)(d + 4) = (f32x4){lo_bf(w.z) * sc, hi_bf(w.z) * sc, lo_bf(w.w) * sc, hi_bf(w.w) * sc};
}

template <int VAR = 0>
__device__ __forceinline__ void item(const Args& A, LAS float* lds, int it, const int wv__) {
    const int tid = TID(), bh = it >> 1, half = it & 1, b = bh >> 3, h = bh & 7;
    const int st = tid >> 3, sc8 = (tid & 7) * 8;
    const bool hasv = ((tid & 7) >> 2) == half;
    const int vc8 = sc8 - half * 32;
    const size_t base = (size_t)b * SEQ * 512 + h * 64;
    const int row = tid >> 3, kp = tid & 7;
    f32x2 s0[4];
#pragma unroll
    for (int i = 0; i < 4; ++i) s0[i] = (f32x2){0.f, 0.f};
    Pre pre; pre_load(pre, A, base + (size_t)st * 512 + sc8, hasv);
    for (int ck = 0; ck < NCH; ++ck) {
        { const int o = st * OPS + sc8;
          st8(lds + L_R + o, pre.r); st8(lds + L_KP + o, pre.k); st8(lds + L_KK + o, pre.kk, pre.rin); st8(lds + L_BN + o, pre.b, pre.rin);
          *(LAS f32x4*)(lds + L_W + o) = pre.w0; *(LAS f32x4*)(lds + L_W + o + 4) = pre.w1;
          if (hasv) { LAS float* vd = lds + L_V + vc8 * VS + st;
            vd[0 * VS] = lo_bf(pre.v.x); vd[1 * VS] = hi_bf(pre.v.x); vd[2 * VS] = lo_bf(pre.v.y); vd[3 * VS] = hi_bf(pre.v.y);
            vd[4 * VS] = lo_bf(pre.v.z); vd[5 * VS] = hi_bf(pre.v.z); vd[6 * VS] = lo_bf(pre.v.w); vd[7 * VS] = hi_bf(pre.v.w); } }
        __syncthreads();
        if (ck + 1 < NCH) pre_load(pre, A, base + (size_t)((ck + 1) * TC + st) * 512 + sc8, hasv);
        if (tid < 256) {
            const LAS float* pk = lds + 8 * kp;
            const LAS float* pv = lds + L_V + row * VS;
            LAS float* pyw = kp == 0 ? lds + L_Y + row * VS : lds + L_DUM + tid * 4;
            const int pyinc = kp == 0 ? 4 : 0;
#define RW_LOAD(P, t_) do { const LAS float* q_ = pk + (t_) * OPS; \
                P##kk0 = *(const LAS f32x4*)(q_ + L_KK); P##kk1 = *(const LAS f32x4*)(q_ + L_KK + 4); \
                P##w0 = *(const LAS f32x4*)(q_ + L_W); P##w1 = *(const LAS f32x4*)(q_ + L_W + 4); \
                P##b0 = *(const LAS f32x4*)(q_ + L_BN); P##b1 = *(const LAS f32x4*)(q_ + L_BN + 4); \
                P##k0 = *(const LAS f32x4*)(q_ + L_KP); P##k1 = *(const LAS f32x4*)(q_ + L_KP + 4); \
                P##r0 = *(const LAS f32x4*)(q_ + L_R); P##r1 = *(const LAS f32x4*)(q_ + L_R + 4); } while (0)
#define F2(v4, i) ((f32x2){(v4)[2 * (i)], (v4)[2 * (i) + 1]})
#define RW_DOT(S, A0, A1) ({ f32x2 p_ = S[0] * F2(A0, 0); p_ = __builtin_elementwise_fma(S[1], F2(A0, 1), p_); p_ = __builtin_elementwise_fma(S[2], F2(A1, 0), p_); p_ = __builtin_elementwise_fma(S[3], F2(A1, 1), p_); p_.x + p_.y; })
#define RW_STEP(P, v_, yo_) do { \
                float sa0 = RW_DOT(s0, P##kk0, P##kk1); \
                const f32x2 va = (f32x2){v_, v_}; \
                f32x2 ta[4]; \
                ta[0] = va * F2(P##k0, 0); ta[1] = va * F2(P##k0, 1); ta[2] = va * F2(P##k1, 0); ta[3] = va * F2(P##k1, 1); \
                sa0 = red8(sa0); \
                const f32x2 sA = (f32x2){sa0, sa0}; \
                ta[0] = __builtin_elementwise_fma(sA, F2(P##b0, 0), ta[0]); ta[1] = __builtin_elementwise_fma(sA, F2(P##b0, 1), ta[1]); \
                ta[2] = __builtin_elementwise_fma(sA, F2(P##b1, 0), ta[2]); ta[3] = __builtin_elementwise_fma(sA, F2(P##b1, 1), ta[3]); \
                s0[0] = __builtin_elementwise_fma(s0[0], F2(P##w0, 0), ta[0]); s0[1] = __builtin_elementwise_fma(s0[1], F2(P##w0, 1), ta[1]); \
                s0[2] = __builtin_elementwise_fma(s0[2], F2(P##w1, 0), ta[2]); s0[3] = __builtin_elementwise_fma(s0[3], F2(P##w1, 1), ta[3]); \
                float y0 = RW_DOT(s0, P##r0, P##r1); \
                yo_ = red8(y0); } while (0)
            f32x4 Akk0, Akk1, Aw0, Aw1, Ab0, Ab1, Ak0, Ak1, Ar0, Ar1;
            f32x4 Bkk0, Bkk1, Bw0, Bw1, Bb0, Bb1, Bk0, Bk1, Br0, Br1;
            RW_LOAD(A, 0);
            f32x4 v4 = *(const LAS f32x4*)pv;
#pragma unroll 1
            for (int t = 0; t < TC; t += 4) {
                const f32x4 vn = *(const LAS f32x4*)(pv + t + 4);
                f32x4 y4;
                RW_LOAD(B, t + 1); RW_STEP(A, v4.x, y4.x);
                RW_LOAD(A, t + 2); RW_STEP(B, v4.y, y4.y);
                RW_LOAD(B, t + 3); RW_STEP(A, v4.z, y4.z);
                RW_LOAD(A, t + 4); RW_STEP(B, v4.w, y4.w);
                *(LAS f32x4*)pyw = y4; pyw += pyinc;
                v4 = vn;
            }
#undef RW_LOAD
#undef RW_DOT
#undef RW_STEP
#undef F2
        }
        __syncthreads();
        if (tid >= 256) {
            const int t = (tid - 256) >> 2, c8 = (tid & 3) * 8;
            const LAS float* yr = lds + L_Y + c8 * VS + t;
            u32x4 w; w.x = cvt_pk_bf16(yr[0 * VS], yr[1 * VS]); w.y = cvt_pk_bf16(yr[2 * VS], yr[3 * VS]); w.z = cvt_pk_bf16(yr[4 * VS], yr[5 * VS]); w.w = cvt_pk_bf16(yr[6 * VS], yr[7 * VS]);
            *(u32x4*)(A.Yout + base + (size_t)(ck * TC + t) * 512 + half * 32 + c8) = w;
        }
    }
    __syncthreads();
}

struct PostArgs { const bf16_t *Y, *G, *BON; const float *ln_w, *ln_b, *BS; bf16_t* mixed; };
__device__ __forceinline__ void post_phase(const PostArgs& A, int gw, int ngw, int lane) {
    float lnw[8], lnb[8];
#pragma unroll
    for (int i = 0; i < 8; ++i) { lnw[i] = A.ln_w[lane * 8 + i]; lnb[i] = A.ln_b[lane * 8 + i]; }
    for (int tk = gw; tk < T; tk += ngw) {
        const size_t o = (size_t)tk * 512 + lane * 8;
        const u32x4 y4 = *(const u32x4*)(A.Y + o), g4 = *(const u32x4*)(A.G + o), b4 = *(const u32x4*)(A.BON + o);
        float y[8] = {lo_bf(y4.x), hi_bf(y4.x), lo_bf(y4.y), hi_bf(y4.y), lo_bf(y4.z), hi_bf(y4.z), lo_bf(y4.w), hi_bf(y4.w)};
        const float g[8] = {lo_bf(g4.x), hi_bf(g4.x), lo_bf(g4.y), hi_bf(g4.y), lo_bf(g4.z), hi_bf(g4.z), lo_bf(g4.w), hi_bf(g4.w)};
        const float bo[8] = {lo_bf(b4.x), hi_bf(b4.x), lo_bf(b4.y), hi_bf(b4.y), lo_bf(b4.z), hi_bf(b4.z), lo_bf(b4.w), hi_bf(b4.w)};
        const float bsc = A.BS[(size_t)tk * 8 + (lane >> 3)];
        float sm = 0.f;
#pragma unroll
        for (int i = 0; i < 8; ++i) sm += y[i];
        sm = red8(sm); const float mean = sm * (1.f / 64.f);
        float sv = 0.f;
#pragma unroll
        for (int i = 0; i < 8; ++i) { y[i] -= mean; sv += y[i] * y[i]; }
        sv = red8(sv); const float rstd = 1.f / sqrtf(sv * (1.f / 64.f) + 64e-5f);
        float ov[8];
#pragma unroll
        for (int i = 0; i < 8; ++i) ov[i] = (y[i] * rstd * lnw[i] + lnb[i] + bsc * bo[i]) * g[i];
        u32x4 w; w.x = cvt_pk_bf16(ov[0], ov[1]); w.y = cvt_pk_bf16(ov[2], ov[3]); w.z = cvt_pk_bf16(ov[4], ov[5]); w.w = cvt_pk_bf16(ov[6], ov[7]);
        *(u32x4*)(A.mixed + (size_t)tk * DM + 1536 + lane * 8) = w;
    }
}
}
namespace rwc {
constexpr int TB = 32;
constexpr int NB = SEQ / TB;
constexpr int OPS = 320;
constexpr int L_KK = 0, L_W = 64, L_BN = 128, L_KP = 192, L_R = 256;
constexpr int O_RAW = 0;
constexpr int O_VT = O_RAW + TB * OPS * 4;
constexpr int VT_ROW = 40, VT_BUF = 2 * 64 * VT_ROW;
constexpr int O_IMG = O_VT + 2 * VT_BUF;
constexpr int RS = 144;
constexpr int I_A = 0, I_R = I_A + 16 * RS, I_B = I_R + 16 * RS, I_K = I_B + 16 * RS, I_BKT = I_K + 16 * RS;
constexpr int SR = 80;
constexpr int I_LAK = I_BKT + 64 * SR, I_TP = I_LAK + 16 * SR, I_MM = I_TP + 16 * SR, I_GC = I_MM + 16 * SR, I_LAB = I_GC + 256, IMG_BYTES = I_LAB + 16 * SR;
constexpr int O_YB = O_IMG + 2 * IMG_BYTES;
constexpr int LDS_BYTES = O_YB + TB * 64 * 4;
struct Args { const bf16_t *R, *K, *KK, *B, *V; const float* W; const float* RIN; const bf16_t* G; const float *BS, *ln_w, *ln_b; bf16_t* mixed; };
typedef unsigned short u16;

struct Pre { u32x2 r, k, kk, b, v; f32x4 w; float rin; };
__device__ __forceinline__ void pre_load(Pre& q, const Args& A, size_t off) {
    q.r = *(const u32x2*)(A.R + off); q.k = *(const u32x2*)(A.K + off); q.kk = *(const u32x2*)(A.KK + off); q.b = *(const u32x2*)(A.B + off); q.v = *(const u32x2*)(A.V + off);
    q.w = *(const f32x4*)(A.W + off);
    q.rin = A.RIN[(off >> 9) * 8 + ((off >> 6) & 7)];
}
__device__ __forceinline__ float red16(float x) { x += DPPF(x, 0xB1); x += DPPF(x, 0x4E); x += DPPF(x, 0x141); x += DPPF(x, 0x140); return x; }
__device__ __forceinline__ void st4(LAS float* d, u32x2 w, float sc = 1.f) { *(LAS f32x4*)d = (f32x4){lo_bf(w.x) * sc, hi_bf(w.x) * sc, lo_bf(w.y) * sc, hi_bf(w.y) * sc}; }
__device__ __forceinline__ f32x4 mfma16(u32x4 a, u32x4 b, f32x4 c) { return __builtin_amdgcn_mfma_f32_16x16x32_bf16(__builtin_bit_cast(bf16x8, a), __builtin_bit_cast(bf16x8, b), c, 0, 0, 0); }

__device__ __forceinline__ void item(const Args& A, LAS unsigned char* lds, int bh, const int wv__) {
    const int tid = TID(), lane = tid & 63, wid = __builtin_amdgcn_readfirstlane(tid >> 6);
    const int b = bh >> 3, h = bh & 7;
    const size_t base = (size_t)b * SEQ * 512 + h * 64;
    const int st = tid >> 4, c4 = (tid & 15) * 4;
    const int n16 = lane & 15, g = lane >> 4;
    f32x4 Z[4];
#pragma unroll
    for (int i = 0; i < 4; ++i) Z[i] = (f32x4){0.f, 0.f, 0.f, 0.f};
    u32x4 Zq[2] = {(u32x4){0u, 0u, 0u, 0u}, (u32x4){0u, 0u, 0u, 0u}};
    Pre pre; pre_load(pre, A, base + (size_t)st * 512 + c4);
    LAS float* raw = (LAS float*)(lds + O_RAW);
    LAS float* yb = (LAS float*)(lds + O_YB);
    const f32x4 lnw = *(const f32x4*)(A.ln_w + h * 64 + c4), lnb = *(const f32x4*)(A.ln_b + h * 64 + c4);
    u32x2 vprev = (u32x2){0u, 0u}, gq = (u32x2){0u, 0u}; float bsq = 0.f;
#define RWC_POST(bprev) do { \
        const f32x4 y4 = *(const LAS f32x4*)(yb + st * 64 + c4); \
        float sm = (y4.x + y4.y) + (y4.z + y4.w); sm = red16(sm); const float mean = sm * (1.f / 64.f); \
        const float d0 = y4.x - mean, d1 = y4.y - mean, d2 = y4.z - mean, d3 = y4.w - mean; \
        float sv = (d0 * d0 + d1 * d1) + (d2 * d2 + d3 * d3); sv = red16(sv); const float rstd = 1.f / sqrtf(sv * (1.f / 64.f) + 64e-5f); \
        const float o0 = (d0 * rstd * lnw.x + lnb.x + bsq * lo_bf(vprev.x)) * lo_bf(gq.x), o1 = (d1 * rstd * lnw.y + lnb.y + bsq * hi_bf(vprev.x)) * hi_bf(gq.x); \
        const float o2 = (d2 * rstd * lnw.z + lnb.z + bsq * lo_bf(vprev.y)) * lo_bf(gq.y), o3 = (d3 * rstd * lnw.w + lnb.w + bsq * hi_bf(vprev.y)) * hi_bf(gq.y); \
        *(u32x2*)(A.mixed + ((size_t)b * SEQ + (bprev) * TB + st) * DM + 1536 + h * 64 + c4) = (u32x2){cvt_pk_bf16(o0, o1), cvt_pk_bf16(o2, o3)}; } while (0)
    for (int bt = 0; bt < NB; ++bt) {
        LAS unsigned char* vt = lds + O_VT + (bt & 1) * VT_BUF;
        { LAS float* d = raw + st * OPS + c4;
          st4(d + L_R, pre.r); st4(d + L_KP, pre.k); st4(d + L_KK, pre.kk, pre.rin); st4(d + L_BN, pre.b, pre.rin); *(LAS f32x4*)(d + L_W) = pre.w;
          LAS unsigned char* vd = vt + ((st >> 4) * 64 + c4) * VT_ROW + (st & 15) * 2;
          *(LAS u16*)(vd) = (u16)(pre.v.x & 0xffffu); *(LAS u16*)(vd + VT_ROW) = (u16)(pre.v.x >> 16); *(LAS u16*)(vd + 2 * VT_ROW) = (u16)(pre.v.y & 0xffffu); *(LAS u16*)(vd + 3 * VT_ROW) = (u16)(pre.v.y >> 16); }
        __syncthreads();
        if (bt > 0) RWC_POST(bt - 1);
        vprev = pre.v;
        { const size_t tk = (size_t)b * SEQ + bt * TB + st; gq = *(const u32x2*)(A.G + tk * 512 + h * 64 + c4); bsq = A.BS[tk * 8 + h]; }
        if (bt + 1 < NB) pre_load(pre, A, base + (size_t)((bt + 1) * TB + st) * 512 + c4);
        { const int c = wid >> 2, gg = wid & 3, j = lane;
          LAS unsigned char* img = lds + O_IMG + c * IMG_BYTES;
          const LAS float* rw = raw + (16 * c) * OPS + j;
          float G = 1.f;
#pragma unroll
          for (int tp = 0; tp < 12; ++tp) { const float wv = rw[tp * OPS + L_W]; G *= (tp < 4 * gg) ? wv : 1.f; }
          float bq[4], kq[4], xw[4], xa[4], xr[4];
#pragma unroll
          for (int e = 0; e < 4; ++e) { const LAS float* q = rw + (4 * gg + e) * OPS; xw[e] = q[L_W]; xa[e] = q[L_KK]; xr[e] = q[L_R]; bq[e] = q[L_BN]; kq[e] = q[L_KP]; }
#pragma unroll
          for (int e = 0; e < 4; ++e) {
              const int t = 4 * gg + e;
              const float Gm1 = G; G *= xw[e]; const float inv = 1.f / G;
              const float at = xa[e] * Gm1, rt = xr[e] * G; bq[e] *= inv; kq[e] *= inv;
              LAS unsigned char* o = img + t * RS + j * 2;
              *(LAS u16*)(o + I_A) = f2bf(at); *(LAS u16*)(o + I_R) = f2bf(rt); *(LAS u16*)(o + I_B) = f2bf(bq[e]); *(LAS u16*)(o + I_K) = f2bf(kq[e]);
          }
          *(LAS u32x4*)(img + I_BKT + j * SR + gg * 16) = (u32x4){cvt_pk_bf16(bq[0], bq[1]), cvt_pk_bf16(bq[2], bq[3]), cvt_pk_bf16(kq[0], kq[1]), cvt_pk_bf16(kq[2], kq[3])};
          if (gg == 3) *(LAS float*)(img + I_GC + j * 4) = G;
        }
        __syncthreads();
        { const int c = wid >> 2, tt = wid & 3;
          LAS unsigned char* img = lds + O_IMG + c * IMG_BYTES;
          const LAS unsigned char* ia = img + (tt < 2 ? I_A : I_R) + n16 * RS + g * 16;
          const LAS unsigned char* ib = img + ((tt & 1) ? I_K : I_B) + n16 * RS + g * 16;
          f32x4 p = (f32x4){0.f, 0.f, 0.f, 0.f};
          p = mfma16(*(const LAS u32x4*)ia, *(const LAS u32x4*)ib, p);
          p = mfma16(*(const LAS u32x4*)(ia + 64), *(const LAS u32x4*)(ib + 64), p);
          const int s = n16;
          if (tt == 0) {
              LAS float* lab = (LAS float*)(img + I_LAB);
#pragma unroll
              for (int r = 0; r < 4; ++r) { const int t = 4 * g + r; lab[t * 20 + s] = t > s ? p[r] : 0.f; }
              asm volatile("s_waitcnt lgkmcnt(0)" ::: "memory");
              float T[16];
#pragma unroll
              for (int t = 0; t < 16; ++t) {
                  float a4[4] = {(s == t) ? 1.f : 0.f, 0.f, 0.f, 0.f};
#pragma unroll
                  for (int q4 = 0; q4 * 4 < t; ++q4) {
                      const f32x4 l4 = *(const LAS f32x4*)(lab + t * 20 + 4 * q4);
#pragma unroll
                      for (int e = 0; e < 4; ++e) if (4 * q4 + e < t) a4[e] += l4[e] * T[4 * q4 + e];
                  }
                  T[t] = (a4[0] + a4[1]) + (a4[2] + a4[3]);
              }
#pragma unroll
              for (int t = 0; t < 16; ++t) *(LAS u16*)(img + I_TP + t * SR + (s >> 2) * 16 + (s & 3) * 2) = f2bf(T[t] - ((s == t) ? 1.f : 0.f));
          } else {
              const int ofs = (tt == 1 ? I_LAK : I_MM) + (s >> 2) * 16 + (tt == 3 ? 8 : 0) + (s & 3) * 2;
#pragma unroll
              for (int r = 0; r < 4; ++r) { const int t = 4 * g + r; const bool keep = tt == 1 ? (t > s) : (t >= s); *(LAS u16*)(img + ofs + t * SR) = f2bf(keep ? p[r] : 0.f); }
          }
        }
        __syncthreads();
        if (wid < 4) {
            const int i = 16 * wid + n16;
#pragma unroll 1
            for (int c = 0; c < 2; ++c) {
                const LAS unsigned char* img = lds + O_IMG + c * IMG_BYTES;
                const LAS unsigned char* ra = img + n16 * RS + g * 8;
                u32x4 aA[2], aR[2], aBK[4]; f32x4 gc[4];
#pragma unroll
                for (int ks = 0; ks < 2; ++ks) {
                    const u32x2 a0 = *(const LAS u32x2*)(ra + I_A + ks * 64), a1 = *(const LAS u32x2*)(ra + I_A + ks * 64 + 32);
                    const u32x2 r0 = *(const LAS u32x2*)(ra + I_R + ks * 64), r1 = *(const LAS u32x2*)(ra + I_R + ks * 64 + 32);
                    aA[ks] = (u32x4){a0.x, a0.y, a1.x, a1.y}; aR[ks] = (u32x4){r0.x, r0.y, r1.x, r1.y};
                }
                const u32x2 vv = *(const LAS u32x2*)(vt + (c * 64 + i) * VT_ROW + g * 8);
                const u32x2 al = *(const LAS u32x2*)(img + I_LAK + n16 * SR + g * 16);
                const u32x2 at = *(const LAS u32x2*)(img + I_TP + n16 * SR + g * 16);
                const u32x4 aM = *(const LAS u32x4*)(img + I_MM + n16 * SR + g * 16);
#pragma unroll
                for (int jt = 0; jt < 4; ++jt) { aBK[jt] = *(const LAS u32x4*)(img + I_BKT + (16 * jt + n16) * SR + g * 16); gc[jt] = *(const LAS f32x4*)(img + I_GC + (16 * jt + 4 * g) * 4); }
                f32x4 D1 = (f32x4){0.f, 0.f, 0.f, 0.f}, D2 = D1;
#pragma unroll
                for (int ks = 0; ks < 2; ++ks) { D1 = mfma16(aA[ks], Zq[ks], D1); D2 = mfma16(aR[ks], Zq[ks], D2); }
                D1 = mfma16((u32x4){al.x, al.y, 0u, 0u}, (u32x4){vv.x, vv.y, 0u, 0u}, D1);
                const f32x4 U = mfma16((u32x4){at.x, at.y, 0u, 0u}, (u32x4){cvt_pk_bf16(D1[0], D1[1]), cvt_pk_bf16(D1[2], D1[3]), 0u, 0u}, D1);
                const u32x4 buv = (u32x4){cvt_pk_bf16(U[0], U[1]), cvt_pk_bf16(U[2], U[3]), vv.x, vv.y};
                const f32x4 Y = mfma16(aM, buv, D2);
#pragma unroll
                for (int jt = 0; jt < 4; ++jt) { Z[jt] = mfma16(aBK[jt], buv, Z[jt]); Z[jt] = Z[jt] * gc[jt]; }
                Zq[0] = (u32x4){cvt_pk_bf16(Z[0][0], Z[0][1]), cvt_pk_bf16(Z[0][2], Z[0][3]), cvt_pk_bf16(Z[1][0], Z[1][1]), cvt_pk_bf16(Z[1][2], Z[1][3])};
                Zq[1] = (u32x4){cvt_pk_bf16(Z[2][0], Z[2][1]), cvt_pk_bf16(Z[2][2], Z[2][3]), cvt_pk_bf16(Z[3][0], Z[3][1]), cvt_pk_bf16(Z[3][2], Z[3][3])};
                LAS float* yo = yb + (16 * c + 4 * g) * 64 + i;
#pragma unroll
                for (int r = 0; r < 4; ++r) yo[r * 64] = Y[r];
            }
        }
    }
    __syncthreads();
    RWC_POST(NB - 1);
    __syncthreads();
#undef RWC_POST
}
}
namespace hg {
constexpr int C = 64, NCH = SEQ / C, HD = 128;
constexpr int RS128 = 272, RS64 = 144;
constexpr int O_QM = 0, O_KM = O_QM + C * RS128, O_QE = O_KM + C * RS128, O_KET = O_QE + C * RS128, O_VT = O_KET + HD * RS64,
              O_STT = O_VT + HD * RS64, O_P = O_STT + HD * RS128, O_TOT = O_P + C * RS64, O_DEC = O_TOT + 4 * HD * 4, O_END = O_DEC + HD * 4;
constexpr int OB_STRIDE = 132;
static_assert(C * OB_STRIDE * 4 <= 2 * C * RS128, "OBUF alias");
constexpr int LDS_BYTES = O_END;
struct Args { const bf16_t* p; const float* lb; const float* out_gain; bf16_t* mixed; };

__device__ __forceinline__ bf16x8 lda8(const LAS unsigned char* base, int row, int rs, int colB) { return *(const LAS bf16x8*)(base + row * rs + colB); }

__device__ __forceinline__ void item(const Args& A, LAS unsigned char* lds, int bh, const int wv__) {
    const int tid = TID(), lane = tid & 63, wid = __builtin_amdgcn_readfirstlane(tid >> 6), r32 = lane & 31, hi = lane >> 5;
    const int b = bh >> 2, h = bh & 3;
    const int ch = tid & 127, part = tid >> 7;
    const float lbc = A.lb[h * HD + ch], omlb = 1.f - lbc;
    const bf16_t* pbase = A.p + (size_t)b * SEQ * NP + h * HD;
    f32x16 sacc[2]; sacc[0] = f32x16{}; sacc[1] = f32x16{};
    const int kb = wid >> 1, vb0 = 2 * (wid & 1);
    for (int i = tid; i < HD * RS128 / 16; i += 512) *(LAS u32x4*)(lds + O_STT + i * 16) = (u32x4){0u, 0u, 0u, 0u};
    LAS float* tot = (LAS float*)(lds + O_TOT);
    LAS float* dec = (LAS float*)(lds + O_DEC);
    LAS float* obuf = (LAS float*)(lds + O_QM);
    bf16_t rq[16], rf[16], ri[16];
    { const bf16_t* pc0 = pbase + (size_t)(part * 16) * NP + ch;
#pragma unroll
      for (int i = 0; i < 16; ++i) { rf[i] = pc0[(size_t)i * NP + C_HF]; rq[i] = pc0[(size_t)i * NP + C_HQ]; ri[i] = pc0[(size_t)i * NP + C_HI]; } }
    for (int ck = 0; ck < NCH; ++ck) {
        const size_t tk_e = (size_t)b * SEQ + ck * C + (tid >> 3);
        const bf16_t* gp_e = A.p + tk_e * NP + C_HG + h * HD + (tid & 7) * 16;
        const u32x4 g0 = *(const u32x4*)gp_e, g1 = *(const u32x4*)(gp_e + 8);
        float lf[16], qv[16], kv[16];
        float run = 0.f;
#pragma unroll
        for (int i = 0; i < 16; ++i) {
            const float z = bf2f(rf[i]);
            const float sg = sigmoidf_(z);
            const float f = lbc + omlb * sg;
            kv[i] = 1.f - f;
            run += __logf(f); lf[i] = run;
            qv[i] = siluf_(bf2f(rq[i]));
        }
        tot[part * HD + ch] = run;
        { unsigned w[8];
#pragma unroll
          for (int i = 0; i < 8; ++i) w[i] = (unsigned)ri[2 * i] | ((unsigned)ri[2 * i + 1] << 16);
          LAS u32x4* d = (LAS u32x4*)(lds + O_VT + ch * RS64 + part * 32);
          d[0] = (u32x4){w[0], w[1], w[2], w[3]}; d[1] = (u32x4){w[4], w[5], w[6], w[7]}; }
        __syncthreads();
        if (ck + 1 < NCH) { const bf16_t* pcn = pbase + (size_t)((ck + 1) * C + part * 16) * NP + ch;
#pragma unroll
            for (int i = 0; i < 16; ++i) { rf[i] = pcn[(size_t)i * NP + C_HF]; rq[i] = pcn[(size_t)i * NP + C_HQ]; ri[i] = pcn[(size_t)i * NP + C_HI]; } }
        float off = 0.f;
#pragma unroll
        for (int pp = 0; pp < 4; ++pp) off += (pp < part) ? tot[pp * HD + ch] : 0.f;
        const float bref = tot[ch] + tot[HD + ch];
        const float blast = bref + tot[2 * HD + ch] + tot[3 * HD + ch];
        const float c_blast = __expf(blast), c_bref = __expf(bref), c_nbref = fast_rcp(c_bref);
        if (part == 0) dec[ch] = c_blast;
        {
            unsigned wk[8];
#pragma unroll
            for (int i = 0; i < 16; ++i) {
                const float bt = off + lf[i];
                const int t = part * 16 + i;
                const float e1 = __expf(fmaxf(bt, -80.f)), e2 = fast_rcp(e1);
                const float qe = qv[i] * e1, qm = qe * c_nbref, km = kv[i] * e2 * c_bref, ke = kv[i] * e2 * c_blast;
                *(LAS bf16_t*)(lds + O_QM + t * RS128 + ch * 2) = f2bf(qm);
                *(LAS bf16_t*)(lds + O_KM + t * RS128 + ch * 2) = f2bf(km);
                *(LAS bf16_t*)(lds + O_QE + t * RS128 + ch * 2) = f2bf(qe);
                if (i & 1) wk[i >> 1] |= ((unsigned)f2bf(ke)) << 16; else wk[i >> 1] = (unsigned)f2bf(ke);
            }
            LAS u32x4* d = (LAS u32x4*)(lds + O_KET + ch * RS64 + part * 32);
            d[0] = (u32x4){wk[0], wk[1], wk[2], wk[3]}; d[1] = (u32x4){wk[4], wk[5], wk[6], wk[7]};
        }
        __syncthreads();
        if (wid < 3) {
            const int ti = wid == 0 ? 0 : 1, si = wid == 2 ? 1 : 0;
            f32x16 sc = f32x16{};
#pragma unroll
            for (int ks = 0; ks < 8; ++ks) {
                const bf16x8 a = lda8(lds + O_QM, ti * 32 + r32, RS128, (ks * 16 + hi * 8) * 2);
                const bf16x8 bb = lda8(lds + O_KM, si * 32 + r32, RS128, (ks * 16 + hi * 8) * 2);
                sc = __builtin_amdgcn_mfma_f32_32x32x16_bf16(a, bb, sc, 0, 0, 0);
            }
#pragma unroll
            for (int r = 0; r < 16; ++r) { const int tl = (r & 3) + 8 * (r >> 2) + 4 * hi; const int tg = ti * 32 + tl, sg = si * 32 + r32;
                const float v = (sg <= tg) ? sc[r] : 0.f;
                *(LAS bf16_t*)(lds + O_P + tg * RS64 + sg * 2) = f2bf(v); }
        } else if (wid == 3) {
#pragma unroll
            for (int r = 0; r < 16; ++r) { const int tl = (r & 3) + 8 * (r >> 2) + 4 * hi; *(LAS bf16_t*)(lds + O_P + tl * RS64 + (32 + r32) * 2) = (bf16_t)0; }
        }
        __syncthreads();
        {
            const int ti = wid >> 2, vj = wid & 3;
            f32x16 oc = f32x16{};
#pragma unroll
            for (int ks = 0; ks < 8; ++ks) {
                const bf16x8 a = lda8(lds + O_QE, ti * 32 + r32, RS128, (ks * 16 + hi * 8) * 2);
                const bf16x8 bb = lda8(lds + O_STT, vj * 32 + r32, RS128, (ks * 16 + hi * 8) * 2);
                oc = __builtin_amdgcn_mfma_f32_32x32x16_bf16(a, bb, oc, 0, 0, 0);
            }
#pragma unroll
            for (int ss = 0; ss < 4; ++ss) {
                const bf16x8 a = lda8(lds + O_P, ti * 32 + r32, RS64, (ss * 16 + hi * 8) * 2);
                const bf16x8 bb = lda8(lds + O_VT, vj * 32 + r32, RS64, (ss * 16 + hi * 8) * 2);
                oc = __builtin_amdgcn_mfma_f32_32x32x16_bf16(a, bb, oc, 0, 0, 0);
            }
#pragma unroll
            for (int r = 0; r < 16; ++r) { const int tl = (r & 3) + 8 * (r >> 2) + 4 * hi; obuf[(ti * 32 + tl) * OB_STRIDE + vj * 32 + r32] = oc[r]; }
        }
#pragma unroll
        for (int j = 0; j < 2; ++j) {
#pragma unroll
            for (int r = 0; r < 16; ++r) { const int kl = (r & 3) + 8 * (r >> 2) + 4 * hi; sacc[j][r] *= dec[kb * 32 + kl]; }
#pragma unroll
            for (int ss = 0; ss < 4; ++ss) {
                const bf16x8 a = lda8(lds + O_KET, kb * 32 + r32, RS64, (ss * 16 + hi * 8) * 2);
                const bf16x8 bb = lda8(lds + O_VT, (vb0 + j) * 32 + r32, RS64, (ss * 16 + hi * 8) * 2);
                sacc[j] = __builtin_amdgcn_mfma_f32_32x32x16_bf16(a, bb, sacc[j], 0, 0, 0);
            }
        }
        __syncthreads();
#pragma unroll
        for (int j = 0; j < 2; ++j)
#pragma unroll
            for (int g = 0; g < 4; ++g) {
                u32x2 w; w.x = cvt_pk_bf16(sacc[j][4 * g], sacc[j][4 * g + 1]); w.y = cvt_pk_bf16(sacc[j][4 * g + 2], sacc[j][4 * g + 3]);
                *(LAS u32x2*)(lds + O_STT + ((vb0 + j) * 32 + r32) * RS128 + (kb * 32 + 8 * g + 4 * hi) * 2) = w;
            }
        {
            const int t = tid >> 3, c0 = (tid & 7) * 16;
            const LAS float* orow = obuf + t * OB_STRIDE + c0;
            float o[16]; float ss = 0.f;
#pragma unroll
            for (int i = 0; i < 4; ++i) { const f32x4 x = *(const LAS f32x4*)(orow + 4 * i); o[4 * i] = x.x; o[4 * i + 1] = x.y; o[4 * i + 2] = x.z; o[4 * i + 3] = x.w; ss += x.x * x.x + x.y * x.y + x.z * x.z + x.w * x.w; }
            ss = sum8f(ss);
            const float rn = 1.f / sqrtf(ss * (1.f / 128.f) + RMS_EPS);
            const size_t tk = tk_e;
            const float gr[16] = {lo_bf(g0.x), hi_bf(g0.x), lo_bf(g0.y), hi_bf(g0.y), lo_bf(g0.z), hi_bf(g0.z), lo_bf(g0.w), hi_bf(g0.w),
                                  lo_bf(g1.x), hi_bf(g1.x), lo_bf(g1.y), hi_bf(g1.y), lo_bf(g1.z), hi_bf(g1.z), lo_bf(g1.w), hi_bf(g1.w)};
            float ov[16];
#pragma unroll
            for (int i = 0; i < 16; ++i) ov[i] = o[i] * rn * A.out_gain[c0 + i] * siluf_(gr[i]);
            u32x4 w0, w1;
            w0.x = cvt_pk_bf16(ov[0], ov[1]); w0.y = cvt_pk_bf16(ov[2], ov[3]); w0.z = cvt_pk_bf16(ov[4], ov[5]); w0.w = cvt_pk_bf16(ov[6], ov[7]);
            w1.x = cvt_pk_bf16(ov[8], ov[9]); w1.y = cvt_pk_bf16(ov[10], ov[11]); w1.z = cvt_pk_bf16(ov[12], ov[13]); w1.w = cvt_pk_bf16(ov[14], ov[15]);
            bf16_t* mp = A.mixed + tk * DM + h * HD + c0;
            *(u32x4*)mp = w0; *(u32x4*)(mp + 8) = w1;
        }
        __syncthreads();
    }
}
}
#define RLX_AGENT __ATOMIC_RELAXED, __HIP_MEMORY_SCOPE_AGENT
#define XB_TMO      128
#define XB_XCNT(j)  (256  + 64 * (j))
#define XB_XSUB(j)  (1280 + 64 * (j))
#define XB_XGEN(j)  (2304 + 64 * (j))
#define XB_TOP      3328
#define XB_TOPGEN   3392
#define XCD_BAR_WORDS 3456
#define XB_SPIN_CAP (1u << 18)

__device__ __forceinline__ unsigned xb_ld(unsigned* p)              { return __hip_atomic_load(p, __ATOMIC_RELAXED, __HIP_MEMORY_SCOPE_AGENT); }
__device__ __forceinline__ unsigned xb_add(unsigned* p, unsigned v) { return __hip_atomic_fetch_add(p, v, __ATOMIC_RELAXED, __HIP_MEMORY_SCOPE_AGENT); }
__device__ __forceinline__ unsigned xb_xcc_id() { return (unsigned)__builtin_amdgcn_s_getreg((3 << 11) | 20) & 0xFu; }
#define XB_SPIN(cond, bar) do { unsigned _sp = 0; while (cond) { __builtin_amdgcn_s_sleep(1); \
    if ((++_sp & 255u) == 0u) { if (xb_ld(&(bar)[XB_TMO])) break; if (_sp > XB_SPIN_CAP) { atomicAdd(&(bar)[XB_TMO], 1u); break; } } } } while (0)

struct XcdBarrier {
    unsigned* bar; unsigned x;
    volatile LAS unsigned* st;
};

__device__ __forceinline__ XcdBarrier xcd_barrier_post(unsigned* bar, volatile LAS unsigned* st, const int wv__) {
    XcdBarrier b; b.bar = bar; b.x = xb_xcc_id(); b.st = st;
    if (TID() == 0) (void)xb_add(&bar[XB_XCNT(b.x)], 1u);
    return b;
}
__device__ __forceinline__ void xcd_barrier_complete(unsigned* bar, unsigned x, unsigned& nloc, unsigned& nx) {
    const unsigned G = gridDim.x * gridDim.y * gridDim.z;
    unsigned sum, cnt, mine, sp = 0u;
    for (;;) {
        sum = 0u; cnt = 0u; mine = 0u;
#pragma unroll
        for (unsigned j = 0; j < 16; ++j) { const unsigned c = xb_ld(&bar[XB_XCNT(j)]); sum += c; cnt += (c > 0u) ? 1u : 0u; mine = (j == x) ? c : mine; }
        if (sum == G) break;
        __builtin_amdgcn_s_sleep(1);
        if ((++sp & 255u) == 0u) { if (xb_ld(&bar[XB_TMO])) break; if (sp > XB_SPIN_CAP) { atomicAdd(&bar[XB_TMO], 1u); break; } }
    }
    nloc = mine > 0u ? mine : 1u; nx = cnt > 0u ? cnt : 1u;
}

__device__ __forceinline__ void xcd_barrier(const XcdBarrier& b, const int wv__) {
    asm volatile("s_waitcnt vmcnt(0)" ::: "memory");
    __syncthreads();
    if (TID() == 0) {
        unsigned* bar = b.bar;
        __builtin_amdgcn_s_waitcnt(0);
        unsigned nloc = b.st[0], nx = b.st[1];
        if (nloc == 0u) { xcd_barrier_complete(bar, b.x, nloc, nx); b.st[0] = nloc; b.st[1] = nx; }
        const unsigned old = xb_add(&bar[XB_XSUB(b.x)], 1u);
        const unsigned gen = old / nloc;
        if (old + 1u == (gen + 1u) * nloc) {
            __builtin_amdgcn_fence(__ATOMIC_RELEASE, "agent");
            asm volatile("s_waitcnt vmcnt(0)" ::: "memory");
            const unsigned og = xb_add(&bar[XB_TOP], 1u);
            const unsigned tg = og / nx;
            if (og + 1u == (tg + 1u) * nx) xb_add(&bar[XB_TOPGEN], 1u);
            else XB_SPIN(xb_ld(&bar[XB_TOPGEN]) == tg, bar);
            __builtin_amdgcn_fence(__ATOMIC_ACQUIRE, "agent");
            xb_add(&bar[XB_XGEN(b.x)], 1u);
            asm volatile("s_waitcnt vmcnt(0)" ::: "memory");
        } else {
            XB_SPIN(xb_ld(&bar[XB_XGEN(b.x)]) == gen, bar);
            __builtin_amdgcn_fence(__ATOMIC_ACQUIRE, "agent");
            asm volatile("s_waitcnt vmcnt(0)" ::: "memory");
        }
    }
    __syncthreads();
}

constexpr int NTHREADS = 512, NWAVES = 8;
constexpr int LDS_ALL = 153600;
static_assert(LDS_ALL >= hg::LDS_BYTES && LDS_ALL >= tok::LDS_BYTES && LDS_ALL >= rwk::LDS_BYTES && LDS_ALL >= rwc::LDS_BYTES && LDS_ALL >= att::LDS_BYTES && LDS_ALL >= pg8::STAGE_BYTES, "LDS");
constexpr int CW_BAR = 4096;
constexpr int PH_PER_LAYER = 7, N_PHASES = 1 + DEPTH * PH_PER_LAYER;

struct KArgs { Ptrs P; int ph_lo, ph_hi, coop, pad; };

#ifdef DUP_TOKMODE
#define TOKMODE (rep ? DUP_TOKMODE : 7)
#else
#define TOKMODE 7
#endif
template <int ph>
__device__ __forceinline__ void run_phase(LAS unsigned char* lds, unsigned char* lds_raw, cg::grid_group& grid, const int G, const int bid, const int wv__) {
        const KArgs __attribute__((address_space(4)))* ka = (const KArgs __attribute__((address_space(4)))*)__builtin_amdgcn_kernarg_segment_ptr();
        asm volatile("" : "+s"(ka));
#define PIN(i) (ka->P.in[i])
        const int tid = TID(), lane = tid & 63, wid = __builtin_amdgcn_readfirstlane(tid >> 6);
        const int gw = bid * NWAVES + wid, ngw = G * NWAVES;
        unsigned char* ws = ka->P.ws;
        float* x = ka->P.out;
        bf16_t* xb = (bf16_t*)(ws + WS_XB); bf16_t* pbuf = (bf16_t*)(ws + WS_P); bf16_t* mixed = (bf16_t*)(ws + WS_MIX);
        bf16_t* qbuf = (bf16_t*)(ws + WS_Q); bf16_t* kvbuf = (bf16_t*)(ws + WS_KV); bf16_t* krbuf = (bf16_t*)(ws + WS_KR);
        bf16_t* act = (bf16_t*)(ws + WS_ACT);
        float* ssA = (float*)(ws + WS_SSA); float* ssB = (float*)(ws + WS_SSBP); float* rsb = (float*)(ws + WS_RS); float* rsq = (float*)(ws + WS_RSQ); float* rskv = (float*)(ws + WS_RSKV);
        const int* pos = (const int*)PIN(1);
        if constexpr (ph == 0) {
            prologue_phase(&ka->P, (LAS float*)lds + wid * (64 * 65), gw, ngw, lane);
#ifdef DUP_PRO
            __syncthreads(); prologue_phase(&ka->P, (LAS float*)lds + wid * (64 * 65), gw, ngw, lane);
#endif
        } else {
            constexpr int l = (ph - 1) / PH_PER_LAYER, sp = (ph - 1) % PH_PER_LAYER;
            unsigned char* wl = ws + WS_W + (size_t)l * W_LAYER;
#ifdef DUP_SP
            const int nrep = (sp == DUP_SP) ? 2 : 1;
#else
            const int nrep = 1;
#endif
            for (int rep = 0; rep < nrep; ++rep) {
            if (rep) { XcdBarrier xb; xb.bar = (unsigned*)(ws + WS_CTL) + CW_BAR; xb.x = xb_xcc_id(); xb.st = (volatile LAS unsigned*)(lds + LDS_ALL - 128); xcd_barrier(xb, wv__); }
            switch (sp) {
            case 0: {
                pg8::Gemm g{xb, (const bf16_t*)(wl + WO_IN), T, NP, DM, DM}; pg8::StaticOrder S; S.init(T, NP, G, bid);
                pg8::prep_row_scales(ssA, rsb, S, tid);
                pg8::EpiScaleBf16 E{pbuf, rsb, NP, 0};
                pg8::gemm_phase<pg8::EpiScaleBf16, pg8::StaticOrder, true, true>(lds, g, S, E, wv__);
            } break;
            case 1: {
                tok::Args A;
                A.p = pbuf; A.pos = pos; A.k_gain = PIN(11) + l * 192;
                A.mu = PIN(12) + l * 1792; A.w0 = PIN(13) + l * 512; A.a0 = PIN(15) + l * 512;
                constexpr int lm = l > 0 ? l - 1 : 0;
                A.v0 = PIN(18) + lm * 512;
                A.k_k = PIN(21) + l * 512; A.k_a = PIN(22) + l * 512; A.r_k = PIN(23) + l * 512;
                A.wl = (const bf16_t*)(wl + WO_LORA);
                A.rs_q = rsq; A.rs_kv = rskv; A.kr = krbuf;
                A.R = (bf16_t*)(ws + WS_RWR); A.K = (bf16_t*)(ws + WS_RWK); A.V = (bf16_t*)(ws + WS_RWV); A.KK = (bf16_t*)(ws + WS_RWKK); A.B = (bf16_t*)(ws + WS_RWB);
                A.G = (bf16_t*)((unsigned char*)x + 64 * MiB); A.BON = (bf16_t*)((unsigned char*)x + 96 * MiB); A.VFIRST = (bf16_t*)(ws + WS_VFIRST); A.W = (float*)((unsigned char*)x); A.RIN = (float*)(ws + WS_RIN); A.BS = (float*)(ws + WS_BS);
#ifdef TOKPROBE
                if (rep) { unsigned char* dq = ws + WS_Q; A.R = (bf16_t*)dq; A.K = (bf16_t*)(dq + 32 * MiB); A.V = (bf16_t*)(dq + 64 * MiB); A.KK = (bf16_t*)(dq + 96 * MiB); A.B = (bf16_t*)(dq + 128 * MiB);
                    A.G = (bf16_t*)(dq + 160 * MiB); A.VFIRST = l == 0 ? (bf16_t*)(dq + 192 * MiB) : A.VFIRST; A.W = (float*)(ws + WS_MIX); A.RIN = (float*)(ws + WS_MIX + 64 * MiB); A.BS = (float*)(ws + WS_MIX + 65 * MiB); }
#endif
                tok::stage_params(A, lds, tid);
                for (int tl = bid; tl < tok::NTILES; tl += G) tok::tile<l>(A, lds, tl, wv__, TOKMODE);
            } break;
            case 2: {
                { pg8::Gemm g{pbuf + C_MQ, (const bf16_t*)(wl + WO_QB), T, QW, 512, NP}; pg8::StaticOrder S; S.init(T, QW, G, bid);
                  pg8::EpiPlainBf16 E{qbuf, QW, 0};
                  pg8::gemm_phase<pg8::EpiPlainBf16, pg8::StaticOrder, true, true>(lds, g, S, E, wv__); }
                { pg8::Gemm g{pbuf + C_MKV, (const bf16_t*)(wl + WO_KVB), T, KVW, 256, NP}; pg8::StaticOrder S; S.init(T, KVW, G, bid);
                  pg8::EpiKV E{kvbuf, rskv, PIN(11) + l * 192, (LAS float*)(lds + pg8::STAGE_BYTES), KVW, 0};
                  pg8::gemm_phase<pg8::EpiKV, pg8::StaticOrder, true, true>(lds, g, S, E, wv__); }
            } break;
            case 3: {
                unsigned* ctr = (unsigned*)(ws + WS_CTL) + 64 * l + 16 * rep;
                LAS int* qslot = (LAS int*)(lds + LDS_ALL - 64);
                constexpr int NQ = 96 + att::N_BLOCKS;
#ifdef DUP_MIX
                const int qlo = rep ? (DUP_MIX == 1 ? 0 : DUP_MIX == 2 ? 64 : 96) : 0, qhi = rep ? (DUP_MIX == 1 ? 64 : DUP_MIX == 2 ? 96 : NQ) : NQ;
#else
                const int qlo = 0, qhi = NQ;
#endif
#ifdef CONV_IN_MIXERS
                if constexpr (l + 1 < DEPTH) {
                    if (!rep && bid % CONV_EVERY == 0) {
                        for (;;) {
                            __syncthreads();
                            if (tid == 0) *qslot = (int)__hip_atomic_fetch_add(ctr + 8, 1u, __ATOMIC_RELAXED, __HIP_MEMORY_SCOPE_AGENT);
                            __syncthreads();
                            const int ci = __builtin_amdgcn_readfirstlane(*qslot);
                            if (ci >= CV_ITEMS) break;
                            convert_queue_item(&ka->P, l + 1, ci, (LAS float*)lds + wid * (64 * 65), wid, lane);
                        }
                    }
                }
#endif
                for (;;) {
                    __syncthreads();
                    if (tid == 0) *qslot = (int)__hip_atomic_fetch_add(ctr, 1u, __ATOMIC_RELAXED, __HIP_MEMORY_SCOPE_AGENT);
                    __syncthreads();
                    const int it = qlo + __builtin_amdgcn_readfirstlane(*qslot);
                    if (it >= qhi) break;
                    if (it < 64) {
                        rwc::Args RA; RA.R = (const bf16_t*)(ws + WS_RWR); RA.K = (const bf16_t*)(ws + WS_RWK); RA.V = (const bf16_t*)(ws + WS_RWV); RA.KK = (const bf16_t*)(ws + WS_RWKK);
                        RA.B = (const bf16_t*)(ws + WS_RWB); RA.W = (const float*)((unsigned char*)x); RA.RIN = (const float*)(ws + WS_RIN);
                        RA.G = (const bf16_t*)((unsigned char*)x + 64 * MiB); RA.BS = (const float*)(ws + WS_BS); RA.ln_w = PIN(24) + l * 512; RA.ln_b = PIN(25) + l * 512;
                        RA.mixed = rep ? (bf16_t*)((unsigned char*)x + 128 * MiB) : mixed;
                        rwc::item(RA, lds, it, wv__);
                    } else if (it < 96) {
                        hg::Args HA; HA.p = pbuf; HA.lb = (const float*)(ws + WS_LB) + l * 512; HA.out_gain = PIN(5) + l * 128; HA.mixed = mixed;
                        hg::item(HA, lds, it - 64, wv__);
                    }
                    else att::attn_one((char*)lds_raw, qbuf, kvbuf, krbuf, mixed, it - 96, pos, PIN(10) + l * 192, wv__);
                }
            } break;
            case 4: {
                pg8::Gemm g{mixed, (const bf16_t*)(wl + WO_O), T, DM, DM, DM}; pg8::StaticOrder S; S.init(T, DM, G, bid);
                pg8::EpiResidB E{l == 0 ? PIN(0) : (const float*)nullptr, (float*)nullptr, xb, ssB, DM, 0};
                pg8::gemm_phase<pg8::EpiResidB, pg8::StaticOrder, true, true>(lds, g, S, E, wv__);
            } break;
            case 5: {
                pg8::Gemm g{xb, (const bf16_t*)(wl + WO_GU), T, 2 * FF, DM, DM}; pg8::StaticOrder S; S.init(T, 2 * FF, G, bid);
                pg8::prep_row_scales(ssB, rsb, S, tid);
                pg8::EpiSwiGLU E{act, rsb, FF, 0};
                pg8::gemm_phase<pg8::EpiSwiGLU, pg8::StaticOrder, true, true>(lds, g, S, E, wv__);
            } break;
            case 6: {
                pg8::Gemm g{act, (const bf16_t*)(wl + WO_DN), T, DM, FF, FF}; pg8::StaticOrder S; S.init(T, DM, G, bid);
                pg8::EpiResidB E{(const float*)nullptr, l == DEPTH - 1 ? x : (float*)nullptr, xb, ssA, DM, 0};
                pg8::gemm_phase<pg8::EpiResidB, pg8::StaticOrder, true, true>(lds, g, S, E, wv__);
            } break;
            }
            }
        }
}
template <int PH0, int PH1>
__device__ __forceinline__ void run_phases(LAS unsigned char* lds, unsigned char* lds_raw, cg::grid_group& grid, const int G, const int bid, const int wv__) {
    if constexpr (PH0 < PH1) {
        run_phase<PH0>(lds, lds_raw, grid, G, bid, wv__);
        if constexpr (PH0 + 1 < PH1) {
            const KArgs __attribute__((address_space(4)))* ka = (const KArgs __attribute__((address_space(4)))*)__builtin_amdgcn_kernarg_segment_ptr();
            XcdBarrier xb; xb.bar = (unsigned*)(ka->P.ws + WS_CTL) + CW_BAR; xb.x = xb_xcc_id(); xb.st = (volatile LAS unsigned*)(lds + LDS_ALL - 128);
            xcd_barrier(xb, wv__);
        }
        run_phases<PH0 + 1, PH1>(lds, lds_raw, grid, G, bid, wv__);
    }
}
__global__ void __launch_bounds__(NTHREADS, 2) mega(KArgs args) {
    extern __shared__ __attribute__((aligned(16))) unsigned char lds_raw[];
    LAS unsigned char* lds = (LAS unsigned char*)lds_raw;
    const int G = gridDim.x, bid = blockIdx.x;
    const int wv__ = __builtin_amdgcn_readfirstlane((int)threadIdx.x >> 6);
    cg::grid_group grid = cg::this_grid();
    {
        volatile LAS unsigned* st = (volatile LAS unsigned*)(lds + LDS_ALL - 128);
        if (threadIdx.x < 2) st[threadIdx.x] = 0u;
        __syncthreads();
        (void)xcd_barrier_post((unsigned*)(args.P.ws + WS_CTL) + CW_BAR, st, wv__);
        grid.sync();
    }
#ifdef DUP_SYNC
    for (int i = 0; i < DUP_SYNC; ++i) { XcdBarrier xb; xb.bar = (unsigned*)(args.P.ws + WS_CTL) + CW_BAR; xb.x = xb_xcc_id(); xb.st = (volatile LAS unsigned*)(lds + LDS_ALL - 128); xcd_barrier(xb, wv__); }
#endif
    run_phases<0, N_PHASES>(lds, lds_raw, grid, G, bid, wv__);
}

extern "C" void kernel_launch(void* const* d_in, const int* in_sizes, int n_in, void* d_out, int out_size, void* d_ws, size_t ws_size, hipStream_t stream) {
    static int grid = 0;
    if (grid == 0) {
        int dev = 0, cus = 0, per_cu = 0;
        hipGetDevice(&dev);
        hipDeviceGetAttribute(&cus, hipDeviceAttributeMultiprocessorCount, dev);
        hipFuncSetAttribute((const void*)mega, hipFuncAttributeMaxDynamicSharedMemorySize, LDS_ALL);
        hipOccupancyMaxActiveBlocksPerMultiprocessor(&per_cu, (const void*)mega, NTHREADS, LDS_ALL);
        if (per_cu < 1) { fprintf(stderr, "kernel_launch: occupancy query says %d blocks/CU\n", per_cu); per_cu = 1; }
        grid = cus * 1;
        if (ws_size < WS_END) fprintf(stderr, "kernel_launch: workspace too small: %zu < %zu\n", ws_size, (size_t)WS_END);
        (void)hipGetLastError();
    }
    hipMemsetAsync((char*)d_ws + WS_CTL, 0, CTL_BYTES, stream);
    KArgs a{};
    for (int i = 0; i < 30; ++i) a.P.in[i] = (const float*)d_in[i];
    a.P.out = (float*)d_out; a.P.ws = (unsigned char*)d_ws;
#if MK_COOP
    a.ph_lo = 0; a.ph_hi = N_PHASES; a.coop = 1;
    void* kargs[] = {&a};
    hipError_t e = hipLaunchCooperativeKernel((const void*)mega, dim3(grid), dim3(NTHREADS), kargs, LDS_ALL, stream);
    if (e != hipSuccess) fprintf(stderr, "cooperative launch failed: %s (grid %d)\n", hipGetErrorString(e), grid);
#else
    for (int ph = 0; ph < N_PHASES; ++ph) {
        a.ph_lo = ph; a.ph_hi = ph + 1; a.coop = 0;
        hipLaunchKernelGGL(mega, dim3(grid), dim3(NTHREADS), LDS_ALL, stream, a);
    }
#endif
}
```

```cpp
#include <hip/hip_runtime.h>
#include <hip/hip_bf16.h>
#include <hip/hip_cooperative_groups.h>
#include <cstdio>
#include <cstdint>
namespace cg = cooperative_groups;

constexpr int BATCH = 8, SEQ = 4096, DM = 2048, DEPTH = 4;
constexpr int T = BATCH * SEQ;
constexpr int NP = 4864;
constexpr int INW = 4672;
constexpr int FF = 5632;
constexpr int C_HQ = 0, C_HF = 512, C_HI = 1024, C_HG = 1536, C_MQ = 2048, C_MKV = 2560, C_MKR = 2816, C_RW = 2880;
constexpr int C_RR = C_RW, C_RK = C_RW + 512, C_RV = C_RW + 1024, C_RWD = C_RW + 1536, C_RAD = C_RW + 1600, C_RGD = C_RW + 1664;
constexpr int QW = 1536, KVW = 2048;
constexpr float RMS_EPS = 1e-6f;

typedef unsigned short bf16_t;
typedef short bf16x8 __attribute__((ext_vector_type(8)));
typedef short s16x4 __attribute__((ext_vector_type(4)));
typedef float f32x2 __attribute__((ext_vector_type(2)));
typedef float f32x4 __attribute__((ext_vector_type(4)));
typedef float f32x16 __attribute__((ext_vector_type(16)));
typedef unsigned u32x2 __attribute__((ext_vector_type(2)));
typedef unsigned u32x4 __attribute__((ext_vector_type(4)));
#define LAS __attribute__((address_space(3)))

constexpr size_t MiB = 1u << 20;
constexpr size_t WS_CTL = 0;
constexpr size_t CTL_BYTES = 65536;
constexpr size_t WS_RS = 1 * MiB;
constexpr size_t WS_SSB = WS_RS + 128 * 1024;
constexpr size_t WS_RSQ = WS_SSB;
constexpr size_t WS_RSKV = WS_RSQ + 128 * 1024;
constexpr size_t WS_LB = WS_RSKV + 128 * 1024;
constexpr size_t WS_RIN = 2 * MiB;
constexpr size_t WS_BS = 3 * MiB;
constexpr size_t WS_W = 4 * MiB;
constexpr size_t W_LAYER = 96 * MiB;
constexpr size_t WO_IN = 0;
constexpr size_t WO_QB = WO_IN + (size_t)NP * DM * 2;
constexpr size_t WO_KVB = WO_QB + (size_t)QW * 512 * 2;
constexpr size_t WO_O = WO_KVB + (size_t)KVW * 256 * 2;
constexpr size_t WO_GU = WO_O + (size_t)DM * DM * 2;
constexpr size_t WO_DN = WO_GU + (size_t)2 * FF * DM * 2;
constexpr size_t WO_LORA = WO_DN + (size_t)DM * FF * 2;
static_assert(WO_LORA + 163840 * 2 <= W_LAYER, "weight layer stride");
constexpr size_t WS_XB = WS_W + DEPTH * W_LAYER;
constexpr size_t WS_P = WS_XB + 128 * MiB;
constexpr size_t WS_MIX = WS_P + 304 * MiB;
constexpr size_t WS_D = WS_MIX + 128 * MiB;
constexpr size_t WS_Q = WS_D;
constexpr size_t WS_KV = WS_Q + 96 * MiB;
constexpr size_t WS_KR = WS_KV + 128 * MiB;
constexpr size_t WS_RWR = WS_KR + 4 * MiB;
constexpr size_t WS_RWK = WS_RWR + 32 * MiB;
constexpr size_t WS_RWV = WS_RWK + 32 * MiB;
constexpr size_t WS_RWKK = WS_RWV + 32 * MiB;
constexpr size_t WS_RWB = WS_RWKK + 32 * MiB;
constexpr size_t WS_VFIRST = WS_RWB + 32 * MiB;
constexpr size_t WS_SSA = WS_VFIRST + 32 * MiB;
constexpr size_t WS_SSBP = WS_SSA + 4 * MiB;
constexpr size_t WS_END = WS_SSBP + 4 * MiB;
constexpr size_t WS_ACT = WS_D;
static_assert(WS_ACT + (size_t)T * FF * 2 <= WS_VFIRST, "act overlay must not reach v_first");
constexpr size_t WS_RWW = WS_XB;
constexpr size_t WS_RWG = WS_XB + 64 * MiB;
constexpr size_t WS_RWBON = WS_XB + 96 * MiB;

__device__ __forceinline__ int tid_from(int wv) { unsigned z = 0u; asm volatile("" : "+v"(z)); return (wv << 6) | (int)__builtin_amdgcn_mbcnt_hi(~0u, __builtin_amdgcn_mbcnt_lo(~0u, z)); }
#define TID() tid_from(wv__)
__device__ __forceinline__ float bf2f(bf16_t v) { return __uint_as_float(((unsigned)v) << 16); }
typedef __bf16 bf16x2_t __attribute__((ext_vector_type(2)));
__device__ __forceinline__ unsigned cvt_pk_bf16(float lo, float hi) { f32x2 v = {lo, hi}; bf16x2_t b = __builtin_convertvector(v, bf16x2_t); return __builtin_bit_cast(unsigned, b); }
__device__ __forceinline__ bf16_t f2bf(float f) { return (bf16_t)(cvt_pk_bf16(f, 0.f) & 0xffffu); }
__device__ __forceinline__ float lo_bf(unsigned w) { return __uint_as_float(w << 16); }
__device__ __forceinline__ float hi_bf(unsigned w) { return __uint_as_float(w & 0xffff0000u); }
__device__ __forceinline__ float fast_exp(float x) { return __builtin_amdgcn_exp2f(x * 1.4426950408889634f); }
__device__ __forceinline__ float fast_rcp(float x) { return __builtin_amdgcn_rcpf(x); }
__device__ __forceinline__ float sigmoidf_(float x) { return fast_rcp(1.f + fast_exp(-x)); }
__device__ __forceinline__ float siluf_(float x) { return x * sigmoidf_(x); }
#define DPPF(x, CTRL) __int_as_float(__builtin_amdgcn_update_dpp(0, __float_as_int(x), CTRL, 0xf, 0xf, true))
__device__ __forceinline__ float wave_sum(float v) {
    v += DPPF(v, 0xB1);
    v += DPPF(v, 0x4E);
    v += DPPF(v, 0x141);
    v += DPPF(v, 0x140);
    const float r0 = __int_as_float(__builtin_amdgcn_readlane(__float_as_int(v), 0)), r1 = __int_as_float(__builtin_amdgcn_readlane(__float_as_int(v), 16));
    const float r2 = __int_as_float(__builtin_amdgcn_readlane(__float_as_int(v), 32)), r3 = __int_as_float(__builtin_amdgcn_readlane(__float_as_int(v), 48));
    return (r0 + r1) + (r2 + r3);
}
__device__ __forceinline__ float xor32f(float x, int lane) { auto rr = __builtin_amdgcn_permlane32_swap(__float_as_uint(x), __float_as_uint(x), false, false); return __uint_as_float(lane < 32 ? rr[1] : rr[0]); }
__device__ __forceinline__ float sum8f(float x) { x += DPPF(x, 0xB1); x += DPPF(x, 0x4E); x += DPPF(x, 0x141); return x; }
#define MK_COOP 1
#define CONV_IN_MIXERS 1
#define CONV_EVERY 5
#define GW_DN 4
#define GW_WO 4
#define GW_GU 4
#define GW_IN 8
namespace pg8 {
#define PG8_LAS __attribute__((address_space(3)))
typedef unsigned short bf16_t;
typedef short bf16x8 __attribute__((ext_vector_type(8)));
typedef float f32x4 __attribute__((ext_vector_type(4)));
typedef unsigned u32x4 __attribute__((ext_vector_type(4)));
constexpr int BM = 256, BK = 64, HALF = 128, HTB = HALF * BK * 2  , STAGE_BYTES = 8 * HTB, NXCD = 8, WGM = 8;

__host__ __device__ __forceinline__ int lds_byte(int r, int c) { const int st = (r >> 4) * 2 + (c >> 5), rr = r & 15, cc = c & 31, ob = rr * 64 + cc * 2; return st * 1024 + (ob ^ (((ob >> 9) & 1) << 5)); }
__host__ __device__ __forceinline__ void stage_rc(int b, int& R, int& C) { const int st = b / 1024, sb = b % 1024, swz = sb ^ (((sb >> 9) & 1) << 5); R = (st >> 1) * 16 + swz / 64; C = (st & 1) * 32 + (swz % 64) / 2; }
__host__ __device__ __forceinline__ int perm32(int rho) { const int n = rho >> 4, i = rho & 15; return 8 * (i >> 2) + 4 * n + (i & 3); }

struct Unit { int pm, pn; };
struct Gemm { const bf16_t* A; const bf16_t* Bt; int M, N, K, lda; };

struct StaticOrder {
    int nM, nN, nwg, G, c, wgm;
    __host__ __device__ void init(int M, int N, int G_, int c_, int wgm_ = WGM) { nM = M / BM; nN = N / BM; nwg = nM * nN; G = G_; c = c_; wgm = wgm_; }
    __host__ __device__ bool next(int i, Unit& u) const {
        const long L = (long)i * G + c; if (L >= nwg) return false;
        int wgid = (int)L; { const int q = nwg / NXCD, r = nwg % NXCD, xcd = wgid % NXCD, off = wgid / NXCD; wgid = (xcd < r ? xcd * (q + 1) : r * (q + 1) + (xcd - r) * q) + off; }
        const int nig = wgm * nN, gid = wgid / nig, fm = gid * wgm, gsz = (nM - fm) < wgm ? (nM - fm) : wgm;
        u.pm = fm + ((wgid % nig) % gsz); u.pn = (wgid % nig) / gsz; return true;
    }
    __device__ __forceinline__ void a_ready(const Unit&) const {}
    __device__ __forceinline__ void done(const Unit&) const {}
};

using ::cvt_pk_bf16;
typedef float f32x2 __attribute__((ext_vector_type(2)));

__device__ __forceinline__ float row_scale32(const float* part, int row) {
    const f32x4* p = (const f32x4*)(part + (size_t)row * 32);
    f32x4 a = p[0] + p[1], b = p[2] + p[3], c = p[4] + p[5], d = p[6] + p[7];
    a = (a + b) + (c + d);
    return 1.f / sqrtf(((a[0] + a[1]) + (a[2] + a[3])) * (1.f / 2048.f) + 1e-6f);
}
struct EpiScaleBf16 {
    static constexpr bool PERM = true, AFTER_DRAIN = false;
    bf16_t* O; const float* rs; int ldc; int ssq;
    __device__ __forceinline__ void operator()(const f32x4 (&acc)[2][2][4][2], const Unit& u, int wr, int wc, int fr_, int fq_) const {
        unsigned z_ = 0u; asm volatile("" : "+v"(z_)); const int ln_ = (int)__builtin_amdgcn_mbcnt_hi(~0u, __builtin_amdgcn_mbcnt_lo(~0u, z_)); const int fr = ln_ & 15, fq = ln_ >> 4; (void)fr_; (void)fq_;
        const int row0 = u.pm * BM + wr * 64 + fr, col0 = u.pn * BM + wc * 32 + 8 * fq;
        float scv[2][4];
#pragma unroll
        for (int ai = 0; ai < 2; ++ai)
#pragma unroll
            for (int m = 0; m < 4; ++m) scv[ai][m] = rs ? rs[row0 + ai * HALF + m * 16] : 1.f;
#pragma unroll
        for (int ai = 0; ai < 2; ++ai)
#pragma unroll
            for (int m = 0; m < 4; ++m) { const int row = row0 + ai * HALF + m * 16; const float sc = scv[ai][m]; bf16_t* rowp = O + (size_t)row * ldc + col0;
#pragma unroll
                for (int bj = 0; bj < 2; ++bj) { const f32x4 v0 = acc[ai][bj][m][0] * sc, v1 = acc[ai][bj][m][1] * sc;
                    u32x4 w; w.x = cvt_pk_bf16(v0[0], v0[1]); w.y = cvt_pk_bf16(v0[2], v0[3]); w.z = cvt_pk_bf16(v1[0], v1[1]); w.w = cvt_pk_bf16(v1[2], v1[3]);
                    *(u32x4*)(rowp + bj * HALF) = w; } }
    }
};
struct EpiPlainBf16 {
    static constexpr bool PERM = true, AFTER_DRAIN = false;
    bf16_t* O; int ldc; int pad_;
    __device__ __forceinline__ void operator()(const f32x4 (&acc)[2][2][4][2], const Unit& u, int wr, int wc, int fr, int fq) const {
        const int row0 = u.pm * BM + wr * 64 + fr, col0 = u.pn * BM + wc * 32 + 8 * fq;
#pragma unroll
        for (int ai = 0; ai < 2; ++ai)
#pragma unroll
            for (int m = 0; m < 4; ++m) { bf16_t* rowp = O + (size_t)(row0 + ai * HALF + m * 16) * ldc + col0;
#pragma unroll
                for (int bj = 0; bj < 2; ++bj) { const f32x4 v0 = acc[ai][bj][m][0], v1 = acc[ai][bj][m][1];
                    u32x4 w; w.x = cvt_pk_bf16(v0[0], v0[1]); w.y = cvt_pk_bf16(v0[2], v0[3]); w.z = cvt_pk_bf16(v1[0], v1[1]); w.w = cvt_pk_bf16(v1[2], v1[3]);
                    *(u32x4*)(rowp + bj * HALF) = w; } }
    }
};
struct EpiResid {
    static constexpr bool PERM = false, AFTER_DRAIN = false;
    float* X; int ldc; int pad_;
    __device__ __forceinline__ void operator()(const f32x4 (&acc)[2][2][4][2], const Unit& u, int wr, int wc, int fr_, int fq_) const {
        unsigned z_ = 0u; asm volatile("" : "+v"(z_)); const int ln_ = (int)__builtin_amdgcn_mbcnt_hi(~0u, __builtin_amdgcn_mbcnt_lo(~0u, z_)); const int fr = ln_ & 15, fq = ln_ >> 4; (void)fr_; (void)fq_;
        const int row0 = u.pm * BM + wr * 64 + fr, col0 = u.pn * BM + wc * 32 + 4 * fq;
#pragma unroll
        for (int ai = 0; ai < 2; ++ai)
#pragma unroll
            for (int m = 0; m < 4; ++m) { float* rowp = X + (size_t)(row0 + ai * HALF + m * 16) * ldc + col0;
                f32x4 xv[2][2];
#pragma unroll
                for (int bj = 0; bj < 2; ++bj)
#pragma unroll
                    for (int n = 0; n < 2; ++n) xv[bj][n] = *(const f32x4*)(rowp + bj * HALF + n * 16);
#pragma unroll
                for (int bj = 0; bj < 2; ++bj)
#pragma unroll
                    for (int n = 0; n < 2; ++n) *(f32x4*)(rowp + bj * HALF + n * 16) = xv[bj][n] + acc[ai][bj][m][n]; }
    }
};
struct EpiKV {
    static constexpr bool PERM = true, AFTER_DRAIN = false;
    bf16_t* O; const float* rs; const float* kg; PG8_LAS float* red; int ldc; int pad_;
    __device__ __forceinline__ void operator()(const f32x4 (&acc)[2][2][4][2], const Unit& u, int wr, int wc, int fr_, int fq_) const {
        unsigned z_ = 0u; asm volatile("" : "+v"(z_)); const int ln_ = (int)__builtin_amdgcn_mbcnt_hi(~0u, __builtin_amdgcn_mbcnt_lo(~0u, z_)); const int fr = ln_ & 15, fq = ln_ >> 4; (void)fr_; (void)fq_;
        const int rl0 = wr * 64 + fr;
        const int col0 = u.pn * BM + wc * 32 + 8 * fq;
#pragma unroll
        for (int ai = 0; ai < 2; ++ai)
#pragma unroll
            for (int m = 0; m < 4; ++m) { const f32x4 a = acc[ai][0][m][0], b = acc[ai][0][m][1];
                float s = ((a[0] * a[0] + a[1] * a[1]) + (a[2] * a[2] + a[3] * a[3])) + ((b[0] * b[0] + b[1] * b[1]) + (b[2] * b[2] + b[3] * b[3]));
                { auto r16 = __builtin_amdgcn_permlane16_swap(__float_as_uint(s), __float_as_uint(s), false, false); s = __uint_as_float(r16[0]) + __uint_as_float(r16[1]);
                  auto r32 = __builtin_amdgcn_permlane32_swap(__float_as_uint(s), __float_as_uint(s), false, false); s = __uint_as_float(r32[0]) + __uint_as_float(r32[1]); }
                if (fq == 0) red[(rl0 + ai * HALF + m * 16) * 4 + wc] = s;
                asm volatile("" ::: "memory"); }
        asm volatile("s_waitcnt lgkmcnt(0)" ::: "memory"); __builtin_amdgcn_s_barrier(); asm volatile("" ::: "memory");
        const unsigned go = (unsigned)(wc * 32 + 8 * fq) * 4u;
        const f32x4 g0 = *(const f32x4*)((const char*)kg + go), g1 = *(const f32x4*)((const char*)kg + go + 16);
#pragma unroll
        for (int ai = 0; ai < 2; ++ai) {
            float scv[4];
#pragma unroll
            for (int m = 0; m < 4; ++m) scv[m] = rs[u.pm * BM + rl0 + ai * HALF + m * 16];
#pragma unroll
            for (int m = 0; m < 4; ++m) { const int rl = rl0 + ai * HALF + m * 16, row = u.pm * BM + rl;
                const f32x4 r4 = *(const PG8_LAS f32x4*)(red + rl * 4);
                const float rk = 1.f / sqrtf(((r4[0] + r4[1]) + (r4[2] + r4[3])) * (1.f / 128.f) + 1e-6f), sc = scv[m];
                bf16_t* rowp = O + (size_t)row * ldc + col0;
                { const f32x4 v0 = acc[ai][0][m][0] * rk * g0, v1 = acc[ai][0][m][1] * rk * g1;
                  u32x4 w; w.x = cvt_pk_bf16(v0[0], v0[1]); w.y = cvt_pk_bf16(v0[2], v0[3]); w.z = cvt_pk_bf16(v1[0], v1[1]); w.w = cvt_pk_bf16(v1[2], v1[3]);
                  *(u32x4*)rowp = w; }
                { const f32x4 v0 = acc[ai][1][m][0] * sc, v1 = acc[ai][1][m][1] * sc;
                  u32x4 w; w.x = cvt_pk_bf16(v0[0], v0[1]); w.y = cvt_pk_bf16(v0[2], v0[3]); w.z = cvt_pk_bf16(v1[0], v1[1]); w.w = cvt_pk_bf16(v1[2], v1[3]);
                  *(u32x4*)(rowp + HALF) = w; }
                asm volatile("" ::: "memory"); } }
        asm volatile("s_waitcnt lgkmcnt(0)" ::: "memory"); __builtin_amdgcn_s_barrier(); asm volatile("" ::: "memory");
    }
};
struct EpiResidN {
    static constexpr bool PERM = false, AFTER_DRAIN = false;
    const float* Xin; float* Xout; bf16_t* xb; float* ssq; int ldc; int pad_;
    __device__ __forceinline__ void operator()(const f32x4 (&acc)[2][2][4][2], const Unit& u, int wr, int wc, int fr_, int fq_) const {
        unsigned z_ = 0u; asm volatile("" : "+v"(z_)); const int ln_ = (int)__builtin_amdgcn_mbcnt_hi(~0u, __builtin_amdgcn_mbcnt_lo(~0u, z_)); const int fr = ln_ & 15, fq = ln_ >> 4; (void)fr_; (void)fq_;
        const int row0 = u.pm * BM + wr * 64 + fr, col0 = u.pn * BM + wc * 32 + 4 * fq;
#pragma unroll
        for (int ai = 0; ai < 2; ++ai)
        {   f32x4 xv[4][2][2];
#pragma unroll
            for (int m = 0; m < 4; ++m)
#pragma unroll
                for (int bj = 0; bj < 2; ++bj)
#pragma unroll
                    for (int n = 0; n < 2; ++n) xv[m][bj][n] = *(const f32x4*)(Xin + (size_t)(row0 + ai * HALF + m * 16) * ldc + col0 + bj * HALF + n * 16);
#pragma unroll
            for (int m = 0; m < 4; ++m) { const int row = row0 + ai * HALF + m * 16; const size_t off = (size_t)row * ldc + col0;
                float s = 0.f;
#pragma unroll
                for (int bj = 0; bj < 2; ++bj)
#pragma unroll
                    for (int n = 0; n < 2; ++n) { const f32x4 v = xv[m][bj][n] + acc[ai][bj][m][n]; *(f32x4*)(Xout + off + bj * HALF + n * 16) = v;
                        u32x2 w; w.x = cvt_pk_bf16(v[0], v[1]); w.y = cvt_pk_bf16(v[2], v[3]); *(u32x2*)(xb + off + bj * HALF + n * 16) = w;
                        s += (v[0] * v[0] + v[1] * v[1]) + (v[2] * v[2] + v[3] * v[3]); }
                { auto r16 = __builtin_amdgcn_permlane16_swap(__float_as_uint(s), __float_as_uint(s), false, false); s = __uint_as_float(r16[0]) + __uint_as_float(r16[1]);
                  auto r32 = __builtin_amdgcn_permlane32_swap(__float_as_uint(s), __float_as_uint(s), false, false); s = __uint_as_float(r32[0]) + __uint_as_float(r32[1]); }
                if (fq == 0) ssq[(size_t)row * 32 + u.pn * 4 + wc] = s; }
        }
    }
};
struct EpiResidB {
    static constexpr bool PERM = true, AFTER_DRAIN = false;
    const float* XinF; float* OutF; bf16_t* xb; float* ssq; int ldc; int pad_;
    __device__ __forceinline__ void operator()(const f32x4 (&acc)[2][2][4][2], const Unit& u, int wr, int wc, int fr_, int fq_) const {
        unsigned z_ = 0u; asm volatile("" : "+v"(z_)); const int ln_ = (int)__builtin_amdgcn_mbcnt_hi(~0u, __builtin_amdgcn_mbcnt_lo(~0u, z_)); const int fr = ln_ & 15, fq = ln_ >> 4; (void)fr_; (void)fq_;
        const int row0 = u.pm * BM + wr * 64 + fr, col0 = u.pn * BM + wc * 32 + 8 * fq;
#pragma unroll
        for (int ai = 0; ai < 2; ++ai) {
            f32x4 r0[4][2], r1[4][2];
#pragma unroll
            for (int m = 0; m < 4; ++m)
#pragma unroll
                for (int bj = 0; bj < 2; ++bj) { const size_t off = (size_t)(row0 + ai * HALF + m * 16) * ldc + col0 + bj * HALF;
                    if (XinF) { r0[m][bj] = *(const f32x4*)(XinF + off); r1[m][bj] = *(const f32x4*)(XinF + off + 4); }
                    else { const u32x4 w = *(const u32x4*)(xb + off); r0[m][bj] = (f32x4){lo_bf(w.x), hi_bf(w.x), lo_bf(w.y), hi_bf(w.y)}; r1[m][bj] = (f32x4){lo_bf(w.z), hi_bf(w.z), lo_bf(w.w), hi_bf(w.w)}; } }
#pragma unroll
            for (int m = 0; m < 4; ++m) { const int row = row0 + ai * HALF + m * 16; float s = 0.f;
#pragma unroll
                for (int bj = 0; bj < 2; ++bj) { const size_t off = (size_t)row * ldc + col0 + bj * HALF;
                    const f32x4 v0 = r0[m][bj] + acc[ai][bj][m][0], v1 = r1[m][bj] + acc[ai][bj][m][1];
                    u32x4 w; w.x = cvt_pk_bf16(v0[0], v0[1]); w.y = cvt_pk_bf16(v0[2], v0[3]); w.z = cvt_pk_bf16(v1[0], v1[1]); w.w = cvt_pk_bf16(v1[2], v1[3]);
                    *(u32x4*)(xb + off) = w;
                    if (OutF) { *(f32x4*)(OutF + off) = v0; *(f32x4*)(OutF + off + 4) = v1; }
                    s += ((v0[0] * v0[0] + v0[1] * v0[1]) + (v0[2] * v0[2] + v0[3] * v0[3])) + ((v1[0] * v1[0] + v1[1] * v1[1]) + (v1[2] * v1[2] + v1[3] * v1[3])); }
                { auto r16 = __builtin_amdgcn_permlane16_swap(__float_as_uint(s), __float_as_uint(s), false, false); s = __uint_as_float(r16[0]) + __uint_as_float(r16[1]);
                  auto r32 = __builtin_amdgcn_permlane32_swap(__float_as_uint(s), __float_as_uint(s), false, false); s = __uint_as_float(r32[0]) + __uint_as_float(r32[1]); }
                if (fq == 0) ssq[(size_t)row * 32 + u.pn * 4 + wc] = s; }
        }
    }
};
struct EpiSwiGLU {
    static constexpr bool PERM = true, AFTER_DRAIN = false;
    bf16_t* O; const float* rs; int ldc; int pad_;
    __device__ __forceinline__ void operator()(const f32x4 (&acc)[2][2][4][2], const Unit& u, int wr, int wc, int fr_, int fq_) const {
        unsigned z_ = 0u; asm volatile("" : "+v"(z_)); const int ln_ = (int)__builtin_amdgcn_mbcnt_hi(~0u, __builtin_amdgcn_mbcnt_lo(~0u, z_)); const int fr = ln_ & 15, fq = ln_ >> 4; (void)fr_; (void)fq_;
        const int row0 = u.pm * BM + wr * 64 + fr, col0 = u.pn * HALF + wc * 32 + 8 * fq;
        float scv[2][4];
#pragma unroll
        for (int ai = 0; ai < 2; ++ai)
#pragma unroll
            for (int m = 0; m < 4; ++m) scv[ai][m] = rs[row0 + ai * HALF + m * 16];
#pragma unroll
        for (int ai = 0; ai < 2; ++ai)
#pragma unroll
            for (int m = 0; m < 4; ++m) { const int row = row0 + ai * HALF + m * 16; const float sc = scv[ai][m]; bf16_t* rowp = O + (size_t)row * ldc + col0;
                float o[8];
#pragma unroll
                for (int n = 0; n < 2; ++n)
#pragma unroll
                    for (int i = 0; i < 4; ++i) { const float g = acc[ai][0][m][n][i] * sc, up = acc[ai][1][m][n][i] * sc;
                        o[n * 4 + i] = g * __builtin_amdgcn_rcpf(1.f + __builtin_amdgcn_exp2f(g * -1.4426950408889634f)) * up; }
                u32x4 w; w.x = cvt_pk_bf16(o[0], o[1]); w.y = cvt_pk_bf16(o[2], o[3]); w.z = cvt_pk_bf16(o[4], o[5]); w.w = cvt_pk_bf16(o[6], o[7]);
                *(u32x4*)rowp = w; }
    }
};

template <class Sched>
__device__ __forceinline__ void prep_row_scales(const float* part, float* rs, const Sched& S, int tid) {
    Unit u; int last = -1;
    for (int i = 0; S.next(i, u); ++i) {
        if (u.pm == last) continue;
        last = u.pm;
        const int row = u.pm * BM + (tid >> 1);
        const f32x4* p = (const f32x4*)(part + (size_t)row * 32 + (tid & 1) * 16);
        f32x4 a = (p[0] + p[1]) + (p[2] + p[3]);
        float s = (a[0] + a[1]) + (a[2] + a[3]);
        s += DPPF(s, 0xB1);
        if ((tid & 1) == 0) rs[row] = 1.f / sqrtf(s * (1.f / 2048.f) + 1e-6f);
    }
    asm volatile("s_waitcnt vmcnt(0)" ::: "memory");
    __syncthreads();
}
template <class Epi, class Sched, bool ALIGN_EPI = false, bool SP2 = false>
__device__ __forceinline__ void gemm_phase(PG8_LAS unsigned char* lds, const Gemm g, const Sched& S, const Epi& E, const int wv__) {
    const int tid = TID(), wid = __builtin_amdgcn_readfirstlane(tid >> 6), lane = tid & 63, wr = wid >> 2, wc = wid & 3, fr = lane & 15, fq = lane >> 4;
    const int K = g.K, nt = K / BK;
    unsigned voffA[2], voffB[2];
#pragma unroll
    for (int i = 0; i < 2; ++i) { int R, C; stage_rc(tid * 16 + i * 8192, R, C); const int Rb = Epi::PERM ? ((R & ~31) + perm32(R & 31)) : R;
        voffA[i] = (unsigned)(R * g.lda + C) * 2u; voffB[i] = (unsigned)(Rb * K + C) * 2u; }
    const size_t kstep = (size_t)(BK * 2);
    const size_t hstepA = (size_t)HALF * g.lda * 2, hstepB = (size_t)HALF * K * 2;
    const size_t tstepA = 2 * hstepA, tstepB = 2 * hstepB;
    const unsigned ldsw = (unsigned)wid * 1024u;
    const int aoff = lds_byte(wr * 64 + fr, fq * 8), boff = lds_byte(wc * 32 + fr, fq * 8);
#define PG8_SA(b, h) (((b) * 2 + (h)) * HTB)
#define PG8_SB(b, h) ((4 + (b) * 2 + (h)) * HTB)
#define PG8_STAGE(bufoff, gbase, voff) do { _Pragma("unroll") for (int _i = 0; _i < 2; ++_i) \
        __builtin_amdgcn_global_load_lds((const unsigned*)((const char*)(gbase) + (voff)[_i]), (PG8_LAS unsigned*)(lds + (bufoff) + ldsw + _i * 8192), 16, 0, 0); } while (0)
#define PG8_LDA(dst, b, h) do { _Pragma("unroll") for (int m = 0; m < 4; ++m) _Pragma("unroll") for (int k = 0; k < 2; ++k) dst[m][k] = *(const PG8_LAS bf16x8*)(lds + PG8_SA(b, h) + aoff + m * 2048 + k * 1024); } while (0)
#define PG8_LDB(dst, b, h) do { _Pragma("unroll") for (int n = 0; n < 2; ++n) _Pragma("unroll") for (int k = 0; k < 2; ++k) dst[n][k] = *(const PG8_LAS bf16x8*)(lds + PG8_SB(b, h) + boff + n * 2048 + k * 1024); } while (0)
#define PG8_MMA(ai, bj, At, Bt) do { __builtin_amdgcn_s_setprio(1); _Pragma("unroll") for (int m = 0; m < 4; ++m) _Pragma("unroll") for (int n = 0; n < 2; ++n) _Pragma("unroll") for (int k = 0; k < 2; ++k) \
        acc[ai][bj][m][n] = __builtin_amdgcn_mfma_f32_16x16x32_bf16(Bt[n][k], At[m][k], acc[ai][bj][m][n], 0, 0, 0); __builtin_amdgcn_s_setprio(0); } while (0)
#define PG8_WAIT_V(n) asm volatile("s_waitcnt vmcnt(" #n ")" ::: "memory")
#define PG8_WAIT_L(n) asm volatile("s_waitcnt lgkmcnt(" #n ")" ::: "memory")
#define PG8_BAR __builtin_amdgcn_s_barrier()
#define PG8_SCHED __builtin_amdgcn_sched_barrier(0)
    Unit cur, nxt; int ui = 0;
    if (!S.next(0, cur)) return;
    f32x4 acc[2][2][4][2];
#pragma unroll
    for (int a = 0; a < 2; ++a)
#pragma unroll
        for (int b = 0; b < 2; ++b)
#pragma unroll
            for (int m = 0; m < 4; ++m)
#pragma unroll
                for (int n = 0; n < 2; ++n) acc[a][b][m][n] = (f32x4){0.f, 0.f, 0.f, 0.f};
    bf16x8 At[4][2], B0[2][2], B1[2][2];
    const char* cA = (const char*)g.A + (size_t)cur.pm * tstepA; const char* cB = (const char*)g.Bt + (size_t)cur.pn * tstepB;
    S.a_ready(cur);
    if constexpr (SP2) {
        PG8_STAGE(PG8_SB(0, 0), cB, voffB); PG8_STAGE(PG8_SB(0, 1), cB + hstepB, voffB); PG8_STAGE(PG8_SA(0, 0), cA, voffA); PG8_STAGE(PG8_SA(0, 1), cA + hstepA, voffA);
        if (wr == 1) PG8_BAR;
        PG8_WAIT_V(2); PG8_BAR;
        PG8_STAGE(PG8_SB(1, 0), cB + kstep, voffB); PG8_STAGE(PG8_SA(1, 0), cA + kstep, voffA); PG8_STAGE(PG8_SB(1, 1), cB + hstepB + kstep, voffB);
        PG8_WAIT_V(6); PG8_BAR;
    } else {
        PG8_STAGE(PG8_SB(0, 0), cB, voffB); PG8_STAGE(PG8_SA(0, 0), cA, voffA); PG8_STAGE(PG8_SB(0, 1), cB + hstepB, voffB); PG8_STAGE(PG8_SA(0, 1), cA + hstepA, voffA);
        if (wr == 1) PG8_BAR;
        PG8_WAIT_V(4); PG8_BAR;
        PG8_STAGE(PG8_SB(1, 0), cB + kstep, voffB); PG8_STAGE(PG8_SA(1, 0), cA + kstep, voffA); PG8_STAGE(PG8_SB(1, 1), cB + hstepB + kstep, voffB);
        PG8_WAIT_V(6); PG8_BAR;
    }
    for (;;) {
        const bool has_next = S.next(ui + 1, nxt);
        const char* nA = has_next ? (const char*)g.A + (size_t)nxt.pm * tstepA : cA; const char* nB = has_next ? (const char*)g.Bt + (size_t)nxt.pn * tstepB : cB;
        for (int t = 0; t < nt; t += 2) {
            const bool last = (t == nt - 2);
            const char* a1 = cA + (size_t)(t + 1) * kstep;
            const char* a2 = last ? nA : cA + (size_t)(t + 2) * kstep; const char* b2 = last ? nB : cB + (size_t)(t + 2) * kstep;
            const char* a3 = a2 + kstep; const char* b3 = b2 + kstep;
            if (last && has_next) S.a_ready(nxt);
            if constexpr (SP2) {
            PG8_LDB(B0, 0, 0); PG8_LDB(B1, 0, 1); PG8_SCHED; PG8_LDA(At, 0, 0); PG8_STAGE(PG8_SA(1, 1), a1 + hstepA, voffA);
            PG8_WAIT_V(8); PG8_WAIT_L(0); PG8_BAR; PG8_MMA(0, 0, At, B0); PG8_MMA(0, 1, At, B1); PG8_BAR; PG8_SCHED;
            PG8_LDA(At, 0, 1); PG8_STAGE(PG8_SB(0, 0), b2, voffB); PG8_STAGE(PG8_SB(0, 1), b2 + hstepB, voffB); PG8_STAGE(PG8_SA(0, 0), a2, voffA);
            PG8_WAIT_V(8); PG8_WAIT_L(0); PG8_BAR; PG8_MMA(1, 0, At, B0); PG8_MMA(1, 1, At, B1); PG8_BAR; PG8_SCHED;
            PG8_LDB(B0, 1, 0); PG8_LDB(B1, 1, 1); PG8_SCHED; PG8_LDA(At, 1, 0); PG8_STAGE(PG8_SA(0, 1), a2 + hstepA, voffA);
            PG8_WAIT_V(8); PG8_WAIT_L(0); PG8_BAR; PG8_MMA(0, 0, At, B0); PG8_MMA(0, 1, At, B1); PG8_BAR; PG8_SCHED;
            PG8_LDA(At, 1, 1); PG8_STAGE(PG8_SB(1, 0), b3, voffB); PG8_STAGE(PG8_SB(1, 1), b3 + hstepB, voffB); PG8_STAGE(PG8_SA(1, 0), a3, voffA);
            PG8_WAIT_V(8); PG8_WAIT_L(0); PG8_BAR; PG8_MMA(1, 0, At, B0); PG8_MMA(1, 1, At, B1); PG8_BAR; PG8_SCHED;
            } else {
            PG8_LDB(B0, 0, 0); PG8_SCHED; PG8_LDA(At, 0, 0); PG8_STAGE(PG8_SA(1, 1), a1 + hstepA, voffA);
            PG8_WAIT_L(8); PG8_BAR; PG8_WAIT_L(0); PG8_MMA(0, 0, At, B0); PG8_BAR; PG8_SCHED;
            PG8_LDB(B1, 0, 1); PG8_STAGE(PG8_SB(0, 0), b2, voffB);
            PG8_BAR; PG8_WAIT_L(0); PG8_MMA(0, 1, At, B1); PG8_BAR;
            PG8_LDA(At, 0, 1); PG8_STAGE(PG8_SA(0, 0), a2, voffA);
            PG8_BAR; PG8_WAIT_L(0); PG8_MMA(1, 0, At, B0); PG8_BAR; PG8_SCHED;
            PG8_STAGE(PG8_SB(0, 1), b2 + hstepB, voffB);
            PG8_WAIT_V(6); PG8_BAR; PG8_MMA(1, 1, At, B1); PG8_BAR;
            PG8_LDB(B0, 1, 0); PG8_SCHED; PG8_LDA(At, 1, 0); PG8_STAGE(PG8_SA(0, 1), a2 + hstepA, voffA);
            PG8_WAIT_L(8); PG8_BAR; PG8_WAIT_L(0); PG8_MMA(0, 0, At, B0); PG8_BAR; PG8_SCHED;
            PG8_LDB(B1, 1, 1); PG8_STAGE(PG8_SB(1, 0), b3, voffB);
            PG8_BAR; PG8_WAIT_L(0); PG8_MMA(0, 1, At, B1); PG8_BAR;
            PG8_LDA(At, 1, 1); PG8_STAGE(PG8_SA(1, 0), a3, voffA);
            PG8_BAR; PG8_WAIT_L(0); PG8_MMA(1, 0, At, B0); PG8_BAR; PG8_SCHED;
            PG8_STAGE(PG8_SB(1, 1), b3 + hstepB, voffB);
            PG8_WAIT_V(6); PG8_BAR; PG8_MMA(1, 1, At, B1); PG8_BAR;
            }
        }
        if constexpr (ALIGN_EPI) { if (wr == 0) PG8_BAR; }
        if constexpr (!Epi::AFTER_DRAIN) { E(acc, cur, wr, wc, fr, fq); S.done(cur); }
        if (!has_next) break;
#pragma unroll
        for (int a = 0; a < 2; ++a)
#pragma unroll
            for (int b = 0; b < 2; ++b)
#pragma unroll
                for (int m = 0; m < 4; ++m)
#pragma unroll
                    for (int n = 0; n < 2; ++n) acc[a][b][m][n] = (f32x4){0.f, 0.f, 0.f, 0.f};
        cur = nxt; cA = nA; cB = nB; ++ui;
        if constexpr (ALIGN_EPI) { if (wr == 1) PG8_BAR; }
    }
    PG8_WAIT_V(0);
    if constexpr (!ALIGN_EPI) { if (wr == 0) PG8_BAR; }
    PG8_BAR;
    if constexpr (Epi::AFTER_DRAIN) { E.fused(acc, cur, wr, wc, fr, fq, lds, wid, lane); S.done(cur); }
#undef PG8_SA
#undef PG8_SB
#undef PG8_STAGE
#undef PG8_LDA
#undef PG8_LDB
#undef PG8_MMA
#undef PG8_WAIT_V
#undef PG8_WAIT_L
#undef PG8_BAR
#undef PG8_SCHED
}
}
__device__ __forceinline__ void rope_cs(int pos, int j, float& c, float& s) {
    const float inv_freq = exp2f(-(float)j * (13.287712379549449f / 32.f));
    const float ang = (float)pos * inv_freq;
    float rev = ang * 0.15915494309189535f; rev = rev - floorf(rev);
    c = __builtin_amdgcn_cosf(rev); s = __builtin_amdgcn_sinf(rev);
}
namespace att {
constexpr int NW = 8, QBLK = 32, KVBLK = 64, QB = NW * QBLK;
constexpr int QS = QW, KS = KVW, KRS = 64, OS = DM;
constexpr int SHM_V = KVBLK * 128 * 2, SHM_K = KVBLK * 128 * 2, SHM_KR = KVBLK * 64 * 2;
constexpr int OFF_V = 0, OFF_K = 2 * SHM_V, OFF_KR = OFF_K + 2 * SHM_K, OFF_WS = OFF_KR + 2 * SHM_KR, OFF_QR = OFF_WS + NW * 64 * 4;
constexpr int LDS_BYTES = OFF_QR + NW * 8 * 64 * 16;
constexpr float SCALE = 0.07216878364870322f;
constexpr float THR = 8.f;
constexpr int NQB = SEQ / QB;

#define KSWZ(row, colB) ((row) * 256 + ((colB) ^ (((row) & 7) << 4)))
#define KRSWZ(row, colB) ((row) * 128 + ((colB) ^ ((((row) >> 1) & 7) << 4)))
#define SBAR() __builtin_amdgcn_sched_barrier(0)
__device__ __forceinline__ int v_st(int k, int c) { const int kk = (k & ~0xC) | ((k & 4) << 1) | ((k & 8) >> 1); return ((kk >> 3) * 4 + (c >> 5)) * 512 + ((kk & 7) * 32 + (c & 31)) * 2; }
__device__ __forceinline__ int v_rd_base(int lane) { return ((lane & 3) << 3) | (((lane >> 2) & 3) << 6) | (((lane >> 4) & 1) << 5) | (((lane >> 5) & 1) << 8); }
constexpr int v_rd_off(int d0, int ks, int half) { return d0 * 512 + ks * 4096 + half * 2048; }
__device__ __forceinline__ int crow(int r, int hi) { return (r & 3) + 8 * (r >> 2) + 4 * hi; }
__device__ __forceinline__ unsigned cvtpk(float lo, float hi) { return cvt_pk_bf16(lo, hi); }
__device__ __forceinline__ bf16x8 load8(const bf16_t* p) { return *reinterpret_cast<const bf16x8*>(p); }

__device__ __forceinline__ void mask_tile(f32x16& p0, f32x16& p1, int dq) {
    const float NEG = -__builtin_inff();
#pragma unroll
    for (int r = 0; r < 16; ++r) {
        const int c = (r & 3) + 8 * (r >> 2);
        if (dq - c < 0) p0[r] = NEG;
        if (dq - c - 32 < 0) p1[r] = NEG;
    }
}
__device__ __forceinline__ void partialSM(f32x16& p0, f32x16& p1, float& m_reg, float& mn, float& alpha) {
    float pmax = p0[0];
#pragma unroll
    for (int r = 1; r < 16; ++r) pmax = fmaxf(pmax, p0[r]);
#pragma unroll
    for (int r = 0; r < 16; ++r) pmax = fmaxf(pmax, p1[r]);
    { auto rr = __builtin_amdgcn_permlane32_swap(__float_as_uint(pmax), __float_as_uint(pmax), false, false);
      pmax = fmaxf(__uint_as_float(rr[0]), __uint_as_float(rr[1])); }
    constexpr float C2 = 1.4426950408889634f * SCALE;
    if (__builtin_expect(__all((pmax - m_reg) * SCALE <= THR), 1)) { mn = m_reg; alpha = 1.f; }
    else { mn = fmaxf(m_reg, pmax); alpha = __builtin_amdgcn_exp2f((m_reg - mn) * C2); m_reg = mn; }
    const float mnL = -mn * C2;
#pragma unroll
    for (int r = 0; r < 16; ++r) p0[r] = fmaf(p0[r], C2, mnL);
#pragma unroll
    for (int r = 0; r < 16; ++r) p1[r] = fmaf(p1[r], C2, mnL);
#pragma unroll
    for (int r = 0; r < 16; ++r) p0[r] = __builtin_amdgcn_exp2f(p0[r]);
}
__device__ __forceinline__ void finishSM(f32x16& p0, f32x16& p1, float alpha, float& l_reg, bf16x8& pa0, bf16x8& pa1, bf16x8& pa2, bf16x8& pa3) {
#pragma unroll
    for (int r = 0; r < 16; ++r) p1[r] = __builtin_amdgcn_exp2f(p1[r]);
    float ps = 0;
#pragma unroll
    for (int r = 0; r < 16; ++r) ps += p0[r];
#pragma unroll
    for (int r = 0; r < 16; ++r) ps += p1[r];
    { auto rr = __builtin_amdgcn_permlane32_swap(__float_as_uint(ps), __float_as_uint(ps), false, false);
      ps = __uint_as_float(rr[0]) + __uint_as_float(rr[1]); }
    l_reg = l_reg * alpha + ps;
#define PK4(P, B_, OUT) do { unsigned a0 = cvtpk(P[B_+0], P[B_+1]), a1 = cvtpk(P[B_+2], P[B_+3]);                          \
        unsigned b0 = cvtpk(P[B_+4], P[B_+5]), b1 = cvtpk(P[B_+6], P[B_+7]);                                             \
        auto r0 = __builtin_amdgcn_permlane32_swap(a0, b0, false, false); auto r1 = __builtin_amdgcn_permlane32_swap(a1, b1, false, false); \
        u32x4 w = {r0[0], r1[0], r0[1], r1[1]}; OUT = *reinterpret_cast<bf16x8*>(&w); } while (0)
    PK4(p0, 0, pa0); PK4(p0, 8, pa1); PK4(p1, 0, pa2); PK4(p1, 8, pa3);
#undef PK4
}
template <int KB>
__device__ __forceinline__ void qkt(f32x16& p0, f32x16& p1, const char* lds, int r32, int hi, const bf16x8* qr, int qro) {
    p0 = f32x16{}; p1 = f32x16{};
    const char* kb[4];
#pragma unroll
    for (int dd = 0; dd < 4; ++dd) kb[dd] = lds + OFF_K + KB * SHM_K + KSWZ(r32, (dd * 16 + hi * 8) * 2);
#pragma unroll
    for (int d0 = 0; d0 < 8; ++d0) { const char* a = kb[d0 & 3] + (d0 >> 2) * 128;
        bf16x8 b0 = *reinterpret_cast<const bf16x8*>(a);
        bf16x8 b1 = *reinterpret_cast<const bf16x8*>(a + 32 * 256);
        const bf16x8 qq = qr[d0];
        p0 = __builtin_amdgcn_mfma_f32_32x32x16_bf16(b0, qq, p0, 0, 0, 0);
        p1 = __builtin_amdgcn_mfma_f32_32x32x16_bf16(b1, qq, p1, 0, 0, 0); }
#pragma unroll
    for (int dd = 0; dd < 4; ++dd) { const char* a = lds + OFF_KR + KB * SHM_KR + KRSWZ(r32, (dd * 16 + hi * 8) * 2);
        bf16x8 b0 = *reinterpret_cast<const bf16x8*>(a);
        bf16x8 b1 = *reinterpret_cast<const bf16x8*>(a + 32 * 128);
        const bf16x8 qq = *reinterpret_cast<const bf16x8*>(lds + qro + dd * 1024);
        p0 = __builtin_amdgcn_mfma_f32_32x32x16_bf16(b0, qq, p0, 0, 0, 0);
        p1 = __builtin_amdgcn_mfma_f32_32x32x16_bf16(b1, qq, p1, 0, 0, 0); }
}
template <int VB>
__device__ __forceinline__ void pv_tile(f32x16* o, int vb0, bf16x8 pa0, bf16x8 pa1, bf16x8 pa2, bf16x8 pa3) {
#define TRRD(dst, off) asm volatile("ds_read_b64_tr_b16 %0, %1 offset:%2" : "=&v"(dst) : "v"(vb0), "i"(off) : "memory")
#define PV_D0(d0) do { s16x4 l0, l1, l2, l3, h0, h1, h2, h3; constexpr int b_ = OFF_V + VB * SHM_V + v_rd_off(d0, 0, 0);   \
        TRRD(l0, b_); TRRD(h0, b_ + 2048); TRRD(l1, b_ + 4096); TRRD(h1, b_ + 6144); TRRD(l2, b_ + 8192); TRRD(h2, b_ + 10240); TRRD(l3, b_ + 12288); TRRD(h3, b_ + 14336); \
        asm volatile("s_waitcnt lgkmcnt(0)" ::: "memory"); SBAR();   \
        o[d0] = __builtin_amdgcn_mfma_f32_32x32x16_bf16(pa0, (bf16x8){l0[0], l0[1], l0[2], l0[3], h0[0], h0[1], h0[2], h0[3]}, o[d0], 0, 0, 0);   \
        o[d0] = __builtin_amdgcn_mfma_f32_32x32x16_bf16(pa1, (bf16x8){l1[0], l1[1], l1[2], l1[3], h1[0], h1[1], h1[2], h1[3]}, o[d0], 0, 0, 0);   \
        o[d0] = __builtin_amdgcn_mfma_f32_32x32x16_bf16(pa2, (bf16x8){l2[0], l2[1], l2[2], l2[3], h2[0], h2[1], h2[2], h2[3]}, o[d0], 0, 0, 0);   \
        o[d0] = __builtin_amdgcn_mfma_f32_32x32x16_bf16(pa3, (bf16x8){l3[0], l3[1], l3[2], l3[3], h3[0], h3[1], h3[2], h3[3]}, o[d0], 0, 0, 0); } while (0)
    PV_D0(0); PV_D0(1); PV_D0(2); PV_D0(3);
#undef PV_D0
#undef TRRD
}

struct BlockRef { const bf16_t* Q; const bf16_t* K; const bf16_t* V; const bf16_t* KR; bf16_t* O; const int* POS; const float* QG; int P0; };
struct Seam { bf16x8 qr[8]; bf16x8 st_v0, st_v1, st_k0, st_k1, st_kr; };
#define VMW() asm volatile("s_waitcnt vmcnt(0)" ::: "memory")
#define VMWN(n) asm volatile("s_waitcnt vmcnt(%0)" :: "i"(n) : "memory")
#define LDG8(base, off) (*reinterpret_cast<const bf16x8*>((const char*)(base) + (off)))
#define SLOAD_H(R_, k0) do { const char* kb_ = (const char*)((R_).K + (size_t)(k0) * KS); const char* rb_ = (const char*)((R_).KR + (size_t)(k0) * KRS);  \
                             S.st_v0 = LDG8(kb_ + 256, offA); S.st_v1 = LDG8(kb_ + 32 * KS * 2 + 256, offA);              \
                             S.st_k0 = LDG8(kb_, offA); S.st_k1 = LDG8(kb_ + 32 * KS * 2, offA);              \
                             S.st_kr = LDG8(rb_, offR); } while (0)
#define SWRITE_HK(bf) do { *(bf16x8*)(lds + OFF_K + (bf) * SHM_K + kws) = S.st_k0; *(bf16x8*)(lds + OFF_K + (bf) * SHM_K + kws + 32 * 256) = S.st_k1; \
                           *(bf16x8*)(lds + OFF_KR + (bf) * SHM_KR + krws) = S.st_kr; } while (0)
#define SWRITE_HV(bf) do { *(bf16x8*)(lds + OFF_V + (bf) * SHM_V + vst0) = S.st_v0; *(bf16x8*)(lds + OFF_V + (bf) * SHM_V + vst1) = S.st_v1; } while (0)
#define SWRITE_H(bf) do { SWRITE_HV(bf); SWRITE_HK(bf); } while (0)
#define QLOAD(R_) do { _Pragma("unroll") for (int d0 = 0; d0 < 8; ++d0) S.qr[d0] = LDG8((const char*)(R_).Q + d0 * 32, offQ); } while (0)

__device__ __forceinline__ void attn_prime(const BlockRef& cur, char* lds, Seam& S, const int wv__) {
    const int tid = TID(), wid = __builtin_amdgcn_readfirstlane(tid >> 6), lane = tid & 63, r32 = lane & 31, hi = lane >> 5;
    const int sr = tid >> 4, sc = (tid & 15) * 8, kws = KSWZ(sr, sc * 2), krr = tid >> 3, krc = (tid & 7) * 8, krws = KRSWZ(krr, krc * 2);
    unsigned offA = (unsigned)(sr * KS + sc) * 2u, offR = (unsigned)(krr * KRS + krc) * 2u, offQ = (unsigned)((wid * QBLK + r32) * QS + hi * 8) * 2u;
    asm volatile("" : "+v"(offA), "+v"(offR), "+v"(offQ));
    QLOAD(cur);
    SLOAD_H(cur, 0); VMW(); SWRITE_HK(0);
    __syncthreads();
}
__device__ __forceinline__ void attn_block(const BlockRef& cur, char* lds, Seam& S, const int wv__) {
    const int tid = TID(), wid = __builtin_amdgcn_readfirstlane(tid >> 6), lane = tid & 63, r32 = lane & 31, hi = lane >> 5;
    const int NT = (cur.P0 + QB) / KVBLK;
    const int qlo = cur.P0 + wid * QBLK, qm = qlo + r32 - 4 * hi;
    float* ws = (float*)(lds + OFF_WS) + wid * 64; float* li_l = ws, * al_l = ws + 32;
    float m_reg = -1e30f, l_reg = 0; f32x16 o[4] = {};
    const int sr = tid >> 4, sc = (tid & 15) * 8, vst0 = v_st(sr, sc), vst1 = v_st(32 + sr, sc), kws = KSWZ(sr, sc * 2);
    const int krr = tid >> 3, krc = (tid & 7) * 8, krws = KRSWZ(krr, krc * 2);
    unsigned offA = (unsigned)(sr * KS + sc) * 2u, offR = (unsigned)(krr * KRS + krc) * 2u, offQ = (unsigned)((wid * QBLK + r32) * QS + hi * 8) * 2u;
    asm volatile("" : "+v"(offA), "+v"(offR), "+v"(offQ));
    const int vb0 = (int)(uintptr_t)lds + v_rd_base(lane);
#define RESC(a) do { if (__any((a) < 1.f)) { if (hi == 0) al_l[r32] = (a); asm volatile("s_waitcnt lgkmcnt(0)" ::: "memory");              \
                     for (int d_ = 0; d_ < 4; ++d_) for (int r = 0; r < 16; ++r) o[d_][r] *= al_l[crow(r, hi)]; } } while (0)
#define KBASE(t) ((t) * KVBLK)
#define MASKT(P0_, P1_, t) do { const int kb_ = KBASE(t); if (kb_ + KVBLK - 1 > qlo) mask_tile(P0_, P1_, qm - kb_); } while (0)
    f32x16 pA0, pA1, pB0, pB1; float mnA, mnB, alA, alB; bf16x8 pa0, pa1, pa2, pa3;
    const int qro = OFF_QR + (wid * 8 * 64 + lane) * 16;
    { bf16x8 tq[8];
#pragma unroll
      for (int dd = 4; dd < 8; ++dd) tq[dd] = LDG8((const char*)cur.Q + 128 + dd * 32, offQ);
      const int pos = cur.POS[wid * QBLK + r32];
      float sn = 0.f, sr = 0.f;
#define UNP(F, x) const u32x4 w_ = __builtin_bit_cast(u32x4, F); float x[8] = {lo_bf(w_.x), hi_bf(w_.x), lo_bf(w_.y), hi_bf(w_.y), lo_bf(w_.z), hi_bf(w_.z), lo_bf(w_.w), hi_bf(w_.w)};
#pragma unroll
      for (int f = 0; f < 8; ++f) { UNP(S.qr[f], x)
#pragma unroll
          for (int e = 0; e < 8; ++e) sn += x[e] * x[e]; }
#pragma unroll
      for (int f = 4; f < 8; ++f) { UNP(tq[f], x)
#pragma unroll
          for (int e = 0; e < 8; ++e) sr += x[e] * x[e]; }
      { auto r0 = __builtin_amdgcn_permlane32_swap(__float_as_uint(sn), __float_as_uint(sn), false, false); sn = __uint_as_float(r0[0]) + __uint_as_float(r0[1]);
        auto r1 = __builtin_amdgcn_permlane32_swap(__float_as_uint(sr), __float_as_uint(sr), false, false); sr = __uint_as_float(r1[0]) + __uint_as_float(r1[1]); }
      const float rn = 1.f / sqrtf(sn * (1.f / 128.f) + RMS_EPS), rr = 1.f / sqrtf(sr * (1.f / 64.f) + RMS_EPS);
#pragma unroll
      for (int f = 0; f < 8; ++f) { UNP(S.qr[f], x)
          const f32x4 g0 = *(const f32x4*)(cur.QG + f * 16 + hi * 8), g1 = *(const f32x4*)(cur.QG + f * 16 + hi * 8 + 4);
          const float g[8] = {g0.x, g0.y, g0.z, g0.w, g1.x, g1.y, g1.z, g1.w};
          u32x4 o; o.x = cvt_pk_bf16(x[0] * rn * g[0], x[1] * rn * g[1]); o.y = cvt_pk_bf16(x[2] * rn * g[2], x[3] * rn * g[3]);
          o.z = cvt_pk_bf16(x[4] * rn * g[4], x[5] * rn * g[5]); o.w = cvt_pk_bf16(x[6] * rn * g[6], x[7] * rn * g[7]);
          S.qr[f] = __builtin_bit_cast(bf16x8, o); }
#pragma unroll
      for (int dd = 0; dd < 2; ++dd) {
          float x1[8], x2[8];
          { UNP(tq[4 + dd], x) for (int e = 0; e < 8; ++e) x1[e] = x[e]; }
          { UNP(tq[6 + dd], x) for (int e = 0; e < 8; ++e) x2[e] = x[e]; }
          const f32x4 ga0 = *(const f32x4*)(cur.QG + 128 + dd * 16 + hi * 8), ga1 = *(const f32x4*)(cur.QG + 128 + dd * 16 + hi * 8 + 4);
          const f32x4 gb0 = *(const f32x4*)(cur.QG + 160 + dd * 16 + hi * 8), gb1 = *(const f32x4*)(cur.QG + 160 + dd * 16 + hi * 8 + 4);
          const float ga[8] = {ga0.x, ga0.y, ga0.z, ga0.w, ga1.x, ga1.y, ga1.z, ga1.w}, gb[8] = {gb0.x, gb0.y, gb0.z, gb0.w, gb1.x, gb1.y, gb1.z, gb1.w};
          float o1[8], o2[8];
#pragma unroll
          for (int e = 0; e < 8; ++e) { float c, s; rope_cs(pos, dd * 16 + hi * 8 + e, c, s);
              const float a = x1[e] * rr * ga[e], b = x2[e] * rr * gb[e]; o1[e] = a * c - b * s; o2[e] = b * c + a * s; }
          u32x4 w1, w2; w1.x = cvt_pk_bf16(o1[0], o1[1]); w1.y = cvt_pk_bf16(o1[2], o1[3]); w1.z = cvt_pk_bf16(o1[4], o1[5]); w1.w = cvt_pk_bf16(o1[6], o1[7]);
          w2.x = cvt_pk_bf16(o2[0], o2[1]); w2.y = cvt_pk_bf16(o2[2], o2[3]); w2.z = cvt_pk_bf16(o2[4], o2[5]); w2.w = cvt_pk_bf16(o2[6], o2[7]);
          tq[4 + dd] = __builtin_bit_cast(bf16x8, w1); tq[6 + dd] = __builtin_bit_cast(bf16x8, w2);
      }
#undef UNP
#pragma unroll
      for (int dd = 0; dd < 4; ++dd) *(bf16x8*)(lds + qro + dd * 1024) = tq[4 + dd]; }
    SWRITE_HV(0); SBAR();
    if (NT > 1) SLOAD_H(cur, KBASE(1));
    SBAR(); qkt<0>(pA0, pA1, lds, r32, hi, S.qr, qro);
    MASKT(pA0, pA1, 0); partialSM(pA0, pA1, m_reg, mnA, alA);
    if (NT > 1) { VMW(); SWRITE_H(1); }
    __syncthreads();
#define HALF_STEP(PX0, PX1, mnX, alX, PY0, PY1, alY, t, KB, VB, SB) do {                                                      \
        SBAR(); qkt<KB>(PX0, PX1, lds, r32, hi, S.qr, qro);                                             \
        finishSM(PY0, PY1, alY, l_reg, pa0, pa1, pa2, pa3); SBAR();                                                           \
        if ((t) + 1 < NT) { SLOAD_H(cur, KBASE((t) + 1)); SBAR(); }                                               \
        pv_tile<VB>(o, vb0, pa0, pa1, pa2, pa3); MASKT(PX0, PX1, (t)); partialSM(PX0, PX1, m_reg, mnX, alX);                                        \
        __syncthreads();                                                                                                      \
        if ((t) + 1 < NT) { VMW(); SWRITE_H(SB); }                                                                          \
        RESC(alX); __syncthreads(); } while (0)
    for (int t = 1; t + 1 < NT; t += 2) {
        HALF_STEP(pB0, pB1, mnB, alB, pA0, pA1, alA, t, 1, 0, 0);
        HALF_STEP(pA0, pA1, mnA, alA, pB0, pB1, alB, t + 1, 0, 1, 1);
    }
    SBAR(); qkt<1>(pB0, pB1, lds, r32, hi, S.qr, qro); SBAR();
    finishSM(pA0, pA1, alA, l_reg, pa0, pa1, pa2, pa3); SBAR();
    pv_tile<0>(o, vb0, pa0, pa1, pa2, pa3);
    MASKT(pB0, pB1, NT - 1); partialSM(pB0, pB1, m_reg, mnB, alB); __syncthreads(); RESC(alB);
    finishSM(pB0, pB1, alB, l_reg, pa0, pa1, pa2, pa3); SBAR(); pv_tile<1>(o, vb0, pa0, pa1, pa2, pa3);
    if (hi == 0) li_l[r32] = l_reg; asm volatile("s_waitcnt lgkmcnt(0)" ::: "memory");
    float rli[16];
#pragma unroll
    for (int r = 0; r < 16; ++r) rli[r] = __builtin_amdgcn_rcpf(li_l[crow(r, hi)]);
    unsigned obase = (unsigned)((wid * QBLK + 4 * hi) * OS + r32) * 2u; asm volatile("" : "+v"(obase));
#pragma unroll
    for (int r = 0; r < 16; ++r) { const unsigned orow_off = (unsigned)(((r & 3) + 8 * (r >> 2)) * OS) * 2u;
#pragma unroll
        for (int d0 = 0; d0 < 4; ++d0) { const float v = o[d0][r] * rli[r];
            const float vn = DPPF(v, 0xB1);
            if ((r32 & 1) == 0) *(unsigned*)((char*)cur.O + (obase + orow_off + (unsigned)(d0 * 64))) = cvtpk(v, vn); } }
    __syncthreads();
#undef RESC
#undef KBASE
#undef MASKT
#undef HALF_STEP
}
#undef VMW
#undef VMWN
#undef SLOAD_H
#undef SWRITE_HK
#undef SWRITE_HV
#undef SWRITE_H
#undef QLOAD
#undef LDG8

__device__ __forceinline__ BlockRef make_ref(int bh, int qb, const bf16_t* q, const bf16_t* kv, const bf16_t* kr, bf16_t* mixed, const int* pos, const float* qg) {
    const int b = bh >> 3, h = bh & 7; BlockRef r;
    r.Q = q + ((size_t)b * SEQ + (size_t)qb * QB) * QS + h * 192;
    r.K = kv + (size_t)b * SEQ * KS + h * 256; r.V = r.K + 128;
    r.KR = kr + (size_t)b * SEQ * KRS;
    r.O = mixed + ((size_t)b * SEQ + (size_t)qb * QB) * OS + 512 + h * 128; r.P0 = qb * QB;
    r.POS = pos + (size_t)b * SEQ + (size_t)qb * QB; r.QG = qg;
    return r;
}
constexpr int N_BLOCKS = BATCH * 8 * NQB;
__device__ __forceinline__ void attn_one(char* lds, const bf16_t* q, const bf16_t* kv, const bf16_t* kr, bf16_t* mixed, int i, const int* pos, const float* qg, const int wv__) {
    Seam S;
    const BlockRef cur = make_ref(i & 63, NQB - 1 - (i >> 6), q, kv, kr, mixed, pos, qg);
    attn_prime(cur, lds, S, wv__);
    attn_block(cur, lds, S, wv__);
}
#undef KSWZ
#undef KRSWZ
#undef SBAR
}
namespace tok {
constexpr int PT = 32;
constexpr int NTILES = T / PT;
constexpr int S_VM = 1040, S_XW = 144, S_XG = 272;
constexpr int O_VM = 0, O_XR = O_VM + PT * S_VM, O_XK = O_XR + PT * S_VM, O_XW = O_XK + PT * S_VM, O_XA = O_XW + PT * S_XW, O_XG = O_XA + PT * S_XW, O_PAR = O_XG + PT * S_XG, O_WB = O_PAR + 6 * 2048, O_END = O_WB + 8 * 2560;
constexpr int LDS_BYTES = O_END;
constexpr size_t WL_W2 = 0, WL_A2 = WL_W2 + 512 * 64, WL_G2 = WL_A2 + 512 * 64, WL_V1 = WL_G2 + 512 * 128, WL_V2 = WL_V1 + 32 * 512, WL_END = WL_V2 + 512 * 32;

struct Args {
    const bf16_t* p; const int* pos;
    const float *k_gain;
    const float *mu, *w0, *a0, *v0, *k_k, *k_a, *r_k;
    const bf16_t* wl;
    float *rs_q, *rs_kv; bf16_t* kr;
    bf16_t *R, *K, *V, *KK, *B, *G, *BON, *VFIRST; float* W; float *RIN, *BS;
};
__device__ __forceinline__ float4 ld4f(const float* p) { return *(const float4*)p; }
__device__ __forceinline__ void bf4(u32x2 w, float* o) { o[0] = lo_bf(w.x); o[1] = hi_bf(w.x); o[2] = lo_bf(w.y); o[3] = hi_bf(w.y); }
__device__ __forceinline__ u32x2 pk4(const float* v) { u32x2 w; w.x = cvt_pk_bf16(v[0], v[1]); w.y = cvt_pk_bf16(v[2], v[3]); return w; }

__device__ __forceinline__ void wave_store_bf16(LAS unsigned char* wb, const u32x2 (&v)[4], bf16_t* gbase, int r32, int hi, int lane) {
#pragma unroll
    for (int g = 0; g < 4; ++g) *(LAS u32x2*)(wb + r32 * 80 + 16 * g + 8 * hi) = v[g];
    asm volatile("" ::: "memory");
#pragma unroll
    for (int i = 0; i < 2; ++i) { const int tk_ = i * 16 + (lane >> 2); const u32x4 x = *(const LAS u32x4*)(wb + tk_ * 80 + (lane & 3) * 16);
        *(u32x4*)((char*)gbase + (size_t)tk_ * 1024 + (lane & 3) * 16) = x; }
    asm volatile("" ::: "memory");
}
__device__ __forceinline__ void wave_store_f32h(LAS unsigned char* wb, const f32x4 (&v)[2], float* gbase, int r32, int hi, int lane) {
#pragma unroll
    for (int j = 0; j < 2; ++j) *(LAS f32x4*)(wb + r32 * 80 + (8 * j + 4 * hi) * 4) = v[j];
    asm volatile("" ::: "memory");
#pragma unroll
    for (int i = 0; i < 2; ++i) { const int tk_ = i * 16 + (lane >> 2); const f32x4 x = *(const LAS f32x4*)(wb + tk_ * 80 + (lane & 3) * 16);
        *(f32x4*)((char*)gbase + (size_t)tk_ * 2048 + (lane & 3) * 16) = x; }
    asm volatile("" ::: "memory");
}
__device__ __forceinline__ void stage_params(const Args& A, LAS unsigned char* lds, int tid) {
    LAS float* P = (LAS float*)(lds + O_PAR);
    P[tid] = A.w0[tid]; P[512 + tid] = A.a0[tid]; P[1024 + tid] = A.v0[tid]; P[1536 + tid] = A.k_k[tid]; P[2048 + tid] = A.k_a[tid]; P[2560 + tid] = A.r_k[tid];
}
template <int LAYER>
__device__ __forceinline__ void tile(const Args& A, LAS unsigned char* lds, int tl, const int wv__, const int mode = 7) {
    const int tid = TID(), lane = tid & 63, wid = __builtin_amdgcn_readfirstlane(tid >> 6), r32 = lane & 31, hi = lane >> 5;
    const int tok0 = tl * PT;
    const bf16_t* p = A.p;
    if (mode & 1) {
        u32x2 k4v[4]; bf16_t krv[4]; int posv[4];
#pragma unroll
        for (int i = 0; i < 4; ++i) {
            const int tk = tok0 + wid + 8 * i; const bf16_t* pr = p + (size_t)tk * NP;
            k4v[i] = *(const u32x2*)(pr + C_MKV + lane * 4); krv[i] = pr[C_MKR + lane]; posv[i] = A.pos[tk];
        }
        const float kg = A.k_gain[128 + lane];
#pragma unroll
        for (int i = 0; i < 4; ++i) {
            const int tk = tok0 + wid + 8 * i;
            const u32x2 k4 = k4v[i];
            float sk = 0.f;
            { float a; a = lo_bf(k4.x); sk += a * a; a = hi_bf(k4.x); sk += a * a; a = lo_bf(k4.y); sk += a * a; a = hi_bf(k4.y); sk += a * a; }
            const float kr = bf2f(krv[i]);
            float skr = kr * kr;
            sk = wave_sum(sk); skr = wave_sum(skr);
            if (lane == 0) A.rs_kv[tk] = 1.f / sqrtf(sk * (1.f / 256.f) + RMS_EPS);
            const float krn = kr * (1.f / sqrtf(skr * (1.f / 64.f) + RMS_EPS)) * kg;
            const float other = xor32f(krn, lane);
            float c, s; rope_cs(posv[i], lane & 31, c, s);
            const float o = (lane < 32) ? (krn * c - other * s) : (krn * c + other * s);
            A.kr[(size_t)tk * 64 + lane] = f2bf(o);
        }
    }
    if (mode & 2) {
#pragma unroll 1
    for (int it = 0; it < 7; ++it) {
        u32x4 cu[2], pv[2]; f32x4 m0[2], m1[2]; int tt[2], jj[2];
#pragma unroll
        for (int u = 0; u < 2; ++u) {
            const int task = tid + (2 * it + u) * 512;
            const int t = task / 224, j = task - t * 224; tt[u] = t; jj[u] = j;
            const int tk = tok0 + t; const bool first = (tk & (SEQ - 1)) == 0;
            const bf16_t* pr = p + (size_t)tk * NP + C_RR + 8 * j;
            cu[u] = *(const u32x4*)pr;
            pv[u] = (u32x4){0u, 0u, 0u, 0u};
            if (!first) pv[u] = *(const u32x4*)(pr - NP);
            m0[u] = *(const f32x4*)(A.mu + 8 * j); m1[u] = *(const f32x4*)(A.mu + 8 * j + 4);
        }
#pragma unroll
        for (int u = 0; u < 2; ++u) {
            const int t = tt[u], j = jj[u];
            const float mu[8] = {m0[u].x, m0[u].y, m0[u].z, m0[u].w, m1[u].x, m1[u].y, m1[u].z, m1[u].w};
            const float c8[8] = {lo_bf(cu[u].x), hi_bf(cu[u].x), lo_bf(cu[u].y), hi_bf(cu[u].y), lo_bf(cu[u].z), hi_bf(cu[u].z), lo_bf(cu[u].w), hi_bf(cu[u].w)};
            const float p8[8] = {lo_bf(pv[u].x), hi_bf(pv[u].x), lo_bf(pv[u].y), hi_bf(pv[u].y), lo_bf(pv[u].z), hi_bf(pv[u].z), lo_bf(pv[u].w), hi_bf(pv[u].w)};
            float o[8];
#pragma unroll
            for (int i = 0; i < 8; ++i) o[i] = c8[i] + (p8[i] - c8[i]) * mu[i];
            if (j >= 192) {
#pragma unroll
                for (int i = 0; i < 8; ++i) { const float m = o[i]; const float e = fast_exp(j < 200 ? 2.f * m : -m); const float r = fast_rcp(e + 1.f);
                    o[i] = j < 200 ? 1.f - 2.f * r : (j < 208 ? m : r); }
            }
            u32x4 w; w.x = cvt_pk_bf16(o[0], o[1]); w.y = cvt_pk_bf16(o[2], o[3]); w.z = cvt_pk_bf16(o[4], o[5]); w.w = cvt_pk_bf16(o[6], o[7]);
            int off;
            if (j < 64) off = O_XR + t * S_VM + j * 16; else if (j < 128) off = O_XK + t * S_VM + (j - 64) * 16; else if (j < 192) off = O_VM + t * S_VM + (j - 128) * 16;
            else if (j < 200) off = O_XW + t * S_XW + (j - 192) * 16; else if (j < 208) off = O_XA + t * S_XW + (j - 200) * 16; else off = O_XG + t * S_XG + (j - 208) * 16;
            *(LAS u32x4*)(lds + off) = w;
        }
    }
    }
    __syncthreads();
    const int h = wid;
    unsigned wo64 = (unsigned)(r32 * 64 + hi * 8) * 2u, wo128 = (unsigned)(r32 * 128 + hi * 8) * 2u, wo32 = (unsigned)(r32 * 32 + hi * 8) * 2u, wo512 = (unsigned)(r32 * 512 + hi * 8) * 2u;
#define GLD8(base, off) (*(const bf16x8*)((const char*)(base) + (off)))
    const bf16_t* w2t = A.wl + WL_W2 + (size_t)(h * 64) * 64; const bf16_t* a2t = A.wl + WL_A2 + (size_t)(h * 64) * 64;
    const bf16_t* g2t = A.wl + WL_G2 + (size_t)(h * 64) * 128; const bf16_t* v2p = A.wl + WL_V2 + (size_t)(h * 64) * 32; const bf16_t* v1t = A.wl + WL_V1;
    if (mode & 4) {
        constexpr int nb = 0;
        asm volatile("" : "+v"(wo64), "+v"(wo128), "+v"(wo32), "+v"(wo512));
        const int trow = nb * 32 + r32;
        const int tk = tok0 + trow; const bool first = (tk & (SEQ - 1)) == 0;
        unsigned e512 = (unsigned)(trow * 512 + 4 * hi);
        asm volatile("" : "+v"(e512));
        const size_t t512 = (size_t)tok0 * 512;
#define CB (h * 64 + mb * 32 + 8 * g)
#define PL4(idx) (*(const LAS f32x4*)(lds + O_PAR + (idx) * 2048 + (CB + 4 * hi) * 4))
#define A2(ptr) ((char*)((ptr) + t512 + CB) + e512 * 2u)
#define A4(ptr) ((char*)((ptr) + t512 + CB) + e512 * 4u)
        bf16x8 vvf[2];
        if (LAYER > 0) {
            f32x16 vv = f32x16{};
#pragma unroll 16
            for (int ks = 0; ks < 32; ++ks) {
                const bf16x8 bv = *(const LAS bf16x8*)(lds + O_VM + trow * S_VM + (ks * 16 + hi * 8) * 2);
                const bf16x8 av = GLD8(v1t + ks * 16, wo512);
                vv = __builtin_amdgcn_mfma_f32_32x32x16_bf16(av, bv, vv, 0, 0, 0);
            }
#pragma unroll
            for (int s = 0; s < 2; ++s) {
                u32x4 bw; bw.x = cvt_pk_bf16(vv[8 * s + 0], vv[8 * s + 1]); bw.y = cvt_pk_bf16(vv[8 * s + 2], vv[8 * s + 3]); bw.z = cvt_pk_bf16(vv[8 * s + 4], vv[8 * s + 5]); bw.w = cvt_pk_bf16(vv[8 * s + 6], vv[8 * s + 7]);
                vvf[s] = __builtin_bit_cast(bf16x8, bw);
            }
        }
        float ss = 0.f, bs = 0.f;
#pragma unroll
        for (int mb = 0; mb < 2; ++mb) {
            f32x16 accW = f32x16{}, accA = f32x16{}, accG = f32x16{}, accV = f32x16{};
            u32x2 vfraw[4];
            if (LAYER > 0) {
#pragma unroll
                for (int g = 0; g < 4; ++g) vfraw[g] = *(const u32x2*)A2(A.VFIRST);
            }
#pragma unroll
            for (int ks = 0; ks < 4; ++ks) {
                const bf16x8 bw = *(const LAS bf16x8*)(lds + O_XW + trow * S_XW + (ks * 16 + hi * 8) * 2);
                const bf16x8 ba = *(const LAS bf16x8*)(lds + O_XA + trow * S_XW + (ks * 16 + hi * 8) * 2);
                const bf16x8 aw = GLD8(w2t + mb * 32 * 64 + ks * 16, wo64);
                const bf16x8 aa = GLD8(a2t + mb * 32 * 64 + ks * 16, wo64);
                accW = __builtin_amdgcn_mfma_f32_32x32x16_bf16(aw, bw, accW, 0, 0, 0);
                accA = __builtin_amdgcn_mfma_f32_32x32x16_bf16(aa, ba, accA, 0, 0, 0);
            }
#pragma unroll
            for (int ks = 0; ks < 8; ++ks) {
                const bf16x8 bg = *(const LAS bf16x8*)(lds + O_XG + trow * S_XG + (ks * 16 + hi * 8) * 2);
                const bf16x8 ag = GLD8(g2t + mb * 32 * 128 + ks * 16, wo128);
                accG = __builtin_amdgcn_mfma_f32_32x32x16_bf16(ag, bg, accG, 0, 0, 0);
            }
            if (LAYER > 0) {
#pragma unroll
                for (int s = 0; s < 2; ++s) {
                    const bf16x8 a2 = GLD8(v2p + mb * 32 * 32 + s * 16, wo32);
                    accV = __builtin_amdgcn_mfma_f32_32x32x16_bf16(a2, vvf[s], accV, 0, 0, 0);
                }
            }
            asm volatile("" ::: "memory");
            f32x4 oW[4]; u32x2 oG[4], oV[4], oR[4], oK[4], oKK[4], oB[4];
#pragma unroll
            for (int g = 0; g < 4; ++g) {
                const f32x4 w0 = PL4(0), a0 = PL4(1);
                const float w0a[4] = {w0.x, w0.y, w0.z, w0.w}, a0a[4] = {a0.x, a0.y, a0.z, a0.w};
                float dec[4], gt[4], av[4];
#pragma unroll
                for (int i = 0; i < 4; ++i) {
                    dec[i] = fast_exp(-0.6065306597126334f * sigmoidf_(accW[4 * g + i] + w0a[i]));
                    gt[i] = accG[4 * g + i];
                    av[i] = sigmoidf_(accA[4 * g + i] + a0a[i]);
                }
                oW[g] = (f32x4){dec[0], dec[1], dec[2], dec[3]};
                oG[g] = pk4(gt);
                float vm[4]; bf4(*(const LAS u32x2*)(lds + O_VM + trow * S_VM + (CB + 4 * hi) * 2), vm);
                float vf[4];
                if (LAYER > 0) {
                    const f32x4 v0 = PL4(2); const float v0a[4] = {v0.x, v0.y, v0.z, v0.w};
                    float vfi[4]; bf4(vfraw[g], vfi);
#pragma unroll
                    for (int i = 0; i < 4; ++i) vf[i] = vm[i] + (vfi[i] - vm[i]) * sigmoidf_(accV[4 * g + i] + v0a[i]);
                } else {
#pragma unroll
                    for (int i = 0; i < 4; ++i) vf[i] = vm[i];
                }
                oV[g] = pk4(vf);
                float xr[4], xk4[4];
                const u32x2 xrraw = *(const LAS u32x2*)(lds + O_XR + trow * S_VM + (CB + 4 * hi) * 2);
                bf4(xrraw, xr); bf4(*(const LAS u32x2*)(lds + O_XK + trow * S_VM + (CB + 4 * hi) * 2), xk4);
                const f32x4 kk4 = PL4(3), ka4 = PL4(4), rk4 = PL4(5);
                const float kka[4] = {kk4.x, kk4.y, kk4.z, kk4.w}, kaa[4] = {ka4.x, ka4.y, ka4.z, ka4.w}, rka[4] = {rk4.x, rk4.y, rk4.z, rk4.w};
                float k2[4], kkv[4], bn[4];
#pragma unroll
                for (int i = 0; i < 4; ++i) {
                    const float xk = xk4[i];
                    kkv[i] = xk * kka[i];
                    ss += kkv[i] * kkv[i];
                    k2[i] = xk * (1.f + (av[i] - 1.f) * kaa[i]);
                    bs += xr[i] * k2[i] * rka[i];
                    bn[i] = -kkv[i] * av[i];
                }
                oR[g] = xrraw; oK[g] = pk4(k2); oKK[g] = pk4(kkv); oB[g] = pk4(bn);
            }
#ifdef TOKPROBE
            if (mode & 8) { unsigned cs = 0u;
#pragma unroll
              for (int g = 0; g < 4; ++g) cs ^= oG[g].x ^ oG[g].y ^ oV[g].x ^ oV[g].y ^ oR[g].x ^ oR[g].y ^ oK[g].x ^ oK[g].y ^ oKK[g].x ^ oKK[g].y ^ oB[g].x ^ oB[g].y ^ __float_as_uint(oW[g].x) ^ __float_as_uint(oW[g].y) ^ __float_as_uint(oW[g].z) ^ __float_as_uint(oW[g].w);
              if (cs == 0x12345679u) A.G[(size_t)tok0 * 512 + lane] = 1; } else
#endif
            { LAS unsigned char* wb = lds + O_WB + wid * 2560;
              const size_t eb = (size_t)tok0 * 512 + h * 64 + mb * 32;
              wave_store_bf16(wb, oG, A.G + eb, r32, hi, lane);
              wave_store_bf16(wb, oV, A.V + eb, r32, hi, lane);
              if (LAYER == 0) wave_store_bf16(wb, oV, A.VFIRST + eb, r32, hi, lane);
              wave_store_bf16(wb, oR, A.R + eb, r32, hi, lane);
              wave_store_bf16(wb, oK, A.K + eb, r32, hi, lane);
              wave_store_bf16(wb, oKK, A.KK + eb, r32, hi, lane);
              wave_store_bf16(wb, oB, A.B + eb, r32, hi, lane);
              { const f32x4 w01[2] = {oW[0], oW[1]}, w23[2] = {oW[2], oW[3]};
                wave_store_f32h(wb, w01, A.W + eb, r32, hi, lane); wave_store_f32h(wb, w23, A.W + eb + 16, r32, hi, lane); } }
        }
        { auto r0 = __builtin_amdgcn_permlane32_swap(__float_as_uint(ss), __float_as_uint(ss), false, false); ss = __uint_as_float(r0[0]) + __uint_as_float(r0[1]);
          auto r1 = __builtin_amdgcn_permlane32_swap(__float_as_uint(bs), __float_as_uint(bs), false, false); bs = __uint_as_float(r1[0]) + __uint_as_float(r1[1]); }
        if (hi == 0) { A.RIN[(size_t)tk * 8 + h] = 1.f / fmaxf(sqrtf(ss), 1e-12f); A.BS[(size_t)tk * 8 + h] = bs; }
    }
#undef CB
#undef PL4
#undef A2
#undef A4
#undef GLD8
    __syncthreads();
}
__device__ __forceinline__ void lora_prep(const float* w2, const float* a2, const float* g2, const float* v1, const float* v2, bf16_t* wl, int gtid, int nthr) {
    for (int i = gtid; i < 512 * 64; i += nthr) { const int n = i >> 6, k = i & 63; wl[WL_W2 + i] = f2bf(w2[k * 512 + n]); wl[WL_A2 + i] = f2bf(a2[k * 512 + n]); }
    for (int i = gtid; i < 512 * 128; i += nthr) { const int n = i >> 7, k = i & 127; wl[WL_G2 + i] = f2bf(g2[k * 512 + n]); }
    if (v1) {
        for (int i = gtid; i < 32 * 512; i += nthr) { const int j = i >> 9, k = i & 511; wl[WL_V1 + i] = f2bf(v1[k * 32 + j]); }
        for (int i = gtid; i < 512 * 32; i += nthr) { const int n = i >> 5, q = i & 31, s = q >> 4, hh = (q >> 3) & 1, jj = q & 7;
            const int kidx = 16 * s + 8 * (jj >> 2) + 4 * hh + (jj & 3); wl[WL_V2 + i] = f2bf(v2[kidx * 512 + n]); }
    }
}
}
struct Ptrs {
    const float* in[30]; float* out; unsigned char* ws;
};
__device__ __forceinline__ void transpose_item(const float* W, int K, int N, bf16_t* WT, const float* gain, int mode, LAS float* scr, int item, int lane) {
    const int nblk = N / 64, kb = item / nblk, nb = item % nblk, k0 = 64 * kb, n0 = 64 * nb;
#pragma unroll 64
    for (int kk = 0; kk < 64; ++kk) { const float g = gain ? gain[k0 + kk] : 1.f; scr[kk * 65 + lane] = W[(size_t)(k0 + kk) * N + n0 + lane] * g; }
    asm volatile("s_waitcnt lgkmcnt(0)" ::: "memory");
    const int c = lane & 7;
#pragma unroll
    for (int j = 0; j < 8; ++j) { const int n = (lane >> 3) + 8 * j; const LAS float* s = scr + (8 * c) * 65 + n;
        u32x4 o; o.x = cvt_pk_bf16(s[0 * 65], s[1 * 65]); o.y = cvt_pk_bf16(s[2 * 65], s[3 * 65]); o.z = cvt_pk_bf16(s[4 * 65], s[5 * 65]); o.w = cvt_pk_bf16(s[6 * 65], s[7 * 65]);
        const int ng = n0 + n; int drow = ng;
        if (mode == 1) { if (ng < FF) drow = 256 * (ng >> 7) + (ng & 127); else { const int f = ng - FF; drow = 256 * (f >> 7) + 128 + (f & 127); } }
        *(u32x4*)(WT + (size_t)drow * K + k0 + 8 * c) = o; }
    asm volatile("s_waitcnt lgkmcnt(0)" ::: "memory");
}
typedef const Ptrs __attribute__((address_space(4)))* PtrTab;
constexpr int CV_IN = (DM / 64) * (INW / 64), CV_QB = (512 / 64) * (QW / 64), CV_KVB = (256 / 64) * (KVW / 64), CV_O = (DM / 64) * (DM / 64),
              CV_GU = (DM / 64) * (2 * FF / 64), CV_DN = (FF / 64) * (DM / 64);
constexpr int CV_NI = CV_IN + CV_QB + CV_KVB + CV_O + CV_GU + CV_DN;
__device__ __forceinline__ void convert_wave_item(PtrTab pt, int l, int it, LAS float* scr, int lane) {
    unsigned char* wl = pt->ws + WS_W + (size_t)l * W_LAYER;
    int r = it;
    if (r < CV_IN) { transpose_item(pt->in[3] + (size_t)l * DM * INW, DM, INW, (bf16_t*)(wl + WO_IN), pt->in[2] + l * DM, 0, scr, r, lane); return; } r -= CV_IN;
    if (r < CV_QB) { transpose_item(pt->in[7] + (size_t)l * 512 * QW, 512, QW, (bf16_t*)(wl + WO_QB), pt->in[6] + l * 512, 0, scr, r, lane); return; } r -= CV_QB;
    if (r < CV_KVB) { transpose_item(pt->in[9] + (size_t)l * 256 * KVW, 256, KVW, (bf16_t*)(wl + WO_KVB), pt->in[8] + l * 256, 0, scr, r, lane); return; } r -= CV_KVB;
    if (r < CV_O) { transpose_item(pt->in[26] + (size_t)l * DM * DM, DM, DM, (bf16_t*)(wl + WO_O), nullptr, 0, scr, r, lane); return; } r -= CV_O;
    if (r < CV_GU) { transpose_item(pt->in[28] + (size_t)l * DM * 2 * FF, DM, 2 * FF, (bf16_t*)(wl + WO_GU), pt->in[27] + l * DM, 1, scr, r, lane); return; } r -= CV_GU;
    transpose_item(pt->in[29] + (size_t)l * FF * DM, FF, DM, (bf16_t*)(wl + WO_DN), nullptr, 0, scr, r, lane);
}
__device__ __forceinline__ void convert_misc(PtrTab pt, int l, int gtid, int nthr) {
    unsigned char* wl = pt->ws + WS_W + (size_t)l * W_LAYER;
    { u32x4* z = (u32x4*)(wl + WO_IN + (size_t)INW * DM * 2); const int n16 = (NP - INW) * DM * 2 / 16;
      for (int i = gtid; i < n16; i += nthr) z[i] = (u32x4){0u, 0u, 0u, 0u}; }
    tok::lora_prep(pt->in[14] + (size_t)l * 64 * 512, pt->in[16] + (size_t)l * 64 * 512, pt->in[17] + (size_t)l * 128 * 512,
                   l > 0 ? pt->in[19] + (size_t)(l - 1) * 512 * 32 : nullptr, l > 0 ? pt->in[20] + (size_t)(l - 1) * 32 * 512 : nullptr,
                   (bf16_t*)(wl + WO_LORA), gtid, nthr);
}
constexpr int CV_TI = (CV_NI + 63) / 64, CV_MISC = 8, CV_ITEMS = CV_TI + CV_MISC;
constexpr int CV_EARLY = CV_IN + CV_QB + CV_KVB;
constexpr int CV_LATE0 = (CV_NI - CV_EARLY + 63) / 64;
__device__ __forceinline__ void convert_queue_item(PtrTab pt, int l, int ci, LAS float* scr, int wid, int lane) {
    asm volatile("" : "+s"(pt));
    if (ci < CV_TI) {
        for (int k = 0; k < 8; ++k) { const int it = ci * 64 + k * 8 + wid; if (it < CV_NI) convert_wave_item(pt, l, it, scr, lane); }
    } else if (ci < CV_ITEMS) convert_misc(pt, l, (ci - CV_TI) * 512 + wid * 64 + lane, CV_MISC * 512);
    else { for (int k = 0; k < 8; ++k) { const int it = CV_EARLY + (ci - CV_ITEMS) * 64 + k * 8 + wid; if (it < CV_NI) convert_wave_item(pt, 0, it, scr, lane); } }
}
__device__ __forceinline__ void prologue_phase(PtrTab pt, LAS float* scr, int gw, int ngw, int lane) {
#ifdef CONV_IN_MIXERS
    for (int it = gw; it < CV_NI; it += ngw) convert_wave_item(pt, 0, it, scr, lane);
    convert_misc(pt, 0, gw * 64 + lane, ngw * 64);
#else
    for (int l = 0; l < DEPTH; ++l) {
        for (int it = gw; it < CV_NI; it += ngw) convert_wave_item(pt, l, it, scr, lane);
        convert_misc(pt, l, gw * 64 + lane, ngw * 64);
    }
#endif
    const float* x_in = pt->in[0]; const float* hb_in = pt->in[4]; unsigned char* ws_ = pt->ws;
    { bf16_t* xb = (bf16_t*)(ws_ + WS_XB); float* ssa = (float*)(ws_ + WS_SSA);
      for (int m0 = gw; m0 < T; m0 += 2 * ngw) {
        f32x4 v[2][8];
#pragma unroll
        for (int u = 0; u < 2; ++u) { const f32x4* xr = (const f32x4*)(x_in + (size_t)(m0 + u * ngw) * DM) + lane;
#pragma unroll
          for (int j = 0; j < 8; ++j) v[u][j] = xr[64 * j]; }
#pragma unroll
        for (int u = 0; u < 2; ++u) {
          const int m = m0 + u * ngw; float s = 0.f;
#pragma unroll
          for (int j = 0; j < 8; ++j) s += (v[u][j].x * v[u][j].x + v[u][j].y * v[u][j].y) + (v[u][j].z * v[u][j].z + v[u][j].w * v[u][j].w);
          s = wave_sum(s);
          if (lane < 32) ssa[(size_t)m * 32 + lane] = lane == 0 ? s : 0.f;
          u32x2* o = (u32x2*)(xb + (size_t)m * DM) + lane;
#pragma unroll
          for (int j = 0; j < 8; ++j) { u32x2 w; w.x = cvt_pk_bf16(v[u][j].x, v[u][j].y); w.y = cvt_pk_bf16(v[u][j].z, v[u][j].w); o[64 * j] = w; }
        }
      } }
    { float* lb = (float*)(ws_ + WS_LB); const float* hb = hb_in;
      for (int c = gw * 64 + lane; c < 512; c += ngw * 64) {
          float v[DEPTH], mx = -1e30f, s = 0.f;
          for (int l = 0; l < DEPTH; ++l) { v[l] = hb[l * 512 + c]; mx = fmaxf(mx, v[l]); }
          for (int l = 0; l < DEPTH; ++l) { v[l] = expf(v[l] - mx); s += v[l]; }
          float cum = 0.f; const float inv = 1.f / s;
          for (int l = 0; l < DEPTH; ++l) { cum += v[l] * inv; lb[l * 512 + c] = cum - v[0] * inv; }
      } }
}

__device__ __forceinline__ void rownorm_phase(const float* x, bf16_t* xb, float* rs, int gw, int ngw, int lane) {
    for (int m = gw; m < T; m += ngw) {
        const f32x4* xr = (const f32x4*)(x + (size_t)m * DM) + lane;
        f32x4 v[8]; float s = 0.f;
#pragma unroll
        for (int j = 0; j < 8; ++j) { v[j] = xr[64 * j]; s += (v[j].x * v[j].x + v[j].y * v[j].y) + (v[j].z * v[j].z + v[j].w * v[j].w); }
        s = wave_sum(s);
        if (lane == 0) rs[m] = 1.f / sqrtf(s * (1.f / DM) + RMS_EPS);
        u32x2* o = (u32x2*)(xb + (size_t)m * DM) + lane;
#pragma unroll
        for (int j = 0; j < 8; ++j) { u32x2 w; w.x = cvt_pk_bf16(v[j].x, v[j].y); w.y = cvt_pk_bf16(v[j].z, v[j].w); o[64 * j] = w; }
    }
}

__device__ __forceinline__ void qknorm_phase(bf16_t* q, bf16_t* kv, const int* pos, const float* q_gain, const float* k_gain, int gw, int ngw, int lane, bf16_t* qo = nullptr, bf16_t* kvo = nullptr) {
    if (!qo) { qo = q; kvo = kv; }
    const float gk0 = k_gain[2 * lane], gk1 = k_gain[2 * lane + 1];
#pragma unroll 2
    for (int tk = gw; tk < T; tk += ngw) {
        bf16_t* qrow = q + (size_t)tk * QW; bf16_t* krow = kv + (size_t)tk * KVW; bf16_t* qorow = qo + (size_t)tk * QW; bf16_t* korow = kvo + (size_t)tk * KVW;
#pragma unroll
        for (int h = 0; h < 8; ++h) {
            const unsigned kn = *(const unsigned*)(krow + h * 256 + 2 * lane);
            const float b0 = lo_bf(kn), b1 = hi_bf(kn);
            const float sk = wave_sum(b0 * b0 + b1 * b1);
            const float rk = 1.f / sqrtf(sk * (1.f / 128.f) + RMS_EPS);
            *(unsigned*)(korow + h * 256 + 2 * lane) = cvt_pk_bf16(b0 * rk * gk0, b1 * rk * gk1);
        }
    }
}
namespace rwk {
constexpr int TC = 64;
constexpr int NCH = SEQ / TC;
constexpr int N_ITEMS = BATCH * 8 * 2;
constexpr int OPS = 320;
constexpr int VS = TC + 4;
constexpr int L_KK = 0, L_W = 64, L_BN = 128, L_KP = 192, L_R = 256, L_V = TC * OPS, L_Y = L_V + 32 * VS, L_DUM = L_Y + 32 * VS, L_END = L_DUM + 512 * 4;
constexpr int LDS_BYTES = L_END * 4;
struct Args { const bf16_t *R, *K, *KK, *B; bf16_t* V; const float* W; const float* RIN; bf16_t* Yout; };

__device__ __forceinline__ float dpp_xor1(float x) { return __int_as_float(__builtin_amdgcn_update_dpp(0, __float_as_int(x), 0xB1, 0xf, 0xf, true)); }
__device__ __forceinline__ float dpp_xor2(float x) { return __int_as_float(__builtin_amdgcn_update_dpp(0, __float_as_int(x), 0x4E, 0xf, 0xf, true)); }
__device__ __forceinline__ float dpp_hmir(float x) { return __int_as_float(__builtin_amdgcn_update_dpp(0, __float_as_int(x), 0x141, 0xf, 0xf, true)); }
__device__ __forceinline__ float red8(float x) { x += dpp_xor1(x); x += dpp_xor2(x); x += dpp_hmir(x); return x; }

struct Pre { u32x4 r, k, v, kk, b; f32x4 w0, w1; float rin; };
__device__ __forceinline__ void pre_load(Pre& q, const Args& A, size_t off, bool hasv) {
    q.r = *(const u32x4*)(A.R + off); q.k = *(const u32x4*)(A.K + off); q.kk = *(const u32x4*)(A.KK + off); q.b = *(const u32x4*)(A.B + off);
    if (hasv) q.v = *(const u32x4*)(A.V + off);
    q.w0 = *(const f32x4*)(A.W + off); q.w1 = *(const f32x4*)(A.W + off + 4);
    q.rin = A.RIN[(off >> 9) * 8 + ((off >> 6) & 7)];
}
__device__ __forceinline__ void st8(LAS float* d, u32x4 w, float sc = 1.f) {
    *(LAS f32x4*)d = (f32x4){lo_bf(w.x) * sc, hi_bf(w.x) * sc, lo_bf(w.y) * sc, hi_bf(w.y) * sc}; *(LAS f32x4*)(d + 4) = (f32x4){lo_bf(w.z) * sc, hi_bf(w.z) * sc, lo_bf(w.w) * sc, hi_bf(w.w) * sc};
}

template <int VAR = 0>
__device__ __forceinline__ void item(const Args& A, LAS float* lds, int it, const int wv__) {
    const int tid = TID(), bh = it >> 1, half = it & 1, b = bh >> 3, h = bh & 7;
    const int st = tid >> 3, sc8 = (tid & 7) * 8;
    const bool hasv = ((tid & 7) >> 2) == half;
    const int vc8 = sc8 - half * 32;
    const size_t base = (size_t)b * SEQ * 512 + h * 64;
    const int row = tid >> 3, kp = tid & 7;
    f32x2 s0[4];
#pragma unroll
    for (int i = 0; i < 4; ++i) s0[i] = (f32x2){0.f, 0.f};
    Pre pre; pre_load(pre, A, base + (size_t)st * 512 + sc8, hasv);
    for (int ck = 0; ck < NCH; ++ck) {
        { const int o = st * OPS + sc8;
          st8(lds + L_R + o, pre.r); st8(lds + L_KP + o, pre.k); st8(lds + L_KK + o, pre.kk, pre.rin); st8(lds + L_BN + o, pre.b, pre.rin);
          *(LAS f32x4*)(lds + L_W + o) = pre.w0; *(LAS f32x4*)(lds + L_W + o + 4) = pre.w1;
          if (hasv) { LAS float* vd = lds + L_V + vc8 * VS + st;
            vd[0 * VS] = lo_bf(pre.v.x); vd[1 * VS] = hi_bf(pre.v.x); vd[2 * VS] = lo_bf(pre.v.y); vd[3 * VS] = hi_bf(pre.v.y);
            vd[4 * VS] = lo_bf(pre.v.z); vd[5 * VS] = hi_bf(pre.v.z); vd[6 * VS] = lo_bf(pre.v.w); vd[7 * VS] = hi_bf(pre.v.w); } }
        __syncthreads();
        if (ck + 1 < NCH) pre_load(pre, A, base + (size_t)((ck + 1) * TC + st) * 512 + sc8, hasv);
        if (tid < 256) {
            const LAS float* pk = lds + 8 * kp;
            const LAS float* pv = lds + L_V + row * VS;
            LAS float* pyw = kp == 0 ? lds + L_Y + row * VS : lds + L_DUM + tid * 4;
            const int pyinc = kp == 0 ? 4 : 0;
#define RW_LOAD(P, t_) do { const LAS float* q_ = pk + (t_) * OPS; \
                P##kk0 = *(const LAS f32x4*)(q_ + L_KK); P##kk1 = *(const LAS f32x4*)(q_ + L_KK + 4); \
                P##w0 = *(const LAS f32x4*)(q_ + L_W); P##w1 = *(const LAS f32x4*)(q_ + L_W + 4); \
                P##b0 = *(const LAS f32x4*)(q_ + L_BN); P##b1 = *(const LAS f32x4*)(q_ + L_BN + 4); \
                P##k0 = *(const LAS f32x4*)(q_ + L_KP); P##k1 = *(const LAS f32x4*)(q_ + L_KP + 4); \
                P##r0 = *(const LAS f32x4*)(q_ + L_R); P##r1 = *(const LAS f32x4*)(q_ + L_R + 4); } while (0)
#define F2(v4, i) ((f32x2){(v4)[2 * (i)], (v4)[2 * (i) + 1]})
#define RW_DOT(S, A0, A1) ({ f32x2 p_ = S[0] * F2(A0, 0); p_ = __builtin_elementwise_fma(S[1], F2(A0, 1), p_); p_ = __builtin_elementwise_fma(S[2], F2(A1, 0), p_); p_ = __builtin_elementwise_fma(S[3], F2(A1, 1), p_); p_.x + p_.y; })
#define RW_STEP(P, v_, yo_) do { \
                float sa0 = RW_DOT(s0, P##kk0, P##kk1); \
                const f32x2 va = (f32x2){v_, v_}; \
                f32x2 ta[4]; \
                ta[0] = va * F2(P##k0, 0); ta[1] = va * F2(P##k0, 1); ta[2] = va * F2(P##k1, 0); ta[3] = va * F2(P##k1, 1); \
                sa0 = red8(sa0); \
                const f32x2 sA = (f32x2){sa0, sa0}; \
                ta[0] = __builtin_elementwise_fma(sA, F2(P##b0, 0), ta[0]); ta[1] = __builtin_elementwise_fma(sA, F2(P##b0, 1), ta[1]); \
                ta[2] = __builtin_elementwise_fma(sA, F2(P##b1, 0), ta[2]); ta[3] = __builtin_elementwise_fma(sA, F2(P##b1, 1), ta[3]); \
                s0[0] = __builtin_elementwise_fma(s0[0], F2(P##w0, 0), ta[0]); s0[1] = __builtin_elementwise_fma(s0[1], F2(P##w0, 1), ta[1]); \
                s0[2] = __builtin_elementwise_fma(s0[2], F2(P##w1, 0), ta[2]); s0[3] = __builtin_elementwise_fma(s0[3], F2(P##w1, 1), ta[3]); \
                float y0 = RW_DOT(s0, P##r0, P##r1); \
                yo_ = red8(y0); } while (0)
            f32x4 Akk0, Akk1, Aw0, Aw1, Ab0, Ab1, Ak0, Ak1, Ar0, Ar1;
            f32x4 Bkk0, Bkk1, Bw0, Bw1, Bb0, Bb1, Bk0, Bk1, Br0, Br1;
            RW_LOAD(A, 0);
            f32x4 v4 = *(const LAS f32x4*)pv;
#pragma unroll 1
            for (int t = 0; t < TC; t += 4) {
                const f32x4 vn = *(const LAS f32x4*)(pv + t + 4);
                f32x4 y4;
                RW_LOAD(B, t + 1); RW_STEP(A, v4.x, y4.x);
                RW_LOAD(A, t + 2); RW_STEP(B, v4.y, y4.y);
                RW_LOAD(B, t + 3); RW_STEP(A, v4.z, y4.z);
                RW_LOAD(A, t + 4); RW_STEP(B, v4.w, y4.w);
                *(LAS f32x4*)pyw = y4; pyw += pyinc;
                v4 = vn;
            }
#undef RW_LOAD
#undef RW_DOT
#undef RW_STEP
#undef F2
        }
        __syncthreads();
        if (tid >= 256) {
            const int t = (tid - 256) >> 2, c8 = (tid & 3) * 8;
            const LAS float* yr = lds + L_Y + c8 * VS + t;
            u32x4 w; w.x = cvt_pk_bf16(yr[0 * VS], yr[1 * VS]); w.y = cvt_pk_bf16(yr[2 * VS], yr[3 * VS]); w.z = cvt_pk_bf16(yr[4 * VS], yr[5 * VS]); w.w = cvt_pk_bf16(yr[6 * VS], yr[7 * VS]);
            *(u32x4*)(A.Yout + base + (size_t)(ck * TC + t) * 512 + half * 32 + c8) = w;
        }
    }
    __syncthreads();
}

struct PostArgs { const bf16_t *Y, *G, *BON; const float *ln_w, *ln_b, *BS; bf16_t* mixed; };
__device__ __forceinline__ void post_phase(const PostArgs& A, int gw, int ngw, int lane) {
    float lnw[8], lnb[8];
#pragma unroll
    for (int i = 0; i < 8; ++i) { lnw[i] = A.ln_w[lane * 8 + i]; lnb[i] = A.ln_b[lane * 8 + i]; }
    for (int tk = gw; tk < T; tk += ngw) {
        const size_t o = (size_t)tk * 512 + lane * 8;
        const u32x4 y4 = *(const u32x4*)(A.Y + o), g4 = *(const u32x4*)(A.G + o), b4 = *(const u32x4*)(A.BON + o);
        float y[8] = {lo_bf(y4.x), hi_bf(y4.x), lo_bf(y4.y), hi_bf(y4.y), lo_bf(y4.z), hi_bf(y4.z), lo_bf(y4.w), hi_bf(y4.w)};
        const float g[8] = {lo_bf(g4.x), hi_bf(g4.x), lo_bf(g4.y), hi_bf(g4.y), lo_bf(g4.z), hi_bf(g4.z), lo_bf(g4.w), hi_bf(g4.w)};
        const float bo[8] = {lo_bf(b4.x), hi_bf(b4.x), lo_bf(b4.y), hi_bf(b4.y), lo_bf(b4.z), hi_bf(b4.z), lo_bf(b4.w), hi_bf(b4.w)};
        const float bsc = A.BS[(size_t)tk * 8 + (lane >> 3)];
        float sm = 0.f;
#pragma unroll
        for (int i = 0; i < 8; ++i) sm += y[i];
        sm = red8(sm); const float mean = sm * (1.f / 64.f);
        float sv = 0.f;
#pragma unroll
        for (int i = 0; i < 8; ++i) { y[i] -= mean; sv += y[i] * y[i]; }
        sv = red8(sv); const float rstd = 1.f / sqrtf(sv * (1.f / 64.f) + 64e-5f);
        float ov[8];
#pragma unroll
        for (int i = 0; i < 8; ++i) ov[i] = (y[i] * rstd * lnw[i] + lnb[i] + bsc * bo[i]) * g[i];
        u32x4 w; w.x = cvt_pk_bf16(ov[0], ov[1]); w.y = cvt_pk_bf16(ov[2], ov[3]); w.z = cvt_pk_bf16(ov[4], ov[5]); w.w = cvt_pk_bf16(ov[6], ov[7]);
        *(u32x4*)(A.mixed + (size_t)tk * DM + 1536 + lane * 8) = w;
    }
}
}
namespace rwc {
constexpr int TB = 32;
constexpr int NB = SEQ / TB;
constexpr int OPS = 320;
constexpr int L_KK = 0, L_W = 64, L_BN = 128, L_KP = 192, L_R = 256;
constexpr int O_RAW = 0;
constexpr int O_VT = O_RAW + TB * OPS * 4;
constexpr int VT_ROW = 40, VT_BUF = 2 * 64 * VT_ROW;
constexpr int O_IMG = O_VT + 2 * VT_BUF;
constexpr int RS = 144;
constexpr int I_A = 0, I_R = I_A + 16 * RS, I_B = I_R + 16 * RS, I_K = I_B + 16 * RS, I_BKT = I_K + 16 * RS;
constexpr int SR = 80;
constexpr int I_LAK = I_BKT + 64 * SR, I_TP = I_LAK + 16 * SR, I_MM = I_TP + 16 * SR, I_GC = I_MM + 16 * SR, I_LAB = I_GC + 256, IMG_BYTES = I_LAB + 16 * SR;
constexpr int O_YB = O_IMG + 2 * IMG_BYTES;
constexpr int LDS_BYTES = O_YB + TB * 64 * 4;
struct Args { const bf16_t *R, *K, *KK, *B, *V; const float* W; const float* RIN; const bf16_t* G; const float *BS, *ln_w, *ln_b; bf16_t* mixed; };
typedef unsigned short u16;

struct Pre { u32x2 r, k, kk, b, v; f32x4 w; float rin; };
__device__ __forceinline__ void pre_load(Pre& q, const Args& A, size_t off) {
    q.r = *(const u32x2*)(A.R + off); q.k = *(const u32x2*)(A.K + off); q.kk = *(const u32x2*)(A.KK + off); q.b = *(const u32x2*)(A.B + off); q.v = *(const u32x2*)(A.V + off);
    q.w = *(const f32x4*)(A.W + off);
    q.rin = A.RIN[(off >> 9) * 8 + ((off >> 6) & 7)];
}
__device__ __forceinline__ float red16(float x) { x += DPPF(x, 0xB1); x += DPPF(x, 0x4E); x += DPPF(x, 0x141); x += DPPF(x, 0x140); return x; }
__device__ __forceinline__ void st4(LAS float* d, u32x2 w, float sc = 1.f) { *(LAS f32x4*)d = (f32x4){lo_bf(w.x) * sc, hi_bf(w.x) * sc, lo_bf(w.y) * sc, hi_bf(w.y) * sc}; }
__device__ __forceinline__ f32x4 mfma16(u32x4 a, u32x4 b, f32x4 c) { return __builtin_amdgcn_mfma_f32_16x16x32_bf16(__builtin_bit_cast(bf16x8, a), __builtin_bit_cast(bf16x8, b), c, 0, 0, 0); }

__device__ __forceinline__ void item(const Args& A, LAS unsigned char* lds, int bh, const int wv__) {
    const int tid = TID(), lane = tid & 63, wid = __builtin_amdgcn_readfirstlane(tid >> 6);
    const int b = bh >> 3, h = bh & 7;
    const size_t base = (size_t)b * SEQ * 512 + h * 64;
    const int st = tid >> 4, c4 = (tid & 15) * 4;
    const int n16 = lane & 15, g = lane >> 4;
    f32x4 Z[4];
#pragma unroll
    for (int i = 0; i < 4; ++i) Z[i] = (f32x4){0.f, 0.f, 0.f, 0.f};
    u32x4 Zq[2] = {(u32x4){0u, 0u, 0u, 0u}, (u32x4){0u, 0u, 0u, 0u}};
    Pre pre; pre_load(pre, A, base + (size_t)st * 512 + c4);
    LAS float* raw = (LAS float*)(lds + O_RAW);
    LAS float* yb = (LAS float*)(lds + O_YB);
    const f32x4 lnw = *(const f32x4*)(A.ln_w + h * 64 + c4), lnb = *(const f32x4*)(A.ln_b + h * 64 + c4);
    u32x2 vprev = (u32x2){0u, 0u}, gq = (u32x2){0u, 0u}; float bsq = 0.f;
#define RWC_POST(bprev) do { \
        const f32x4 y4 = *(const LAS f32x4*)(yb + st * 64 + c4); \
        float sm = (y4.x + y4.y) + (y4.z + y4.w); sm = red16(sm); const float mean = sm * (1.f / 64.f); \
        const float d0 = y4.x - mean, d1 = y4.y - mean, d2 = y4.z - mean, d3 = y4.w - mean; \
        float sv = (d0 * d0 + d1 * d1) + (d2 * d2 + d3 * d3); sv = red16(sv); const float rstd = 1.f / sqrtf(sv * (1.f / 64.f) + 64e-5f); \
        const float o0 = (d0 * rstd * lnw.x + lnb.x + bsq * lo_bf(vprev.x)) * lo_bf(gq.x), o1 = (d1 * rstd * lnw.y + lnb.y + bsq * hi_bf(vprev.x)) * hi_bf(gq.x); \
        const float o2 = (d2 * rstd * lnw.z + lnb.z + bsq * lo_bf(vprev.y)) * lo_bf(gq.y), o3 = (d3 * rstd * lnw.w + lnb.w + bsq * hi_bf(vprev.y)) * hi_bf(gq.y); \
        *(u32x2*)(A.mixed + ((size_t)b * SEQ + (bprev) * TB + st) * DM + 1536 + h * 64 + c4) = (u32x2){cvt_pk_bf16(o0, o1), cvt_pk_bf16(o2, o3)}; } while (0)
    for (int bt = 0; bt < NB; ++bt) {
        LAS unsigned char* vt = lds + O_VT + (bt & 1) * VT_BUF;
        { LAS float* d = raw + st * OPS + c4;
          st4(d + L_R, pre.r); st4(d + L_KP, pre.k); st4(d + L_KK, pre.kk, pre.rin); st4(d + L_BN, pre.b, pre.rin); *(LAS f32x4*)(d + L_W) = pre.w;
          LAS unsigned char* vd = vt + ((st >> 4) * 64 + c4) * VT_ROW + (st & 15) * 2;
          *(LAS u16*)(vd) = (u16)(pre.v.x & 0xffffu); *(LAS u16*)(vd + VT_ROW) = (u16)(pre.v.x >> 16); *(LAS u16*)(vd + 2 * VT_ROW) = (u16)(pre.v.y & 0xffffu); *(LAS u16*)(vd + 3 * VT_ROW) = (u16)(pre.v.y >> 16); }
        __syncthreads();
        if (bt > 0) RWC_POST(bt - 1);
        vprev = pre.v;
        { const size_t tk = (size_t)b * SEQ + bt * TB + st; gq = *(const u32x2*)(A.G + tk * 512 + h * 64 + c4); bsq = A.BS[tk * 8 + h]; }
        if (bt + 1 < NB) pre_load(pre, A, base + (size_t)((bt + 1) * TB + st) * 512 + c4);
        { const int c = wid >> 2, gg = wid & 3, j = lane;
          LAS unsigned char* img = lds + O_IMG + c * IMG_BYTES;
          const LAS float* rw = raw + (16 * c) * OPS + j;
          float G = 1.f;
#pragma unroll
          for (int tp = 0; tp < 12; ++tp) { const float wv = rw[tp * OPS + L_W]; G *= (tp < 4 * gg) ? wv : 1.f; }
          float bq[4], kq[4], xw[4], xa[4], xr[4];
#pragma unroll
          for (int e = 0; e < 4; ++e) { const LAS float* q = rw + (4 * gg + e) * OPS; xw[e] = q[L_W]; xa[e] = q[L_KK]; xr[e] = q[L_R]; bq[e] = q[L_BN]; kq[e] = q[L_KP]; }
#pragma unroll
          for (int e = 0; e < 4; ++e) {
              const int t = 4 * gg + e;
              const float Gm1 = G; G *= xw[e]; const float inv = 1.f / G;
              const float at = xa[e] * Gm1, rt = xr[e] * G; bq[e] *= inv; kq[e] *= inv;
              LAS unsigned char* o = img + t * RS + j * 2;
              *(LAS u16*)(o + I_A) = f2bf(at); *(LAS u16*)(o + I_R) = f2bf(rt); *(LAS u16*)(o + I_B) = f2bf(bq[e]); *(LAS u16*)(o + I_K) = f2bf(kq[e]);
          }
          *(LAS u32x4*)(img + I_BKT + j * SR + gg * 16) = (u32x4){cvt_pk_bf16(bq[0], bq[1]), cvt_pk_bf16(bq[2], bq[3]), cvt_pk_bf16(kq[0], kq[1]), cvt_pk_bf16(kq[2], kq[3])};
          if (gg == 3) *(LAS float*)(img + I_GC + j * 4) = G;
        }
        __syncthreads();
        { const int c = wid >> 2, tt = wid & 3;
          LAS unsigned char* img = lds + O_IMG + c * IMG_BYTES;
          const LAS unsigned char* ia = img + (tt < 2 ? I_A : I_R) + n16 * RS + g * 16;
          const LAS unsigned char* ib = img + ((tt & 1) ? I_K : I_B) + n16 * RS + g * 16;
          f32x4 p = (f32x4){0.f, 0.f, 0.f, 0.f};
          p = mfma16(*(const LAS u32x4*)ia, *(const LAS u32x4*)ib, p);
          p = mfma16(*(const LAS u32x4*)(ia + 64), *(const LAS u32x4*)(ib + 64), p);
          const int s = n16;
          if (tt == 0) {
              LAS float* lab = (LAS float*)(img + I_LAB);
#pragma unroll
              for (int r = 0; r < 4; ++r) { const int t = 4 * g + r; lab[t * 20 + s] = t > s ? p[r] : 0.f; }
              asm volatile("s_waitcnt lgkmcnt(0)" ::: "memory");
              float T[16];
#pragma unroll
              for (int t = 0; t < 16; ++t) {
                  float a4[4] = {(s == t) ? 1.f : 0.f, 0.f, 0.f, 0.f};
#pragma unroll
                  for (int q4 = 0; q4 * 4 < t; ++q4) {
                      const f32x4 l4 = *(const LAS f32x4*)(lab + t * 20 + 4 * q4);
#pragma unroll
                      for (int e = 0; e < 4; ++e) if (4 * q4 + e < t) a4[e] += l4[e] * T[4 * q4 + e];
                  }
                  T[t] = (a4[0] + a4[1]) + (a4[2] + a4[3]);
              }
#pragma unroll
              for (int t = 0; t < 16; ++t) *(LAS u16*)(img + I_TP + t * SR + (s >> 2) * 16 + (s & 3) * 2) = f2bf(T[t] - ((s == t) ? 1.f : 0.f));
          } else {
              const int ofs = (tt == 1 ? I_LAK : I_MM) + (s >> 2) * 16 + (tt == 3 ? 8 : 0) + (s & 3) * 2;
#pragma unroll
              for (int r = 0; r < 4; ++r) { const int t = 4 * g + r; const bool keep = tt == 1 ? (t > s) : (t >= s); *(LAS u16*)(img + ofs + t * SR) = f2bf(keep ? p[r] : 0.f); }
          }
        }
        __syncthreads();
        if (wid < 4) {
            const int i = 16 * wid + n16;
#pragma unroll 1
            for (int c = 0; c < 2; ++c) {
                const LAS unsigned char* img = lds + O_IMG + c * IMG_BYTES;
                const LAS unsigned char* ra = img + n16 * RS + g * 8;
                u32x4 aA[2], aR[2], aBK[4]; f32x4 gc[4];
#pragma unroll
                for (int ks = 0; ks < 2; ++ks) {
                    const u32x2 a0 = *(const LAS u32x2*)(ra + I_A + ks * 64), a1 = *(const LAS u32x2*)(ra + I_A + ks * 64 + 32);
                    const u32x2 r0 = *(const LAS u32x2*)(ra + I_R + ks * 64), r1 = *(const LAS u32x2*)(ra + I_R + ks * 64 + 32);
                    aA[ks] = (u32x4){a0.x, a0.y, a1.x, a1.y}; aR[ks] = (u32x4){r0.x, r0.y, r1.x, r1.y};
                }
                const u32x2 vv = *(const LAS u32x2*)(vt + (c * 64 + i) * VT_ROW + g * 8);
                const u32x2 al = *(const LAS u32x2*)(img + I_LAK + n16 * SR + g * 16);
                const u32x2 at = *(const LAS u32x2*)(img + I_TP + n16 * SR + g * 16);
                const u32x4 aM = *(const LAS u32x4*)(img + I_MM + n16 * SR + g * 16);
#pragma unroll
                for (int jt = 0; jt < 4; ++jt) { aBK[jt] = *(const LAS u32x4*)(img + I_BKT + (16 * jt + n16) * SR + g * 16); gc[jt] = *(const LAS f32x4*)(img + I_GC + (16 * jt + 4 * g) * 4); }
                f32x4 D1 = (f32x4){0.f, 0.f, 0.f, 0.f}, D2 = D1;
#pragma unroll
                for (int ks = 0; ks < 2; ++ks) { D1 = mfma16(aA[ks], Zq[ks], D1); D2 = mfma16(aR[ks], Zq[ks], D2); }
                D1 = mfma16((u32x4){al.x, al.y, 0u, 0u}, (u32x4){vv.x, vv.y, 0u, 0u}, D1);
                const f32x4 U = mfma16((u32x4){at.x, at.y, 0u, 0u}, (u32x4){cvt_pk_bf16(D1[0], D1[1]), cvt_pk_bf16(D1[2], D1[3]), 0u, 0u}, D1);
                const u32x4 buv = (u32x4){cvt_pk_bf16(U[0], U[1]), cvt_pk_bf16(U[2], U[3]), vv.x, vv.y};
                const f32x4 Y = mfma16(aM, buv, D2);
#pragma unroll
                for (int jt = 0; jt < 4; ++jt) { Z[jt] = mfma16(aBK[jt], buv, Z[jt]); Z[jt] = Z[jt] * gc[jt]; }
                Zq[0] = (u32x4){cvt_pk_bf16(Z[0][0], Z[0][1]), cvt_pk_bf16(Z[0][2], Z[0][3]), cvt_pk_bf16(Z[1][0], Z[1][1]), cvt_pk_bf16(Z[1][2], Z[1][3])};
                Zq[1] = (u32x4){cvt_pk_bf16(Z[2][0], Z[2][1]), cvt_pk_bf16(Z[2][2], Z[2][3]), cvt_pk_bf16(Z[3][0], Z[3][1]), cvt_pk_bf16(Z[3][2], Z[3][3])};
                LAS float* yo = yb + (16 * c + 4 * g) * 64 + i;
#pragma unroll
                for (int r = 0; r < 4; ++r) yo[r * 64] = Y[r];
            }
        }
    }
    __syncthreads();
    RWC_POST(NB - 1);
    __syncthreads();
#undef RWC_POST
}
}
namespace hg {
constexpr int C = 64, NCH = SEQ / C, HD = 128;
constexpr int RS128 = 272, RS64 = 144;
constexpr int O_QM = 0, O_KM = O_QM + C * RS128, O_QE = O_KM + C * RS128, O_KET = O_QE + C * RS128, O_VT = O_KET + HD * RS64,
              O_STT = O_VT + HD * RS64, O_P = O_STT + HD * RS128, O_TOT = O_P + C * RS64, O_DEC = O_TOT + 4 * HD * 4, O_END = O_DEC + HD * 4;
constexpr int OB_STRIDE = 132;
static_assert(C * OB_STRIDE * 4 <= 2 * C * RS128, "OBUF alias");
constexpr int LDS_BYTES = O_END;
struct Args { const bf16_t* p; const float* lb; const float* out_gain; bf16_t* mixed; };

__device__ __forceinline__ bf16x8 lda8(const LAS unsigned char* base, int row, int rs, int colB) { return *(const LAS bf16x8*)(base + row * rs + colB); }

__device__ __forceinline__ void item(const Args& A, LAS unsigned char* lds, int bh, const int wv__) {
    const int tid = TID(), lane = tid & 63, wid = __builtin_amdgcn_readfirstlane(tid >> 6), r32 = lane & 31, hi = lane >> 5;
    const int b = bh >> 2, h = bh & 3;
    const int ch = tid & 127, part = tid >> 7;
    const float lbc = A.lb[h * HD + ch], omlb = 1.f - lbc;
    const bf16_t* pbase = A.p + (size_t)b * SEQ * NP + h * HD;
    f32x16 sacc[2]; sacc[0] = f32x16{}; sacc[1] = f32x16{};
    const int kb = wid >> 1, vb0 = 2 * (wid & 1);
    for (int i = tid; i < HD * RS128 / 16; i += 512) *(LAS u32x4*)(lds + O_STT + i * 16) = (u32x4){0u, 0u, 0u, 0u};
    LAS float* tot = (LAS float*)(lds + O_TOT);
    LAS float* dec = (LAS float*)(lds + O_DEC);
    LAS float* obuf = (LAS float*)(lds + O_QM);
    bf16_t rq[16], rf[16], ri[16];
    { const bf16_t* pc0 = pbase + (size_t)(part * 16) * NP + ch;
#pragma unroll
      for (int i = 0; i < 16; ++i) { rf[i] = pc0[(size_t)i * NP + C_HF]; rq[i] = pc0[(size_t)i * NP + C_HQ]; ri[i] = pc0[(size_t)i * NP + C_HI]; } }
    for (int ck = 0; ck < NCH; ++ck) {
        const size_t tk_e = (size_t)b * SEQ + ck * C + (tid >> 3);
        const bf16_t* gp_e = A.p + tk_e * NP + C_HG + h * HD + (tid & 7) * 16;
        const u32x4 g0 = *(const u32x4*)gp_e, g1 = *(const u32x4*)(gp_e + 8);
        float lf[16], qv[16], kv[16];
        float run = 0.f;
#pragma unroll
        for (int i = 0; i < 16; ++i) {
            const float z = bf2f(rf[i]);
            const float sg = sigmoidf_(z);
            const float f = lbc + omlb * sg;
            kv[i] = 1.f - f;
            run += __logf(f); lf[i] = run;
            qv[i] = siluf_(bf2f(rq[i]));
        }
        tot[part * HD + ch] = run;
        { unsigned w[8];
#pragma unroll
          for (int i = 0; i < 8; ++i) w[i] = (unsigned)ri[2 * i] | ((unsigned)ri[2 * i + 1] << 16);
          LAS u32x4* d = (LAS u32x4*)(lds + O_VT + ch * RS64 + part * 32);
          d[0] = (u32x4){w[0], w[1], w[2], w[3]}; d[1] = (u32x4){w[4], w[5], w[6], w[7]}; }
        __syncthreads();
        if (ck + 1 < NCH) { const bf16_t* pcn = pbase + (size_t)((ck + 1) * C + part * 16) * NP + ch;
#pragma unroll
            for (int i = 0; i < 16; ++i) { rf[i] = pcn[(size_t)i * NP + C_HF]; rq[i] = pcn[(size_t)i * NP + C_HQ]; ri[i] = pcn[(size_t)i * NP + C_HI]; } }
        float off = 0.f;
#pragma unroll
        for (int pp = 0; pp < 4; ++pp) off += (pp < part) ? tot[pp * HD + ch] : 0.f;
        const float bref = tot[ch] + tot[HD + ch];
        const float blast = bref + tot[2 * HD + ch] + tot[3 * HD + ch];
        const float c_blast = __expf(blast), c_bref = __expf(bref), c_nbref = fast_rcp(c_bref);
        if (part == 0) dec[ch] = c_blast;
        {
            unsigned wk[8];
#pragma unroll
            for (int i = 0; i < 16; ++i) {
                const float bt = off + lf[i];
                const int t = part * 16 + i;
                const float e1 = __expf(fmaxf(bt, -80.f)), e2 = fast_rcp(e1);
                const float qe = qv[i] * e1, qm = qe * c_nbref, km = kv[i] * e2 * c_bref, ke = kv[i] * e2 * c_blast;
                *(LAS bf16_t*)(lds + O_QM + t * RS128 + ch * 2) = f2bf(qm);
                *(LAS bf16_t*)(lds + O_KM + t * RS128 + ch * 2) = f2bf(km);
                *(LAS bf16_t*)(lds + O_QE + t * RS128 + ch * 2) = f2bf(qe);
                if (i & 1) wk[i >> 1] |= ((unsigned)f2bf(ke)) << 16; else wk[i >> 1] = (unsigned)f2bf(ke);
            }
            LAS u32x4* d = (LAS u32x4*)(lds + O_KET + ch * RS64 + part * 32);
            d[0] = (u32x4){wk[0], wk[1], wk[2], wk[3]}; d[1] = (u32x4){wk[4], wk[5], wk[6], wk[7]};
        }
        __syncthreads();
        if (wid < 3) {
            const int ti = wid == 0 ? 0 : 1, si = wid == 2 ? 1 : 0;
            f32x16 sc = f32x16{};
#pragma unroll
            for (int ks = 0; ks < 8; ++ks) {
                const bf16x8 a = lda8(lds + O_QM, ti * 32 + r32, RS128, (ks * 16 + hi * 8) * 2);
                const bf16x8 bb = lda8(lds + O_KM, si * 32 + r32, RS128, (ks * 16 + hi * 8) * 2);
                sc = __builtin_amdgcn_mfma_f32_32x32x16_bf16(a, bb, sc, 0, 0, 0);
            }
#pragma unroll
            for (int r = 0; r < 16; ++r) { const int tl = (r & 3) + 8 * (r >> 2) + 4 * hi; const int tg = ti * 32 + tl, sg = si * 32 + r32;
                const float v = (sg <= tg) ? sc[r] : 0.f;
                *(LAS bf16_t*)(lds + O_P + tg * RS64 + sg * 2) = f2bf(v); }
        } else if (wid == 3) {
#pragma unroll
            for (int r = 0; r < 16; ++r) { const int tl = (r & 3) + 8 * (r >> 2) + 4 * hi; *(LAS bf16_t*)(lds + O_P + tl * RS64 + (32 + r32) * 2) = (bf16_t)0; }
        }
        __syncthreads();
        {
            const int ti = wid >> 2, vj = wid & 3;
            f32x16 oc = f32x16{};
#pragma unroll
            for (int ks = 0; ks < 8; ++ks) {
                const bf16x8 a = lda8(lds + O_QE, ti * 32 + r32, RS128, (ks * 16 + hi * 8) * 2);
                const bf16x8 bb = lda8(lds + O_STT, vj * 32 + r32, RS128, (ks * 16 + hi * 8) * 2);
                oc = __builtin_amdgcn_mfma_f32_32x32x16_bf16(a, bb, oc, 0, 0, 0);
            }
#pragma unroll
            for (int ss = 0; ss < 4; ++ss) {
                const bf16x8 a = lda8(lds + O_P, ti * 32 + r32, RS64, (ss * 16 + hi * 8) * 2);
                const bf16x8 bb = lda8(lds + O_VT, vj * 32 + r32, RS64, (ss * 16 + hi * 8) * 2);
                oc = __builtin_amdgcn_mfma_f32_32x32x16_bf16(a, bb, oc, 0, 0, 0);
            }
#pragma unroll
            for (int r = 0; r < 16; ++r) { const int tl = (r & 3) + 8 * (r >> 2) + 4 * hi; obuf[(ti * 32 + tl) * OB_STRIDE + vj * 32 + r32] = oc[r]; }
        }
#pragma unroll
        for (int j = 0; j < 2; ++j) {
#pragma unroll
            for (int r = 0; r < 16; ++r) { const int kl = (r & 3) + 8 * (r >> 2) + 4 * hi; sacc[j][r] *= dec[kb * 32 + kl]; }
#pragma unroll
            for (int ss = 0; ss < 4; ++ss) {
                const bf16x8 a = lda8(lds + O_KET, kb * 32 + r32, RS64, (ss * 16 + hi * 8) * 2);
                const bf16x8 bb = lda8(lds + O_VT, (vb0 + j) * 32 + r32, RS64, (ss * 16 + hi * 8) * 2);
                sacc[j] = __builtin_amdgcn_mfma_f32_32x32x16_bf16(a, bb, sacc[j], 0, 0, 0);
            }
        }
        __syncthreads();
#pragma unroll
        for (int j = 0; j < 2; ++j)
#pragma unroll
            for (int g = 0; g < 4; ++g) {
                u32x2 w; w.x = cvt_pk_bf16(sacc[j][4 * g], sacc[j][4 * g + 1]); w.y = cvt_pk_bf16(sacc[j][4 * g + 2], sacc[j][4 * g + 3]);
                *(LAS u32x2*)(lds + O_STT + ((vb0 + j) * 32 + r32) * RS128 + (kb * 32 + 8 * g + 4 * hi) * 2) = w;
            }
        {
            const int t = tid >> 3, c0 = (tid & 7) * 16;
            const LAS float* orow = obuf + t * OB_STRIDE + c0;
            float o[16]; float ss = 0.f;
#pragma unroll
            for (int i = 0; i < 4; ++i) { const f32x4 x = *(const LAS f32x4*)(orow + 4 * i); o[4 * i] = x.x; o[4 * i + 1] = x.y; o[4 * i + 2] = x.z; o[4 * i + 3] = x.w; ss += x.x * x.x + x.y * x.y + x.z * x.z + x.w * x.w; }
            ss = sum8f(ss);
            const float rn = 1.f / sqrtf(ss * (1.f / 128.f) + RMS_EPS);
            const size_t tk = tk_e;
            const float gr[16] = {lo_bf(g0.x), hi_bf(g0.x), lo_bf(g0.y), hi_bf(g0.y), lo_bf(g0.z), hi_bf(g0.z), lo_bf(g0.w), hi_bf(g0.w),
                                  lo_bf(g1.x), hi_bf(g1.x), lo_bf(g1.y), hi_bf(g1.y), lo_bf(g1.z), hi_bf(g1.z), lo_bf(g1.w), hi_bf(g1.w)};
            float ov[16];
#pragma unroll
            for (int i = 0; i < 16; ++i) ov[i] = o[i] * rn * A.out_gain[c0 + i] * siluf_(gr[i]);
            u32x4 w0, w1;
            w0.x = cvt_pk_bf16(ov[0], ov[1]); w0.y = cvt_pk_bf16(ov[2], ov[3]); w0.z = cvt_pk_bf16(ov[4], ov[5]); w0.w = cvt_pk_bf16(ov[6], ov[7]);
            w1.x = cvt_pk_bf16(ov[8], ov[9]); w1.y = cvt_pk_bf16(ov[10], ov[11]); w1.z = cvt_pk_bf16(ov[12], ov[13]); w1.w = cvt_pk_bf16(ov[14], ov[15]);
            bf16_t* mp = A.mixed + tk * DM + h * HD + c0;
            *(u32x4*)mp = w0; *(u32x4*)(mp + 8) = w1;
        }
        __syncthreads();
    }
}
}
#define RLX_AGENT __ATOMIC_RELAXED, __HIP_MEMORY_SCOPE_AGENT
#define XB_TMO      128
#define XB_XCNT(j)  (256  + 64 * (j))
#define XB_XSUB(j)  (1280 + 64 * (j))
#define XB_XGEN(j)  (2304 + 64 * (j))
#define XB_TOP      3328
#define XB_TOPGEN   3392
#define XCD_BAR_WORDS 3456
#define XB_SPIN_CAP (1u << 18)

__device__ __forceinline__ unsigned xb_ld(unsigned* p)              { return __hip_atomic_load(p, __ATOMIC_RELAXED, __HIP_MEMORY_SCOPE_AGENT); }
__device__ __forceinline__ unsigned xb_add(unsigned* p, unsigned v) { return __hip_atomic_fetch_add(p, v, __ATOMIC_RELAXED, __HIP_MEMORY_SCOPE_AGENT); }
__device__ __forceinline__ unsigned xb_xcc_id() { return (unsigned)__builtin_amdgcn_s_getreg((3 << 11) | 20) & 0xFu; }
#define XB_SPIN(cond, bar) do { unsigned _sp = 0; while (cond) { __builtin_amdgcn_s_sleep(1); \
    if ((++_sp & 255u) == 0u) { if (xb_ld(&(bar)[XB_TMO])) break; if (_sp > XB_SPIN_CAP) { atomicAdd(&(bar)[XB_TMO], 1u); break; } } } } while (0)

struct XcdBarrier {
    unsigned* bar; unsigned x;
    volatile LAS unsigned* st;
};

__device__ __forceinline__ XcdBarrier xcd_barrier_post(unsigned* bar, volatile LAS unsigned* st, const int wv__) {
    XcdBarrier b; b.bar = bar; b.x = xb_xcc_id(); b.st = st;
    if (TID() == 0) (void)xb_add(&bar[XB_XCNT(b.x)], 1u);
    return b;
}
__device__ __forceinline__ void xcd_barrier_complete(unsigned* bar, unsigned x, unsigned& nloc, unsigned& nx) {
    const unsigned G = gridDim.x * gridDim.y * gridDim.z;
    unsigned sum, cnt, mine, sp = 0u;
    for (;;) {
        sum = 0u; cnt = 0u; mine = 0u;
#pragma unroll
        for (unsigned j = 0; j < 16; ++j) { const unsigned c = xb_ld(&bar[XB_XCNT(j)]); sum += c; cnt += (c > 0u) ? 1u : 0u; mine = (j == x) ? c : mine; }
        if (sum == G) break;
        __builtin_amdgcn_s_sleep(1);
        if ((++sp & 255u) == 0u) { if (xb_ld(&bar[XB_TMO])) break; if (sp > XB_SPIN_CAP) { atomicAdd(&bar[XB_TMO], 1u); break; } }
    }
    nloc = mine > 0u ? mine : 1u; nx = cnt > 0u ? cnt : 1u;
}

__device__ __forceinline__ void xcd_barrier(const XcdBarrier& b, const int wv__) {
    asm volatile("s_waitcnt vmcnt(0)" ::: "memory");
    __syncthreads();
    if (TID() == 0) {
        unsigned* bar = b.bar;
        __builtin_amdgcn_s_waitcnt(0);
        unsigned nloc = b.st[0], nx = b.st[1];
        if (nloc == 0u) { xcd_barrier_complete(bar, b.x, nloc, nx); b.st[0] = nloc; b.st[1] = nx; }
        const unsigned old = xb_add(&bar[XB_XSUB(b.x)], 1u);
        const unsigned gen = old / nloc;
        if (old + 1u == (gen + 1u) * nloc) {
            __builtin_amdgcn_fence(__ATOMIC_RELEASE, "agent");
            asm volatile("s_waitcnt vmcnt(0)" ::: "memory");
            const unsigned og = xb_add(&bar[XB_TOP], 1u);
            const unsigned tg = og / nx;
            if (og + 1u == (tg + 1u) * nx) xb_add(&bar[XB_TOPGEN], 1u);
            else XB_SPIN(xb_ld(&bar[XB_TOPGEN]) == tg, bar);
            __builtin_amdgcn_fence(__ATOMIC_ACQUIRE, "agent");
            xb_add(&bar[XB_XGEN(b.x)], 1u);
            asm volatile("s_waitcnt vmcnt(0)" ::: "memory");
        } else {
            XB_SPIN(xb_ld(&bar[XB_XGEN(b.x)]) == gen, bar);
            __builtin_amdgcn_fence(__ATOMIC_ACQUIRE, "agent");
            asm volatile("s_waitcnt vmcnt(0)" ::: "memory");
        }
    }
    __syncthreads();
}

constexpr int NTHREADS = 512, NWAVES = 8;
constexpr int LDS_ALL = 153600;
static_assert(LDS_ALL >= hg::LDS_BYTES && LDS_ALL >= tok::LDS_BYTES && LDS_ALL >= rwk::LDS_BYTES && LDS_ALL >= rwc::LDS_BYTES && LDS_ALL >= att::LDS_BYTES && LDS_ALL >= pg8::STAGE_BYTES, "LDS");
constexpr int CW_BAR = 4096;
constexpr int PH_PER_LAYER = 7, N_PHASES = 1 + DEPTH * PH_PER_LAYER;

struct KArgs { Ptrs P; int ph_lo, ph_hi, coop, pad; };

#ifdef DUP_TOKMODE
#define TOKMODE (rep ? DUP_TOKMODE : 7)
#else
#define TOKMODE 7
#endif
template <int ph>
__device__ __forceinline__ void run_phase(LAS unsigned char* lds, unsigned char* lds_raw, cg::grid_group& grid, const int G, const int bid, const int wv__) {
        const KArgs __attribute__((address_space(4)))* ka = (const KArgs __attribute__((address_space(4)))*)__builtin_amdgcn_kernarg_segment_ptr();
        asm volatile("" : "+s"(ka));
#define PIN(i) (ka->P.in[i])
        const int tid = TID(), lane = tid & 63, wid = __builtin_amdgcn_readfirstlane(tid >> 6);
        const int gw = bid * NWAVES + wid, ngw = G * NWAVES;
        unsigned char* ws = ka->P.ws;
        float* x = ka->P.out;
        bf16_t* xb = (bf16_t*)(ws + WS_XB); bf16_t* pbuf = (bf16_t*)(ws + WS_P); bf16_t* mixed = (bf16_t*)(ws + WS_MIX);
        bf16_t* qbuf = (bf16_t*)(ws + WS_Q); bf16_t* kvbuf = (bf16_t*)(ws + WS_KV); bf16_t* krbuf = (bf16_t*)(ws + WS_KR);
        bf16_t* act = (bf16_t*)(ws + WS_ACT);
        float* ssA = (float*)(ws + WS_SSA); float* ssB = (float*)(ws + WS_SSBP); float* rsb = (float*)(ws + WS_RS); float* rsq = (float*)(ws + WS_RSQ); float* rskv = (float*)(ws + WS_RSKV);
        const int* pos = (const int*)PIN(1);
        if constexpr (ph == 0) {
            prologue_phase(&ka->P, (LAS float*)lds + wid * (64 * 65), gw, ngw, lane);
#ifdef DUP_PRO
            __syncthreads(); prologue_phase(&ka->P, (LAS float*)lds + wid * (64 * 65), gw, ngw, lane);
#endif
        } else {
            constexpr int l = (ph - 1) / PH_PER_LAYER, sp = (ph - 1) % PH_PER_LAYER;
            unsigned char* wl = ws + WS_W + (size_t)l * W_LAYER;
#ifdef DUP_SP
            const int nrep = (sp == DUP_SP) ? 2 : 1;
#else
            const int nrep = 1;
#endif
            for (int rep = 0; rep < nrep; ++rep) {
            if (rep) { XcdBarrier xb; xb.bar = (unsigned*)(ws + WS_CTL) + CW_BAR; xb.x = xb_xcc_id(); xb.st = (volatile LAS unsigned*)(lds + LDS_ALL - 128); xcd_barrier(xb, wv__); }
            switch (sp) {
            case 0: {
                pg8::Gemm g{xb, (const bf16_t*)(wl + WO_IN), T, NP, DM, DM}; pg8::StaticOrder S; S.init(T, NP, G, bid, GW_IN);
                pg8::prep_row_scales(ssA, rsb, S, tid);
                pg8::EpiScaleBf16 E{pbuf, rsb, NP, 0};
                pg8::gemm_phase<pg8::EpiScaleBf16, pg8::StaticOrder, true, true>(lds, g, S, E, wv__);
            } break;
            case 1: {
                tok::Args A;
                A.p = pbuf; A.pos = pos; A.k_gain = PIN(11) + l * 192;
                A.mu = PIN(12) + l * 1792; A.w0 = PIN(13) + l * 512; A.a0 = PIN(15) + l * 512;
                constexpr int lm = l > 0 ? l - 1 : 0;
                A.v0 = PIN(18) + lm * 512;
                A.k_k = PIN(21) + l * 512; A.k_a = PIN(22) + l * 512; A.r_k = PIN(23) + l * 512;
                A.wl = (const bf16_t*)(wl + WO_LORA);
                A.rs_q = rsq; A.rs_kv = rskv; A.kr = krbuf;
                A.R = (bf16_t*)(ws + WS_RWR); A.K = (bf16_t*)(ws + WS_RWK); A.V = (bf16_t*)(ws + WS_RWV); A.KK = (bf16_t*)(ws + WS_RWKK); A.B = (bf16_t*)(ws + WS_RWB);
                A.G = (bf16_t*)((unsigned char*)x + 64 * MiB); A.BON = (bf16_t*)((unsigned char*)x + 96 * MiB); A.VFIRST = (bf16_t*)(ws + WS_VFIRST); A.W = (float*)((unsigned char*)x); A.RIN = (float*)(ws + WS_RIN); A.BS = (float*)(ws + WS_BS);
#ifdef TOKPROBE
                if (rep) { unsigned char* dq = ws + WS_Q; A.R = (bf16_t*)dq; A.K = (bf16_t*)(dq + 32 * MiB); A.V = (bf16_t*)(dq + 64 * MiB); A.KK = (bf16_t*)(dq + 96 * MiB); A.B = (bf16_t*)(dq + 128 * MiB);
                    A.G = (bf16_t*)(dq + 160 * MiB); A.VFIRST = l == 0 ? (bf16_t*)(dq + 192 * MiB) : A.VFIRST; A.W = (float*)(ws + WS_MIX); A.RIN = (float*)(ws + WS_MIX + 64 * MiB); A.BS = (float*)(ws + WS_MIX + 65 * MiB); }
#endif
                tok::stage_params(A, lds, tid);
                for (int tl = bid; tl < tok::NTILES; tl += G) tok::tile<l>(A, lds, tl, wv__, TOKMODE);
            } break;
            case 2: {
                { pg8::Gemm g{pbuf + C_MQ, (const bf16_t*)(wl + WO_QB), T, QW, 512, NP}; pg8::StaticOrder S; S.init(T, QW, G, bid);
                  pg8::EpiPlainBf16 E{qbuf, QW, 0};
                  pg8::gemm_phase<pg8::EpiPlainBf16, pg8::StaticOrder, true, true>(lds, g, S, E, wv__); }
                { pg8::Gemm g{pbuf + C_MKV, (const bf16_t*)(wl + WO_KVB), T, KVW, 256, NP}; pg8::StaticOrder S; S.init(T, KVW, G, bid);
                  pg8::EpiKV E{kvbuf, rskv, PIN(11) + l * 192, (LAS float*)(lds + pg8::STAGE_BYTES), KVW, 0};
                  pg8::gemm_phase<pg8::EpiKV, pg8::StaticOrder, true, true>(lds, g, S, E, wv__); }
            } break;
            case 3: {
                unsigned* ctr = (unsigned*)(ws + WS_CTL) + 64 * l + 16 * rep;
                LAS int* qslot = (LAS int*)(lds + LDS_ALL - 64);
                constexpr int NQ = 96 + att::N_BLOCKS;
#ifdef DUP_MIX
                const int qlo = rep ? (DUP_MIX == 1 ? 0 : DUP_MIX == 2 ? 64 : 96) : 0, qhi = rep ? (DUP_MIX == 1 ? 64 : DUP_MIX == 2 ? 96 : NQ) : NQ;
#else
                const int qlo = 0, qhi = NQ;
#endif
#ifdef CONV_IN_MIXERS
                if constexpr (l + 1 < DEPTH) {
                    if (!rep && bid % CONV_EVERY == 0) {
                        for (;;) {
                            __syncthreads();
                            if (tid == 0) *qslot = (int)__hip_atomic_fetch_add(ctr + 8, 1u, __ATOMIC_RELAXED, __HIP_MEMORY_SCOPE_AGENT);
                            __syncthreads();
                            const int ci = __builtin_amdgcn_readfirstlane(*qslot);
                            if (ci >= CV_ITEMS) break;
                            convert_queue_item(&ka->P, l + 1, ci, (LAS float*)lds + wid * (64 * 65), wid, lane);
                        }
                    }
                }
#endif
                for (;;) {
                    __syncthreads();
                    if (tid == 0) *qslot = (int)__hip_atomic_fetch_add(ctr, 1u, __ATOMIC_RELAXED, __HIP_MEMORY_SCOPE_AGENT);
                    __syncthreads();
                    const int it = qlo + __builtin_amdgcn_readfirstlane(*qslot);
                    if (it >= qhi) break;
                    if (it < 64) {
                        rwc::Args RA; RA.R = (const bf16_t*)(ws + WS_RWR); RA.K = (const bf16_t*)(ws + WS_RWK); RA.V = (const bf16_t*)(ws + WS_RWV); RA.KK = (const bf16_t*)(ws + WS_RWKK);
                        RA.B = (const bf16_t*)(ws + WS_RWB); RA.W = (const float*)((unsigned char*)x); RA.RIN = (const float*)(ws + WS_RIN);
                        RA.G = (const bf16_t*)((unsigned char*)x + 64 * MiB); RA.BS = (const float*)(ws + WS_BS); RA.ln_w = PIN(24) + l * 512; RA.ln_b = PIN(25) + l * 512;
                        RA.mixed = rep ? (bf16_t*)((unsigned char*)x + 128 * MiB) : mixed;
                        rwc::item(RA, lds, it, wv__);
                    } else if (it < 96) {
                        hg::Args HA; HA.p = pbuf; HA.lb = (const float*)(ws + WS_LB) + l * 512; HA.out_gain = PIN(5) + l * 128; HA.mixed = mixed;
                        hg::item(HA, lds, it - 64, wv__);
                    }
                    else att::attn_one((char*)lds_raw, qbuf, kvbuf, krbuf, mixed, it - 96, pos, PIN(10) + l * 192, wv__);
                }
            } break;
            case 4: {
                pg8::Gemm g{mixed, (const bf16_t*)(wl + WO_O), T, DM, DM, DM}; pg8::StaticOrder S; S.init(T, DM, G, bid, GW_WO);
                pg8::EpiResidB E{l == 0 ? PIN(0) : (const float*)nullptr, (float*)nullptr, xb, ssB, DM, 0};
                pg8::gemm_phase<pg8::EpiResidB, pg8::StaticOrder, true, true>(lds, g, S, E, wv__);
            } break;
            case 5: {
                pg8::Gemm g{xb, (const bf16_t*)(wl + WO_GU), T, 2 * FF, DM, DM}; pg8::StaticOrder S; S.init(T, 2 * FF, G, bid, GW_GU);
                pg8::prep_row_scales(ssB, rsb, S, tid);
                pg8::EpiSwiGLU E{act, rsb, FF, 0};
                pg8::gemm_phase<pg8::EpiSwiGLU, pg8::StaticOrder, true, true>(lds, g, S, E, wv__);
            } break;
            case 6: {
                pg8::Gemm g{act, (const bf16_t*)(wl + WO_DN), T, DM, FF, FF}; pg8::StaticOrder S; S.init(T, DM, G, bid, GW_DN);
                pg8::EpiResidB E{(const float*)nullptr, l == DEPTH - 1 ? x : (float*)nullptr, xb, ssA, DM, 0};
                pg8::gemm_phase<pg8::EpiResidB, pg8::StaticOrder, true, true>(lds, g, S, E, wv__);
            } break;
            }
            }
        }
}
template <int PH0, int PH1>
__device__ __forceinline__ void run_phases(LAS unsigned char* lds, unsigned char* lds_raw, cg::grid_group& grid, const int G, const int bid, const int wv__) {
    if constexpr (PH0 < PH1) {
        run_phase<PH0>(lds, lds_raw, grid, G, bid, wv__);
        if constexpr (PH0 + 1 < PH1) {
            const KArgs __attribute__((address_space(4)))* ka = (const KArgs __attribute__((address_space(4)))*)__builtin_amdgcn_kernarg_segment_ptr();
            XcdBarrier xb; xb.bar = (unsigned*)(ka->P.ws + WS_CTL) + CW_BAR; xb.x = xb_xcc_id(); xb.st = (volatile LAS unsigned*)(lds + LDS_ALL - 128);
            xcd_barrier(xb, wv__);
        }
        run_phases<PH0 + 1, PH1>(lds, lds_raw, grid, G, bid, wv__);
    }
}
__global__ void __launch_bounds__(NTHREADS, 2) mega(KArgs args) {
    extern __shared__ __attribute__((aligned(16))) unsigned char lds_raw[];
    LAS unsigned char* lds = (LAS unsigned char*)lds_raw;
    const int G = gridDim.x, bid = blockIdx.x;
    const int wv__ = __builtin_amdgcn_readfirstlane((int)threadIdx.x >> 6);
    cg::grid_group grid = cg::this_grid();
    {
        volatile LAS unsigned* st = (volatile LAS unsigned*)(lds + LDS_ALL - 128);
        if (threadIdx.x < 2) st[threadIdx.x] = 0u;
        __syncthreads();
        (void)xcd_barrier_post((unsigned*)(args.P.ws + WS_CTL) + CW_BAR, st, wv__);
        grid.sync();
    }
#ifdef DUP_SYNC
    for (int i = 0; i < DUP_SYNC; ++i) { XcdBarrier xb; xb.bar = (unsigned*)(args.P.ws + WS_CTL) + CW_BAR; xb.x = xb_xcc_id(); xb.st = (volatile LAS unsigned*)(lds + LDS_ALL - 128); xcd_barrier(xb, wv__); }
#endif
    run_phases<0, N_PHASES>(lds, lds_raw, grid, G, bid, wv__);
}

extern "C" void kernel_launch(void* const* d_in, const int* in_sizes, int n_in, void* d_out, int out_size, void* d_ws, size_t ws_size, hipStream_t stream) {
    static int grid = 0;
    if (grid == 0) {
        int dev = 0, cus = 0, per_cu = 0;
        hipGetDevice(&dev);
        hipDeviceGetAttribute(&cus, hipDeviceAttributeMultiprocessorCount, dev);
        hipFuncSetAttribute((const void*)mega, hipFuncAttributeMaxDynamicSharedMemorySize, LDS_ALL);
        hipOccupancyMaxActiveBlocksPerMultiprocessor(&per_cu, (const void*)mega, NTHREADS, LDS_ALL);
        if (per_cu < 1) { fprintf(stderr, "kernel_launch: occupancy query says %d blocks/CU\n", per_cu); per_cu = 1; }
        grid = cus * 1;
        if (ws_size < WS_END) fprintf(stderr, "kernel_launch: workspace too small: %zu < %zu\n", ws_size, (size_t)WS_END);
        (void)hipGetLastError();
    }
    hipMemsetAsync((char*)d_ws + WS_CTL, 0, CTL_BYTES, stream);
    KArgs a{};
    for (int i = 0; i < 30; ++i) a.P.in[i] = (const float*)d_in[i];
    a.P.out = (float*)d_out; a.P.ws = (unsigned char*)d_ws;
#if MK_COOP
    a.ph_lo = 0; a.ph_hi = N_PHASES; a.coop = 1;
    void* kargs[] = {&a};
    hipError_t e = hipLaunchCooperativeKernel((const void*)mega, dim3(grid), dim3(NTHREADS), kargs, LDS_ALL, stream);
    if (e != hipSuccess) fprintf(stderr, "cooperative launch failed: %s (grid %d)\n", hipGetErrorString(e), grid);
#else
    for (int ph = 0; ph < N_PHASES; ++ph) {
        a.ph_lo = ph; a.ph_hi = ph + 1; a.coop = 0;
        hipLaunchKernelGGL(mega, dim3(grid), dim3(NTHREADS), LDS_ALL, stream, a);
    }
#endif
}
```

```cpp
#include <hip/hip_runtime.h>
#include <hip/hip_bf16.h>
#include <hip/hip_cooperative_groups.h>
#include <cstdio>
#include <cstdint>
namespace cg = cooperative_groups;

constexpr int BATCH = 8, SEQ = 4096, DM = 2048, DEPTH = 4;
constexpr int T = BATCH * SEQ;
constexpr int NP = 4864;
constexpr int INW = 4672;
constexpr int FF = 5632;
constexpr int C_HQ = 0, C_HF = 512, C_HI = 1024, C_HG = 1536, C_MQ = 2048, C_MKV = 2560, C_MKR = 2816, C_RW = 2880;
constexpr int C_RR = C_RW, C_RK = C_RW + 512, C_RV = C_RW + 1024, C_RWD = C_RW + 1536, C_RAD = C_RW + 1600, C_RGD = C_RW + 1664;
constexpr int QW = 1536, KVW = 2048;
constexpr float RMS_EPS = 1e-6f;

typedef unsigned short bf16_t;
typedef short bf16x8 __attribute__((ext_vector_type(8)));
typedef short s16x4 __attribute__((ext_vector_type(4)));
typedef float f32x2 __attribute__((ext_vector_type(2)));
typedef float f32x4 __attribute__((ext_vector_type(4)));
typedef float f32x16 __attribute__((ext_vector_type(16)));
typedef unsigned u32x2 __attribute__((ext_vector_type(2)));
typedef unsigned u32x4 __attribute__((ext_vector_type(4)));
#define LAS __attribute__((address_space(3)))

constexpr size_t MiB = 1u << 20;
constexpr size_t WS_CTL = 0;
constexpr size_t CTL_BYTES = 65536;
constexpr size_t WS_RS = 1 * MiB;
constexpr size_t WS_SSB = WS_RS + 128 * 1024;
constexpr size_t WS_RSQ = WS_SSB;
constexpr size_t WS_RSKV = WS_RSQ + 128 * 1024;
constexpr size_t WS_LB = WS_RSKV + 128 * 1024;
constexpr size_t WS_RIN = 2 * MiB;
constexpr size_t WS_BS = 3 * MiB;
constexpr size_t WS_W = 4 * MiB;
constexpr size_t W_LAYER = 96 * MiB;
constexpr size_t WO_IN = 0;
constexpr size_t WO_QB = WO_IN + (size_t)NP * DM * 2;
constexpr size_t WO_KVB = WO_QB + (size_t)QW * 512 * 2;
constexpr size_t WO_O = WO_KVB + (size_t)KVW * 256 * 2;
constexpr size_t WO_GU = WO_O + (size_t)DM * DM * 2;
constexpr size_t WO_DN = WO_GU + (size_t)2 * FF * DM * 2;
constexpr size_t WO_LORA = WO_DN + (size_t)DM * FF * 2;
static_assert(WO_LORA + 163840 * 2 <= W_LAYER, "weight layer stride");
constexpr size_t WS_XB = WS_W + DEPTH * W_LAYER;
constexpr size_t WS_P = WS_XB + 128 * MiB;
constexpr size_t WS_MIX = WS_P + 304 * MiB;
constexpr size_t WS_D = WS_MIX + 128 * MiB;
constexpr size_t WS_Q = WS_D;
constexpr size_t WS_KV = WS_Q + 96 * MiB;
constexpr size_t WS_KR = WS_KV + 128 * MiB;
constexpr size_t WS_RWR = WS_KR + 4 * MiB;
constexpr size_t WS_RWK = WS_RWR + 32 * MiB;
constexpr size_t WS_RWV = WS_RWK + 32 * MiB;
constexpr size_t WS_RWKK = WS_RWV + 32 * MiB;
constexpr size_t WS_RWB = WS_RWKK + 32 * MiB;
constexpr size_t WS_VFIRST = WS_RWB + 32 * MiB;
constexpr size_t WS_SSA = WS_VFIRST + 32 * MiB;
constexpr size_t WS_SSBP = WS_SSA + 4 * MiB;
constexpr size_t WS_END = WS_SSBP + 4 * MiB;
constexpr size_t WS_ACT = WS_D;
static_assert(WS_ACT + (size_t)T * FF * 2 <= WS_VFIRST, "act overlay must not reach v_first");
constexpr size_t WS_RWW = WS_XB;
constexpr size_t WS_RWG = WS_XB + 64 * MiB;
constexpr size_t WS_RWBON = WS_XB + 96 * MiB;

__device__ __forceinline__ int tid_from(int wv) { unsigned z = 0u; asm volatile("" : "+v"(z)); return (wv << 6) | (int)__builtin_amdgcn_mbcnt_hi(~0u, __builtin_amdgcn_mbcnt_lo(~0u, z)); }
#define TID() tid_from(wv__)
__device__ __forceinline__ float bf2f(bf16_t v) { return __uint_as_float(((unsigned)v) << 16); }
typedef __bf16 bf16x2_t __attribute__((ext_vector_type(2)));
__device__ __forceinline__ unsigned cvt_pk_bf16(float lo, float hi) { f32x2 v = {lo, hi}; bf16x2_t b = __builtin_convertvector(v, bf16x2_t); return __builtin_bit_cast(unsigned, b); }
__device__ __forceinline__ bf16_t f2bf(float f) { return (bf16_t)(cvt_pk_bf16(f, 0.f) & 0xffffu); }
__device__ __forceinline__ float lo_bf(unsigned w) { return __uint_as_float(w << 16); }
__device__ __forceinline__ float hi_bf(unsigned w) { return __uint_as_float(w & 0xffff0000u); }
__device__ __forceinline__ float fast_exp(float x) { return __builtin_amdgcn_exp2f(x * 1.4426950408889634f); }
__device__ __forceinline__ float fast_rcp(float x) { return __builtin_amdgcn_rcpf(x); }
__device__ __forceinline__ float sigmoidf_(float x) { return fast_rcp(1.f + fast_exp(-x)); }
__device__ __forceinline__ float siluf_(float x) { return x * sigmoidf_(x); }
#define DPPF(x, CTRL) __int_as_float(__builtin_amdgcn_update_dpp(0, __float_as_int(x), CTRL, 0xf, 0xf, true))
__device__ __forceinline__ float wave_sum(float v) {
    v += DPPF(v, 0xB1);
    v += DPPF(v, 0x4E);
    v += DPPF(v, 0x141);
    v += DPPF(v, 0x140);
    const float r0 = __int_as_float(__builtin_amdgcn_readlane(__float_as_int(v), 0)), r1 = __int_as_float(__builtin_amdgcn_readlane(__float_as_int(v), 16));
    const float r2 = __int_as_float(__builtin_amdgcn_readlane(__float_as_int(v), 32)), r3 = __int_as_float(__builtin_amdgcn_readlane(__float_as_int(v), 48));
    return (r0 + r1) + (r2 + r3);
}
__device__ __forceinline__ float xor32f(float x, int lane) { auto rr = __builtin_amdgcn_permlane32_swap(__float_as_uint(x), __float_as_uint(x), false, false); return __uint_as_float(lane < 32 ? rr[1] : rr[0]); }
__device__ __forceinline__ float sum8f(float x) { x += DPPF(x, 0xB1); x += DPPF(x, 0x4E); x += DPPF(x, 0x141); return x; }
#define MK_COOP 1
#define CONV_IN_MIXERS 1
#define CONV_EVERY 5
#define GW_DN 4
#define GW_WO 4
#define GW_GU 4
#define GW_IN 8
namespace pg8 {
#define PG8_LAS __attribute__((address_space(3)))
typedef unsigned short bf16_t;
typedef short bf16x8 __attribute__((ext_vector_type(8)));
typedef float f32x4 __attribute__((ext_vector_type(4)));
typedef unsigned u32x4 __attribute__((ext_vector_type(4)));
constexpr int BM = 256, BK = 64, HALF = 128, HTB = HALF * BK * 2  , STAGE_BYTES = 8 * HTB, NXCD = 8, WGM = 8;

__host__ __device__ __forceinline__ int lds_byte(int r, int c) { const int st = (r >> 4) * 2 + (c >> 5), rr = r & 15, cc = c & 31, ob = rr * 64 + cc * 2; return st * 1024 + (ob ^ (((ob >> 9) & 1) << 5)); }
__host__ __device__ __forceinline__ void stage_rc(int b, int& R, int& C) { const int st = b / 1024, sb = b % 1024, swz = sb ^ (((sb >> 9) & 1) << 5); R = (st >> 1) * 16 + swz / 64; C = (st & 1) * 32 + (swz % 64) / 2; }
__host__ __device__ __forceinline__ int perm32(int rho) { const int n = rho >> 4, i = rho & 15; return 8 * (i >> 2) + 4 * n + (i & 3); }

struct Unit { int pm, pn; };
struct Gemm { const bf16_t* A; const bf16_t* Bt; int M, N, K, lda; };

struct StaticOrder {
    int nM, nN, nwg, G, c, wgm;
    __host__ __device__ void init(int M, int N, int G_, int c_, int wgm_ = WGM) { nM = M / BM; nN = N / BM; nwg = nM * nN; G = G_; c = c_; wgm = wgm_; }
    __host__ __device__ bool next(int i, Unit& u) const {
        const long L = (long)i * G + c; if (L >= nwg) return false;
        int wgid = (int)L; { const int q = nwg / NXCD, r = nwg % NXCD, xcd = wgid % NXCD, off = wgid / NXCD; wgid = (xcd < r ? xcd * (q + 1) : r * (q + 1) + (xcd - r) * q) + off; }
        const int nig = wgm * nN, gid = wgid / nig, fm = gid * wgm, gsz = (nM - fm) < wgm ? (nM - fm) : wgm;
        u.pm = fm + ((wgid % nig) % gsz); u.pn = (wgid % nig) / gsz; return true;
    }
    __device__ __forceinline__ void a_ready(const Unit&) const {}
    __device__ __forceinline__ void done(const Unit&) const {}
};

using ::cvt_pk_bf16;
typedef float f32x2 __attribute__((ext_vector_type(2)));

__device__ __forceinline__ float row_scale32(const float* part, int row) {
    const f32x4* p = (const f32x4*)(part + (size_t)row * 32);
    f32x4 a = p[0] + p[1], b = p[2] + p[3], c = p[4] + p[5], d = p[6] + p[7];
    a = (a + b) + (c + d);
    return 1.f / sqrtf(((a[0] + a[1]) + (a[2] + a[3])) * (1.f / 2048.f) + 1e-6f);
}
struct EpiScaleBf16 {
    static constexpr bool PERM = true, AFTER_DRAIN = false;
    bf16_t* O; const float* rs; int ldc; int ssq;
    __device__ __forceinline__ void operator()(const f32x4 (&acc)[2][2][4][2], const Unit& u, int wr, int wc, int fr_, int fq_) const {
        unsigned z_ = 0u; asm volatile("" : "+v"(z_)); const int ln_ = (int)__builtin_amdgcn_mbcnt_hi(~0u, __builtin_amdgcn_mbcnt_lo(~0u, z_)); const int fr = ln_ & 15, fq = ln_ >> 4; (void)fr_; (void)fq_;
        const int row0 = u.pm * BM + wr * 64 + fr, col0 = u.pn * BM + wc * 32 + 8 * fq;
        float scv[2][4];
#pragma unroll
        for (int ai = 0; ai < 2; ++ai)
#pragma unroll
            for (int m = 0; m < 4; ++m) scv[ai][m] = rs ? rs[row0 + ai * HALF + m * 16] : 1.f;
#pragma unroll
        for (int ai = 0; ai < 2; ++ai)
#pragma unroll
            for (int m = 0; m < 4; ++m) { const int row = row0 + ai * HALF + m * 16; const float sc = scv[ai][m]; bf16_t* rowp = O + (size_t)row * ldc + col0;
#pragma unroll
                for (int bj = 0; bj < 2; ++bj) { const f32x4 v0 = acc[ai][bj][m][0] * sc, v1 = acc[ai][bj][m][1] * sc;
                    u32x4 w; w.x = cvt_pk_bf16(v0[0], v0[1]); w.y = cvt_pk_bf16(v0[2], v0[3]); w.z = cvt_pk_bf16(v1[0], v1[1]); w.w = cvt_pk_bf16(v1[2], v1[3]);
#ifdef NT_P
                    __builtin_nontemporal_store(w, (u32x4*)(rowp + bj * HALF)); } }
#else
                    *(u32x4*)(rowp + bj * HALF) = w; } }
#endif
    }
};
struct EpiPlainBf16 {
    static constexpr bool PERM = true, AFTER_DRAIN = false;
    bf16_t* O; int ldc; int pad_;
    __device__ __forceinline__ void operator()(const f32x4 (&acc)[2][2][4][2], const Unit& u, int wr, int wc, int fr, int fq) const {
        const int row0 = u.pm * BM + wr * 64 + fr, col0 = u.pn * BM + wc * 32 + 8 * fq;
#pragma unroll
        for (int ai = 0; ai < 2; ++ai)
#pragma unroll
            for (int m = 0; m < 4; ++m) { bf16_t* rowp = O + (size_t)(row0 + ai * HALF + m * 16) * ldc + col0;
#pragma unroll
                for (int bj = 0; bj < 2; ++bj) { const f32x4 v0 = acc[ai][bj][m][0], v1 = acc[ai][bj][m][1];
                    u32x4 w; w.x = cvt_pk_bf16(v0[0], v0[1]); w.y = cvt_pk_bf16(v0[2], v0[3]); w.z = cvt_pk_bf16(v1[0], v1[1]); w.w = cvt_pk_bf16(v1[2], v1[3]);
                    *(u32x4*)(rowp + bj * HALF) = w; } }
    }
};
struct EpiResid {
    static constexpr bool PERM = false, AFTER_DRAIN = false;
    float* X; int ldc; int pad_;
    __device__ __forceinline__ void operator()(const f32x4 (&acc)[2][2][4][2], const Unit& u, int wr, int wc, int fr_, int fq_) const {
        unsigned z_ = 0u; asm volatile("" : "+v"(z_)); const int ln_ = (int)__builtin_amdgcn_mbcnt_hi(~0u, __builtin_amdgcn_mbcnt_lo(~0u, z_)); const int fr = ln_ & 15, fq = ln_ >> 4; (void)fr_; (void)fq_;
        const int row0 = u.pm * BM + wr * 64 + fr, col0 = u.pn * BM + wc * 32 + 4 * fq;
#pragma unroll
        for (int ai = 0; ai < 2; ++ai)
#pragma unroll
            for (int m = 0; m < 4; ++m) { float* rowp = X + (size_t)(row0 + ai * HALF + m * 16) * ldc + col0;
                f32x4 xv[2][2];
#pragma unroll
                for (int bj = 0; bj < 2; ++bj)
#pragma unroll
                    for (int n = 0; n < 2; ++n) xv[bj][n] = *(const f32x4*)(rowp + bj * HALF + n * 16);
#pragma unroll
                for (int bj = 0; bj < 2; ++bj)
#pragma unroll
                    for (int n = 0; n < 2; ++n) *(f32x4*)(rowp + bj * HALF + n * 16) = xv[bj][n] + acc[ai][bj][m][n]; }
    }
};
struct EpiKV {
    static constexpr bool PERM = true, AFTER_DRAIN = false;
    bf16_t* O; const float* rs; const float* kg; PG8_LAS float* red; int ldc; int pad_;
    __device__ __forceinline__ void operator()(const f32x4 (&acc)[2][2][4][2], const Unit& u, int wr, int wc, int fr_, int fq_) const {
        unsigned z_ = 0u; asm volatile("" : "+v"(z_)); const int ln_ = (int)__builtin_amdgcn_mbcnt_hi(~0u, __builtin_amdgcn_mbcnt_lo(~0u, z_)); const int fr = ln_ & 15, fq = ln_ >> 4; (void)fr_; (void)fq_;
        const int rl0 = wr * 64 + fr;
        const int col0 = u.pn * BM + wc * 32 + 8 * fq;
#pragma unroll
        for (int ai = 0; ai < 2; ++ai)
#pragma unroll
            for (int m = 0; m < 4; ++m) { const f32x4 a = acc[ai][0][m][0], b = acc[ai][0][m][1];
                float s = ((a[0] * a[0] + a[1] * a[1]) + (a[2] * a[2] + a[3] * a[3])) + ((b[0] * b[0] + b[1] * b[1]) + (b[2] * b[2] + b[3] * b[3]));
                { auto r16 = __builtin_amdgcn_permlane16_swap(__float_as_uint(s), __float_as_uint(s), false, false); s = __uint_as_float(r16[0]) + __uint_as_float(r16[1]);
                  auto r32 = __builtin_amdgcn_permlane32_swap(__float_as_uint(s), __float_as_uint(s), false, false); s = __uint_as_float(r32[0]) + __uint_as_float(r32[1]); }
                if (fq == 0) red[(rl0 + ai * HALF + m * 16) * 4 + wc] = s;
                asm volatile("" ::: "memory"); }
        asm volatile("s_waitcnt lgkmcnt(0)" ::: "memory"); __builtin_amdgcn_s_barrier(); asm volatile("" ::: "memory");
        const unsigned go = (unsigned)(wc * 32 + 8 * fq) * 4u;
        const f32x4 g0 = *(const f32x4*)((const char*)kg + go), g1 = *(const f32x4*)((const char*)kg + go + 16);
#pragma unroll
        for (int ai = 0; ai < 2; ++ai) {
            float scv[4];
#pragma unroll
            for (int m = 0; m < 4; ++m) scv[m] = rs[u.pm * BM + rl0 + ai * HALF + m * 16];
#pragma unroll
            for (int m = 0; m < 4; ++m) { const int rl = rl0 + ai * HALF + m * 16, row = u.pm * BM + rl;
                const f32x4 r4 = *(const PG8_LAS f32x4*)(red + rl * 4);
                const float rk = 1.f / sqrtf(((r4[0] + r4[1]) + (r4[2] + r4[3])) * (1.f / 128.f) + 1e-6f), sc = scv[m];
                bf16_t* rowp = O + (size_t)row * ldc + col0;
                { const f32x4 v0 = acc[ai][0][m][0] * rk * g0, v1 = acc[ai][0][m][1] * rk * g1;
                  u32x4 w; w.x = cvt_pk_bf16(v0[0], v0[1]); w.y = cvt_pk_bf16(v0[2], v0[3]); w.z = cvt_pk_bf16(v1[0], v1[1]); w.w = cvt_pk_bf16(v1[2], v1[3]);
                  *(u32x4*)rowp = w; }
                { const f32x4 v0 = acc[ai][1][m][0] * sc, v1 = acc[ai][1][m][1] * sc;
                  u32x4 w; w.x = cvt_pk_bf16(v0[0], v0[1]); w.y = cvt_pk_bf16(v0[2], v0[3]); w.z = cvt_pk_bf16(v1[0], v1[1]); w.w = cvt_pk_bf16(v1[2], v1[3]);
                  *(u32x4*)(rowp + HALF) = w; }
                asm volatile("" ::: "memory"); } }
        asm volatile("s_waitcnt lgkmcnt(0)" ::: "memory"); __builtin_amdgcn_s_barrier(); asm volatile("" ::: "memory");
    }
};
struct EpiResidN {
    static constexpr bool PERM = false, AFTER_DRAIN = false;
    const float* Xin; float* Xout; bf16_t* xb; float* ssq; int ldc; int pad_;
    __device__ __forceinline__ void operator()(const f32x4 (&acc)[2][2][4][2], const Unit& u, int wr, int wc, int fr_, int fq_) const {
        unsigned z_ = 0u; asm volatile("" : "+v"(z_)); const int ln_ = (int)__builtin_amdgcn_mbcnt_hi(~0u, __builtin_amdgcn_mbcnt_lo(~0u, z_)); const int fr = ln_ & 15, fq = ln_ >> 4; (void)fr_; (void)fq_;
        const int row0 = u.pm * BM + wr * 64 + fr, col0 = u.pn * BM + wc * 32 + 4 * fq;
#pragma unroll
        for (int ai = 0; ai < 2; ++ai)
        {   f32x4 xv[4][2][2];
#pragma unroll
            for (int m = 0; m < 4; ++m)
#pragma unroll
                for (int bj = 0; bj < 2; ++bj)
#pragma unroll
                    for (int n = 0; n < 2; ++n) xv[m][bj][n] = *(const f32x4*)(Xin + (size_t)(row0 + ai * HALF + m * 16) * ldc + col0 + bj * HALF + n * 16);
#pragma unroll
            for (int m = 0; m < 4; ++m) { const int row = row0 + ai * HALF + m * 16; const size_t off = (size_t)row * ldc + col0;
                float s = 0.f;
#pragma unroll
                for (int bj = 0; bj < 2; ++bj)
#pragma unroll
                    for (int n = 0; n < 2; ++n) { const f32x4 v = xv[m][bj][n] + acc[ai][bj][m][n]; *(f32x4*)(Xout + off + bj * HALF + n * 16) = v;
                        u32x2 w; w.x = cvt_pk_bf16(v[0], v[1]); w.y = cvt_pk_bf16(v[2], v[3]); *(u32x2*)(xb + off + bj * HALF + n * 16) = w;
                        s += (v[0] * v[0] + v[1] * v[1]) + (v[2] * v[2] + v[3] * v[3]); }
                { auto r16 = __builtin_amdgcn_permlane16_swap(__float_as_uint(s), __float_as_uint(s), false, false); s = __uint_as_float(r16[0]) + __uint_as_float(r16[1]);
                  auto r32 = __builtin_amdgcn_permlane32_swap(__float_as_uint(s), __float_as_uint(s), false, false); s = __uint_as_float(r32[0]) + __uint_as_float(r32[1]); }
                if (fq == 0) ssq[(size_t)row * 32 + u.pn * 4 + wc] = s; }
        }
    }
};
struct EpiResidB {
    static constexpr bool PERM = true, AFTER_DRAIN = false;
    const float* XinF; float* OutF; bf16_t* xb; float* ssq; int ldc; int pad_;
    __device__ __forceinline__ void operator()(const f32x4 (&acc)[2][2][4][2], const Unit& u, int wr, int wc, int fr_, int fq_) const {
        unsigned z_ = 0u; asm volatile("" : "+v"(z_)); const int ln_ = (int)__builtin_amdgcn_mbcnt_hi(~0u, __builtin_amdgcn_mbcnt_lo(~0u, z_)); const int fr = ln_ & 15, fq = ln_ >> 4; (void)fr_; (void)fq_;
        const int row0 = u.pm * BM + wr * 64 + fr, col0 = u.pn * BM + wc * 32 + 8 * fq;
#pragma unroll
        for (int ai = 0; ai < 2; ++ai) {
            f32x4 r0[4][2], r1[4][2];
#pragma unroll
            for (int m = 0; m < 4; ++m)
#pragma unroll
                for (int bj = 0; bj < 2; ++bj) { const size_t off = (size_t)(row0 + ai * HALF + m * 16) * ldc + col0 + bj * HALF;
                    if (XinF) { r0[m][bj] = *(const f32x4*)(XinF + off); r1[m][bj] = *(const f32x4*)(XinF + off + 4); }
                    else { const u32x4 w = *(const u32x4*)(xb + off); r0[m][bj] = (f32x4){lo_bf(w.x), hi_bf(w.x), lo_bf(w.y), hi_bf(w.y)}; r1[m][bj] = (f32x4){lo_bf(w.z), hi_bf(w.z), lo_bf(w.w), hi_bf(w.w)}; } }
#pragma unroll
            for (int m = 0; m < 4; ++m) { const int row = row0 + ai * HALF + m * 16; float s = 0.f;
#pragma unroll
                for (int bj = 0; bj < 2; ++bj) { const size_t off = (size_t)row * ldc + col0 + bj * HALF;
                    const f32x4 v0 = r0[m][bj] + acc[ai][bj][m][0], v1 = r1[m][bj] + acc[ai][bj][m][1];
                    u32x4 w; w.x = cvt_pk_bf16(v0[0], v0[1]); w.y = cvt_pk_bf16(v0[2], v0[3]); w.z = cvt_pk_bf16(v1[0], v1[1]); w.w = cvt_pk_bf16(v1[2], v1[3]);
                    *(u32x4*)(xb + off) = w;
                    if (OutF) { *(f32x4*)(OutF + off) = v0; *(f32x4*)(OutF + off + 4) = v1; }
                    s += ((v0[0] * v0[0] + v0[1] * v0[1]) + (v0[2] * v0[2] + v0[3] * v0[3])) + ((v1[0] * v1[0] + v1[1] * v1[1]) + (v1[2] * v1[2] + v1[3] * v1[3])); }
                { auto r16 = __builtin_amdgcn_permlane16_swap(__float_as_uint(s), __float_as_uint(s), false, false); s = __uint_as_float(r16[0]) + __uint_as_float(r16[1]);
                  auto r32 = __builtin_amdgcn_permlane32_swap(__float_as_uint(s), __float_as_uint(s), false, false); s = __uint_as_float(r32[0]) + __uint_as_float(r32[1]); }
                if (fq == 0) ssq[(size_t)row * 32 + u.pn * 4 + wc] = s; }
        }
    }
};
struct EpiSwiGLU {
    static constexpr bool PERM = true, AFTER_DRAIN = false;
    bf16_t* O; const float* rs; int ldc; int pad_;
    __device__ __forceinline__ void operator()(const f32x4 (&acc)[2][2][4][2], const Unit& u, int wr, int wc, int fr_, int fq_) const {
        unsigned z_ = 0u; asm volatile("" : "+v"(z_)); const int ln_ = (int)__builtin_amdgcn_mbcnt_hi(~0u, __builtin_amdgcn_mbcnt_lo(~0u, z_)); const int fr = ln_ & 15, fq = ln_ >> 4; (void)fr_; (void)fq_;
        const int row0 = u.pm * BM + wr * 64 + fr, col0 = u.pn * HALF + wc * 32 + 8 * fq;
        float scv[2][4];
#pragma unroll
        for (int ai = 0; ai < 2; ++ai)
#pragma unroll
            for (int m = 0; m < 4; ++m) scv[ai][m] = rs[row0 + ai * HALF + m * 16];
#pragma unroll
        for (int ai = 0; ai < 2; ++ai)
#pragma unroll
            for (int m = 0; m < 4; ++m) { const int row = row0 + ai * HALF + m * 16; const float sc = scv[ai][m]; bf16_t* rowp = O + (size_t)row * ldc + col0;
                float o[8];
#pragma unroll
                for (int n = 0; n < 2; ++n)
#pragma unroll
                    for (int i = 0; i < 4; ++i) { const float g = acc[ai][0][m][n][i] * sc, up = acc[ai][1][m][n][i] * sc;
                        o[n * 4 + i] = g * __builtin_amdgcn_rcpf(1.f + __builtin_amdgcn_exp2f(g * -1.4426950408889634f)) * up; }
                u32x4 w; w.x = cvt_pk_bf16(o[0], o[1]); w.y = cvt_pk_bf16(o[2], o[3]); w.z = cvt_pk_bf16(o[4], o[5]); w.w = cvt_pk_bf16(o[6], o[7]);
#ifdef NT_ACT
                __builtin_nontemporal_store(w, (u32x4*)rowp); }
#else
                *(u32x4*)rowp = w; }
#endif
    }
};

template <class Sched>
__device__ __forceinline__ void prep_row_scales(const float* part, float* rs, const Sched& S, int tid) {
    Unit u; int last = -1;
    for (int i = 0; S.next(i, u); ++i) {
        if (u.pm == last) continue;
        last = u.pm;
        const int row = u.pm * BM + (tid >> 1);
        const f32x4* p = (const f32x4*)(part + (size_t)row * 32 + (tid & 1) * 16);
        f32x4 a = (p[0] + p[1]) + (p[2] + p[3]);
        float s = (a[0] + a[1]) + (a[2] + a[3]);
        s += DPPF(s, 0xB1);
        if ((tid & 1) == 0) rs[row] = 1.f / sqrtf(s * (1.f / 2048.f) + 1e-6f);
    }
    asm volatile("s_waitcnt vmcnt(0)" ::: "memory");
    __syncthreads();
}
template <class Epi, class Sched, bool ALIGN_EPI = false, bool SP2 = false>
__device__ __forceinline__ void gemm_phase(PG8_LAS unsigned char* lds, const Gemm g, const Sched& S, const Epi& E, const int wv__) {
    const int tid = TID(), wid = __builtin_amdgcn_readfirstlane(tid >> 6), lane = tid & 63, wr = wid >> 2, wc = wid & 3, fr = lane & 15, fq = lane >> 4;
    const int K = g.K, nt = K / BK;
    unsigned voffA[2], voffB[2];
#pragma unroll
    for (int i = 0; i < 2; ++i) { int R, C; stage_rc(tid * 16 + i * 8192, R, C); const int Rb = Epi::PERM ? ((R & ~31) + perm32(R & 31)) : R;
        voffA[i] = (unsigned)(R * g.lda + C) * 2u; voffB[i] = (unsigned)(Rb * K + C) * 2u; }
    const size_t kstep = (size_t)(BK * 2);
    const size_t hstepA = (size_t)HALF * g.lda * 2, hstepB = (size_t)HALF * K * 2;
    const size_t tstepA = 2 * hstepA, tstepB = 2 * hstepB;
    const unsigned ldsw = (unsigned)wid * 1024u;
    const int aoff = lds_byte(wr * 64 + fr, fq * 8), boff = lds_byte(wc * 32 + fr, fq * 8);
#define PG8_SA(b, h) (((b) * 2 + (h)) * HTB)
#define PG8_SB(b, h) ((4 + (b) * 2 + (h)) * HTB)
#define PG8_STAGE(bufoff, gbase, voff) do { _Pragma("unroll") for (int _i = 0; _i < 2; ++_i) \
        __builtin_amdgcn_global_load_lds((const unsigned*)((const char*)(gbase) + (voff)[_i]), (PG8_LAS unsigned*)(lds + (bufoff) + ldsw + _i * 8192), 16, 0, 0); } while (0)
#define PG8_LDA(dst, b, h) do { _Pragma("unroll") for (int m = 0; m < 4; ++m) _Pragma("unroll") for (int k = 0; k < 2; ++k) dst[m][k] = *(const PG8_LAS bf16x8*)(lds + PG8_SA(b, h) + aoff + m * 2048 + k * 1024); } while (0)
#define PG8_LDB(dst, b, h) do { _Pragma("unroll") for (int n = 0; n < 2; ++n) _Pragma("unroll") for (int k = 0; k < 2; ++k) dst[n][k] = *(const PG8_LAS bf16x8*)(lds + PG8_SB(b, h) + boff + n * 2048 + k * 1024); } while (0)
#define PG8_MMA(ai, bj, At, Bt) do { __builtin_amdgcn_s_setprio(1); _Pragma("unroll") for (int m = 0; m < 4; ++m) _Pragma("unroll") for (int n = 0; n < 2; ++n) _Pragma("unroll") for (int k = 0; k < 2; ++k) \
        acc[ai][bj][m][n] = __builtin_amdgcn_mfma_f32_16x16x32_bf16(Bt[n][k], At[m][k], acc[ai][bj][m][n], 0, 0, 0); __builtin_amdgcn_s_setprio(0); } while (0)
#define PG8_WAIT_V(n) asm volatile("s_waitcnt vmcnt(" #n ")" ::: "memory")
#define PG8_WAIT_L(n) asm volatile("s_waitcnt lgkmcnt(" #n ")" ::: "memory")
#define PG8_BAR __builtin_amdgcn_s_barrier()
#define PG8_SCHED __builtin_amdgcn_sched_barrier(0)
    Unit cur, nxt; int ui = 0;
    if (!S.next(0, cur)) return;
    f32x4 acc[2][2][4][2];
#pragma unroll
    for (int a = 0; a < 2; ++a)
#pragma unroll
        for (int b = 0; b < 2; ++b)
#pragma unroll
            for (int m = 0; m < 4; ++m)
#pragma unroll
                for (int n = 0; n < 2; ++n) acc[a][b][m][n] = (f32x4){0.f, 0.f, 0.f, 0.f};
    bf16x8 At[4][2], B0[2][2], B1[2][2];
    const char* cA = (const char*)g.A + (size_t)cur.pm * tstepA; const char* cB = (const char*)g.Bt + (size_t)cur.pn * tstepB;
    S.a_ready(cur);
    if constexpr (SP2) {
        PG8_STAGE(PG8_SB(0, 0), cB, voffB); PG8_STAGE(PG8_SB(0, 1), cB + hstepB, voffB); PG8_STAGE(PG8_SA(0, 0), cA, voffA); PG8_STAGE(PG8_SA(0, 1), cA + hstepA, voffA);
        if (wr == 1) PG8_BAR;
        PG8_WAIT_V(2); PG8_BAR;
        PG8_STAGE(PG8_SB(1, 0), cB + kstep, voffB); PG8_STAGE(PG8_SA(1, 0), cA + kstep, voffA); PG8_STAGE(PG8_SB(1, 1), cB + hstepB + kstep, voffB);
        PG8_WAIT_V(6); PG8_BAR;
    } else {
        PG8_STAGE(PG8_SB(0, 0), cB, voffB); PG8_STAGE(PG8_SA(0, 0), cA, voffA); PG8_STAGE(PG8_SB(0, 1), cB + hstepB, voffB); PG8_STAGE(PG8_SA(0, 1), cA + hstepA, voffA);
        if (wr == 1) PG8_BAR;
        PG8_WAIT_V(4); PG8_BAR;
        PG8_STAGE(PG8_SB(1, 0), cB + kstep, voffB); PG8_STAGE(PG8_SA(1, 0), cA + kstep, voffA); PG8_STAGE(PG8_SB(1, 1), cB + hstepB + kstep, voffB);
        PG8_WAIT_V(6); PG8_BAR;
    }
    for (;;) {
        const bool has_next = S.next(ui + 1, nxt);
        const char* nA = has_next ? (const char*)g.A + (size_t)nxt.pm * tstepA : cA; const char* nB = has_next ? (const char*)g.Bt + (size_t)nxt.pn * tstepB : cB;
        for (int t = 0; t < nt; t += 2) {
            const bool last = (t == nt - 2);
            const char* a1 = cA + (size_t)(t + 1) * kstep;
            const char* a2 = last ? nA : cA + (size_t)(t + 2) * kstep; const char* b2 = last ? nB : cB + (size_t)(t + 2) * kstep;
            const char* a3 = a2 + kstep; const char* b3 = b2 + kstep;
            if (last && has_next) S.a_ready(nxt);
            if constexpr (SP2) {
            PG8_LDB(B0, 0, 0); PG8_LDB(B1, 0, 1); PG8_SCHED; PG8_LDA(At, 0, 0); PG8_STAGE(PG8_SA(1, 1), a1 + hstepA, voffA);
            PG8_WAIT_V(8); PG8_WAIT_L(0); PG8_BAR; PG8_MMA(0, 0, At, B0); PG8_MMA(0, 1, At, B1); PG8_BAR; PG8_SCHED;
            PG8_LDA(At, 0, 1); PG8_STAGE(PG8_SB(0, 0), b2, voffB); PG8_STAGE(PG8_SB(0, 1), b2 + hstepB, voffB); PG8_STAGE(PG8_SA(0, 0), a2, voffA);
            PG8_WAIT_V(8); PG8_WAIT_L(0); PG8_BAR; PG8_MMA(1, 0, At, B0); PG8_MMA(1, 1, At, B1); PG8_BAR; PG8_SCHED;
            PG8_LDB(B0, 1, 0); PG8_LDB(B1, 1, 1); PG8_SCHED; PG8_LDA(At, 1, 0); PG8_STAGE(PG8_SA(0, 1), a2 + hstepA, voffA);
            PG8_WAIT_V(8); PG8_WAIT_L(0); PG8_BAR; PG8_MMA(0, 0, At, B0); PG8_MMA(0, 1, At, B1); PG8_BAR; PG8_SCHED;
            PG8_LDA(At, 1, 1); PG8_STAGE(PG8_SB(1, 0), b3, voffB); PG8_STAGE(PG8_SB(1, 1), b3 + hstepB, voffB); PG8_STAGE(PG8_SA(1, 0), a3, voffA);
            PG8_WAIT_V(8); PG8_WAIT_L(0); PG8_BAR; PG8_MMA(1, 0, At, B0); PG8_MMA(1, 1, At, B1); PG8_BAR; PG8_SCHED;
            } else {
            PG8_LDB(B0, 0, 0); PG8_SCHED; PG8_LDA(At, 0, 0); PG8_STAGE(PG8_SA(1, 1), a1 + hstepA, voffA);
            PG8_WAIT_L(8); PG8_BAR; PG8_WAIT_L(0); PG8_MMA(0, 0, At, B0); PG8_BAR; PG8_SCHED;
            PG8_LDB(B1, 0, 1); PG8_STAGE(PG8_SB(0, 0), b2, voffB);
            PG8_BAR; PG8_WAIT_L(0); PG8_MMA(0, 1, At, B1); PG8_BAR;
            PG8_LDA(At, 0, 1); PG8_STAGE(PG8_SA(0, 0), a2, voffA);
            PG8_BAR; PG8_WAIT_L(0); PG8_MMA(1, 0, At, B0); PG8_BAR; PG8_SCHED;
            PG8_STAGE(PG8_SB(0, 1), b2 + hstepB, voffB);
            PG8_WAIT_V(6); PG8_BAR; PG8_MMA(1, 1, At, B1); PG8_BAR;
            PG8_LDB(B0, 1, 0); PG8_SCHED; PG8_LDA(At, 1, 0); PG8_STAGE(PG8_SA(0, 1), a2 + hstepA, voffA);
            PG8_WAIT_L(8); PG8_BAR; PG8_WAIT_L(0); PG8_MMA(0, 0, At, B0); PG8_BAR; PG8_SCHED;
            PG8_LDB(B1, 1, 1); PG8_STAGE(PG8_SB(1, 0), b3, voffB);
            PG8_BAR; PG8_WAIT_L(0); PG8_MMA(0, 1, At, B1); PG8_BAR;
            PG8_LDA(At, 1, 1); PG8_STAGE(PG8_SA(1, 0), a3, voffA);
            PG8_BAR; PG8_WAIT_L(0); PG8_MMA(1, 0, At, B0); PG8_BAR; PG8_SCHED;
            PG8_STAGE(PG8_SB(1, 1), b3 + hstepB, voffB);
            PG8_WAIT_V(6); PG8_BAR; PG8_MMA(1, 1, At, B1); PG8_BAR;
            }
        }
        if constexpr (ALIGN_EPI) { if (wr == 0) PG8_BAR; }
        if constexpr (!Epi::AFTER_DRAIN) { E(acc, cur, wr, wc, fr, fq); S.done(cur); }
        if (!has_next) break;
#pragma unroll
        for (int a = 0; a < 2; ++a)
#pragma unroll
            for (int b = 0; b < 2; ++b)
#pragma unroll
                for (int m = 0; m < 4; ++m)
#pragma unroll
                    for (int n = 0; n < 2; ++n) acc[a][b][m][n] = (f32x4){0.f, 0.f, 0.f, 0.f};
        cur = nxt; cA = nA; cB = nB; ++ui;
        if constexpr (ALIGN_EPI) { if (wr == 1) PG8_BAR; }
    }
    PG8_WAIT_V(0);
    if constexpr (!ALIGN_EPI) { if (wr == 0) PG8_BAR; }
    PG8_BAR;
    if constexpr (Epi::AFTER_DRAIN) { E.fused(acc, cur, wr, wc, fr, fq, lds, wid, lane); S.done(cur); }
#undef PG8_SA
#undef PG8_SB
#undef PG8_STAGE
#undef PG8_LDA
#undef PG8_LDB
#undef PG8_MMA
#undef PG8_WAIT_V
#undef PG8_WAIT_L
#undef PG8_BAR
#undef PG8_SCHED
}
}
__device__ __forceinline__ void rope_cs(int pos, int j, float& c, float& s) {
    const float inv_freq = exp2f(-(float)j * (13.287712379549449f / 32.f));
    const float ang = (float)pos * inv_freq;
    float rev = ang * 0.15915494309189535f; rev = rev - floorf(rev);
    c = __builtin_amdgcn_cosf(rev); s = __builtin_amdgcn_sinf(rev);
}
namespace att {
constexpr int NW = 8, QBLK = 32, KVBLK = 64, QB = NW * QBLK;
constexpr int QS = QW, KS = KVW, KRS = 64, OS = DM;
constexpr int SHM_V = KVBLK * 128 * 2, SHM_K = KVBLK * 128 * 2, SHM_KR = KVBLK * 64 * 2;
constexpr int OFF_V = 0, OFF_K = 2 * SHM_V, OFF_KR = OFF_K + 2 * SHM_K, OFF_WS = OFF_KR + 2 * SHM_KR, OFF_QR = OFF_WS + NW * 64 * 4;
constexpr int LDS_BYTES = OFF_QR + NW * 8 * 64 * 16;
constexpr float SCALE = 0.07216878364870322f;
constexpr float THR = 8.f;
constexpr int NQB = SEQ / QB;

#define KSWZ(row, colB) ((row) * 256 + ((colB) ^ (((row) & 7) << 4)))
#define KRSWZ(row, colB) ((row) * 128 + ((colB) ^ ((((row) >> 1) & 7) << 4)))
#define SBAR() __builtin_amdgcn_sched_barrier(0)
__device__ __forceinline__ int v_st(int k, int c) { const int kk = (k & ~0xC) | ((k & 4) << 1) | ((k & 8) >> 1); return ((kk >> 3) * 4 + (c >> 5)) * 512 + ((kk & 7) * 32 + (c & 31)) * 2; }
__device__ __forceinline__ int v_rd_base(int lane) { return ((lane & 3) << 3) | (((lane >> 2) & 3) << 6) | (((lane >> 4) & 1) << 5) | (((lane >> 5) & 1) << 8); }
constexpr int v_rd_off(int d0, int ks, int half) { return d0 * 512 + ks * 4096 + half * 2048; }
__device__ __forceinline__ int crow(int r, int hi) { return (r & 3) + 8 * (r >> 2) + 4 * hi; }
__device__ __forceinline__ unsigned cvtpk(float lo, float hi) { return cvt_pk_bf16(lo, hi); }
__device__ __forceinline__ bf16x8 load8(const bf16_t* p) { return *reinterpret_cast<const bf16x8*>(p); }

__device__ __forceinline__ void mask_tile(f32x16& p0, f32x16& p1, int dq) {
    const float NEG = -__builtin_inff();
#pragma unroll
    for (int r = 0; r < 16; ++r) {
        const int c = (r & 3) + 8 * (r >> 2);
        if (dq - c < 0) p0[r] = NEG;
        if (dq - c - 32 < 0) p1[r] = NEG;
    }
}
__device__ __forceinline__ void partialSM(f32x16& p0, f32x16& p1, float& m_reg, float& mn, float& alpha) {
    float pmax = p0[0];
#pragma unroll
    for (int r = 1; r < 16; ++r) pmax = fmaxf(pmax, p0[r]);
#pragma unroll
    for (int r = 0; r < 16; ++r) pmax = fmaxf(pmax, p1[r]);
    { auto rr = __builtin_amdgcn_permlane32_swap(__float_as_uint(pmax), __float_as_uint(pmax), false, false);
      pmax = fmaxf(__uint_as_float(rr[0]), __uint_as_float(rr[1])); }
    constexpr float C2 = 1.4426950408889634f * SCALE;
    if (__builtin_expect(__all((pmax - m_reg) * SCALE <= THR), 1)) { mn = m_reg; alpha = 1.f; }
    else { mn = fmaxf(m_reg, pmax); alpha = __builtin_amdgcn_exp2f((m_reg - mn) * C2); m_reg = mn; }
    const float mnL = -mn * C2;
#pragma unroll
    for (int r = 0; r < 16; ++r) p0[r] = fmaf(p0[r], C2, mnL);
#pragma unroll
    for (int r = 0; r < 16; ++r) p1[r] = fmaf(p1[r], C2, mnL);
#pragma unroll
    for (int r = 0; r < 16; ++r) p0[r] = __builtin_amdgcn_exp2f(p0[r]);
}
__device__ __forceinline__ void finishSM(f32x16& p0, f32x16& p1, float alpha, float& l_reg, bf16x8& pa0, bf16x8& pa1, bf16x8& pa2, bf16x8& pa3) {
#pragma unroll
    for (int r = 0; r < 16; ++r) p1[r] = __builtin_amdgcn_exp2f(p1[r]);
    float ps = 0;
#pragma unroll
    for (int r = 0; r < 16; ++r) ps += p0[r];
#pragma unroll
    for (int r = 0; r < 16; ++r) ps += p1[r];
    { auto rr = __builtin_amdgcn_permlane32_swap(__float_as_uint(ps), __float_as_uint(ps), false, false);
      ps = __uint_as_float(rr[0]) + __uint_as_float(rr[1]); }
    l_reg = l_reg * alpha + ps;
#define PK4(P, B_, OUT) do { unsigned a0 = cvtpk(P[B_+0], P[B_+1]), a1 = cvtpk(P[B_+2], P[B_+3]);                          \
        unsigned b0 = cvtpk(P[B_+4], P[B_+5]), b1 = cvtpk(P[B_+6], P[B_+7]);                                             \
        auto r0 = __builtin_amdgcn_permlane32_swap(a0, b0, false, false); auto r1 = __builtin_amdgcn_permlane32_swap(a1, b1, false, false); \
        u32x4 w = {r0[0], r1[0], r0[1], r1[1]}; OUT = *reinterpret_cast<bf16x8*>(&w); } while (0)
    PK4(p0, 0, pa0); PK4(p0, 8, pa1); PK4(p1, 0, pa2); PK4(p1, 8, pa3);
#undef PK4
}
template <int KB>
__device__ __forceinline__ void qkt(f32x16& p0, f32x16& p1, const char* lds, int r32, int hi, const bf16x8* qr, int qro) {
    p0 = f32x16{}; p1 = f32x16{};
    const char* kb[4];
#pragma unroll
    for (int dd = 0; dd < 4; ++dd) kb[dd] = lds + OFF_K + KB * SHM_K + KSWZ(r32, (dd * 16 + hi * 8) * 2);
#pragma unroll
    for (int d0 = 0; d0 < 8; ++d0) { const char* a = kb[d0 & 3] + (d0 >> 2) * 128;
        bf16x8 b0 = *reinterpret_cast<const bf16x8*>(a);
        bf16x8 b1 = *reinterpret_cast<const bf16x8*>(a + 32 * 256);
        const bf16x8 qq = qr[d0];
        p0 = __builtin_amdgcn_mfma_f32_32x32x16_bf16(b0, qq, p0, 0, 0, 0);
        p1 = __builtin_amdgcn_mfma_f32_32x32x16_bf16(b1, qq, p1, 0, 0, 0); }
#pragma unroll
    for (int dd = 0; dd < 4; ++dd) { const char* a = lds + OFF_KR + KB * SHM_KR + KRSWZ(r32, (dd * 16 + hi * 8) * 2);
        bf16x8 b0 = *reinterpret_cast<const bf16x8*>(a);
        bf16x8 b1 = *reinterpret_cast<const bf16x8*>(a + 32 * 128);
        const bf16x8 qq = *reinterpret_cast<const bf16x8*>(lds + qro + dd * 1024);
        p0 = __builtin_amdgcn_mfma_f32_32x32x16_bf16(b0, qq, p0, 0, 0, 0);
        p1 = __builtin_amdgcn_mfma_f32_32x32x16_bf16(b1, qq, p1, 0, 0, 0); }
}
template <int VB>
__device__ __forceinline__ void pv_tile(f32x16* o, int vb0, bf16x8 pa0, bf16x8 pa1, bf16x8 pa2, bf16x8 pa3) {
#define TRRD(dst, off) asm volatile("ds_read_b64_tr_b16 %0, %1 offset:%2" : "=&v"(dst) : "v"(vb0), "i"(off) : "memory")
#define PV_D0(d0) do { s16x4 l0, l1, l2, l3, h0, h1, h2, h3; constexpr int b_ = OFF_V + VB * SHM_V + v_rd_off(d0, 0, 0);   \
        TRRD(l0, b_); TRRD(h0, b_ + 2048); TRRD(l1, b_ + 4096); TRRD(h1, b_ + 6144); TRRD(l2, b_ + 8192); TRRD(h2, b_ + 10240); TRRD(l3, b_ + 12288); TRRD(h3, b_ + 14336); \
        asm volatile("s_waitcnt lgkmcnt(0)" ::: "memory"); SBAR();   \
        o[d0] = __builtin_amdgcn_mfma_f32_32x32x16_bf16(pa0, (bf16x8){l0[0], l0[1], l0[2], l0[3], h0[0], h0[1], h0[2], h0[3]}, o[d0], 0, 0, 0);   \
        o[d0] = __builtin_amdgcn_mfma_f32_32x32x16_bf16(pa1, (bf16x8){l1[0], l1[1], l1[2], l1[3], h1[0], h1[1], h1[2], h1[3]}, o[d0], 0, 0, 0);   \
        o[d0] = __builtin_amdgcn_mfma_f32_32x32x16_bf16(pa2, (bf16x8){l2[0], l2[1], l2[2], l2[3], h2[0], h2[1], h2[2], h2[3]}, o[d0], 0, 0, 0);   \
        o[d0] = __builtin_amdgcn_mfma_f32_32x32x16_bf16(pa3, (bf16x8){l3[0], l3[1], l3[2], l3[3], h3[0], h3[1], h3[2], h3[3]}, o[d0], 0, 0, 0); } while (0)
    PV_D0(0); PV_D0(1); PV_D0(2); PV_D0(3);
#undef PV_D0
#undef TRRD
}

struct BlockRef { const bf16_t* Q; const bf16_t* K; const bf16_t* V; const bf16_t* KR; bf16_t* O; const int* POS; const float* QG; int P0; };
struct Seam { bf16x8 qr[8]; bf16x8 st_v0, st_v1, st_k0, st_k1, st_kr; };
#define VMW() asm volatile("s_waitcnt vmcnt(0)" ::: "memory")
#define VMWN(n) asm volatile("s_waitcnt vmcnt(%0)" :: "i"(n) : "memory")
#define LDG8(base, off) (*reinterpret_cast<const bf16x8*>((const char*)(base) + (off)))
#define SLOAD_H(R_, k0) do { const char* kb_ = (const char*)((R_).K + (size_t)(k0) * KS); const char* rb_ = (const char*)((R_).KR + (size_t)(k0) * KRS);  \
                             S.st_v0 = LDG8(kb_ + 256, offA); S.st_v1 = LDG8(kb_ + 32 * KS * 2 + 256, offA);              \
                             S.st_k0 = LDG8(kb_, offA); S.st_k1 = LDG8(kb_ + 32 * KS * 2, offA);              \
                             S.st_kr = LDG8(rb_, offR); } while (0)
#define SWRITE_HK(bf) do { *(bf16x8*)(lds + OFF_K + (bf) * SHM_K + kws) = S.st_k0; *(bf16x8*)(lds + OFF_K + (bf) * SHM_K + kws + 32 * 256) = S.st_k1; \
                           *(bf16x8*)(lds + OFF_KR + (bf) * SHM_KR + krws) = S.st_kr; } while (0)
#define SWRITE_HV(bf) do { *(bf16x8*)(lds + OFF_V + (bf) * SHM_V + vst0) = S.st_v0; *(bf16x8*)(lds + OFF_V + (bf) * SHM_V + vst1) = S.st_v1; } while (0)
#define SWRITE_H(bf) do { SWRITE_HV(bf); SWRITE_HK(bf); } while (0)
#define QLOAD(R_) do { _Pragma("unroll") for (int d0 = 0; d0 < 8; ++d0) S.qr[d0] = LDG8((const char*)(R_).Q + d0 * 32, offQ); } while (0)

__device__ __forceinline__ void attn_prime(const BlockRef& cur, char* lds, Seam& S, const int wv__) {
    const int tid = TID(), wid = __builtin_amdgcn_readfirstlane(tid >> 6), lane = tid & 63, r32 = lane & 31, hi = lane >> 5;
    const int sr = tid >> 4, sc = (tid & 15) * 8, kws = KSWZ(sr, sc * 2), krr = tid >> 3, krc = (tid & 7) * 8, krws = KRSWZ(krr, krc * 2);
    unsigned offA = (unsigned)(sr * KS + sc) * 2u, offR = (unsigned)(krr * KRS + krc) * 2u, offQ = (unsigned)((wid * QBLK + r32) * QS + hi * 8) * 2u;
    asm volatile("" : "+v"(offA), "+v"(offR), "+v"(offQ));
    QLOAD(cur);
    SLOAD_H(cur, 0); VMW(); SWRITE_HK(0);
    __syncthreads();
}
__device__ __forceinline__ void attn_block(const BlockRef& cur, char* lds, Seam& S, const int wv__) {
    const int tid = TID(), wid = __builtin_amdgcn_readfirstlane(tid >> 6), lane = tid & 63, r32 = lane & 31, hi = lane >> 5;
    const int NT = (cur.P0 + QB) / KVBLK;
    const int qlo = cur.P0 + wid * QBLK, qm = qlo + r32 - 4 * hi;
    float* ws = (float*)(lds + OFF_WS) + wid * 64; float* li_l = ws, * al_l = ws + 32;
    float m_reg = -1e30f, l_reg = 0; f32x16 o[4] = {};
    const int sr = tid >> 4, sc = (tid & 15) * 8, vst0 = v_st(sr, sc), vst1 = v_st(32 + sr, sc), kws = KSWZ(sr, sc * 2);
    const int krr = tid >> 3, krc = (tid & 7) * 8, krws = KRSWZ(krr, krc * 2);
    unsigned offA = (unsigned)(sr * KS + sc) * 2u, offR = (unsigned)(krr * KRS + krc) * 2u, offQ = (unsigned)((wid * QBLK + r32) * QS + hi * 8) * 2u;
    asm volatile("" : "+v"(offA), "+v"(offR), "+v"(offQ));
    const int vb0 = (int)(uintptr_t)lds + v_rd_base(lane);
#define RESC(a) do { if (__any((a) < 1.f)) { if (hi == 0) al_l[r32] = (a); asm volatile("s_waitcnt lgkmcnt(0)" ::: "memory");              \
                     for (int d_ = 0; d_ < 4; ++d_) for (int r = 0; r < 16; ++r) o[d_][r] *= al_l[crow(r, hi)]; } } while (0)
#define KBASE(t) ((t) * KVBLK)
#define MASKT(P0_, P1_, t) do { const int kb_ = KBASE(t); if (kb_ + KVBLK - 1 > qlo) mask_tile(P0_, P1_, qm - kb_); } while (0)
    f32x16 pA0, pA1, pB0, pB1; float mnA, mnB, alA, alB; bf16x8 pa0, pa1, pa2, pa3;
    const int qro = OFF_QR + (wid * 8 * 64 + lane) * 16;
    { bf16x8 tq[8];
#pragma unroll
      for (int dd = 4; dd < 8; ++dd) tq[dd] = LDG8((const char*)cur.Q + 128 + dd * 32, offQ);
      const int pos = cur.POS[wid * QBLK + r32];
      float sn = 0.f, sr = 0.f;
#define UNP(F, x) const u32x4 w_ = __builtin_bit_cast(u32x4, F); float x[8] = {lo_bf(w_.x), hi_bf(w_.x), lo_bf(w_.y), hi_bf(w_.y), lo_bf(w_.z), hi_bf(w_.z), lo_bf(w_.w), hi_bf(w_.w)};
#pragma unroll
      for (int f = 0; f < 8; ++f) { UNP(S.qr[f], x)
#pragma unroll
          for (int e = 0; e < 8; ++e) sn += x[e] * x[e]; }
#pragma unroll
      for (int f = 4; f < 8; ++f) { UNP(tq[f], x)
#pragma unroll
          for (int e = 0; e < 8; ++e) sr += x[e] * x[e]; }
      { auto r0 = __builtin_amdgcn_permlane32_swap(__float_as_uint(sn), __float_as_uint(sn), false, false); sn = __uint_as_float(r0[0]) + __uint_as_float(r0[1]);
        auto r1 = __builtin_amdgcn_permlane32_swap(__float_as_uint(sr), __float_as_uint(sr), false, false); sr = __uint_as_float(r1[0]) + __uint_as_float(r1[1]); }
      const float rn = 1.f / sqrtf(sn * (1.f / 128.f) + RMS_EPS), rr = 1.f / sqrtf(sr * (1.f / 64.f) + RMS_EPS);
#pragma unroll
      for (int f = 0; f < 8; ++f) { UNP(S.qr[f], x)
          const f32x4 g0 = *(const f32x4*)(cur.QG + f * 16 + hi * 8), g1 = *(const f32x4*)(cur.QG + f * 16 + hi * 8 + 4);
          const float g[8] = {g0.x, g0.y, g0.z, g0.w, g1.x, g1.y, g1.z, g1.w};
          u32x4 o; o.x = cvt_pk_bf16(x[0] * rn * g[0], x[1] * rn * g[1]); o.y = cvt_pk_bf16(x[2] * rn * g[2], x[3] * rn * g[3]);
          o.z = cvt_pk_bf16(x[4] * rn * g[4], x[5] * rn * g[5]); o.w = cvt_pk_bf16(x[6] * rn * g[6], x[7] * rn * g[7]);
          S.qr[f] = __builtin_bit_cast(bf16x8, o); }
#pragma unroll
      for (int dd = 0; dd < 2; ++dd) {
          float x1[8], x2[8];
          { UNP(tq[4 + dd], x) for (int e = 0; e < 8; ++e) x1[e] = x[e]; }
          { UNP(tq[6 + dd], x) for (int e = 0; e < 8; ++e) x2[e] = x[e]; }
          const f32x4 ga0 = *(const f32x4*)(cur.QG + 128 + dd * 16 + hi * 8), ga1 = *(const f32x4*)(cur.QG + 128 + dd * 16 + hi * 8 + 4);
          const f32x4 gb0 = *(const f32x4*)(cur.QG + 160 + dd * 16 + hi * 8), gb1 = *(const f32x4*)(cur.QG + 160 + dd * 16 + hi * 8 + 4);
          const float ga[8] = {ga0.x, ga0.y, ga0.z, ga0.w, ga1.x, ga1.y, ga1.z, ga1.w}, gb[8] = {gb0.x, gb0.y, gb0.z, gb0.w, gb1.x, gb1.y, gb1.z, gb1.w};
          float o1[8], o2[8];
#pragma unroll
          for (int e = 0; e < 8; ++e) { float c, s; rope_cs(pos, dd * 16 + hi * 8 + e, c, s);
              const float a = x1[e] * rr * ga[e], b = x2[e] * rr * gb[e]; o1[e] = a * c - b * s; o2[e] = b * c + a * s; }
          u32x4 w1, w2; w1.x = cvt_pk_bf16(o1[0], o1[1]); w1.y = cvt_pk_bf16(o1[2], o1[3]); w1.z = cvt_pk_bf16(o1[4], o1[5]); w1.w = cvt_pk_bf16(o1[6], o1[7]);
          w2.x = cvt_pk_bf16(o2[0], o2[1]); w2.y = cvt_pk_bf16(o2[2], o2[3]); w2.z = cvt_pk_bf16(o2[4], o2[5]); w2.w = cvt_pk_bf16(o2[6], o2[7]);
          tq[4 + dd] = __builtin_bit_cast(bf16x8, w1); tq[6 + dd] = __builtin_bit_cast(bf16x8, w2);
      }
#undef UNP
#pragma unroll
      for (int dd = 0; dd < 4; ++dd) *(bf16x8*)(lds + qro + dd * 1024) = tq[4 + dd]; }
    SWRITE_HV(0); SBAR();
    if (NT > 1) SLOAD_H(cur, KBASE(1));
    SBAR(); qkt<0>(pA0, pA1, lds, r32, hi, S.qr, qro);
    MASKT(pA0, pA1, 0); partialSM(pA0, pA1, m_reg, mnA, alA);
    if (NT > 1) { VMW(); SWRITE_H(1); }
    __syncthreads();
#define HALF_STEP(PX0, PX1, mnX, alX, PY0, PY1, alY, t, KB, VB, SB) do {                                                      \
        SBAR(); qkt<KB>(PX0, PX1, lds, r32, hi, S.qr, qro);                                             \
        finishSM(PY0, PY1, alY, l_reg, pa0, pa1, pa2, pa3); SBAR();                                                           \
        if ((t) + 1 < NT) { SLOAD_H(cur, KBASE((t) + 1)); SBAR(); }                                               \
        pv_tile<VB>(o, vb0, pa0, pa1, pa2, pa3); MASKT(PX0, PX1, (t)); partialSM(PX0, PX1, m_reg, mnX, alX);                                        \
        __syncthreads();                                                                                                      \
        if ((t) + 1 < NT) { VMW(); SWRITE_H(SB); }                                                                          \
        RESC(alX); __syncthreads(); } while (0)
    for (int t = 1; t + 1 < NT; t += 2) {
        HALF_STEP(pB0, pB1, mnB, alB, pA0, pA1, alA, t, 1, 0, 0);
        HALF_STEP(pA0, pA1, mnA, alA, pB0, pB1, alB, t + 1, 0, 1, 1);
    }
    SBAR(); qkt<1>(pB0, pB1, lds, r32, hi, S.qr, qro); SBAR();
    finishSM(pA0, pA1, alA, l_reg, pa0, pa1, pa2, pa3); SBAR();
    pv_tile<0>(o, vb0, pa0, pa1, pa2, pa3);
    MASKT(pB0, pB1, NT - 1); partialSM(pB0, pB1, m_reg, mnB, alB); __syncthreads(); RESC(alB);
    finishSM(pB0, pB1, alB, l_reg, pa0, pa1, pa2, pa3); SBAR(); pv_tile<1>(o, vb0, pa0, pa1, pa2, pa3);
    if (hi == 0) li_l[r32] = l_reg; asm volatile("s_waitcnt lgkmcnt(0)" ::: "memory");
    float rli[16];
#pragma unroll
    for (int r = 0; r < 16; ++r) rli[r] = __builtin_amdgcn_rcpf(li_l[crow(r, hi)]);
    unsigned obase = (unsigned)((wid * QBLK + 4 * hi) * OS + r32) * 2u; asm volatile("" : "+v"(obase));
#pragma unroll
    for (int r = 0; r < 16; ++r) { const unsigned orow_off = (unsigned)(((r & 3) + 8 * (r >> 2)) * OS) * 2u;
#pragma unroll
        for (int d0 = 0; d0 < 4; ++d0) { const float v = o[d0][r] * rli[r];
            const float vn = DPPF(v, 0xB1);
            if ((r32 & 1) == 0) *(unsigned*)((char*)cur.O + (obase + orow_off + (unsigned)(d0 * 64))) = cvtpk(v, vn); } }
    __syncthreads();
#undef RESC
#undef KBASE
#undef MASKT
#undef HALF_STEP
}
#undef VMW
#undef VMWN
#undef SLOAD_H
#undef SWRITE_HK
#undef SWRITE_HV
#undef SWRITE_H
#undef QLOAD
#undef LDG8

__device__ __forceinline__ BlockRef make_ref(int bh, int qb, const bf16_t* q, const bf16_t* kv, const bf16_t* kr, bf16_t* mixed, const int* pos, const float* qg) {
    const int b = bh >> 3, h = bh & 7; BlockRef r;
    r.Q = q + ((size_t)b * SEQ + (size_t)qb * QB) * QS + h * 192;
    r.K = kv + (size_t)b * SEQ * KS + h * 256; r.V = r.K + 128;
    r.KR = kr + (size_t)b * SEQ * KRS;
    r.O = mixed + ((size_t)b * SEQ + (size_t)qb * QB) * OS + 512 + h * 128; r.P0 = qb * QB;
    r.POS = pos + (size_t)b * SEQ + (size_t)qb * QB; r.QG = qg;
    return r;
}
constexpr int N_BLOCKS = BATCH * 8 * NQB;
__device__ __forceinline__ void attn_one(char* lds, const bf16_t* q, const bf16_t* kv, const bf16_t* kr, bf16_t* mixed, int i, const int* pos, const float* qg, const int wv__) {
    Seam S;
    const BlockRef cur = make_ref(i & 63, NQB - 1 - (i >> 6), q, kv, kr, mixed, pos, qg);
    attn_prime(cur, lds, S, wv__);
    attn_block(cur, lds, S, wv__);
}
#undef KSWZ
#undef KRSWZ
#undef SBAR
}
namespace tok {
constexpr int PT = 32;
constexpr int NTILES = T / PT;
constexpr int S_VM = 1040, S_XW = 144, S_XG = 272;
constexpr int O_VM = 0, O_XR = O_VM + PT * S_VM, O_XK = O_XR + PT * S_VM, O_XW = O_XK + PT * S_VM, O_XA = O_XW + PT * S_XW, O_XG = O_XA + PT * S_XW, O_PAR = O_XG + PT * S_XG, O_WB = O_PAR + 6 * 2048, O_END = O_WB + 8 * 2560;
constexpr int LDS_BYTES = O_END;
constexpr size_t WL_W2 = 0, WL_A2 = WL_W2 + 512 * 64, WL_G2 = WL_A2 + 512 * 64, WL_V1 = WL_G2 + 512 * 128, WL_V2 = WL_V1 + 32 * 512, WL_END = WL_V2 + 512 * 32;

struct Args {
    const bf16_t* p; const int* pos;
    const float *k_gain;
    const float *mu, *w0, *a0, *v0, *k_k, *k_a, *r_k;
    const bf16_t* wl;
    float *rs_q, *rs_kv; bf16_t* kr;
    bf16_t *R, *K, *V, *KK, *B, *G, *BON, *VFIRST; float* W; float *RIN, *BS;
};
__device__ __forceinline__ float4 ld4f(const float* p) { return *(const float4*)p; }
__device__ __forceinline__ void bf4(u32x2 w, float* o) { o[0] = lo_bf(w.x); o[1] = hi_bf(w.x); o[2] = lo_bf(w.y); o[3] = hi_bf(w.y); }
__device__ __forceinline__ u32x2 pk4(const float* v) { u32x2 w; w.x = cvt_pk_bf16(v[0], v[1]); w.y = cvt_pk_bf16(v[2], v[3]); return w; }

__device__ __forceinline__ void wave_store_bf16(LAS unsigned char* wb, const u32x2 (&v)[4], bf16_t* gbase, int r32, int hi, int lane) {
#pragma unroll
    for (int g = 0; g < 4; ++g) *(LAS u32x2*)(wb + r32 * 80 + 16 * g + 8 * hi) = v[g];
    asm volatile("" ::: "memory");
#pragma unroll
    for (int i = 0; i < 2; ++i) { const int tk_ = i * 16 + (lane >> 2); const u32x4 x = *(const LAS u32x4*)(wb + tk_ * 80 + (lane & 3) * 16);
        *(u32x4*)((char*)gbase + (size_t)tk_ * 1024 + (lane & 3) * 16) = x; }
    asm volatile("" ::: "memory");
}
__device__ __forceinline__ void wave_store_f32h(LAS unsigned char* wb, const f32x4 (&v)[2], float* gbase, int r32, int hi, int lane) {
#pragma unroll
    for (int j = 0; j < 2; ++j) *(LAS f32x4*)(wb + r32 * 80 + (8 * j + 4 * hi) * 4) = v[j];
    asm volatile("" ::: "memory");
#pragma unroll
    for (int i = 0; i < 2; ++i) { const int tk_ = i * 16 + (lane >> 2); const f32x4 x = *(const LAS f32x4*)(wb + tk_ * 80 + (lane & 3) * 16);
        *(f32x4*)((char*)gbase + (size_t)tk_ * 2048 + (lane & 3) * 16) = x; }
    asm volatile("" ::: "memory");
}
__device__ __forceinline__ void stage_params(const Args& A, LAS unsigned char* lds, int tid) {
    LAS float* P = (LAS float*)(lds + O_PAR);
    P[tid] = A.w0[tid]; P[512 + tid] = A.a0[tid]; P[1024 + tid] = A.v0[tid]; P[1536 + tid] = A.k_k[tid]; P[2048 + tid] = A.k_a[tid]; P[2560 + tid] = A.r_k[tid];
}
template <int LAYER>
__device__ __forceinline__ void tile(const Args& A, LAS unsigned char* lds, int tl, const int wv__, const int mode = 7) {
    const int tid = TID(), lane = tid & 63, wid = __builtin_amdgcn_readfirstlane(tid >> 6), r32 = lane & 31, hi = lane >> 5;
    const int tok0 = tl * PT;
    const bf16_t* p = A.p;
    if (mode & 1) {
        u32x2 k4v[4]; bf16_t krv[4]; int posv[4];
#pragma unroll
        for (int i = 0; i < 4; ++i) {
            const int tk = tok0 + wid + 8 * i; const bf16_t* pr = p + (size_t)tk * NP;
            k4v[i] = *(const u32x2*)(pr + C_MKV + lane * 4); krv[i] = pr[C_MKR + lane]; posv[i] = A.pos[tk];
        }
        const float kg = A.k_gain[128 + lane];
#pragma unroll
        for (int i = 0; i < 4; ++i) {
            const int tk = tok0 + wid + 8 * i;
            const u32x2 k4 = k4v[i];
            float sk = 0.f;
            { float a; a = lo_bf(k4.x); sk += a * a; a = hi_bf(k4.x); sk += a * a; a = lo_bf(k4.y); sk += a * a; a = hi_bf(k4.y); sk += a * a; }
            const float kr = bf2f(krv[i]);
            float skr = kr * kr;
            sk = wave_sum(sk); skr = wave_sum(skr);
            if (lane == 0) A.rs_kv[tk] = 1.f / sqrtf(sk * (1.f / 256.f) + RMS_EPS);
            const float krn = kr * (1.f / sqrtf(skr * (1.f / 64.f) + RMS_EPS)) * kg;
            const float other = xor32f(krn, lane);
            float c, s; rope_cs(posv[i], lane & 31, c, s);
            const float o = (lane < 32) ? (krn * c - other * s) : (krn * c + other * s);
            A.kr[(size_t)tk * 64 + lane] = f2bf(o);
        }
    }
    if (mode & 2) {
#pragma unroll 1
    for (int it = 0; it < 7; ++it) {
        u32x4 cu[2], pv[2]; f32x4 m0[2], m1[2]; int tt[2], jj[2];
#pragma unroll
        for (int u = 0; u < 2; ++u) {
            const int task = tid + (2 * it + u) * 512;
            const int t = task / 224, j = task - t * 224; tt[u] = t; jj[u] = j;
            const int tk = tok0 + t; const bool first = (tk & (SEQ - 1)) == 0;
            const bf16_t* pr = p + (size_t)tk * NP + C_RR + 8 * j;
            cu[u] = *(const u32x4*)pr;
            pv[u] = (u32x4){0u, 0u, 0u, 0u};
            if (!first) pv[u] = *(const u32x4*)(pr - NP);
            m0[u] = *(const f32x4*)(A.mu + 8 * j); m1[u] = *(const f32x4*)(A.mu + 8 * j + 4);
        }
#pragma unroll
        for (int u = 0; u < 2; ++u) {
            const int t = tt[u], j = jj[u];
            const float mu[8] = {m0[u].x, m0[u].y, m0[u].z, m0[u].w, m1[u].x, m1[u].y, m1[u].z, m1[u].w};
            const float c8[8] = {lo_bf(cu[u].x), hi_bf(cu[u].x), lo_bf(cu[u].y), hi_bf(cu[u].y), lo_bf(cu[u].z), hi_bf(cu[u].z), lo_bf(cu[u].w), hi_bf(cu[u].w)};
            const float p8[8] = {lo_bf(pv[u].x), hi_bf(pv[u].x), lo_bf(pv[u].y), hi_bf(pv[u].y), lo_bf(pv[u].z), hi_bf(pv[u].z), lo_bf(pv[u].w), hi_bf(pv[u].w)};
            float o[8];
#pragma unroll
            for (int i = 0; i < 8; ++i) o[i] = c8[i] + (p8[i] - c8[i]) * mu[i];
            if (j >= 192) {
#pragma unroll
                for (int i = 0; i < 8; ++i) { const float m = o[i]; const float e = fast_exp(j < 200 ? 2.f * m : -m); const float r = fast_rcp(e + 1.f);
                    o[i] = j < 200 ? 1.f - 2.f * r : (j < 208 ? m : r); }
            }
            u32x4 w; w.x = cvt_pk_bf16(o[0], o[1]); w.y = cvt_pk_bf16(o[2], o[3]); w.z = cvt_pk_bf16(o[4], o[5]); w.w = cvt_pk_bf16(o[6], o[7]);
            int off;
            if (j < 64) off = O_XR + t * S_VM + j * 16; else if (j < 128) off = O_XK + t * S_VM + (j - 64) * 16; else if (j < 192) off = O_VM + t * S_VM + (j - 128) * 16;
            else if (j < 200) off = O_XW + t * S_XW + (j - 192) * 16; else if (j < 208) off = O_XA + t * S_XW + (j - 200) * 16; else off = O_XG + t * S_XG + (j - 208) * 16;
            *(LAS u32x4*)(lds + off) = w;
        }
    }
    }
    __syncthreads();
    const int h = wid;
    unsigned wo64 = (unsigned)(r32 * 64 + hi * 8) * 2u, wo128 = (unsigned)(r32 * 128 + hi * 8) * 2u, wo32 = (unsigned)(r32 * 32 + hi * 8) * 2u, wo512 = (unsigned)(r32 * 512 + hi * 8) * 2u;
#define GLD8(base, off) (*(const bf16x8*)((const char*)(base) + (off)))
    const bf16_t* w2t = A.wl + WL_W2 + (size_t)(h * 64) * 64; const bf16_t* a2t = A.wl + WL_A2 + (size_t)(h * 64) * 64;
    const bf16_t* g2t = A.wl + WL_G2 + (size_t)(h * 64) * 128; const bf16_t* v2p = A.wl + WL_V2 + (size_t)(h * 64) * 32; const bf16_t* v1t = A.wl + WL_V1;
    if (mode & 4) {
        constexpr int nb = 0;
        asm volatile("" : "+v"(wo64), "+v"(wo128), "+v"(wo32), "+v"(wo512));
        const int trow = nb * 32 + r32;
        const int tk = tok0 + trow; const bool first = (tk & (SEQ - 1)) == 0;
        unsigned e512 = (unsigned)(trow * 512 + 4 * hi);
        asm volatile("" : "+v"(e512));
        const size_t t512 = (size_t)tok0 * 512;
#define CB (h * 64 + mb * 32 + 8 * g)
#define PL4(idx) (*(const LAS f32x4*)(lds + O_PAR + (idx) * 2048 + (CB + 4 * hi) * 4))
#define A2(ptr) ((char*)((ptr) + t512 + CB) + e512 * 2u)
#define A4(ptr) ((char*)((ptr) + t512 + CB) + e512 * 4u)
        bf16x8 vvf[2];
        if (LAYER > 0) {
            f32x16 vv = f32x16{};
#pragma unroll 16
            for (int ks = 0; ks < 32; ++ks) {
                const bf16x8 bv = *(const LAS bf16x8*)(lds + O_VM + trow * S_VM + (ks * 16 + hi * 8) * 2);
                const bf16x8 av = GLD8(v1t + ks * 16, wo512);
                vv = __builtin_amdgcn_mfma_f32_32x32x16_bf16(av, bv, vv, 0, 0, 0);
            }
#pragma unroll
            for (int s = 0; s < 2; ++s) {
                u32x4 bw; bw.x = cvt_pk_bf16(vv[8 * s + 0], vv[8 * s + 1]); bw.y = cvt_pk_bf16(vv[8 * s + 2], vv[8 * s + 3]); bw.z = cvt_pk_bf16(vv[8 * s + 4], vv[8 * s + 5]); bw.w = cvt_pk_bf16(vv[8 * s + 6], vv[8 * s + 7]);
                vvf[s] = __builtin_bit_cast(bf16x8, bw);
            }
        }
        float ss = 0.f, bs = 0.f;
#pragma unroll
        for (int mb = 0; mb < 2; ++mb) {
            f32x16 accW = f32x16{}, accA = f32x16{}, accG = f32x16{}, accV = f32x16{};
            u32x2 vfraw[4];
            if (LAYER > 0) {
#pragma unroll
                for (int g = 0; g < 4; ++g) vfraw[g] = *(const u32x2*)A2(A.VFIRST);
            }
#pragma unroll
            for (int ks = 0; ks < 4; ++ks) {
                const bf16x8 bw = *(const LAS bf16x8*)(lds + O_XW + trow * S_XW + (ks * 16 + hi * 8) * 2);
                const bf16x8 ba = *(const LAS bf16x8*)(lds + O_XA + trow * S_XW + (ks * 16 + hi * 8) * 2);
                const bf16x8 aw = GLD8(w2t + mb * 32 * 64 + ks * 16, wo64);
                const bf16x8 aa = GLD8(a2t + mb * 32 * 64 + ks * 16, wo64);
                accW = __builtin_amdgcn_mfma_f32_32x32x16_bf16(aw, bw, accW, 0, 0, 0);
                accA = __builtin_amdgcn_mfma_f32_32x32x16_bf16(aa, ba, accA, 0, 0, 0);
            }
#pragma unroll
            for (int ks = 0; ks < 8; ++ks) {
                const bf16x8 bg = *(const LAS bf16x8*)(lds + O_XG + trow * S_XG + (ks * 16 + hi * 8) * 2);
                const bf16x8 ag = GLD8(g2t + mb * 32 * 128 + ks * 16, wo128);
                accG = __builtin_amdgcn_mfma_f32_32x32x16_bf16(ag, bg, accG, 0, 0, 0);
            }
            if (LAYER > 0) {
#pragma unroll
                for (int s = 0; s < 2; ++s) {
                    const bf16x8 a2 = GLD8(v2p + mb * 32 * 32 + s * 16, wo32);
                    accV = __builtin_amdgcn_mfma_f32_32x32x16_bf16(a2, vvf[s], accV, 0, 0, 0);
                }
            }
            asm volatile("" ::: "memory");
            f32x4 oW[4]; u32x2 oG[4], oV[4], oR[4], oK[4], oKK[4], oB[4];
#pragma unroll
            for (int g = 0; g < 4; ++g) {
                const f32x4 w0 = PL4(0), a0 = PL4(1);
                const float w0a[4] = {w0.x, w0.y, w0.z, w0.w}, a0a[4] = {a0.x, a0.y, a0.z, a0.w};
                float dec[4], gt[4], av[4];
#pragma unroll
                for (int i = 0; i < 4; ++i) {
                    dec[i] = fast_exp(-0.6065306597126334f * sigmoidf_(accW[4 * g + i] + w0a[i]));
                    gt[i] = accG[4 * g + i];
                    av[i] = sigmoidf_(accA[4 * g + i] + a0a[i]);
                }
                oW[g] = (f32x4){dec[0], dec[1], dec[2], dec[3]};
                oG[g] = pk4(gt);
                float vm[4]; bf4(*(const LAS u32x2*)(lds + O_VM + trow * S_VM + (CB + 4 * hi) * 2), vm);
                float vf[4];
                if (LAYER > 0) {
                    const f32x4 v0 = PL4(2); const float v0a[4] = {v0.x, v0.y, v0.z, v0.w};
                    float vfi[4]; bf4(vfraw[g], vfi);
#pragma unroll
                    for (int i = 0; i < 4; ++i) vf[i] = vm[i] + (vfi[i] - vm[i]) * sigmoidf_(accV[4 * g + i] + v0a[i]);
                } else {
#pragma unroll
                    for (int i = 0; i < 4; ++i) vf[i] = vm[i];
                }
                oV[g] = pk4(vf);
                float xr[4], xk4[4];
                const u32x2 xrraw = *(const LAS u32x2*)(lds + O_XR + trow * S_VM + (CB + 4 * hi) * 2);
                bf4(xrraw, xr); bf4(*(const LAS u32x2*)(lds + O_XK + trow * S_VM + (CB + 4 * hi) * 2), xk4);
                const f32x4 kk4 = PL4(3), ka4 = PL4(4), rk4 = PL4(5);
                const float kka[4] = {kk4.x, kk4.y, kk4.z, kk4.w}, kaa[4] = {ka4.x, ka4.y, ka4.z, ka4.w}, rka[4] = {rk4.x, rk4.y, rk4.z, rk4.w};
                float k2[4], kkv[4], bn[4];
#pragma unroll
                for (int i = 0; i < 4; ++i) {
                    const float xk = xk4[i];
                    kkv[i] = xk * kka[i];
                    ss += kkv[i] * kkv[i];
                    k2[i] = xk * (1.f + (av[i] - 1.f) * kaa[i]);
                    bs += xr[i] * k2[i] * rka[i];
                    bn[i] = -kkv[i] * av[i];
                }
                oR[g] = xrraw; oK[g] = pk4(k2); oKK[g] = pk4(kkv); oB[g] = pk4(bn);
            }
#ifdef TOKPROBE
            if (mode & 8) { unsigned cs = 0u;
#pragma unroll
              for (int g = 0; g < 4; ++g) cs ^= oG[g].x ^ oG[g].y ^ oV[g].x ^ oV[g].y ^ oR[g].x ^ oR[g].y ^ oK[g].x ^ oK[g].y ^ oKK[g].x ^ oKK[g].y ^ oB[g].x ^ oB[g].y ^ __float_as_uint(oW[g].x) ^ __float_as_uint(oW[g].y) ^ __float_as_uint(oW[g].z) ^ __float_as_uint(oW[g].w);
              if (cs == 0x12345679u) A.G[(size_t)tok0 * 512 + lane] = 1; } else
#endif
            { LAS unsigned char* wb = lds + O_WB + wid * 2560;
              const size_t eb = (size_t)tok0 * 512 + h * 64 + mb * 32;
              wave_store_bf16(wb, oG, A.G + eb, r32, hi, lane);
              wave_store_bf16(wb, oV, A.V + eb, r32, hi, lane);
              if (LAYER == 0) wave_store_bf16(wb, oV, A.VFIRST + eb, r32, hi, lane);
              wave_store_bf16(wb, oR, A.R + eb, r32, hi, lane);
              wave_store_bf16(wb, oK, A.K + eb, r32, hi, lane);
              wave_store_bf16(wb, oKK, A.KK + eb, r32, hi, lane);
              wave_store_bf16(wb, oB, A.B + eb, r32, hi, lane);
              { const f32x4 w01[2] = {oW[0], oW[1]}, w23[2] = {oW[2], oW[3]};
                wave_store_f32h(wb, w01, A.W + eb, r32, hi, lane); wave_store_f32h(wb, w23, A.W + eb + 16, r32, hi, lane); } }
        }
        { auto r0 = __builtin_amdgcn_permlane32_swap(__float_as_uint(ss), __float_as_uint(ss), false, false); ss = __uint_as_float(r0[0]) + __uint_as_float(r0[1]);
          auto r1 = __builtin_amdgcn_permlane32_swap(__float_as_uint(bs), __float_as_uint(bs), false, false); bs = __uint_as_float(r1[0]) + __uint_as_float(r1[1]); }
        if (hi == 0) { A.RIN[(size_t)tk * 8 + h] = 1.f / fmaxf(sqrtf(ss), 1e-12f); A.BS[(size_t)tk * 8 + h] = bs; }
    }
#undef CB
#undef PL4
#undef A2
#undef A4
#undef GLD8
    __syncthreads();
}
__device__ __forceinline__ void lora_prep(const float* w2, const float* a2, const float* g2, const float* v1, const float* v2, bf16_t* wl, int gtid, int nthr) {
    for (int i = gtid; i < 512 * 64; i += nthr) { const int n = i >> 6, k = i & 63; wl[WL_W2 + i] = f2bf(w2[k * 512 + n]); wl[WL_A2 + i] = f2bf(a2[k * 512 + n]); }
    for (int i = gtid; i < 512 * 128; i += nthr) { const int n = i >> 7, k = i & 127; wl[WL_G2 + i] = f2bf(g2[k * 512 + n]); }
    if (v1) {
        for (int i = gtid; i < 32 * 512; i += nthr) { const int j = i >> 9, k = i & 511; wl[WL_V1 + i] = f2bf(v1[k * 32 + j]); }
        for (int i = gtid; i < 512 * 32; i += nthr) { const int n = i >> 5, q = i & 31, s = q >> 4, hh = (q >> 3) & 1, jj = q & 7;
            const int kidx = 16 * s + 8 * (jj >> 2) + 4 * hh + (jj & 3); wl[WL_V2 + i] = f2bf(v2[kidx * 512 + n]); }
    }
}
}
struct Ptrs {
    const float* in[30]; float* out; unsigned char* ws;
};
#ifdef NT_W
#define CV_LD(p) __builtin_nontemporal_load(p)
#else
#define CV_LD(p) (*(p))
#endif
__device__ __forceinline__ void transpose_item(const float* W, int K, int N, bf16_t* WT, const float* gain, int mode, LAS float* scr, int item, int lane) {
    const int nblk = N / 64, kb = item / nblk, nb = item % nblk, k0 = 64 * kb, n0 = 64 * nb;
#pragma unroll 64
    for (int kk = 0; kk < 64; ++kk) { const float g = gain ? gain[k0 + kk] : 1.f; scr[kk * 65 + lane] = CV_LD(&W[(size_t)(k0 + kk) * N + n0 + lane]) * g; }
    asm volatile("s_waitcnt lgkmcnt(0)" ::: "memory");
    const int c = lane & 7;
#pragma unroll
    for (int j = 0; j < 8; ++j) { const int n = (lane >> 3) + 8 * j; const LAS float* s = scr + (8 * c) * 65 + n;
        u32x4 o; o.x = cvt_pk_bf16(s[0 * 65], s[1 * 65]); o.y = cvt_pk_bf16(s[2 * 65], s[3 * 65]); o.z = cvt_pk_bf16(s[4 * 65], s[5 * 65]); o.w = cvt_pk_bf16(s[6 * 65], s[7 * 65]);
        const int ng = n0 + n; int drow = ng;
        if (mode == 1) { if (ng < FF) drow = 256 * (ng >> 7) + (ng & 127); else { const int f = ng - FF; drow = 256 * (f >> 7) + 128 + (f & 127); } }
        *(u32x4*)(WT + (size_t)drow * K + k0 + 8 * c) = o; }
    asm volatile("s_waitcnt lgkmcnt(0)" ::: "memory");
}
typedef const Ptrs __attribute__((address_space(4)))* PtrTab;
constexpr int CV_IN = (DM / 64) * (INW / 64), CV_QB = (512 / 64) * (QW / 64), CV_KVB = (256 / 64) * (KVW / 64), CV_O = (DM / 64) * (DM / 64),
              CV_GU = (DM / 64) * (2 * FF / 64), CV_DN = (FF / 64) * (DM / 64);
constexpr int CV_NI = CV_IN + CV_QB + CV_KVB + CV_O + CV_GU + CV_DN;
__device__ __forceinline__ void convert_wave_item(PtrTab pt, int l, int it, LAS float* scr, int lane) {
    unsigned char* wl = pt->ws + WS_W + (size_t)l * W_LAYER;
    int r = it;
    if (r < CV_IN) { transpose_item(pt->in[3] + (size_t)l * DM * INW, DM, INW, (bf16_t*)(wl + WO_IN), pt->in[2] + l * DM, 0, scr, r, lane); return; } r -= CV_IN;
    if (r < CV_QB) { transpose_item(pt->in[7] + (size_t)l * 512 * QW, 512, QW, (bf16_t*)(wl + WO_QB), pt->in[6] + l * 512, 0, scr, r, lane); return; } r -= CV_QB;
    if (r < CV_KVB) { transpose_item(pt->in[9] + (size_t)l * 256 * KVW, 256, KVW, (bf16_t*)(wl + WO_KVB), pt->in[8] + l * 256, 0, scr, r, lane); return; } r -= CV_KVB;
    if (r < CV_O) { transpose_item(pt->in[26] + (size_t)l * DM * DM, DM, DM, (bf16_t*)(wl + WO_O), nullptr, 0, scr, r, lane); return; } r -= CV_O;
    if (r < CV_GU) { transpose_item(pt->in[28] + (size_t)l * DM * 2 * FF, DM, 2 * FF, (bf16_t*)(wl + WO_GU), pt->in[27] + l * DM, 1, scr, r, lane); return; } r -= CV_GU;
    transpose_item(pt->in[29] + (size_t)l * FF * DM, FF, DM, (bf16_t*)(wl + WO_DN), nullptr, 0, scr, r, lane);
}
struct TrJob { const float* W; bf16_t* WT; const float* gain; int K, N, mode, item; };
__device__ __forceinline__ TrJob tr_job(PtrTab pt, int l, int it) {
    unsigned char* wl = pt->ws + WS_W + (size_t)l * W_LAYER;
    int r = it;
    if (r < CV_IN) return TrJob{pt->in[3] + (size_t)l * DM * INW, (bf16_t*)(wl + WO_IN), pt->in[2] + l * DM, DM, INW, 0, r}; r -= CV_IN;
    if (r < CV_QB) return TrJob{pt->in[7] + (size_t)l * 512 * QW, (bf16_t*)(wl + WO_QB), pt->in[6] + l * 512, 512, QW, 0, r}; r -= CV_QB;
    if (r < CV_KVB) return TrJob{pt->in[9] + (size_t)l * 256 * KVW, (bf16_t*)(wl + WO_KVB), pt->in[8] + l * 256, 256, KVW, 0, r}; r -= CV_KVB;
    if (r < CV_O) return TrJob{pt->in[26] + (size_t)l * DM * DM, (bf16_t*)(wl + WO_O), nullptr, DM, DM, 0, r}; r -= CV_O;
    if (r < CV_GU) return TrJob{pt->in[28] + (size_t)l * DM * 2 * FF, (bf16_t*)(wl + WO_GU), pt->in[27] + l * DM, DM, 2 * FF, 1, r}; r -= CV_GU;
    return TrJob{pt->in[29] + (size_t)l * FF * DM, (bf16_t*)(wl + WO_DN), nullptr, FF, DM, 0, r};
}
__device__ __forceinline__ void tr_load(float (&v)[64], const TrJob& j, int lane) {
    const int nblk = j.N / 64, kb = j.item / nblk, nb = j.item % nblk;
    const float* src = j.W + (size_t)(64 * kb) * j.N + 64 * nb + lane;
#pragma unroll
    for (int kk = 0; kk < 64; ++kk) v[kk] = src[(size_t)kk * j.N];
}
__device__ __forceinline__ void tr_finish(const float (&v)[64], const TrJob& j, LAS float* scr, int lane) {
    const int nblk = j.N / 64, kb = j.item / nblk, nb = j.item % nblk, k0 = 64 * kb, n0 = 64 * nb;
#pragma unroll
    for (int kk = 0; kk < 64; ++kk) { const float g = j.gain ? j.gain[k0 + kk] : 1.f; scr[kk * 65 + lane] = v[kk] * g; }
    asm volatile("s_waitcnt lgkmcnt(0)" ::: "memory");
    const int c = lane & 7;
#pragma unroll
    for (int q = 0; q < 8; ++q) { const int n = (lane >> 3) + 8 * q; const LAS float* s = scr + (8 * c) * 65 + n;
        u32x4 o; o.x = cvt_pk_bf16(s[0 * 65], s[1 * 65]); o.y = cvt_pk_bf16(s[2 * 65], s[3 * 65]); o.z = cvt_pk_bf16(s[4 * 65], s[5 * 65]); o.w = cvt_pk_bf16(s[6 * 65], s[7 * 65]);
        const int ng = n0 + n; int drow = ng;
        if (j.mode == 1) { if (ng < FF) drow = 256 * (ng >> 7) + (ng & 127); else { const int f = ng - FF; drow = 256 * (f >> 7) + 128 + (f & 127); } }
        *(u32x4*)(j.WT + (size_t)drow * j.K + k0 + 8 * c) = o; }
    asm volatile("s_waitcnt lgkmcnt(0)" ::: "memory");
}
__device__ __forceinline__ void convert_seq(PtrTab pt, int l, int it0, int stride, int n, LAS float* scr, int lane) {
    if (n <= 0) return;
    float a[64], b[64];
    TrJob ja = tr_job(pt, l, it0), jb = ja;
    tr_load(a, ja, lane);
    int i = 1;
    for (;;) {
        if (i < n) { jb = tr_job(pt, l, it0 + i * stride); tr_load(b, jb, lane); }
        tr_finish(a, ja, scr, lane);
        if (i >= n) break;
        ++i;
        if (i < n) { ja = tr_job(pt, l, it0 + i * stride); tr_load(a, ja, lane); }
        tr_finish(b, jb, scr, lane);
        if (i >= n) break;
        ++i;
    }
}
__device__ __forceinline__ void convert_misc(PtrTab pt, int l, int gtid, int nthr) {
    unsigned char* wl = pt->ws + WS_W + (size_t)l * W_LAYER;
    { u32x4* z = (u32x4*)(wl + WO_IN + (size_t)INW * DM * 2); const int n16 = (NP - INW) * DM * 2 / 16;
      for (int i = gtid; i < n16; i += nthr) z[i] = (u32x4){0u, 0u, 0u, 0u}; }
    tok::lora_prep(pt->in[14] + (size_t)l * 64 * 512, pt->in[16] + (size_t)l * 64 * 512, pt->in[17] + (size_t)l * 128 * 512,
                   l > 0 ? pt->in[19] + (size_t)(l - 1) * 512 * 32 : nullptr, l > 0 ? pt->in[20] + (size_t)(l - 1) * 32 * 512 : nullptr,
                   (bf16_t*)(wl + WO_LORA), gtid, nthr);
}
constexpr int CV_TI = (CV_NI + 63) / 64, CV_MISC = 8, CV_ITEMS = CV_TI + CV_MISC;
constexpr int CV_EARLY = CV_IN + CV_QB + CV_KVB;
constexpr int CV_LATE0 = (CV_NI - CV_EARLY + 63) / 64;
__device__ __forceinline__ void convert_queue_item(PtrTab pt, int l, int ci, LAS float* scr, int wid, int lane) {
    asm volatile("" : "+s"(pt));
    if (ci < CV_TI) {
        { const int it0 = ci * 64 + wid; int n = (CV_NI - it0 + 7) / 8; n = n > 8 ? 8 : n; convert_seq(pt, l, it0, 8, n, scr, lane); }
    } else if (ci < CV_ITEMS) convert_misc(pt, l, (ci - CV_TI) * 512 + wid * 64 + lane, CV_MISC * 512);
    else { for (int k = 0; k < 8; ++k) { const int it = CV_EARLY + (ci - CV_ITEMS) * 64 + k * 8 + wid; if (it < CV_NI) convert_wave_item(pt, 0, it, scr, lane); } }
}
__device__ __forceinline__ void prologue_phase(PtrTab pt, LAS float* scr, int gw, int ngw, int lane) {
#ifdef CONV_IN_MIXERS
    convert_seq(pt, 0, gw, ngw, (CV_NI - gw + ngw - 1) / ngw, scr, lane);
    convert_misc(pt, 0, gw * 64 + lane, ngw * 64);
#else
    for (int l = 0; l < DEPTH; ++l) {
        for (int it = gw; it < CV_NI; it += ngw) convert_wave_item(pt, l, it, scr, lane);
        convert_misc(pt, l, gw * 64 + lane, ngw * 64);
    }
#endif
    const float* x_in = pt->in[0]; const float* hb_in = pt->in[4]; unsigned char* ws_ = pt->ws;
    { bf16_t* xb = (bf16_t*)(ws_ + WS_XB); float* ssa = (float*)(ws_ + WS_SSA);
      for (int m0 = gw; m0 < T; m0 += 2 * ngw) {
        f32x4 v[2][8];
#pragma unroll
        for (int u = 0; u < 2; ++u) { const f32x4* xr = (const f32x4*)(x_in + (size_t)(m0 + u * ngw) * DM) + lane;
#pragma unroll
          for (int j = 0; j < 8; ++j) v[u][j] = xr[64 * j]; }
#pragma unroll
        for (int u = 0; u < 2; ++u) {
          const int m = m0 + u * ngw; float s = 0.f;
#pragma unroll
          for (int j = 0; j < 8; ++j) s += (v[u][j].x * v[u][j].x + v[u][j].y * v[u][j].y) + (v[u][j].z * v[u][j].z + v[u][j].w * v[u][j].w);
          s = wave_sum(s);
          if (lane < 32) ssa[(size_t)m * 32 + lane] = lane == 0 ? s : 0.f;
          u32x2* o = (u32x2*)(xb + (size_t)m * DM) + lane;
#pragma unroll
          for (int j = 0; j < 8; ++j) { u32x2 w; w.x = cvt_pk_bf16(v[u][j].x, v[u][j].y); w.y = cvt_pk_bf16(v[u][j].z, v[u][j].w); o[64 * j] = w; }
        }
      } }
    { float* lb = (float*)(ws_ + WS_LB); const float* hb = hb_in;
      for (int c = gw * 64 + lane; c < 512; c += ngw * 64) {
          float v[DEPTH], mx = -1e30f, s = 0.f;
          for (int l = 0; l < DEPTH; ++l) { v[l] = hb[l * 512 + c]; mx = fmaxf(mx, v[l]); }
          for (int l = 0; l < DEPTH; ++l) { v[l] = expf(v[l] - mx); s += v[l]; }
          float cum = 0.f; const float inv = 1.f / s;
          for (int l = 0; l < DEPTH; ++l) { cum += v[l] * inv; lb[l * 512 + c] = cum - v[0] * inv; }
      } }
}

__device__ __forceinline__ void rownorm_phase(const float* x, bf16_t* xb, float* rs, int gw, int ngw, int lane) {
    for (int m = gw; m < T; m += ngw) {
        const f32x4* xr = (const f32x4*)(x + (size_t)m * DM) + lane;
        f32x4 v[8]; float s = 0.f;
#pragma unroll
        for (int j = 0; j < 8; ++j) { v[j] = xr[64 * j]; s += (v[j].x * v[j].x + v[j].y * v[j].y) + (v[j].z * v[j].z + v[j].w * v[j].w); }
        s = wave_sum(s);
        if (lane == 0) rs[m] = 1.f / sqrtf(s * (1.f / DM) + RMS_EPS);
        u32x2* o = (u32x2*)(xb + (size_t)m * DM) + lane;
#pragma unroll
        for (int j = 0; j < 8; ++j) { u32x2 w; w.x = cvt_pk_bf16(v[j].x, v[j].y); w.y = cvt_pk_bf16(v[j].z, v[j].w); o[64 * j] = w; }
    }
}

__device__ __forceinline__ void qknorm_phase(bf16_t* q, bf16_t* kv, const int* pos, const float* q_gain, const float* k_gain, int gw, int ngw, int lane, bf16_t* qo = nullptr, bf16_t* kvo = nullptr) {
    if (!qo) { qo = q; kvo = kv; }
    const float gk0 = k_gain[2 * lane], gk1 = k_gain[2 * lane + 1];
#pragma unroll 2
    for (int tk = gw; tk < T; tk += ngw) {
        bf16_t* qrow = q + (size_t)tk * QW; bf16_t* krow = kv + (size_t)tk * KVW; bf16_t* qorow = qo + (size_t)tk * QW; bf16_t* korow = kvo + (size_t)tk * KVW;
#pragma unroll
        for (int h = 0; h < 8; ++h) {
            const unsigned kn = *(const unsigned*)(krow + h * 256 + 2 * lane);
            const float b0 = lo_bf(kn), b1 = hi_bf(kn);
            const float sk = wave_sum(b0 * b0 + b1 * b1);
            const float rk = 1.f / sqrtf(sk * (1.f / 128.f) + RMS_EPS);
            *(unsigned*)(korow + h * 256 + 2 * lane) = cvt_pk_bf16(b0 * rk * gk0, b1 * rk * gk1);
        }
    }
}
namespace rwk {
constexpr int TC = 64;
constexpr int NCH = SEQ / TC;
constexpr int N_ITEMS = BATCH * 8 * 2;
constexpr int OPS = 320;
constexpr int VS = TC + 4;
constexpr int L_KK = 0, L_W = 64, L_BN = 128, L_KP = 192, L_R = 256, L_V = TC * OPS, L_Y = L_V + 32 * VS, L_DUM = L_Y + 32 * VS, L_END = L_DUM + 512 * 4;
constexpr int LDS_BYTES = L_END * 4;
struct Args { const bf16_t *R, *K, *KK, *B; bf16_t* V; const float* W; const float* RIN; bf16_t* Yout; };

__device__ __forceinline__ float dpp_xor1(float x) { return __int_as_float(__builtin_amdgcn_update_dpp(0, __float_as_int(x), 0xB1, 0xf, 0xf, true)); }
__device__ __forceinline__ float dpp_xor2(float x) { return __int_as_float(__builtin_amdgcn_update_dpp(0, __float_as_int(x), 0x4E, 0xf, 0xf, true)); }
__device__ __forceinline__ float dpp_hmir(float x) { return __int_as_float(__builtin_amdgcn_update_dpp(0, __float_as_int(x), 0x141, 0xf, 0xf, true)); }
__device__ __forceinline__ float red8(float x) { x += dpp_xor1(x); x += dpp_xor2(x); x += dpp_hmir(x); return x; }

struct Pre { u32x4 r, k, v, kk, b; f32x4 w0, w1; float rin; };
__device__ __forceinline__ void pre_load(Pre& q, const Args& A, size_t off, bool hasv) {
    q.r = *(const u32x4*)(A.R + off); q.k = *(const u32x4*)(A.K + off); q.kk = *(const u32x4*)(A.KK + off); q.b = *(const u32x4*)(A.B + off);
    if (hasv) q.v = *(const u32x4*)(A.V + off);
    q.w0 = *(const f32x4*)(A.W + off); q.w1 = *(const f32x4*)(A.W + off + 4);
    q.rin = A.RIN[(off >> 9) * 8 + ((off >> 6) & 7)];
}
__device__ __forceinline__ void st8(LAS float* d, u32x4 w, float sc = 1.f) {
    *(LAS f32x4*)d = (f32x4){lo_bf(w.x) * sc, hi_bf(w.x) * sc, lo_bf(w.y) * sc, hi_bf(w.y) * sc}; *(LAS f32x4*)(d + 4) = (f32x4){lo_bf(w.z) * sc, hi_bf(w.z) * sc, lo_bf(w.w) * sc, hi_bf(w.w) * sc};
}

template <int VAR = 0>
__device__ __forceinline__ void item(const Args& A, LAS float* lds, int it, const int wv__) {
    const int tid = TID(), bh = it >> 1, half = it & 1, b = bh >> 3, h = bh & 7;
    const int st = tid >> 3, sc8 = (tid & 7) * 8;
    const bool hasv = ((tid & 7) >> 2) == half;
    const int vc8 = sc8 - half * 32;
    const size_t base = (size_t)b * SEQ * 512 + h * 64;
    const int row = tid >> 3, kp = tid & 7;
    f32x2 s0[4];
#pragma unroll
    for (int i = 0; i < 4; ++i) s0[i] = (f32x2){0.f, 0.f};
    Pre pre; pre_load(pre, A, base + (size_t)st * 512 + sc8, hasv);
    for (int ck = 0; ck < NCH; ++ck) {
        { const int o = st * OPS + sc8;
          st8(lds + L_R + o, pre.r); st8(lds + L_KP + o, pre.k); st8(lds + L_KK + o, pre.kk, pre.rin); st8(lds + L_BN + o, pre.b, pre.rin);
          *(LAS f32x4*)(lds + L_W + o) = pre.w0; *(LAS f32x4*)(lds + L_W + o + 4) = pre.w1;
          if (hasv) { LAS float* vd = lds + L_V + vc8 * VS + st;
            vd[0 * VS] = lo_bf(pre.v.x); vd[1 * VS] = hi_bf(pre.v.x); vd[2 * VS] = lo_bf(pre.v.y); vd[3 * VS] = hi_bf(pre.v.y);
            vd[4 * VS] = lo_bf(pre.v.z); vd[5 * VS] = hi_bf(pre.v.z); vd[6 * VS] = lo_bf(pre.v.w); vd[7 * VS] = hi_bf(pre.v.w); } }
        __syncthreads();
        if (ck + 1 < NCH) pre_load(pre, A, base + (size_t)((ck + 1) * TC + st) * 512 + sc8, hasv);
        if (tid < 256) {
            const LAS float* pk = lds + 8 * kp;
            const LAS float* pv = lds + L_V + row * VS;
            LAS float* pyw = kp == 0 ? lds + L_Y + row * VS : lds + L_DUM + tid * 4;
            const int pyinc = kp == 0 ? 4 : 0;
#define RW_LOAD(P, t_) do { const LAS float* q_ = pk + (t_) * OPS; \
                P##kk0 = *(const LAS f32x4*)(q_ + L_KK); P##kk1 = *(const LAS f32x4*)(q_ + L_KK + 4); \
                P##w0 = *(const LAS f32x4*)(q_ + L_W); P##w1 = *(const LAS f32x4*)(q_ + L_W + 4); \
                P##b0 = *(const LAS f32x4*)(q_ + L_BN); P##b1 = *(const LAS f32x4*)(q_ + L_BN + 4); \
                P##k0 = *(const LAS f32x4*)(q_ + L_KP); P##k1 = *(const LAS f32x4*)(q_ + L_KP + 4); \
                P##r0 = *(const LAS f32x4*)(q_ + L_R); P##r1 = *(const LAS f32x4*)(q_ + L_R + 4); } while (0)
#define F2(v4, i) ((f32x2){(v4)[2 * (i)], (v4)[2 * (i) + 1]})
#define RW_DOT(S, A0, A1) ({ f32x2 p_ = S[0] * F2(A0, 0); p_ = __builtin_elementwise_fma(S[1], F2(A0, 1), p_); p_ = __builtin_elementwise_fma(S[2], F2(A1, 0), p_); p_ = __builtin_elementwise_fma(S[3], F2(A1, 1), p_); p_.x + p_.y; })
#define RW_STEP(P, v_, yo_) do { \
                float sa0 = RW_DOT(s0, P##kk0, P##kk1); \
                const f32x2 va = (f32x2){v_, v_}; \
                f32x2 ta[4]; \
                ta[0] = va * F2(P##k0, 0); ta[1] = va * F2(P##k0, 1); ta[2] = va * F2(P##k1, 0); ta[3] = va * F2(P##k1, 1); \
                sa0 = red8(sa0); \
                const f32x2 sA = (f32x2){sa0, sa0}; \
                ta[0] = __builtin_elementwise_fma(sA, F2(P##b0, 0), ta[0]); ta[1] = __builtin_elementwise_fma(sA, F2(P##b0, 1), ta[1]); \
                ta[2] = __builtin_elementwise_fma(sA, F2(P##b1, 0), ta[2]); ta[3] = __builtin_elementwise_fma(sA, F2(P##b1, 1), ta[3]); \
                s0[0] = __builtin_elementwise_fma(s0[0], F2(P##w0, 0), ta[0]); s0[1] = __builtin_elementwise_fma(s0[1], F2(P##w0, 1), ta[1]); \
                s0[2] = __builtin_elementwise_fma(s0[2], F2(P##w1, 0), ta[2]); s0[3] = __builtin_elementwise_fma(s0[3], F2(P##w1, 1), ta[3]); \
                float y0 = RW_DOT(s0, P##r0, P##r1); \
                yo_ = red8(y0); } while (0)
            f32x4 Akk0, Akk1, Aw0, Aw1, Ab0, Ab1, Ak0, Ak1, Ar0, Ar1;
            f32x4 Bkk0, Bkk1, Bw0, Bw1, Bb0, Bb1, Bk0, Bk1, Br0, Br1;
            RW_LOAD(A, 0);
            f32x4 v4 = *(const LAS f32x4*)pv;
#pragma unroll 1
            for (int t = 0; t < TC; t += 4) {
                const f32x4 vn = *(const LAS f32x4*)(pv + t + 4);
                f32x4 y4;
                RW_LOAD(B, t + 1); RW_STEP(A, v4.x, y4.x);
                RW_LOAD(A, t + 2); RW_STEP(B, v4.y, y4.y);
                RW_LOAD(B, t + 3); RW_STEP(A, v4.z, y4.z);
                RW_LOAD(A, t + 4); RW_STEP(B, v4.w, y4.w);
                *(LAS f32x4*)pyw = y4; pyw += pyinc;
                v4 = vn;
            }
#undef RW_LOAD
#undef RW_DOT
#undef RW_STEP
#undef F2
        }
        __syncthreads();
        if (tid >= 256) {
            const int t = (tid - 256) >> 2, c8 = (tid & 3) * 8;
            const LAS float* yr = lds + L_Y + c8 * VS + t;
            u32x4 w; w.x = cvt_pk_bf16(yr[0 * VS], yr[1 * VS]); w.y = cvt_pk_bf16(yr[2 * VS], yr[3 * VS]); w.z = cvt_pk_bf16(yr[4 * VS], yr[5 * VS]); w.w = cvt_pk_bf16(yr[6 * VS], yr[7 * VS]);
            *(u32x4*)(A.Yout + base + (size_t)(ck * TC + t) * 512 + half * 32 + c8) = w;
        }
    }
    __syncthreads();
}

struct PostArgs { const bf16_t *Y, *G, *BON; const float *ln_w, *ln_b, *BS; bf16_t* mixed; };
__device__ __forceinline__ void post_phase(const PostArgs& A, int gw, int ngw, int lane) {
    float lnw[8], lnb[8];
#pragma unroll
    for (int i = 0; i < 8; ++i) { lnw[i] = A.ln_w[lane * 8 + i]; lnb[i] = A.ln_b[lane * 8 + i]; }
    for (int tk = gw; tk < T; tk += ngw) {
        const size_t o = (size_t)tk * 512 + lane * 8;
        const u32x4 y4 = *(const u32x4*)(A.Y + o), g4 = *(const u32x4*)(A.G + o), b4 = *(const u32x4*)(A.BON + o);
        float y[8] = {lo_bf(y4.x), hi_bf(y4.x), lo_bf(y4.y), hi_bf(y4.y), lo_bf(y4.z), hi_bf(y4.z), lo_bf(y4.w), hi_bf(y4.w)};
        const float g[8] = {lo_bf(g4.x), hi_bf(g4.x), lo_bf(g4.y), hi_bf(g4.y), lo_bf(g4.z), hi_bf(g4.z), lo_bf(g4.w), hi_bf(g4.w)};
        const float bo[8] = {lo_bf(b4.x), hi_bf(b4.x), lo_bf(b4.y), hi_bf(b4.y), lo_bf(b4.z), hi_bf(b4.z), lo_bf(b4.w), hi_bf(b4.w)};
        const float bsc = A.BS[(size_t)tk * 8 + (lane >> 3)];
        float sm = 0.f;
#pragma unroll
        for (int i = 0; i < 8; ++i) sm += y[i];
        sm = red8(sm); const float mean = sm * (1.f / 64.f);
        float sv = 0.f;
#pragma unroll
        for (int i = 0; i < 8; ++i) { y[i] -= mean; sv += y[i] * y[i]; }
        sv = red8(sv); const float rstd = 1.f / sqrtf(sv * (1.f / 64.f) + 64e-5f);
        float ov[8];
#pragma unroll
        for (int i = 0; i < 8; ++i) ov[i] = (y[i] * rstd * lnw[i] + lnb[i] + bsc * bo[i]) * g[i];
        u32x4 w; w.x = cvt_pk_bf16(ov[0], ov[1]); w.y = cvt_pk_bf16(ov[2], ov[3]); w.z = cvt_pk_bf16(ov[4], ov[5]); w.w = cvt_pk_bf16(ov[6], ov[7]);
        *(u32x4*)(A.mixed + (size_t)tk * DM + 1536 + lane * 8) = w;
    }
}
}
namespace rwc {
constexpr int TB = 32;
constexpr int NB = SEQ / TB;
constexpr int OPS = 320;
constexpr int L_KK = 0, L_W = 64, L_BN = 128, L_KP = 192, L_R = 256;
constexpr int O_RAW = 0;
constexpr int O_VT = O_RAW + TB * OPS * 4;
constexpr int VT_ROW = 40, VT_BUF = 2 * 64 * VT_ROW;
constexpr int O_IMG = O_VT + 2 * VT_BUF;
constexpr int RS = 144;
constexpr int I_A = 0, I_R = I_A + 16 * RS, I_B = I_R + 16 * RS, I_K = I_B + 16 * RS, I_BKT = I_K + 16 * RS;
constexpr int SR = 80;
constexpr int I_LAK = I_BKT + 64 * SR, I_TP = I_LAK + 16 * SR, I_MM = I_TP + 16 * SR, I_GC = I_MM + 16 * SR, I_LAB = I_GC + 256, IMG_BYTES = I_LAB + 16 * SR;
constexpr int O_YB = O_IMG + 2 * IMG_BYTES;
constexpr int LDS_BYTES = O_YB + TB * 64 * 4;
struct Args { const bf16_t *R, *K, *KK, *B, *V; const float* W; const float* RIN; const bf16_t* G; const float *BS, *ln_w, *ln_b; bf16_t* mixed; };
typedef unsigned short u16;

struct Pre { u32x2 r, k, kk, b, v; f32x4 w; float rin; };
__device__ __forceinline__ void pre_load(Pre& q, const Args& A, size_t off) {
    q.r = *(const u32x2*)(A.R + off); q.k = *(const u32x2*)(A.K + off); q.kk = *(const u32x2*)(A.KK + off); q.b = *(const u32x2*)(A.B + off); q.v = *(const u32x2*)(A.V + off);
    q.w = *(const f32x4*)(A.W + off);
    q.rin = A.RIN[(off >> 9) * 8 + ((off >> 6) & 7)];
}
__device__ __forceinline__ float red16(float x) { x += DPPF(x, 0xB1); x += DPPF(x, 0x4E); x += DPPF(x, 0x141); x += DPPF(x, 0x140); return x; }
__device__ __forceinline__ void st4(LAS float* d, u32x2 w, float sc = 1.f) { *(LAS f32x4*)d = (f32x4){lo_bf(w.x) * sc, hi_bf(w.x) * sc, lo_bf(w.y) * sc, hi_bf(w.y) * sc}; }
__device__ __forceinline__ f32x4 mfma16(u32x4 a, u32x4 b, f32x4 c) { return __builtin_amdgcn_mfma_f32_16x16x32_bf16(__builtin_bit_cast(bf16x8, a), __builtin_bit_cast(bf16x8, b), c, 0, 0, 0); }

__device__ __forceinline__ void item(const Args& A, LAS unsigned char* lds, int bh, const int wv__) {
    const int tid = TID(), lane = tid & 63, wid = __builtin_amdgcn_readfirstlane(tid >> 6);
    const int b = bh >> 3, h = bh & 7;
    const size_t base = (size_t)b * SEQ * 512 + h * 64;
    const int st = tid >> 4, c4 = (tid & 15) * 4;
    const int n16 = lane & 15, g = lane >> 4;
    f32x4 Z[4];
#pragma unroll
    for (int i = 0; i < 4; ++i) Z[i] = (f32x4){0.f, 0.f, 0.f, 0.f};
    u32x4 Zq[2] = {(u32x4){0u, 0u, 0u, 0u}, (u32x4){0u, 0u, 0u, 0u}};
    Pre pre; pre_load(pre, A, base + (size_t)st * 512 + c4);
    LAS float* raw = (LAS float*)(lds + O_RAW);
    LAS float* yb = (LAS float*)(lds + O_YB);
    const f32x4 lnw = *(const f32x4*)(A.ln_w + h * 64 + c4), lnb = *(const f32x4*)(A.ln_b + h * 64 + c4);
    u32x2 vprev = (u32x2){0u, 0u}, gq = (u32x2){0u, 0u}; float bsq = 0.f;
#define RWC_POST(bprev) do { \
        const f32x4 y4 = *(const LAS f32x4*)(yb + st * 64 + c4); \
        float sm = (y4.x + y4.y) + (y4.z + y4.w); sm = red16(sm); const float mean = sm * (1.f / 64.f); \
        const float d0 = y4.x - mean, d1 = y4.y - mean, d2 = y4.z - mean, d3 = y4.w - mean; \
        float sv = (d0 * d0 + d1 * d1) + (d2 * d2 + d3 * d3); sv = red16(sv); const float rstd = 1.f / sqrtf(sv * (1.f / 64.f) + 64e-5f); \
        const float o0 = (d0 * rstd * lnw.x + lnb.x + bsq * lo_bf(vprev.x)) * lo_bf(gq.x), o1 = (d1 * rstd * lnw.y + lnb.y + bsq * hi_bf(vprev.x)) * hi_bf(gq.x); \
        const float o2 = (d2 * rstd * lnw.z + lnb.z + bsq * lo_bf(vprev.y)) * lo_bf(gq.y), o3 = (d3 * rstd * lnw.w + lnb.w + bsq * hi_bf(vprev.y)) * hi_bf(gq.y); \
        *(u32x2*)(A.mixed + ((size_t)b * SEQ + (bprev) * TB + st) * DM + 1536 + h * 64 + c4) = (u32x2){cvt_pk_bf16(o0, o1), cvt_pk_bf16(o2, o3)}; } while (0)
    for (int bt = 0; bt < NB; ++bt) {
        LAS unsigned char* vt = lds + O_VT + (bt & 1) * VT_BUF;
        { LAS float* d = raw + st * OPS + c4;
          st4(d + L_R, pre.r); st4(d + L_KP, pre.k); st4(d + L_KK, pre.kk, pre.rin); st4(d + L_BN, pre.b, pre.rin); *(LAS f32x4*)(d + L_W) = pre.w;
          LAS unsigned char* vd = vt + ((st >> 4) * 64 + c4) * VT_ROW + (st & 15) * 2;
          *(LAS u16*)(vd) = (u16)(pre.v.x & 0xffffu); *(LAS u16*)(vd + VT_ROW) = (u16)(pre.v.x >> 16); *(LAS u16*)(vd + 2 * VT_ROW) = (u16)(pre.v.y & 0xffffu); *(LAS u16*)(vd + 3 * VT_ROW) = (u16)(pre.v.y >> 16); }
        __syncthreads();
        if (bt > 0) RWC_POST(bt - 1);
        vprev = pre.v;
        { const size_t tk = (size_t)b * SEQ + bt * TB + st; gq = *(const u32x2*)(A.G + tk * 512 + h * 64 + c4); bsq = A.BS[tk * 8 + h]; }
        if (bt + 1 < NB) pre_load(pre, A, base + (size_t)((bt + 1) * TB + st) * 512 + c4);
        { const int c = wid >> 2, gg = wid & 3, j = lane;
          LAS unsigned char* img = lds + O_IMG + c * IMG_BYTES;
          const LAS float* rw = raw + (16 * c) * OPS + j;
          float G = 1.f;
#pragma unroll
          for (int tp = 0; tp < 12; ++tp) { const float wv = rw[tp * OPS + L_W]; G *= (tp < 4 * gg) ? wv : 1.f; }
          float bq[4], kq[4], xw[4], xa[4], xr[4];
#pragma unroll
          for (int e = 0; e < 4; ++e) { const LAS float* q = rw + (4 * gg + e) * OPS; xw[e] = q[L_W]; xa[e] = q[L_KK]; xr[e] = q[L_R]; bq[e] = q[L_BN]; kq[e] = q[L_KP]; }
#pragma unroll
          for (int e = 0; e < 4; ++e) {
              const int t = 4 * gg + e;
              const float Gm1 = G; G *= xw[e]; const float inv = 1.f / G;
              const float at = xa[e] * Gm1, rt = xr[e] * G; bq[e] *= inv; kq[e] *= inv;
              LAS unsigned char* o = img + t * RS + j * 2;
              *(LAS u16*)(o + I_A) = f2bf(at); *(LAS u16*)(o + I_R) = f2bf(rt); *(LAS u16*)(o + I_B) = f2bf(bq[e]); *(LAS u16*)(o + I_K) = f2bf(kq[e]);
          }
          *(LAS u32x4*)(img + I_BKT + j * SR + gg * 16) = (u32x4){cvt_pk_bf16(bq[0], bq[1]), cvt_pk_bf16(bq[2], bq[3]), cvt_pk_bf16(kq[0], kq[1]), cvt_pk_bf16(kq[2], kq[3])};
          if (gg == 3) *(LAS float*)(img + I_GC + j * 4) = G;
        }
        __syncthreads();
        { const int c = wid >> 2, tt = wid & 3;
          LAS unsigned char* img = lds + O_IMG + c * IMG_BYTES;
          const LAS unsigned char* ia = img + (tt < 2 ? I_A : I_R) + n16 * RS + g * 16;
          const LAS unsigned char* ib = img + ((tt & 1) ? I_K : I_B) + n16 * RS + g * 16;
          f32x4 p = (f32x4){0.f, 0.f, 0.f, 0.f};
          p = mfma16(*(const LAS u32x4*)ia, *(const LAS u32x4*)ib, p);
          p = mfma16(*(const LAS u32x4*)(ia + 64), *(const LAS u32x4*)(ib + 64), p);
          const int s = n16;
          if (tt == 0) {
              LAS float* lab = (LAS float*)(img + I_LAB);
#pragma unroll
              for (int r = 0; r < 4; ++r) { const int t = 4 * g + r; lab[t * 20 + s] = t > s ? p[r] : 0.f; }
              asm volatile("s_waitcnt lgkmcnt(0)" ::: "memory");
              float T[16];
#pragma unroll
              for (int t = 0; t < 16; ++t) {
                  float a4[4] = {(s == t) ? 1.f : 0.f, 0.f, 0.f, 0.f};
#pragma unroll
                  for (int q4 = 0; q4 * 4 < t; ++q4) {
                      const f32x4 l4 = *(const LAS f32x4*)(lab + t * 20 + 4 * q4);
#pragma unroll
                      for (int e = 0; e < 4; ++e) if (4 * q4 + e < t) a4[e] += l4[e] * T[4 * q4 + e];
                  }
                  T[t] = (a4[0] + a4[1]) + (a4[2] + a4[3]);
              }
#pragma unroll
              for (int t = 0; t < 16; ++t) *(LAS u16*)(img + I_TP + t * SR + (s >> 2) * 16 + (s & 3) * 2) = f2bf(T[t] - ((s == t) ? 1.f : 0.f));
          } else {
              const int ofs = (tt == 1 ? I_LAK : I_MM) + (s >> 2) * 16 + (tt == 3 ? 8 : 0) + (s & 3) * 2;
#pragma unroll
              for (int r = 0; r < 4; ++r) { const int t = 4 * g + r; const bool keep = tt == 1 ? (t > s) : (t >= s); *(LAS u16*)(img + ofs + t * SR) = f2bf(keep ? p[r] : 0.f); }
          }
        }
        __syncthreads();
        if (wid < 4) {
            const int i = 16 * wid + n16;
#pragma unroll 1
            for (int c = 0; c < 2; ++c) {
                const LAS unsigned char* img = lds + O_IMG + c * IMG_BYTES;
                const LAS unsigned char* ra = img + n16 * RS + g * 8;
                u32x4 aA[2], aR[2], aBK[4]; f32x4 gc[4];
#pragma unroll
                for (int ks = 0; ks < 2; ++ks) {
                    const u32x2 a0 = *(const LAS u32x2*)(ra + I_A + ks * 64), a1 = *(const LAS u32x2*)(ra + I_A + ks * 64 + 32);
                    const u32x2 r0 = *(const LAS u32x2*)(ra + I_R + ks * 64), r1 = *(const LAS u32x2*)(ra + I_R + ks * 64 + 32);
                    aA[ks] = (u32x4){a0.x, a0.y, a1.x, a1.y}; aR[ks] = (u32x4){r0.x, r0.y, r1.x, r1.y};
                }
                const u32x2 vv = *(const LAS u32x2*)(vt + (c * 64 + i) * VT_ROW + g * 8);
                const u32x2 al = *(const LAS u32x2*)(img + I_LAK + n16 * SR + g * 16);
                const u32x2 at = *(const LAS u32x2*)(img + I_TP + n16 * SR + g * 16);
                const u32x4 aM = *(const LAS u32x4*)(img + I_MM + n16 * SR + g * 16);
#pragma unroll
                for (int jt = 0; jt < 4; ++jt) { aBK[jt] = *(const LAS u32x4*)(img + I_BKT + (16 * jt + n16) * SR + g * 16); gc[jt] = *(const LAS f32x4*)(img + I_GC + (16 * jt + 4 * g) * 4); }
                f32x4 D1 = (f32x4){0.f, 0.f, 0.f, 0.f}, D2 = D1;
#pragma unroll
                for (int ks = 0; ks < 2; ++ks) { D1 = mfma16(aA[ks], Zq[ks], D1); D2 = mfma16(aR[ks], Zq[ks], D2); }
                D1 = mfma16((u32x4){al.x, al.y, 0u, 0u}, (u32x4){vv.x, vv.y, 0u, 0u}, D1);
                const f32x4 U = mfma16((u32x4){at.x, at.y, 0u, 0u}, (u32x4){cvt_pk_bf16(D1[0], D1[1]), cvt_pk_bf16(D1[2], D1[3]), 0u, 0u}, D1);
                const u32x4 buv = (u32x4){cvt_pk_bf16(U[0], U[1]), cvt_pk_bf16(U[2], U[3]), vv.x, vv.y};
                const f32x4 Y = mfma16(aM, buv, D2);
#pragma unroll
                for (int jt = 0; jt < 4; ++jt) { Z[jt] = mfma16(aBK[jt], buv, Z[jt]); Z[jt] = Z[jt] * gc[jt]; }
                Zq[0] = (u32x4){cvt_pk_bf16(Z[0][0], Z[0][1]), cvt_pk_bf16(Z[0][2], Z[0][3]), cvt_pk_bf16(Z[1][0], Z[1][1]), cvt_pk_bf16(Z[1][2], Z[1][3])};
                Zq[1] = (u32x4){cvt_pk_bf16(Z[2][0], Z[2][1]), cvt_pk_bf16(Z[2][2], Z[2][3]), cvt_pk_bf16(Z[3][0], Z[3][1]), cvt_pk_bf16(Z[3][2], Z[3][3])};
                LAS float* yo = yb + (16 * c + 4 * g) * 64 + i;
#pragma unroll
                for (int r = 0; r < 4; ++r) yo[r * 64] = Y[r];
            }
        }
    }
    __syncthreads();
    RWC_POST(NB - 1);
    __syncthreads();
#undef RWC_POST
}
}
namespace hg {
constexpr int C = 64, NCH = SEQ / C, HD = 128;
constexpr int RS128 = 272, RS64 = 144;
constexpr int O_QM = 0, O_KM = O_QM + C * RS128, O_QE = O_KM + C * RS128, O_KET = O_QE + C * RS128, O_VT = O_KET + HD * RS64,
              O_STT = O_VT + HD * RS64, O_P = O_STT + HD * RS128, O_TOT = O_P + C * RS64, O_DEC = O_TOT + 4 * HD * 4, O_END = O_DEC + HD * 4;
constexpr int OB_STRIDE = 132;
static_assert(C * OB_STRIDE * 4 <= 2 * C * RS128, "OBUF alias");
constexpr int LDS_BYTES = O_END;
struct Args { const bf16_t* p; const float* lb; const float* out_gain; bf16_t* mixed; };

__device__ __forceinline__ bf16x8 lda8(const LAS unsigned char* base, int row, int rs, int colB) { return *(const LAS bf16x8*)(base + row * rs + colB); }

__device__ __forceinline__ void item(const Args& A, LAS unsigned char* lds, int bh, const int wv__) {
    const int tid = TID(), lane = tid & 63, wid = __builtin_amdgcn_readfirstlane(tid >> 6), r32 = lane & 31, hi = lane >> 5;
    const int b = bh >> 2, h = bh & 3;
    const int ch = tid & 127, part = tid >> 7;
    const float lbc = A.lb[h * HD + ch], omlb = 1.f - lbc;
    const bf16_t* pbase = A.p + (size_t)b * SEQ * NP + h * HD;
    f32x16 sacc[2]; sacc[0] = f32x16{}; sacc[1] = f32x16{};
    const int kb = wid >> 1, vb0 = 2 * (wid & 1);
    for (int i = tid; i < HD * RS128 / 16; i += 512) *(LAS u32x4*)(lds + O_STT + i * 16) = (u32x4){0u, 0u, 0u, 0u};
    LAS float* tot = (LAS float*)(lds + O_TOT);
    LAS float* dec = (LAS float*)(lds + O_DEC);
    LAS float* obuf = (LAS float*)(lds + O_QM);
    bf16_t rq[16], rf[16], ri[16];
    { const bf16_t* pc0 = pbase + (size_t)(part * 16) * NP + ch;
#pragma unroll
      for (int i = 0; i < 16; ++i) { rf[i] = pc0[(size_t)i * NP + C_HF]; rq[i] = pc0[(size_t)i * NP + C_HQ]; ri[i] = pc0[(size_t)i * NP + C_HI]; } }
    for (int ck = 0; ck < NCH; ++ck) {
        const size_t tk_e = (size_t)b * SEQ + ck * C + (tid >> 3);
        const bf16_t* gp_e = A.p + tk_e * NP + C_HG + h * HD + (tid & 7) * 16;
        const u32x4 g0 = *(const u32x4*)gp_e, g1 = *(const u32x4*)(gp_e + 8);
        float lf[16], qv[16], kv[16];
        float run = 0.f;
#pragma unroll
        for (int i = 0; i < 16; ++i) {
            const float z = bf2f(rf[i]);
            const float sg = sigmoidf_(z);
            const float f = lbc + omlb * sg;
            kv[i] = 1.f - f;
            run += __logf(f); lf[i] = run;
            qv[i] = siluf_(bf2f(rq[i]));
        }
        tot[part * HD + ch] = run;
        { unsigned w[8];
#pragma unroll
          for (int i = 0; i < 8; ++i) w[i] = (unsigned)ri[2 * i] | ((unsigned)ri[2 * i + 1] << 16);
          LAS u32x4* d = (LAS u32x4*)(lds + O_VT + ch * RS64 + part * 32);
          d[0] = (u32x4){w[0], w[1], w[2], w[3]}; d[1] = (u32x4){w[4], w[5], w[6], w[7]}; }
        __syncthreads();
        if (ck + 1 < NCH) { const bf16_t* pcn = pbase + (size_t)((ck + 1) * C + part * 16) * NP + ch;
#pragma unroll
            for (int i = 0; i < 16; ++i) { rf[i] = pcn[(size_t)i * NP + C_HF]; rq[i] = pcn[(size_t)i * NP + C_HQ]; ri[i] = pcn[(size_t)i * NP + C_HI]; } }
        float off = 0.f;
#pragma unroll
        for (int pp = 0; pp < 4; ++pp) off += (pp < part) ? tot[pp * HD + ch] : 0.f;
        const float bref = tot[ch] + tot[HD + ch];
        const float blast = bref + tot[2 * HD + ch] + tot[3 * HD + ch];
        const float c_blast = __expf(blast), c_bref = __expf(bref), c_nbref = fast_rcp(c_bref);
        if (part == 0) dec[ch] = c_blast;
        {
            unsigned wk[8];
#pragma unroll
            for (int i = 0; i < 16; ++i) {
                const float bt = off + lf[i];
                const int t = part * 16 + i;
                const float e1 = __expf(fmaxf(bt, -80.f)), e2 = fast_rcp(e1);
                const float qe = qv[i] * e1, qm = qe * c_nbref, km = kv[i] * e2 * c_bref, ke = kv[i] * e2 * c_blast;
                *(LAS bf16_t*)(lds + O_QM + t * RS128 + ch * 2) = f2bf(qm);
                *(LAS bf16_t*)(lds + O_KM + t * RS128 + ch * 2) = f2bf(km);
                *(LAS bf16_t*)(lds + O_QE + t * RS128 + ch * 2) = f2bf(qe);
                if (i & 1) wk[i >> 1] |= ((unsigned)f2bf(ke)) << 16; else wk[i >> 1] = (unsigned)f2bf(ke);
            }
            LAS u32x4* d = (LAS u32x4*)(lds + O_KET + ch * RS64 + part * 32);
            d[0] = (u32x4){wk[0], wk[1], wk[2], wk[3]}; d[1] = (u32x4){wk[4], wk[5], wk[6], wk[7]};
        }
        __syncthreads();
        if (wid < 3) {
            const int ti = wid == 0 ? 0 : 1, si = wid == 2 ? 1 : 0;
            f32x16 sc = f32x16{};
#pragma unroll
            for (int ks = 0; ks < 8; ++ks) {
                const bf16x8 a = lda8(lds + O_QM, ti * 32 + r32, RS128, (ks * 16 + hi * 8) * 2);
                const bf16x8 bb = lda8(lds + O_KM, si * 32 + r32, RS128, (ks * 16 + hi * 8) * 2);
                sc = __builtin_amdgcn_mfma_f32_32x32x16_bf16(a, bb, sc, 0, 0, 0);
            }
#pragma unroll
            for (int r = 0; r < 16; ++r) { const int tl = (r & 3) + 8 * (r >> 2) + 4 * hi; const int tg = ti * 32 + tl, sg = si * 32 + r32;
                const float v = (sg <= tg) ? sc[r] : 0.f;
                *(LAS bf16_t*)(lds + O_P + tg * RS64 + sg * 2) = f2bf(v); }
        } else if (wid == 3) {
#pragma unroll
            for (int r = 0; r < 16; ++r) { const int tl = (r & 3) + 8 * (r >> 2) + 4 * hi; *(LAS bf16_t*)(lds + O_P + tl * RS64 + (32 + r32) * 2) = (bf16_t)0; }
        }
        __syncthreads();
        {
            const int ti = wid >> 2, vj = wid & 3;
            f32x16 oc = f32x16{};
#pragma unroll
            for (int ks = 0; ks < 8; ++ks) {
                const bf16x8 a = lda8(lds + O_QE, ti * 32 + r32, RS128, (ks * 16 + hi * 8) * 2);
                const bf16x8 bb = lda8(lds + O_STT, vj * 32 + r32, RS128, (ks * 16 + hi * 8) * 2);
                oc = __builtin_amdgcn_mfma_f32_32x32x16_bf16(a, bb, oc, 0, 0, 0);
            }
#pragma unroll
            for (int ss = 0; ss < 4; ++ss) {
                const bf16x8 a = lda8(lds + O_P, ti * 32 + r32, RS64, (ss * 16 + hi * 8) * 2);
                const bf16x8 bb = lda8(lds + O_VT, vj * 32 + r32, RS64, (ss * 16 + hi * 8) * 2);
                oc = __builtin_amdgcn_mfma_f32_32x32x16_bf16(a, bb, oc, 0, 0, 0);
            }
#pragma unroll
            for (int r = 0; r < 16; ++r) { const int tl = (r & 3) + 8 * (r >> 2) + 4 * hi; obuf[(ti * 32 + tl) * OB_STRIDE + vj * 32 + r32] = oc[r]; }
        }
#pragma unroll
        for (int j = 0; j < 2; ++j) {
#pragma unroll
            for (int r = 0; r < 16; ++r) { const int kl = (r & 3) + 8 * (r >> 2) + 4 * hi; sacc[j][r] *= dec[kb * 32 + kl]; }
#pragma unroll
            for (int ss = 0; ss < 4; ++ss) {
                const bf16x8 a = lda8(lds + O_KET, kb * 32 + r32, RS64, (ss * 16 + hi * 8) * 2);
                const bf16x8 bb = lda8(lds + O_VT, (vb0 + j) * 32 + r32, RS64, (ss * 16 + hi * 8) * 2);
                sacc[j] = __builtin_amdgcn_mfma_f32_32x32x16_bf16(a, bb, sacc[j], 0, 0, 0);
            }
        }
        __syncthreads();
#pragma unroll
        for (int j = 0; j < 2; ++j)
#pragma unroll
            for (int g = 0; g < 4; ++g) {
                u32x2 w; w.x = cvt_pk_bf16(sacc[j][4 * g], sacc[j][4 * g + 1]); w.y = cvt_pk_bf16(sacc[j][4 * g + 2], sacc[j][4 * g + 3]);
                *(LAS u32x2*)(lds + O_STT + ((vb0 + j) * 32 + r32) * RS128 + (kb * 32 + 8 * g + 4 * hi) * 2) = w;
            }
        {
            const int t = tid >> 3, c0 = (tid & 7) * 16;
            const LAS float* orow = obuf + t * OB_STRIDE + c0;
            float o[16]; float ss = 0.f;
#pragma unroll
            for (int i = 0; i < 4; ++i) { const f32x4 x = *(const LAS f32x4*)(orow + 4 * i); o[4 * i] = x.x; o[4 * i + 1] = x.y; o[4 * i + 2] = x.z; o[4 * i + 3] = x.w; ss += x.x * x.x + x.y * x.y + x.z * x.z + x.w * x.w; }
            ss = sum8f(ss);
            const float rn = 1.f / sqrtf(ss * (1.f / 128.f) + RMS_EPS);
            const size_t tk = tk_e;
            const float gr[16] = {lo_bf(g0.x), hi_bf(g0.x), lo_bf(g0.y), hi_bf(g0.y), lo_bf(g0.z), hi_bf(g0.z), lo_bf(g0.w), hi_bf(g0.w),
                                  lo_bf(g1.x), hi_bf(g1.x), lo_bf(g1.y), hi_bf(g1.y), lo_bf(g1.z), hi_bf(g1.z), lo_bf(g1.w), hi_bf(g1.w)};
            float ov[16];
#pragma unroll
            for (int i = 0; i < 16; ++i) ov[i] = o[i] * rn * A.out_gain[c0 + i] * siluf_(gr[i]);
            u32x4 w0, w1;
            w0.x = cvt_pk_bf16(ov[0], ov[1]); w0.y = cvt_pk_bf16(ov[2], ov[3]); w0.z = cvt_pk_bf16(ov[4], ov[5]); w0.w = cvt_pk_bf16(ov[6], ov[7]);
            w1.x = cvt_pk_bf16(ov[8], ov[9]); w1.y = cvt_pk_bf16(ov[10], ov[11]); w1.z = cvt_pk_bf16(ov[12], ov[13]); w1.w = cvt_pk_bf16(ov[14], ov[15]);
            bf16_t* mp = A.mixed + tk * DM + h * HD + c0;
            *(u32x4*)mp = w0; *(u32x4*)(mp + 8) = w1;
        }
        __syncthreads();
    }
}
}
#define RLX_AGENT __ATOMIC_RELAXED, __HIP_MEMORY_SCOPE_AGENT
#define XB_TMO      128
#define XB_XCNT(j)  (256  + 64 * (j))
#define XB_XSUB(j)  (1280 + 64 * (j))
#define XB_XGEN(j)  (2304 + 64 * (j))
#define XB_TOP      3328
#define XB_TOPGEN   3392
#define XCD_BAR_WORDS 3456
#define XB_SPIN_CAP (1u << 18)

__device__ __forceinline__ unsigned xb_ld(unsigned* p)              { return __hip_atomic_load(p, __ATOMIC_RELAXED, __HIP_MEMORY_SCOPE_AGENT); }
__device__ __forceinline__ unsigned xb_add(unsigned* p, unsigned v) { return __hip_atomic_fetch_add(p, v, __ATOMIC_RELAXED, __HIP_MEMORY_SCOPE_AGENT); }
__device__ __forceinline__ unsigned xb_xcc_id() { return (unsigned)__builtin_amdgcn_s_getreg((3 << 11) | 20) & 0xFu; }
#define XB_SPIN(cond, bar) do { unsigned _sp = 0; while (cond) { __builtin_amdgcn_s_sleep(1); \
    if ((++_sp & 255u) == 0u) { if (xb_ld(&(bar)[XB_TMO])) break; if (_sp > XB_SPIN_CAP) { atomicAdd(&(bar)[XB_TMO], 1u); break; } } } } while (0)

struct XcdBarrier {
    unsigned* bar; unsigned x;
    volatile LAS unsigned* st;
};

__device__ __forceinline__ XcdBarrier xcd_barrier_post(unsigned* bar, volatile LAS unsigned* st, const int wv__) {
    XcdBarrier b; b.bar = bar; b.x = xb_xcc_id(); b.st = st;
    if (TID() == 0) (void)xb_add(&bar[XB_XCNT(b.x)], 1u);
    return b;
}
__device__ __forceinline__ void xcd_barrier_complete(unsigned* bar, unsigned x, unsigned& nloc, unsigned& nx) {
    const unsigned G = gridDim.x * gridDim.y * gridDim.z;
    unsigned sum, cnt, mine, sp = 0u;
    for (;;) {
        sum = 0u; cnt = 0u; mine = 0u;
#pragma unroll
        for (unsigned j = 0; j < 16; ++j) { const unsigned c = xb_ld(&bar[XB_XCNT(j)]); sum += c; cnt += (c > 0u) ? 1u : 0u; mine = (j == x) ? c : mine; }
        if (sum == G) break;
        __builtin_amdgcn_s_sleep(1);
        if ((++sp & 255u) == 0u) { if (xb_ld(&bar[XB_TMO])) break; if (sp > XB_SPIN_CAP) { atomicAdd(&bar[XB_TMO], 1u); break; } }
    }
    nloc = mine > 0u ? mine : 1u; nx = cnt > 0u ? cnt : 1u;
}

__device__ __forceinline__ void xcd_barrier(const XcdBarrier& b, const int wv__) {
    asm volatile("s_waitcnt vmcnt(0)" ::: "memory");
    __syncthreads();
    if (TID() == 0) {
        unsigned* bar = b.bar;
        __builtin_amdgcn_s_waitcnt(0);
        unsigned nloc = b.st[0], nx = b.st[1];
        if (nloc == 0u) { xcd_barrier_complete(bar, b.x, nloc, nx); b.st[0] = nloc; b.st[1] = nx; }
        const unsigned old = xb_add(&bar[XB_XSUB(b.x)], 1u);
        const unsigned gen = old / nloc;
        if (old + 1u == (gen + 1u) * nloc) {
            __builtin_amdgcn_fence(__ATOMIC_RELEASE, "agent");
            asm volatile("s_waitcnt vmcnt(0)" ::: "memory");
            const unsigned og = xb_add(&bar[XB_TOP], 1u);
            const unsigned tg = og / nx;
            if (og + 1u == (tg + 1u) * nx) xb_add(&bar[XB_TOPGEN], 1u);
            else XB_SPIN(xb_ld(&bar[XB_TOPGEN]) == tg, bar);
            __builtin_amdgcn_fence(__ATOMIC_ACQUIRE, "agent");
            xb_add(&bar[XB_XGEN(b.x)], 1u);
            asm volatile("s_waitcnt vmcnt(0)" ::: "memory");
        } else {
            XB_SPIN(xb_ld(&bar[XB_XGEN(b.x)]) == gen, bar);
            __builtin_amdgcn_fence(__ATOMIC_ACQUIRE, "agent");
            asm volatile("s_waitcnt vmcnt(0)" ::: "memory");
        }
    }
    __syncthreads();
}

constexpr int NTHREADS = 512, NWAVES = 8;
constexpr int LDS_ALL = 153600;
static_assert(LDS_ALL >= hg::LDS_BYTES && LDS_ALL >= tok::LDS_BYTES && LDS_ALL >= rwk::LDS_BYTES && LDS_ALL >= rwc::LDS_BYTES && LDS_ALL >= att::LDS_BYTES && LDS_ALL >= pg8::STAGE_BYTES, "LDS");
constexpr int CW_BAR = 4096;
constexpr int PH_PER_LAYER = 7, N_PHASES = 1 + DEPTH * PH_PER_LAYER;

struct KArgs { Ptrs P; int ph_lo, ph_hi, coop, pad; };

#ifdef DUP_TOKMODE
#define TOKMODE (rep ? DUP_TOKMODE : 7)
#else
#define TOKMODE 7
#endif
template <int ph>
__device__ __forceinline__ void run_phase(LAS unsigned char* lds, unsigned char* lds_raw, cg::grid_group& grid, const int G, const int bid, const int wv__) {
        const KArgs __attribute__((address_space(4)))* ka = (const KArgs __attribute__((address_space(4)))*)__builtin_amdgcn_kernarg_segment_ptr();
        asm volatile("" : "+s"(ka));
#define PIN(i) (ka->P.in[i])
        const int tid = TID(), lane = tid & 63, wid = __builtin_amdgcn_readfirstlane(tid >> 6);
        const int gw = bid * NWAVES + wid, ngw = G * NWAVES;
        unsigned char* ws = ka->P.ws;
        float* x = ka->P.out;
        bf16_t* xb = (bf16_t*)(ws + WS_XB); bf16_t* pbuf = (bf16_t*)(ws + WS_P); bf16_t* mixed = (bf16_t*)(ws + WS_MIX);
        bf16_t* qbuf = (bf16_t*)(ws + WS_Q); bf16_t* kvbuf = (bf16_t*)(ws + WS_KV); bf16_t* krbuf = (bf16_t*)(ws + WS_KR);
        bf16_t* act = (bf16_t*)(ws + WS_ACT);
        float* ssA = (float*)(ws + WS_SSA); float* ssB = (float*)(ws + WS_SSBP); float* rsb = (float*)(ws + WS_RS); float* rsq = (float*)(ws + WS_RSQ); float* rskv = (float*)(ws + WS_RSKV);
        const int* pos = (const int*)PIN(1);
        if constexpr (ph == 0) {
            prologue_phase(&ka->P, (LAS float*)lds + wid * (64 * 65), gw, ngw, lane);
#ifdef DUP_PRO
            __syncthreads(); prologue_phase(&ka->P, (LAS float*)lds + wid * (64 * 65), gw, ngw, lane);
#endif
        } else {
            constexpr int l = (ph - 1) / PH_PER_LAYER, sp = (ph - 1) % PH_PER_LAYER;
            unsigned char* wl = ws + WS_W + (size_t)l * W_LAYER;
#ifdef DUP_SP
            const int nrep = (sp == DUP_SP) ? 2 : 1;
#else
            const int nrep = 1;
#endif
            for (int rep = 0; rep < nrep; ++rep) {
            if (rep) { XcdBarrier xb; xb.bar = (unsigned*)(ws + WS_CTL) + CW_BAR; xb.x = xb_xcc_id(); xb.st = (volatile LAS unsigned*)(lds + LDS_ALL - 128); xcd_barrier(xb, wv__); }
            switch (sp) {
            case 0: {
                pg8::Gemm g{xb, (const bf16_t*)(wl + WO_IN), T, NP, DM, DM}; pg8::StaticOrder S; S.init(T, NP, G, bid, GW_IN);
                pg8::prep_row_scales(ssA, rsb, S, tid);
                pg8::EpiScaleBf16 E{pbuf, rsb, NP, 0};
                pg8::gemm_phase<pg8::EpiScaleBf16, pg8::StaticOrder, true, true>(lds, g, S, E, wv__);
            } break;
            case 1: {
                tok::Args A;
                A.p = pbuf; A.pos = pos; A.k_gain = PIN(11) + l * 192;
                A.mu = PIN(12) + l * 1792; A.w0 = PIN(13) + l * 512; A.a0 = PIN(15) + l * 512;
                constexpr int lm = l > 0 ? l - 1 : 0;
                A.v0 = PIN(18) + lm * 512;
                A.k_k = PIN(21) + l * 512; A.k_a = PIN(22) + l * 512; A.r_k = PIN(23) + l * 512;
                A.wl = (const bf16_t*)(wl + WO_LORA);
                A.rs_q = rsq; A.rs_kv = rskv; A.kr = krbuf;
                A.R = (bf16_t*)(ws + WS_RWR); A.K = (bf16_t*)(ws + WS_RWK); A.V = (bf16_t*)(ws + WS_RWV); A.KK = (bf16_t*)(ws + WS_RWKK); A.B = (bf16_t*)(ws + WS_RWB);
                A.G = (bf16_t*)((unsigned char*)x + 64 * MiB); A.BON = (bf16_t*)((unsigned char*)x + 96 * MiB); A.VFIRST = (bf16_t*)(ws + WS_VFIRST); A.W = (float*)((unsigned char*)x); A.RIN = (float*)(ws + WS_RIN); A.BS = (float*)(ws + WS_BS);
#ifdef TOKPROBE
                if (rep) { unsigned char* dq = ws + WS_Q; A.R = (bf16_t*)dq; A.K = (bf16_t*)(dq + 32 * MiB); A.V = (bf16_t*)(dq + 64 * MiB); A.KK = (bf16_t*)(dq + 96 * MiB); A.B = (bf16_t*)(dq + 128 * MiB);
                    A.G = (bf16_t*)(dq + 160 * MiB); A.VFIRST = l == 0 ? (bf16_t*)(dq + 192 * MiB) : A.VFIRST; A.W = (float*)(ws + WS_MIX); A.RIN = (float*)(ws + WS_MIX + 64 * MiB); A.BS = (float*)(ws + WS_MIX + 65 * MiB); }
#endif
                tok::stage_params(A, lds, tid);
                for (int tl = bid; tl < tok::NTILES; tl += G) tok::tile<l>(A, lds, tl, wv__, TOKMODE);
            } break;
            case 2: {
                { pg8::Gemm g{pbuf + C_MQ, (const bf16_t*)(wl + WO_QB), T, QW, 512, NP}; pg8::StaticOrder S; S.init(T, QW, G, bid);
                  pg8::EpiPlainBf16 E{qbuf, QW, 0};
                  pg8::gemm_phase<pg8::EpiPlainBf16, pg8::StaticOrder, true, true>(lds, g, S, E, wv__); }
                { pg8::Gemm g{pbuf + C_MKV, (const bf16_t*)(wl + WO_KVB), T, KVW, 256, NP}; pg8::StaticOrder S; S.init(T, KVW, G, bid);
                  pg8::EpiKV E{kvbuf, rskv, PIN(11) + l * 192, (LAS float*)(lds + pg8::STAGE_BYTES), KVW, 0};
                  pg8::gemm_phase<pg8::EpiKV, pg8::StaticOrder, true, true>(lds, g, S, E, wv__); }
            } break;
            case 3: {
                unsigned* ctr = (unsigned*)(ws + WS_CTL) + 64 * l + 16 * rep;
                LAS int* qslot = (LAS int*)(lds + LDS_ALL - 64);
                constexpr int NQ = 96 + att::N_BLOCKS;
#ifdef DUP_MIX
                const int qlo = rep ? (DUP_MIX == 1 ? 0 : DUP_MIX == 2 ? 64 : 96) : 0, qhi = rep ? (DUP_MIX == 1 ? 64 : DUP_MIX == 2 ? 96 : NQ) : NQ;
#else
                const int qlo = 0, qhi = NQ;
#endif
#ifdef CONV_IN_MIXERS
                if constexpr (l + 1 < DEPTH) {
                    if (!rep && bid % CONV_EVERY == 0) {
                        for (;;) {
                            __syncthreads();
                            if (tid == 0) *qslot = (int)__hip_atomic_fetch_add(ctr + 8, 1u, __ATOMIC_RELAXED, __HIP_MEMORY_SCOPE_AGENT);
                            __syncthreads();
                            const int ci = __builtin_amdgcn_readfirstlane(*qslot);
                            if (ci >= CV_ITEMS) break;
                            convert_queue_item(&ka->P, l + 1, ci, (LAS float*)lds + wid * (64 * 65), wid, lane);
                        }
                    }
                }
#endif
                for (;;) {
                    __syncthreads();
                    if (tid == 0) *qslot = (int)__hip_atomic_fetch_add(ctr, 1u, __ATOMIC_RELAXED, __HIP_MEMORY_SCOPE_AGENT);
                    __syncthreads();
                    const int it = qlo + __builtin_amdgcn_readfirstlane(*qslot);
                    if (it >= qhi) break;
                    if (it < 64) {
                        rwc::Args RA; RA.R = (const bf16_t*)(ws + WS_RWR); RA.K = (const bf16_t*)(ws + WS_RWK); RA.V = (const bf16_t*)(ws + WS_RWV); RA.KK = (const bf16_t*)(ws + WS_RWKK);
                        RA.B = (const bf16_t*)(ws + WS_RWB); RA.W = (const float*)((unsigned char*)x); RA.RIN = (const float*)(ws + WS_RIN);
                        RA.G = (const bf16_t*)((unsigned char*)x + 64 * MiB); RA.BS = (const float*)(ws + WS_BS); RA.ln_w = PIN(24) + l * 512; RA.ln_b = PIN(25) + l * 512;
                        RA.mixed = rep ? (bf16_t*)((unsigned char*)x + 128 * MiB) : mixed;
                        rwc::item(RA, lds, it, wv__);
                    } else if (it < 96) {
                        hg::Args HA; HA.p = pbuf; HA.lb = (const float*)(ws + WS_LB) + l * 512; HA.out_gain = PIN(5) + l * 128; HA.mixed = mixed;
                        hg::item(HA, lds, it - 64, wv__);
                    }
                    else att::attn_one((char*)lds_raw, qbuf, kvbuf, krbuf, mixed, it - 96, pos, PIN(10) + l * 192, wv__);
                }
            } break;
            case 4: {
                pg8::Gemm g{mixed, (const bf16_t*)(wl + WO_O), T, DM, DM, DM}; pg8::StaticOrder S; S.init(T, DM, G, bid, GW_WO);
                pg8::EpiResidB E{l == 0 ? PIN(0) : (const float*)nullptr, (float*)nullptr, xb, ssB, DM, 0};
                pg8::gemm_phase<pg8::EpiResidB, pg8::StaticOrder, true, true>(lds, g, S, E, wv__);
            } break;
            case 5: {
                pg8::Gemm g{xb, (const bf16_t*)(wl + WO_GU), T, 2 * FF, DM, DM}; pg8::StaticOrder S; S.init(T, 2 * FF, G, bid, GW_GU);
                pg8::prep_row_scales(ssB, rsb, S, tid);
                pg8::EpiSwiGLU E{act, rsb, FF, 0};
                pg8::gemm_phase<pg8::EpiSwiGLU, pg8::StaticOrder, true, true>(lds, g, S, E, wv__);
            } break;
            case 6: {
                pg8::Gemm g{act, (const bf16_t*)(wl + WO_DN), T, DM, FF, FF}; pg8::StaticOrder S; S.init(T, DM, G, bid, GW_DN);
                pg8::EpiResidB E{(const float*)nullptr, l == DEPTH - 1 ? x : (float*)nullptr, xb, ssA, DM, 0};
                pg8::gemm_phase<pg8::EpiResidB, pg8::StaticOrder, true, true>(lds, g, S, E, wv__);
            } break;
            }
            }
        }
}
template <int PH0, int PH1>
__device__ __forceinline__ void run_phases(LAS unsigned char* lds, unsigned char* lds_raw, cg::grid_group& grid, const int G, const int bid, const int wv__) {
    if constexpr (PH0 < PH1) {
        run_phase<PH0>(lds, lds_raw, grid, G, bid, wv__);
        if constexpr (PH0 + 1 < PH1) {
            const KArgs __attribute__((address_space(4)))* ka = (const KArgs __attribute__((address_space(4)))*)__builtin_amdgcn_kernarg_segment_ptr();
            XcdBarrier xb; xb.bar = (unsigned*)(ka->P.ws + WS_CTL) + CW_BAR; xb.x = xb_xcc_id(); xb.st = (volatile LAS unsigned*)(lds + LDS_ALL - 128);
            xcd_barrier(xb, wv__);
        }
        run_phases<PH0 + 1, PH1>(lds, lds_raw, grid, G, bid, wv__);
    }
}
__global__ void __launch_bounds__(NTHREADS, 2) mega(KArgs args) {
    extern __shared__ __attribute__((aligned(16))) unsigned char lds_raw[];
    LAS unsigned char* lds = (LAS unsigned char*)lds_raw;
    const int G = gridDim.x, bid = blockIdx.x;
    const int wv__ = __builtin_amdgcn_readfirstlane((int)threadIdx.x >> 6);
    cg::grid_group grid = cg::this_grid();
    {
        volatile LAS unsigned* st = (volatile LAS unsigned*)(lds + LDS_ALL - 128);
        if (threadIdx.x < 2) st[threadIdx.x] = 0u;
        __syncthreads();
        (void)xcd_barrier_post((unsigned*)(args.P.ws + WS_CTL) + CW_BAR, st, wv__);
        grid.sync();
    }
#ifdef DUP_SYNC
    for (int i = 0; i < DUP_SYNC; ++i) { XcdBarrier xb; xb.bar = (unsigned*)(args.P.ws + WS_CTL) + CW_BAR; xb.x = xb_xcc_id(); xb.st = (volatile LAS unsigned*)(lds + LDS_ALL - 128); xcd_barrier(xb, wv__); }
#endif
    run_phases<0, N_PHASES>(lds, lds_raw, grid, G, bid, wv__);
}

extern "C" void kernel_launch(void* const* d_in, const int* in_sizes, int n_in, void* d_out, int out_size, void* d_ws, size_t ws_size, hipStream_t stream) {
    static int grid = 0;
    if (grid == 0) {
        int dev = 0, cus = 0, per_cu = 0;
        hipGetDevice(&dev);
        hipDeviceGetAttribute(&cus, hipDeviceAttributeMultiprocessorCount, dev);
        hipFuncSetAttribute((const void*)mega, hipFuncAttributeMaxDynamicSharedMemorySize, LDS_ALL);
        hipOccupancyMaxActiveBlocksPerMultiprocessor(&per_cu, (const void*)mega, NTHREADS, LDS_ALL);
        if (per_cu < 1) { fprintf(stderr, "kernel_launch: occupancy query says %d blocks/CU\n", per_cu); per_cu = 1; }
        grid = cus * 1;
        if (ws_size < WS_END) fprintf(stderr, "kernel_launch: workspace too small: %zu < %zu\n", ws_size, (size_t)WS_END);
        (void)hipGetLastError();
    }
    hipMemsetAsync((char*)d_ws + WS_CTL, 0, CTL_BYTES, stream);
    KArgs a{};
    for (int i = 0; i < 30; ++i) a.P.in[i] = (const float*)d_in[i];
    a.P.out = (float*)d_out; a.P.ws = (unsigned char*)d_ws;
#if MK_COOP
    a.ph_lo = 0; a.ph_hi = N_PHASES; a.coop = 1;
    void* kargs[] = {&a};
    hipError_t e = hipLaunchCooperativeKernel((const void*)mega, dim3(grid), dim3(NTHREADS), kargs, LDS_ALL, stream);
    if (e != hipSuccess) fprintf(stderr, "cooperative launch failed: %s (grid %d)\n", hipGetErrorString(e), grid);
#else
    for (int ph = 0; ph < N_PHASES; ++ph) {
        a.ph_lo = ph; a.ph_hi = ph + 1; a.coop = 0;
        hipLaunchKernelGGL(mega, dim3(grid), dim3(NTHREADS), LDS_ALL, stream, a);
    }
#endif
}
```
